# Optimizing an MI355X kernel written in HIP

```python
import jax
import jax.numpy as jnp
from jax import lax
import numpy as np

D_MODEL = 1024
BATCH = 8
SEQ = 2048
DEPTH = 2

N_META = 16
RMS_EPS = 1e-6
LN_EPS = 1e-5
D_A = D_MODEL // 2
D_B = D_MODEL // 2
CONV_A_WIDTH = 31
CONV_B_WIDTH = 3
EVEN_COLS = 2 * D_A + 3 * D_B
HEAD_DIM = 64
N_Q_HEADS = 8
N_KV_HEADS = 2
GQA_GROUP = N_Q_HEADS // N_KV_HEADS
D_ATT = N_Q_HEADS * HEAD_DIM
D_KV = N_KV_HEADS * HEAD_DIM
WINDOW = 128
BLOCK = 128
ROPE_THETA = 10000.0
RWKV_HEAD = 64
D_R = D_MODEL // 2
N_R_HEADS = D_R // RWKV_HEAD
LORA_W = 64
LORA_A = 64
LORA_G = 128
RWKV_GN_EPS = 64e-5
ATT_COLS = D_ATT + 2 * D_KV
RWKV_COLS = 3 * D_R + LORA_W + LORA_A + LORA_G
ODD_COLS = ATT_COLS + RWKV_COLS
D_FF = 2816
FF_CONV_WIDTH = 3
NEG_INF = -1e30

kernel_name = 'hybrid_conv_swa_rwkv7_block'


def rms_norm(x, g):
    xf = x.astype(jnp.float32)
    y = xf * lax.rsqrt(jnp.mean(xf * xf, axis=-1, keepdims=True) + RMS_EPS)
    return (y * g.astype(jnp.float32)).astype(x.dtype)


def layer_norm(x, g, b):
    xf = x.astype(jnp.float32)
    mu = jnp.mean(xf, axis=-1, keepdims=True)
    var = jnp.mean(jnp.square(xf - mu), axis=-1, keepdims=True)
    y = (xf - mu) * lax.rsqrt(var + LN_EPS)
    return (y * g.astype(jnp.float32) + b.astype(jnp.float32)).astype(x.dtype)


def causal_dwconv(x, w):
    k_width, ch = w.shape
    return lax.conv_general_dilated(
        x, w[:, None, :].astype(x.dtype), window_strides=(1,),
        padding=[(k_width - 1, 0)], dimension_numbers=('NWC', 'WIO', 'NWC'),
        feature_group_count=ch)


def rope(x, pos):
    half = x.shape[-1] // 2
    inv = ROPE_THETA ** (-jnp.arange(half, dtype=jnp.float32) / half)
    ang = pos.astype(jnp.float32)[:, None] * inv[None, :]
    cos = jnp.cos(ang)[None, :, None, :]
    sin = jnp.sin(ang)[None, :, None, :]
    xf = x.astype(jnp.float32)
    x1, x2 = xf[..., :half], xf[..., half:]
    return jnp.concatenate([x1 * cos - x2 * sin, x2 * cos + x1 * sin], axis=-1).astype(x.dtype)


def conformer_conv_group(a_val, a_gate, conv_w, ln_g, ln_b):
    u = a_val * jax.nn.sigmoid(a_gate)
    u = causal_dwconv(u, conv_w)
    return jax.nn.silu(layer_norm(u, ln_g, ln_b))


def short_conv_group(gate_b, gate_c, x_in, conv_w):
    return gate_b * causal_dwconv(gate_c * x_in, conv_w)


def even_mixer(h, w_in, conv_a, ln_a_g, ln_a_b, conv_b, w_out):
    p = h @ w_in
    a_val, a_gate, g_b, g_c, x_in = jnp.split(
        p, [D_A, 2 * D_A, 2 * D_A + D_B, 2 * D_A + 2 * D_B], axis=-1)
    y = jnp.concatenate([conformer_conv_group(a_val, a_gate, conv_a, ln_a_g, ln_a_b),
                         short_conv_group(g_b, g_c, x_in, conv_b)], axis=-1)
    return y @ w_out


def swa_sink_attention(q, k, v, sinks):
    bsz, t_len = q.shape[:2]
    pad = BLOCK - N_META
    t_pad = t_len + pad
    nb = t_pad // BLOCK
    padt = lambda z: jnp.pad(z, ((0, 0), (pad, 0), (0, 0), (0, 0)))
    qb = padt(q).reshape(bsz, nb, BLOCK, N_KV_HEADS, GQA_GROUP, HEAD_DIM)
    kb = padt(k).reshape(bsz, nb, BLOCK, N_KV_HEADS, HEAD_DIM)
    vb = padt(v).reshape(bsz, nb, BLOCK, N_KV_HEADS, HEAD_DIM)

    def band(z):
        prev = jnp.pad(z, ((0, 0), (1, 0), (0, 0), (0, 0), (0, 0)))[:, :-1]
        return jnp.concatenate([prev, z], axis=2)

    k_band, v_band = band(kb), band(vb)
    k_meta, v_meta = k[:, :N_META], v[:, :N_META]
    scale = HEAD_DIM ** -0.5
    s_band = jnp.einsum('bnqkgd,bnskd->bnkgqs', qb, k_band).astype(jnp.float32) * scale
    s_meta = jnp.einsum('bnqkgd,bmkd->bnkgqm', qb, k_meta).astype(jnp.float32) * scale

    blk0 = jnp.arange(nb)[:, None] * BLOCK
    t_pos = blk0 + jnp.arange(BLOCK)[None, :]
    s_pos = blk0 - BLOCK + jnp.arange(2 * BLOCK)[None, :]
    dist = t_pos[:, :, None] - s_pos[:, None, :]
    band_ok = (s_pos[:, None, :] >= BLOCK) & (dist >= 0) & (dist < WINDOW)
    meta_ok = (pad + jnp.arange(N_META))[None, None, :] <= t_pos[:, :, None]
    s_band = jnp.where(band_ok[None, :, None, None], s_band, NEG_INF)
    s_meta = jnp.where(meta_ok[None, :, None, None], s_meta, NEG_INF)
    s_sink = jnp.broadcast_to(
        sinks.astype(jnp.float32).reshape(1, 1, N_KV_HEADS, GQA_GROUP, 1, 1),
        s_band.shape[:-1] + (1,))
    prob = jax.nn.softmax(jnp.concatenate([s_band, s_meta, s_sink], axis=-1), axis=-1)
    p_band = prob[..., :2 * BLOCK].astype(v.dtype)
    p_meta = prob[..., 2 * BLOCK:2 * BLOCK + N_META].astype(v.dtype)
    out = (jnp.einsum('bnkgqs,bnskd->bnqkgd', p_band, v_band)
           + jnp.einsum('bnkgqm,bmkd->bnqkgd', p_meta, v_meta))
    return out.reshape(bsz, t_pad, D_ATT)[:, pad:]


def wkv7_scan(r, w, k, v, a, b):
    bsz, _, nh, n = r.shape

    def step(s, inp):
        r_t, w_t, k_t, v_t, a_t, b_t = inp
        sa = jnp.einsum('bhij,bhj->bhi', s, a_t)
        s = s * w_t[:, :, None, :] + sa[..., None] * b_t[:, :, None, :] + v_t[..., None] * k_t[:, :, None, :]
        return s, jnp.einsum('bhij,bhj->bhi', s, r_t)

    xs = tuple(jnp.moveaxis(z, 1, 0) for z in (r, w, k, v, a, b))
    s0 = jnp.zeros((bsz, nh, n, n), jnp.float32)
    _, y = lax.scan(step, s0, xs)
    return jnp.moveaxis(y, 0, 1)


def rwkv7_group(pr, mu, w0, w2, a0, a2, g2, k_k, k_a, r_k, lnx_g, lnx_b):
    f32 = jnp.float32
    bsz, t_len, _ = pr.shape
    pr = pr.astype(f32)
    prev = jnp.pad(pr, ((0, 0), (1, 0), (0, 0)))[:, :-1]
    pr = pr + (prev - pr) * mu.astype(f32)
    r, k, v, wd, ad, gd = jnp.split(
        pr, [D_R, 2 * D_R, 3 * D_R, 3 * D_R + LORA_W, 3 * D_R + LORA_W + LORA_A], axis=-1)
    w_log = -jax.nn.softplus(-(w0.astype(f32) + jnp.tanh(wd) @ w2.astype(f32))) - 0.5
    decay = jnp.exp(-jnp.exp(w_log))
    alpha = jax.nn.sigmoid(a0.astype(f32) + ad @ a2.astype(f32))
    g = jax.nn.sigmoid(gd) @ g2.astype(f32)
    heads = lambda z: z.reshape(bsz, t_len, N_R_HEADS, RWKV_HEAD)
    kk = heads(k * k_k.astype(f32))
    kk = kk / jnp.maximum(jnp.sqrt(jnp.sum(kk * kk, axis=-1, keepdims=True)), 1e-12)
    k = k * (1.0 + (alpha - 1.0) * k_a.astype(f32))
    r_h, k_h, v_h, a_h = heads(r), heads(k), heads(v), heads(alpha)
    y = wkv7_scan(r_h, heads(decay), k_h, v_h, -kk, kk * a_h)
    mean = jnp.mean(y, axis=-1, keepdims=True)
    var = jnp.mean(jnp.square(y - mean), axis=-1, keepdims=True)
    y = ((y - mean) * lax.rsqrt(var + RWKV_GN_EPS)).reshape(bsz, t_len, D_R)
    y = y * lnx_g.astype(f32) + lnx_b.astype(f32)
    bonus = jnp.sum(r_h * k_h * r_k.astype(f32), axis=-1, keepdims=True) * v_h
    y = y + bonus.reshape(bsz, t_len, D_R)
    return y * g


def odd_mixer(h, w_in, sinks, mu, w0, w2, a0, a2, g2, k_k, k_a, r_k, lnx_g, lnx_b, w_out):
    bsz, t_len, _ = h.shape
    p = h @ w_in
    q = p[..., :D_ATT].reshape(bsz, t_len, N_Q_HEADS, HEAD_DIM)
    k = p[..., D_ATT:D_ATT + D_KV].reshape(bsz, t_len, N_KV_HEADS, HEAD_DIM)
    v = p[..., D_ATT + D_KV:ATT_COLS].reshape(bsz, t_len, N_KV_HEADS, HEAD_DIM)
    pos = jnp.arange(t_len)
    y_att = swa_sink_attention(rope(q, pos), rope(k, pos), v, sinks)
    y_rwkv = rwkv7_group(p[..., ATT_COLS:], mu, w0, w2, a0, a2, g2, k_k, k_a, r_k, lnx_g, lnx_b)
    y = jnp.concatenate([y_att.astype(h.dtype), y_rwkv.astype(h.dtype)], axis=-1)
    return y @ w_out


def conv_glu(h, w_up, conv_w, conv_b, w_down):
    u = h @ w_up
    gate, val = u[..., :D_FF], u[..., D_FF:]
    gate = causal_dwconv(gate, conv_w) + conv_b.astype(h.dtype)
    return (jax.nn.silu(gate) * val) @ w_down


def setup_inputs(seed: int = 0) -> dict:
    key = jax.random.key(seed)
    ks = iter(jax.random.split(key, 32))
    f32 = jnp.float32
    nrm = lambda shape, s: jax.random.normal(next(ks), shape, f32) * s
    uni = lambda shape, lo, hi: jax.random.uniform(next(ks), shape, f32, lo, hi)
    ne = (DEPTH + 1) // 2
    no = DEPTH // 2
    return {
        'x': nrm((BATCH, SEQ, D_MODEL), 1.0),
        'meta_tokens': nrm((N_META, D_MODEL), 1.0),
        'norm_mix': 1.0 + nrm((DEPTH, D_MODEL), 0.02),
        'norm_ffn': 1.0 + nrm((DEPTH, D_MODEL), 0.02),
        'norm_final': 1.0 + nrm((D_MODEL,), 0.02),
        'ev_w_in': nrm((ne, D_MODEL, EVEN_COLS), D_MODEL ** -0.5),
        'ev_conv_a': nrm((ne, CONV_A_WIDTH, D_A), CONV_A_WIDTH ** -0.5),
        'ev_ln_a_g': 1.0 + nrm((ne, D_A), 0.02),
        'ev_ln_a_b': nrm((ne, D_A), 0.02),
        'ev_conv_b': nrm((ne, CONV_B_WIDTH, D_B), CONV_B_WIDTH ** -0.5),
        'ev_w_out': nrm((ne, D_A + D_B, D_MODEL), (D_A + D_B) ** -0.5),
        'od_w_in': nrm((no, D_MODEL, ODD_COLS), D_MODEL ** -0.5),
        'od_sinks': nrm((no, N_Q_HEADS), 0.5),
        'od_mu': uni((no, RWKV_COLS), 0.0, 1.0),
        'od_w0': uni((no, D_R), -6.0, -1.0),
        'od_w2': nrm((no, LORA_W, D_R), 0.1),
        'od_a0': nrm((no, D_R), 0.1),
        'od_a2': nrm((no, LORA_A, D_R), 0.1),
        'od_g2': nrm((no, LORA_G, D_R), LORA_G ** -0.5),
        'od_k_k': 0.85 + nrm((no, D_R), 0.02),
        'od_k_a': 1.0 + nrm((no, D_R), 0.02),
        'od_r_k': nrm((no, N_R_HEADS, RWKV_HEAD), 0.1),
        'od_lnx_g': 1.0 + nrm((no, D_R), 0.02),
        'od_lnx_b': nrm((no, D_R), 0.02),
        'od_w_out': nrm((no, D_ATT + D_R, D_MODEL), (D_ATT + D_R) ** -0.5),
        'ff_w_up': nrm((DEPTH, D_MODEL, 2 * D_FF), D_MODEL ** -0.5),
        'ff_conv': nrm((DEPTH, FF_CONV_WIDTH, D_FF), FF_CONV_WIDTH ** -0.5),
        'ff_conv_b': nrm((DEPTH, D_FF), 0.02),
        'ff_w_down': nrm((DEPTH, D_FF, D_MODEL), D_FF ** -0.5),
    }


def reference(x, meta_tokens, norm_mix, norm_ffn, norm_final,
              ev_w_in, ev_conv_a, ev_ln_a_g, ev_ln_a_b, ev_conv_b, ev_w_out,
              od_w_in, od_sinks, od_mu, od_w0, od_w2, od_a0, od_a2, od_g2,
              od_k_k, od_k_a, od_r_k, od_lnx_g, od_lnx_b, od_w_out,
              ff_w_up, ff_conv, ff_conv_b, ff_w_down):
    bsz = x.shape[0]
    meta = jnp.broadcast_to(meta_tokens[None].astype(x.dtype), (bsz, N_META, D_MODEL))
    h = jnp.concatenate([meta, x], axis=1)
    for i in range(DEPTH):
        hn = rms_norm(h, norm_mix[i])
        j = i // 2
        if i % 2 == 0:
            h = h + even_mixer(hn, ev_w_in[j], ev_conv_a[j], ev_ln_a_g[j], ev_ln_a_b[j],
                               ev_conv_b[j], ev_w_out[j])
        else:
            h = h + odd_mixer(hn, od_w_in[j], od_sinks[j], od_mu[j], od_w0[j], od_w2[j],
                              od_a0[j], od_a2[j], od_g2[j], od_k_k[j], od_k_a[j], od_r_k[j],
                              od_lnx_g[j], od_lnx_b[j], od_w_out[j])
        h = h + conv_glu(rms_norm(h, norm_ffn[i]), ff_w_up[i], ff_conv[i], ff_conv_b[i], ff_w_down[i])
    return rms_norm(h, norm_final)[:, N_META:]
```

```cpp
#include <hip/hip_runtime.h>
#include <hip/hip_cooperative_groups.h>
#include <cstdio>
#include <cstdint>
namespace cg = cooperative_groups;

#ifndef MK_N_LAUNCHES
#define MK_N_LAUNCHES 1
#endif

constexpr int NB = 8, SEQ = 2048, NMETA = 16, TT = SEQ + NMETA, DM = 1024;
constexpr int MR = NB * SEQ;
constexpr int MP = MR + 256;
constexpr int DFF = 2816, FCH = 1408;
constexpr int NIN = 2560;
constexpr int PRW = 1792;

namespace pg8 {
#define PG8_LAS __attribute__((address_space(3)))
typedef unsigned short bf16_t;
typedef short bf16x8 __attribute__((ext_vector_type(8)));
typedef float f32x4 __attribute__((ext_vector_type(4)));
typedef unsigned u32x4 __attribute__((ext_vector_type(4)));
constexpr int BM = 256, BK = 64, HALF = 128, HTB = HALF * BK * 2  , STAGE_BYTES = 8 * HTB, NXCD = 8, WGM = 8;

__host__ __device__ __forceinline__ int lds_byte(int r, int c) { const int st = (r >> 4) * 2 + (c >> 5), rr = r & 15, cc = c & 31, ob = rr * 64 + cc * 2; return st * 1024 + (ob ^ (((ob >> 9) & 1) << 5)); }
__host__ __device__ __forceinline__ void stage_rc(int b, int& R, int& C) { const int st = b / 1024, sb = b % 1024, swz = sb ^ (((sb >> 9) & 1) << 5); R = (st >> 1) * 16 + swz / 64; C = (st & 1) * 32 + (swz % 64) / 2; }
__host__ __device__ __forceinline__ int perm32(int rho) { const int n = rho >> 4, i = rho & 15; return 8 * (i >> 2) + 4 * n + (i & 3); }

struct Unit { int pm, pn; };
struct Gemm { const bf16_t* A; const bf16_t* Bt; int M, N, K, lda, ldb; };

struct StaticOrder {
    int nM, nN, nwg, G, c;
    __host__ __device__ void init(int M, int N, int G_, int c_) { nM = M / BM; nN = N / BM; nwg = nM * nN; G = G_; c = c_; }
    __host__ __device__ bool next(int i, Unit& u) const {
        const long L = (long)i * G + c; if (L >= nwg) return false;
        int wgid = (int)L; { const int q = nwg / NXCD, r = nwg % NXCD, xcd = wgid % NXCD, off = wgid / NXCD; wgid = (xcd < r ? xcd * (q + 1) : r * (q + 1) + (xcd - r) * q) + off; }
        const int nig = WGM * nN, gid = wgid / nig, fm = gid * WGM, gsz = (nM - fm) < WGM ? (nM - fm) : WGM;
        u.pm = fm + ((wgid % nig) % gsz); u.pn = (wgid % nig) / gsz; return true;
    }
    __device__ __forceinline__ void a_ready(const Unit&) const {}
    __device__ __forceinline__ void done(const Unit&) const {}
};

__device__ __forceinline__ unsigned cvt_pk_bf16(float lo, float hi) { unsigned r; asm volatile("v_cvt_pk_bf16_f32 %0, %1, %2" : "=v"(r) : "v"(lo), "v"(hi)); return r; }
__device__ __forceinline__ u32x4 pack8(const f32x4 a, const f32x4 b) { u32x4 w; w.x = cvt_pk_bf16(a[0], a[1]); w.y = cvt_pk_bf16(a[2], a[3]); w.z = cvt_pk_bf16(b[0], b[1]); w.w = cvt_pk_bf16(b[2], b[3]); return w; }
__device__ __forceinline__ float sigmoidf_(float x) { return __builtin_amdgcn_rcpf(1.0f + __expf(-x)); }
__device__ __forceinline__ f32x4 sig4(const f32x4 x) { return (f32x4){sigmoidf_(x[0]), sigmoidf_(x[1]), sigmoidf_(x[2]), sigmoidf_(x[3])}; }
__device__ __forceinline__ float row_rstd(const float* part, int row) {
    const f32x4* p = (const f32x4*)(part + (size_t)row * 16); const f32x4 a = p[0], b = p[1], c = p[2], d = p[3];
    const float s = ((a[0] + a[1]) + (a[2] + a[3])) + ((b[0] + b[1]) + (b[2] + b[3])) + ((c[0] + c[1]) + (c[2] + c[3])) + ((d[0] + d[1]) + (d[2] + d[3]));
    return rsqrtf(s * (1.0f / 1024.0f) + 1e-6f);
}
__device__ __forceinline__ int tpos_of_row(int row) { return row < MR ? (NMETA + (row & (SEQ - 1))) : (row < MR + NMETA ? row - MR : 0); }

struct EpiIn0 {
    static constexpr bool PERM = true, AFTER_DRAIN = false;
    bf16_t* U; bf16_t* WC; bf16_t* GB; const float* part;
    __device__ __forceinline__ void operator()(const f32x4 (&acc)[2][2][4][2], const Unit& u, int wr, int wc, int fr, int fq) const {
        const int row0 = u.pm * BM + wr * 64 + fr;
#pragma unroll
        for (int ai = 0; ai < 2; ++ai)
#pragma unroll
            for (int m = 0; m < 4; ++m) {
                const int row = row0 + ai * HALF + m * 16; const float rs = row_rstd(part, row);
                if (u.pn < 8) {
                    bf16_t* dst = (u.pn < 4 ? U : WC) + (size_t)row * 512 + (u.pn & 3) * 128 + wc * 32 + 8 * fq;
                    const f32x4 a0 = acc[ai][0][m][0] * rs, a1 = acc[ai][0][m][1] * rs, b0 = acc[ai][1][m][0] * rs, b1 = acc[ai][1][m][1] * rs;
                    f32x4 o0, o1;
                    if (u.pn < 4) { o0 = a0 * sig4(b0); o1 = a1 * sig4(b1); } else { o0 = a0 * b0; o1 = a1 * b1; }
                    *(u32x4*)dst = pack8(o0, o1);
                } else {
#pragma unroll
                    for (int bj = 0; bj < 2; ++bj) { bf16_t* dst = GB + (size_t)row * 512 + (u.pn - 8) * 256 + bj * HALF + wc * 32 + 8 * fq;
                        *(u32x4*)dst = pack8(acc[ai][bj][m][0] * rs, acc[ai][bj][m][1] * rs); }
                }
            }
    }
};
struct EpiRes {
    static constexpr bool PERM = true, AFTER_DRAIN = false;
    const float* base; float* out; float* hmeta; bf16_t* Abuf; float* part; int mode;
    __device__ __forceinline__ void operator()(const f32x4 (&acc)[2][2][4][2], const Unit& u, int wr, int wc, int fr, int fq) const {
        const float* bp = u.pm < 64 ? base + (size_t)u.pm * BM * DM : hmeta; float* op = u.pm < 64 ? out + (size_t)u.pm * BM * DM : hmeta;
#pragma unroll
        for (int ai = 0; ai < 2; ++ai)
#pragma unroll
            for (int m = 0; m < 4; ++m) {
                const int lr = wr * 64 + fr + ai * HALF + m * 16, row = u.pm * BM + lr; float ss = 0.f;
#pragma unroll
                for (int bj = 0; bj < 2; ++bj) { const int col = u.pn * BM + bj * HALF + wc * 32 + 8 * fq;
                    f32x4 h0 = *(const f32x4*)(bp + (size_t)lr * DM + col), h1 = *(const f32x4*)(bp + (size_t)lr * DM + col + 4);
                    h0 += acc[ai][bj][m][0]; h1 += acc[ai][bj][m][1];
                    *(f32x4*)(op + (size_t)lr * DM + col) = h0; *(f32x4*)(op + (size_t)lr * DM + col + 4) = h1;
                    if (mode) { ss += (h0[0] * h0[0] + h0[1] * h0[1]) + (h0[2] * h0[2] + h0[3] * h0[3]) + (h1[0] * h1[0] + h1[1] * h1[1]) + (h1[2] * h1[2] + h1[3] * h1[3]);
                        *(u32x4*)(Abuf + (size_t)row * DM + col) = pack8(h0, h1); } }
                if (mode) { ss += __shfl_xor(ss, 16); ss += __shfl_xor(ss, 32); if (fq == 0) part[(size_t)row * 16 + u.pn * 4 + wc] = ss; }
            }
    }
};
struct EpiUp {
    static constexpr bool PERM = true, AFTER_DRAIN = false;
    bf16_t* G; bf16_t* V; const float* part;
    __device__ __forceinline__ void operator()(const f32x4 (&acc)[2][2][4][2], const Unit& u, int wr, int wc, int fr, int fq) const {
        const int row0 = u.pm * BM + wr * 64 + fr;
#pragma unroll
        for (int ai = 0; ai < 2; ++ai)
#pragma unroll
            for (int m = 0; m < 4; ++m) {
                const int row = row0 + ai * HALF + m * 16; const float rs = row_rstd(part, row);
                const size_t off = (size_t)row * FCH + u.pn * 128 + wc * 32 + 8 * fq;
                *(u32x4*)(G + off) = pack8(acc[ai][0][m][0] * rs, acc[ai][0][m][1] * rs);
                *(u32x4*)(V + off) = pack8(acc[ai][1][m][0] * rs, acc[ai][1][m][1] * rs);
            }
    }
};
struct EpiIn1 {
    static constexpr bool PERM = true, AFTER_DRAIN = false;
    bf16_t* Q; bf16_t* KB; bf16_t* VB; bf16_t* PR; const float* part; const float* ropec; const float* ropes;
    __device__ __forceinline__ void operator()(const f32x4 (&acc)[2][2][4][2], const Unit& u, int wr, int wc, int fr, int fq) const {
        const int row0 = u.pm * BM + wr * 64 + fr;
#pragma unroll
        for (int ai = 0; ai < 2; ++ai)
#pragma unroll
            for (int m = 0; m < 4; ++m) {
                const int row = row0 + ai * HALF + m * 16; const float rs = row_rstd(part, row);
                if (u.pn >= 3) {
#pragma unroll
                    for (int bj = 0; bj < 2; ++bj) *(u32x4*)(PR + (size_t)row * PRW + (u.pn - 3) * 256 + bj * HALF + wc * 32 + 8 * fq) = pack8(acc[ai][bj][m][0] * rs, acc[ai][bj][m][1] * rs);
                } else {
                    const f32x4 a0 = acc[ai][0][m][0] * rs, a1 = acc[ai][0][m][1] * rs, b0 = acc[ai][1][m][0] * rs, b1 = acc[ai][1][m][1] * rs;
                    if (u.pn == 2 && wc >= 2) {
                        bf16_t* dst = VB + (size_t)row * 128 + (wc - 2) * 64 + 8 * fq;
                        *(u32x4*)dst = pack8(a0, a1); *(u32x4*)(dst + 32) = pack8(b0, b1);
                    } else {
                        const int t = tpos_of_row(row);
                        const f32x4 c0 = *(const f32x4*)(ropec + t * 32 + 8 * fq), c1 = *(const f32x4*)(ropec + t * 32 + 8 * fq + 4);
                        const f32x4 s0 = *(const f32x4*)(ropes + t * 32 + 8 * fq), s1 = *(const f32x4*)(ropes + t * 32 + 8 * fq + 4);
                        const f32x4 x0 = a0 * c0 - b0 * s0, x1 = a1 * c1 - b1 * s1, y0 = b0 * c0 + a0 * s0, y1 = b1 * c1 + a1 * s1;
                        bf16_t* dst = (u.pn == 2) ? KB + (size_t)row * 128 + wc * 64 + 8 * fq : Q + (size_t)row * 512 + (u.pn * 4 + wc) * 64 + 8 * fq;
                        *(u32x4*)dst = pack8(x0, x1); *(u32x4*)(dst + 32) = pack8(y0, y1);
                    }
                }
            }
    }
};

template <class Epi, class Sched, bool ALIGN_EPI = false, bool SP2 = false>
__device__ __forceinline__ void gemm_phase(PG8_LAS unsigned char* lds, const Gemm g, const Sched& S, const Epi& E, const int tid_in) {
    int tid_ = tid_in; asm volatile("" : "+v"(tid_));
    const int tid = tid_, wid = __builtin_amdgcn_readfirstlane(tid >> 6), lane = tid & 63, wr = wid >> 2, wc = wid & 3, fr = lane & 15, fq = lane >> 4;
    const int K = g.K, nt = K / BK;
    unsigned voffA[2], voffB[2];
#pragma unroll
    for (int i = 0; i < 2; ++i) { int R, C; stage_rc(tid * 16 + i * 8192, R, C); const int Rb = Epi::PERM ? ((R & ~31) + perm32(R & 31)) : R;
        voffA[i] = (unsigned)(R * g.lda + C) * 2u; voffB[i] = (unsigned)(Rb * g.ldb + C) * 2u; }
    const size_t kstep = (size_t)(BK * 2);
    const size_t hstepA = (size_t)HALF * g.lda * 2, hstepB = (size_t)HALF * g.ldb * 2;
    const size_t tstepA = 2 * hstepA, tstepB = 2 * hstepB;
    const unsigned ldsw = (unsigned)wid * 1024u;
    const int aoff = lds_byte(wr * 64 + fr, fq * 8), boff = lds_byte(wc * 32 + fr, fq * 8);
#define PG8_SA(b, h) (((b) * 2 + (h)) * HTB)
#define PG8_SB(b, h) ((4 + (b) * 2 + (h)) * HTB)
#define PG8_STAGE(bufoff, gbase, voff) do { _Pragma("unroll") for (int _i = 0; _i < 2; ++_i) \
        __builtin_amdgcn_global_load_lds((const unsigned*)((const char*)(gbase) + (voff)[_i]), (PG8_LAS unsigned*)(lds + (bufoff) + ldsw + _i * 8192), 16, 0, 0); } while (0)
#define PG8_LDA(dst, b, h) do { _Pragma("unroll") for (int m = 0; m < 4; ++m) _Pragma("unroll") for (int k = 0; k < 2; ++k) dst[m][k] = *(const PG8_LAS bf16x8*)(lds + PG8_SA(b, h) + aoff + m * 2048 + k * 1024); } while (0)
#define PG8_LDB(dst, b, h) do { _Pragma("unroll") for (int n = 0; n < 2; ++n) _Pragma("unroll") for (int k = 0; k < 2; ++k) dst[n][k] = *(const PG8_LAS bf16x8*)(lds + PG8_SB(b, h) + boff + n * 2048 + k * 1024); } while (0)
#define PG8_MMA(ai, bj, At, Bt) do { __builtin_amdgcn_s_setprio(1); _Pragma("unroll") for (int m = 0; m < 4; ++m) _Pragma("unroll") for (int n = 0; n < 2; ++n) _Pragma("unroll") for (int k = 0; k < 2; ++k) \
        acc[ai][bj][m][n] = __builtin_amdgcn_mfma_f32_16x16x32_bf16(Bt[n][k], At[m][k], acc[ai][bj][m][n], 0, 0, 0); __builtin_amdgcn_s_setprio(0); } while (0)
#define PG8_WAIT_V(n) asm volatile("s_waitcnt vmcnt(" #n ")" ::: "memory")
#define PG8_WAIT_L(n) asm volatile("s_waitcnt lgkmcnt(" #n ")" ::: "memory")
#define PG8_BAR __builtin_amdgcn_s_barrier()
#define PG8_SCHED __builtin_amdgcn_sched_barrier(0)
    Unit cur, nxt; int ui = 0;
    if (!S.next(0, cur)) return;
    f32x4 acc[2][2][4][2];
#pragma unroll
    for (int a = 0; a < 2; ++a)
#pragma unroll
        for (int b = 0; b < 2; ++b)
#pragma unroll
            for (int m = 0; m < 4; ++m)
#pragma unroll
                for (int n = 0; n < 2; ++n) acc[a][b][m][n] = (f32x4){0.f, 0.f, 0.f, 0.f};
    bf16x8 At[4][2], B0[2][2], B1[2][2];
    const char* cA = (const char*)g.A + (size_t)cur.pm * tstepA; const char* cB = (const char*)g.Bt + (size_t)cur.pn * tstepB;
    S.a_ready(cur);
    if constexpr (SP2) {
        PG8_STAGE(PG8_SB(0, 0), cB, voffB); PG8_STAGE(PG8_SB(0, 1), cB + hstepB, voffB); PG8_STAGE(PG8_SA(0, 0), cA, voffA); PG8_STAGE(PG8_SA(0, 1), cA + hstepA, voffA);
        if (wr == 1) PG8_BAR;
        PG8_WAIT_V(2); PG8_BAR;
        PG8_STAGE(PG8_SB(1, 0), cB + kstep, voffB); PG8_STAGE(PG8_SA(1, 0), cA + kstep, voffA); PG8_STAGE(PG8_SB(1, 1), cB + hstepB + kstep, voffB);
        PG8_WAIT_V(6); PG8_BAR;
    } else {
        PG8_STAGE(PG8_SB(0, 0), cB, voffB); PG8_STAGE(PG8_SA(0, 0), cA, voffA); PG8_STAGE(PG8_SB(0, 1), cB + hstepB, voffB); PG8_STAGE(PG8_SA(0, 1), cA + hstepA, voffA);
        if (wr == 1) PG8_BAR;
        PG8_WAIT_V(4); PG8_BAR;
        PG8_STAGE(PG8_SB(1, 0), cB + kstep, voffB); PG8_STAGE(PG8_SA(1, 0), cA + kstep, voffA); PG8_STAGE(PG8_SB(1, 1), cB + hstepB + kstep, voffB);
        PG8_WAIT_V(6); PG8_BAR;
    }
    for (;;) {
        const bool has_next = S.next(ui + 1, nxt);
        const char* nA = has_next ? (const char*)g.A + (size_t)nxt.pm * tstepA : cA; const char* nB = has_next ? (const char*)g.Bt + (size_t)nxt.pn * tstepB : cB;
        for (int t = 0; t < nt; t += 2) {
            const bool last = (t == nt - 2);
            const char* a1 = cA + (size_t)(t + 1) * kstep;
            const char* a2 = last ? nA : cA + (size_t)(t + 2) * kstep; const char* b2 = last ? nB : cB + (size_t)(t + 2) * kstep;
            const char* a3 = a2 + kstep; const char* b3 = b2 + kstep;
            if (last && has_next) S.a_ready(nxt);
            if constexpr (SP2) {
            PG8_LDB(B0, 0, 0); PG8_LDB(B1, 0, 1); PG8_SCHED; PG8_LDA(At, 0, 0); PG8_STAGE(PG8_SA(1, 1), a1 + hstepA, voffA);
            PG8_WAIT_V(8); PG8_WAIT_L(0); PG8_BAR; PG8_MMA(0, 0, At, B0); PG8_MMA(0, 1, At, B1); PG8_BAR; PG8_SCHED;
            PG8_LDA(At, 0, 1); PG8_STAGE(PG8_SB(0, 0), b2, voffB); PG8_STAGE(PG8_SB(0, 1), b2 + hstepB, voffB); PG8_STAGE(PG8_SA(0, 0), a2, voffA);
            PG8_WAIT_V(8); PG8_WAIT_L(0); PG8_BAR; PG8_MMA(1, 0, At, B0); PG8_MMA(1, 1, At, B1); PG8_BAR; PG8_SCHED;
            PG8_LDB(B0, 1, 0); PG8_LDB(B1, 1, 1); PG8_SCHED; PG8_LDA(At, 1, 0); PG8_STAGE(PG8_SA(0, 1), a2 + hstepA, voffA);
            PG8_WAIT_V(8); PG8_WAIT_L(0); PG8_BAR; PG8_MMA(0, 0, At, B0); PG8_MMA(0, 1, At, B1); PG8_BAR; PG8_SCHED;
            PG8_LDA(At, 1, 1); PG8_STAGE(PG8_SB(1, 0), b3, voffB); PG8_STAGE(PG8_SB(1, 1), b3 + hstepB, voffB); PG8_STAGE(PG8_SA(1, 0), a3, voffA);
            PG8_WAIT_V(8); PG8_WAIT_L(0); PG8_BAR; PG8_MMA(1, 0, At, B0); PG8_MMA(1, 1, At, B1); PG8_BAR; PG8_SCHED;
            } else {
            PG8_LDB(B0, 0, 0); PG8_SCHED; PG8_LDA(At, 0, 0); PG8_STAGE(PG8_SA(1, 1), a1 + hstepA, voffA);
            PG8_WAIT_L(8); PG8_BAR; PG8_WAIT_L(0); PG8_MMA(0, 0, At, B0); PG8_BAR; PG8_SCHED;
            PG8_LDB(B1, 0, 1); PG8_STAGE(PG8_SB(0, 0), b2, voffB);
            PG8_BAR; PG8_WAIT_L(0); PG8_MMA(0, 1, At, B1); PG8_BAR;
            PG8_LDA(At, 0, 1); PG8_STAGE(PG8_SA(0, 0), a2, voffA);
            PG8_BAR; PG8_WAIT_L(0); PG8_MMA(1, 0, At, B0); PG8_BAR; PG8_SCHED;
            PG8_STAGE(PG8_SB(0, 1), b2 + hstepB, voffB);
            PG8_WAIT_V(6); PG8_BAR; PG8_MMA(1, 1, At, B1); PG8_BAR;
            PG8_LDB(B0, 1, 0); PG8_SCHED; PG8_LDA(At, 1, 0); PG8_STAGE(PG8_SA(0, 1), a2 + hstepA, voffA);
            PG8_WAIT_L(8); PG8_BAR; PG8_WAIT_L(0); PG8_MMA(0, 0, At, B0); PG8_BAR; PG8_SCHED;
            PG8_LDB(B1, 1, 1); PG8_STAGE(PG8_SB(1, 0), b3, voffB);
            PG8_BAR; PG8_WAIT_L(0); PG8_MMA(0, 1, At, B1); PG8_BAR;
            PG8_LDA(At, 1, 1); PG8_STAGE(PG8_SA(1, 0), a3, voffA);
            PG8_BAR; PG8_WAIT_L(0); PG8_MMA(1, 0, At, B0); PG8_BAR; PG8_SCHED;
            PG8_STAGE(PG8_SB(1, 1), b3 + hstepB, voffB);
            PG8_WAIT_V(6); PG8_BAR; PG8_MMA(1, 1, At, B1); PG8_BAR;
            }
        }
        if constexpr (ALIGN_EPI) { if (wr == 0) PG8_BAR; }
        if constexpr (!Epi::AFTER_DRAIN) { E(acc, cur, wr, wc, fr, fq); S.done(cur); }
        if (!has_next) break;
#pragma unroll
        for (int a = 0; a < 2; ++a)
#pragma unroll
            for (int b = 0; b < 2; ++b)
#pragma unroll
                for (int m = 0; m < 4; ++m)
#pragma unroll
                    for (int n = 0; n < 2; ++n) acc[a][b][m][n] = (f32x4){0.f, 0.f, 0.f, 0.f};
        cur = nxt; cA = nA; cB = nB; ++ui;
        if constexpr (ALIGN_EPI) { if (wr == 1) PG8_BAR; }
    }
    PG8_WAIT_V(0);
    if constexpr (!ALIGN_EPI) { if (wr == 0) PG8_BAR; }
    PG8_BAR;
    if constexpr (Epi::AFTER_DRAIN) { E.fused(acc, cur, wr, wc, fr, fq, lds, wid, lane); S.done(cur); }
#undef PG8_SA
#undef PG8_SB
#undef PG8_STAGE
#undef PG8_LDA
#undef PG8_LDB
#undef PG8_MMA
#undef PG8_WAIT_V
#undef PG8_WAIT_L
#undef PG8_BAR
#undef PG8_SCHED
}
}

constexpr int NWAVES = 8, NTHR = 512;
constexpr int LDS_BYTES = 147456;
#define GAS __attribute__((address_space(1)))
#define LAS __attribute__((address_space(3)))
typedef unsigned short bf16;
typedef unsigned v4u __attribute__((ext_vector_type(4)));
typedef unsigned v2u __attribute__((ext_vector_type(2)));
typedef float f32x4 __attribute__((ext_vector_type(4)));
typedef float f32x2 __attribute__((ext_vector_type(2)));
typedef float f32x16 __attribute__((ext_vector_type(16)));
typedef short bf16x8 __attribute__((ext_vector_type(8)));
typedef short s16x4 __attribute__((ext_vector_type(4)));

constexpr size_t MiB = 1u << 20;
constexpr size_t WS_CTL = 0;
constexpr size_t WS_PART = 1 * MiB;
constexpr size_t WS_ROPE = 3 * MiB;
constexpr size_t WS_HMETA = 4 * MiB;
constexpr size_t WS_LORA = 5 * MiB;
constexpr size_t WS_W = 6 * MiB;
constexpr size_t W_IN0 = WS_W, W_OUT0 = W_IN0 + (size_t)NIN * DM * 2, W_UP0 = W_OUT0 + (size_t)DM * DM * 2, W_DN0 = W_UP0 + (size_t)2 * DFF * DM * 2,
                 W_IN1 = W_DN0 + (size_t)DM * DFF * 2, W_OUT1 = W_IN1 + (size_t)NIN * DM * 2, W_UP1 = W_OUT1 + (size_t)DM * DM * 2, W_DN1 = W_UP1 + (size_t)2 * DFF * DM * 2,
                 W_END = W_DN1 + (size_t)DM * DFF * 2;
constexpr size_t WS_A = 56 * MiB;
constexpr size_t WS_R = 89 * MiB;
static_assert(W_END <= WS_A && WS_A + (size_t)MP * DM * 2 <= WS_R, "ws map");
constexpr size_t R_U = WS_R, R_WC = R_U + (size_t)MP * 512 * 2, R_GB = R_WC + (size_t)MP * 512 * 2, R_Y0 = R_GB + (size_t)MP * 512 * 2;
constexpr size_t R_G = WS_R, R_V = R_G + (size_t)MP * FCH * 2, R_HM = R_V + (size_t)MP * FCH * 2, R_FFN_END = R_HM + (size_t)MP * FCH * 2;
constexpr size_t R_Q = WS_R, R_KB = R_Q + (size_t)MP * 512 * 2, R_VB = R_KB + (size_t)MP * 128 * 2, R_PR = R_VB + (size_t)MP * 128 * 2, R_Y1 = R_PR + (size_t)MP * PRW * 2, R_L1_END = R_Y1 + (size_t)MP * DM * 2;
constexpr size_t WS_END = 256 * MiB;
static_assert(R_FFN_END <= WS_END && R_L1_END <= WS_END && R_Y0 + (size_t)MP * DM * 2 <= WS_END, "ws map 2");

#define LDS_WAIT() asm volatile("s_waitcnt lgkmcnt(0)" ::: "memory")
__device__ __forceinline__ unsigned f2bf(float f) { unsigned u = __builtin_bit_cast(unsigned, f); return (u + 0x7fffu + ((u >> 16) & 1u)) >> 16; }
__device__ __forceinline__ unsigned pk2(float lo, float hi) { return f2bf(lo) | (f2bf(hi) << 16); }
__device__ __forceinline__ float bf2f(unsigned short v) { return __builtin_bit_cast(float, (unsigned)v << 16); }
__device__ __forceinline__ float bflo(unsigned w) { return __builtin_bit_cast(float, w << 16); }
__device__ __forceinline__ float bfhi(unsigned w) { return __builtin_bit_cast(float, w & 0xffff0000u); }
__device__ __forceinline__ float sigm(float x) { return __builtin_amdgcn_rcpf(1.0f + __expf(-x)); }
__device__ __forceinline__ float dppf(float x, int ctrl_sel) {
    const int v = __builtin_bit_cast(int, x); int r;
    if (ctrl_sel == 0) r = __builtin_amdgcn_update_dpp(v, v, 0xB1, 0xF, 0xF, false);
    else if (ctrl_sel == 1) r = __builtin_amdgcn_update_dpp(v, v, 0x4E, 0xF, 0xF, false);
    else if (ctrl_sel == 2) r = __builtin_amdgcn_update_dpp(v, v, 0x141, 0xF, 0xF, false);
    else r = __builtin_amdgcn_update_dpp(v, v, 0x140, 0xF, 0xF, false);
    return __builtin_bit_cast(float, r);
}
__device__ __forceinline__ float sum16(float x) { x += dppf(x, 0); x += dppf(x, 1); x += dppf(x, 2); x += dppf(x, 3); return x; }
__device__ __forceinline__ float sum32(float x) { x = sum16(x); x += __shfl_xor(x, 16); return x; }
__device__ __forceinline__ float wave_sum(float v) {
#pragma unroll
    for (int o = 1; o < 64; o <<= 1) v += __shfl_xor(v, o);
    return v;
}
__device__ __forceinline__ int row_of(int b, int t) { return t >= NMETA ? b * SEQ + (t - NMETA) : MR + t; }

struct Args { const float* in[29]; float* out; unsigned char* ws; int ph_lo, ph_hi; };
typedef const __attribute__((address_space(4))) Args CArgs;

struct Frame {
    LAS unsigned char* lds; int tid, lane, wave, G, wg;
    float* out; unsigned char* ws;
};

__device__ __forceinline__ int colmap(int kind, int d) {
    if (kind == 0) return d;
    const int tile = d >> 8, bj = (d >> 7) & 1, cc = d & 127;
    if (kind == 1) {
        if (tile < 4) return (bj ? 512 : 0) + 128 * tile + cc;
        if (tile < 8) return (bj ? 2048 : 1536) + 128 * (tile - 4) + cc;
        return 1024 + (d - 2048);
    }
    if (kind == 2) return (bj ? DFF : 0) + 128 * tile + cc;
    const int w = cc >> 5, dd = cc & 31;
    if (tile < 2) return 64 * (4 * tile + w) + 32 * bj + dd;
    if (tile == 2) return (w < 2 ? 512 + 64 * w : 640 + 64 * (w - 2)) + 32 * bj + dd;
    return d;
}
__device__ __forceinline__ void p0_transpose_item(const float* W, int K, int N, bf16* WT, const float* gvec, int kind, LAS float* scr, int item, int nblk, int lane) {
    const int kb = item / nblk, db = item % nblk, k0 = 64 * kb, d0 = 32 * db, n0 = colmap(kind, d0);
#pragma unroll 8
    for (int i = 0; i < 32; ++i) { const int kk = 2 * i + (lane >> 5); float v = W[(size_t)(k0 + kk) * N + n0 + (lane & 31)]; if (gvec) v *= gvec[k0 + kk]; scr[kk * 33 + (lane & 31)] = v; }
    LDS_WAIT(); asm volatile("" ::: "memory");
    const int c = lane & 7;
#pragma unroll
    for (int j = 0; j < 4; ++j) { const int n = (lane >> 3) + 8 * j; const LAS float* s = scr + (8 * c) * 33 + n;
        v4u o; o.x = pk2(s[0 * 33], s[1 * 33]); o.y = pk2(s[2 * 33], s[3 * 33]); o.z = pk2(s[4 * 33], s[5 * 33]); o.w = pk2(s[6 * 33], s[7 * 33]);
        *(GAS v4u*)(WT + (size_t)(d0 + n) * K + k0 + 8 * c) = o; }
    LDS_WAIT(); asm volatile("" ::: "memory");
}
__device__ __forceinline__ void p0_job(Frame& F, LAS float* scr, int gw, int NGW, int& base, const float* W, int K, int N, size_t dst, const float* g, int kind) {
    const int nblk = N / 32, nitems = (K / 64) * nblk;
    int it = gw - (base % NGW); if (it < 0) it += NGW;
    for (; it < nitems; it += NGW) p0_transpose_item(W, K, N, (bf16*)(F.ws + dst), g, kind, scr, it, nblk, F.lane);
    base += nitems;
}
__device__ __forceinline__ void p0_prologue(Frame& F, CArgs& A) {
    LAS float* scr = (LAS float*)(F.lds + F.wave * 16384);
    const int gw = F.wg * NWAVES + F.wave, NGW = F.G * NWAVES, lane = F.lane;
    unsigned char* ws = F.ws;
    const float* norm_mix = A.in[2]; const float* norm_ffn = A.in[3];
    int base = 0;
    p0_job(F, scr, gw, NGW, base, A.in[5], DM, NIN, W_IN0, norm_mix, 1);
    p0_job(F, scr, gw, NGW, base, A.in[10], DM, DM, W_OUT0, nullptr, 0);
    p0_job(F, scr, gw, NGW, base, A.in[25], DM, 2 * DFF, W_UP0, norm_ffn, 2);
    p0_job(F, scr, gw, NGW, base, A.in[28], DFF, DM, W_DN0, nullptr, 0);
    p0_job(F, scr, gw, NGW, base, A.in[11], DM, NIN, W_IN1, norm_mix + DM, 3);
    p0_job(F, scr, gw, NGW, base, A.in[24], DM, DM, W_OUT1, nullptr, 0);
    p0_job(F, scr, gw, NGW, base, A.in[25] + (size_t)DM * 2 * DFF, DM, 2 * DFF, W_UP1, norm_ffn + DM, 2);
    p0_job(F, scr, gw, NGW, base, A.in[28] + (size_t)DFF * DM, DFF, DM, W_DN1, nullptr, 0);
    p0_job(F, scr, gw, NGW, base, A.in[15], 64, 512, WS_LORA, nullptr, 0);
    p0_job(F, scr, gw, NGW, base, A.in[17], 64, 512, WS_LORA + 512 * 64 * 2, nullptr, 0);
    p0_job(F, scr, gw, NGW, base, A.in[18], 128, 512, WS_LORA + 2 * 512 * 64 * 2, nullptr, 0);
    const float* x = A.in[0]; const float* meta = A.in[1];
    bf16* A0 = (bf16*)(ws + WS_A); float* part = (float*)(ws + WS_PART); float* hmeta = (float*)(ws + WS_HMETA);
    for (int row = gw; row < MP; row += NGW) {
        float* pp = part + (size_t)row * 16;
        if (row < MR + NMETA) {
            const float* src = row < MR ? x + (size_t)row * DM : meta + (size_t)(row - MR) * DM;
            float ss = 0.f;
#pragma unroll
            for (int j = 0; j < 4; ++j) { const f32x4 v = *(const GAS f32x4*)(src + j * 256 + lane * 4); ss += (v[0] * v[0] + v[1] * v[1]) + (v[2] * v[2] + v[3] * v[3]);
                v2u o; o.x = pk2(v[0], v[1]); o.y = pk2(v[2], v[3]); *(GAS v2u*)(A0 + (size_t)row * DM + j * 256 + lane * 4) = o;
                if (row >= MR) *(GAS f32x4*)(hmeta + (size_t)(row - MR) * DM + j * 256 + lane * 4) = v; }
            ss = wave_sum(ss);
            if (lane < 16) pp[lane] = lane == 0 ? ss : 0.f;
        } else {
            if (lane < 16) pp[lane] = 0.f;
#pragma unroll
            for (int j = 0; j < 4; ++j) *(GAS f32x4*)(hmeta + (size_t)(row - MR) * DM + j * 256 + lane * 4) = (f32x4){0.f, 0.f, 0.f, 0.f};
        }
    }
    float* rc = (float*)(ws + WS_ROPE); float* rsn = rc + TT * 32;
    for (int i = gw * 64 + lane; i < TT * 32; i += NGW * 64) {
        const int t = i >> 5, d = i & 31;
        const float inv = exp2f(-(float)d * (13.287712379549449f / 32.0f));
        const float ang = (float)t * inv;
        const double rev = (double)ang * 0.15915494309189535; const double fr = rev - floor(rev);
        const float a = (float)(fr * 6.283185307179586);
        rc[i] = __cosf(a); rsn[i] = __sinf(a);
    }
}

__device__ __forceinline__ void conv0_phase(Frame& F, CArgs& A) {
    const bf16* U = (const bf16*)(F.ws + R_U); const bf16* WC = (const bf16*)(F.ws + R_WC); const bf16* GB = (const bf16*)(F.ws + R_GB); bf16* Y0 = (bf16*)(F.ws + R_Y0);
    const float* conv_a = A.in[6]; const float* ln_g = A.in[7]; const float* ln_b = A.in[8]; const float* conv_b = A.in[9];
    const int half = F.tid >> 8, ht = F.tid & 255, c0 = 2 * ht;
    LAS float* tile = (LAS float*)(F.lds + half * 40960);
    LAS float* stats = (LAS float*)(F.lds + half * 40960 + 32768);
    float wa[31][2];
#pragma unroll
    for (int j = 0; j < 31; ++j) { const f32x2 w = *(const f32x2*)(conv_a + j * 512 + c0); wa[j][0] = w.x; wa[j][1] = w.y; }
    float wb[3][2];
#pragma unroll
    for (int j = 0; j < 3; ++j) { const f32x2 w = *(const f32x2*)(conv_b + j * 512 + c0); wb[j][0] = w.x; wb[j][1] = w.y; }
    const f32x2 lg = *(const f32x2*)(ln_g + c0), lb = *(const f32x2*)(ln_b + c0);
    const int NU = NB * 128 + 1;
    const int nhu = 2 * F.G;
    for (int u0 = 0; u0 < NU; u0 += nhu) {
        const int u = u0 + F.wg * 2 + half; const bool act = u < NU;
        int b = 0, t0 = 0; if (act) { if (u == NB * 128) { b = 0; t0 = 0; } else { b = u >> 7; t0 = 16 + 16 * (u & 127); } }
        if (act) {
            unsigned uin[46];
#pragma unroll
            for (int i = 0; i < 46; ++i) { const int t = t0 - 30 + i; uin[i] = t >= 0 ? *(const unsigned*)(U + (size_t)row_of(b, t) * 512 + c0) : 0u; }
#pragma unroll
            for (int o = 0; o < 16; ++o) { float a0 = 0.f, a1 = 0.f;
#pragma unroll
                for (int j = 0; j < 31; ++j) { a0 += wa[j][0] * bflo(uin[o + j]); a1 += wa[j][1] * bfhi(uin[o + j]); }
                *(LAS f32x2*)(tile + o * 512 + c0) = (f32x2){a0, a1}; }
        }
        __syncthreads();
        if (act) {
            const int tok = ht >> 4, q = ht & 15; float s = 0.f, ss = 0.f;
#pragma unroll
            for (int i = 0; i < 8; ++i) { const f32x4 v = *(const LAS f32x4*)(tile + tok * 512 + i * 64 + q * 4); s += (v[0] + v[1]) + (v[2] + v[3]); ss += (v[0] * v[0] + v[1] * v[1]) + (v[2] * v[2] + v[3] * v[3]); }
            s = sum16(s); ss = sum16(ss);
            if (q == 0) { const float mu = s * (1.f / 512.f); float var = ss * (1.f / 512.f) - mu * mu; var = var < 0.f ? 0.f : var; stats[tok * 2] = mu; stats[tok * 2 + 1] = rsqrtf(var + 1e-5f); }
        }
        __syncthreads();
        if (act) {
            unsigned win[18];
#pragma unroll
            for (int i = 0; i < 18; ++i) { const int t = t0 - 2 + i; win[i] = t >= 0 ? *(const unsigned*)(WC + (size_t)row_of(b, t) * 512 + c0) : 0u; }
#pragma unroll
            for (int o = 0; o < 16; ++o) {
                const int row = row_of(b, t0 + o);
                const f32x2 v = *(const LAS f32x2*)(tile + o * 512 + c0); const float mu = stats[o * 2], rs = stats[o * 2 + 1];
                float y0 = (v.x - mu) * rs * lg.x + lb.x, y1 = (v.y - mu) * rs * lg.y + lb.y; y0 *= sigm(y0); y1 *= sigm(y1);
                *(unsigned*)(Y0 + (size_t)row * DM + c0) = pk2(y0, y1);
                float z0 = 0.f, z1 = 0.f;
#pragma unroll
                for (int j = 0; j < 3; ++j) { z0 += wb[j][0] * bflo(win[o + j]); z1 += wb[j][1] * bfhi(win[o + j]); }
                const unsigned gbv = *(const unsigned*)(GB + (size_t)row * 512 + c0);
                *(unsigned*)(Y0 + (size_t)row * DM + 512 + c0) = pk2(z0 * bflo(gbv), z1 * bfhi(gbv));
            }
        }
        __syncthreads();
    }
}

__device__ __forceinline__ void ffn_mid_phase(Frame& F, CArgs& A, int layer, int chunk) {
    const bf16* G = (const bf16*)(F.ws + R_G); const bf16* V = (const bf16*)(F.ws + R_V); bf16* HM = (bf16*)(F.ws + R_HM);
    const float* cw = A.in[26] + (size_t)layer * 3 * DFF + chunk * FCH; const float* cb = A.in[27] + (size_t)layer * DFF + chunk * FCH;
    constexpr int NCG = FCH / 8;
    const int NITEM = (NB * 128 + 1) * NCG;
    for (int it = F.wg * NTHR + F.tid; it < NITEM; it += F.G * NTHR) {
        const int cgp = it % NCG, blk = it / NCG, c0 = cgp * 8;
        int b, t0; if (blk == NB * 128) { b = 0; t0 = 0; } else { b = blk >> 7; t0 = 16 + 16 * (blk & 127); }
        float w0[8], w1[8], w2[8], bb[8];
#pragma unroll
        for (int e = 0; e < 8; ++e) { w0[e] = cw[c0 + e]; w1[e] = cw[DFF + c0 + e]; w2[e] = cw[2 * DFF + c0 + e]; bb[e] = cb[c0 + e]; }
        float g2[8], g1[8];
#pragma unroll
        for (int e = 0; e < 8; ++e) { g2[e] = 0.f; g1[e] = 0.f; }
        if (t0 >= 2) { const v4u a = *(const v4u*)(G + (size_t)row_of(b, t0 - 2) * FCH + c0), c = *(const v4u*)(G + (size_t)row_of(b, t0 - 1) * FCH + c0);
#pragma unroll
            for (int e = 0; e < 4; ++e) { g2[2 * e] = bflo(a[e]); g2[2 * e + 1] = bfhi(a[e]); g1[2 * e] = bflo(c[e]); g1[2 * e + 1] = bfhi(c[e]); } }
#pragma unroll 4
        for (int o = 0; o < 16; ++o) {
            const size_t off = (size_t)row_of(b, t0 + o) * FCH + c0;
            const v4u gv = *(const v4u*)(G + off), vv = *(const v4u*)(V + off);
            float g0[8], vf[8];
#pragma unroll
            for (int e = 0; e < 4; ++e) { g0[2 * e] = bflo(gv[e]); g0[2 * e + 1] = bfhi(gv[e]); vf[2 * e] = bflo(vv[e]); vf[2 * e + 1] = bfhi(vv[e]); }
            float r[8];
#pragma unroll
            for (int e = 0; e < 8; ++e) { const float z = w0[e] * g2[e] + w1[e] * g1[e] + w2[e] * g0[e] + bb[e]; r[e] = z * sigm(z) * vf[e]; g2[e] = g1[e]; g1[e] = g0[e]; }
            v4u o4; o4.x = pk2(r[0], r[1]); o4.y = pk2(r[2], r[3]); o4.z = pk2(r[4], r[5]); o4.w = pk2(r[6], r[7]);
            *(v4u*)(HM + off) = o4;
        }
    }
}

__device__ __forceinline__ int crow(int r, int hi) { return (r & 3) + 8 * (r >> 2) + 4 * hi; }
constexpr int ATT_KS = 72, ATT_VS = 232, ATT_K_BYTES = 224 * ATT_KS * 2;
__device__ __forceinline__ void attn_unit(Frame& F, const float* sinks, int b, int kvh, int qb) {
    const bf16* Q = (const bf16*)(F.ws + R_Q); const bf16* KB = (const bf16*)(F.ws + R_KB); const bf16* VB = (const bf16*)(F.ws + R_VB); bf16* Y1 = (bf16*)(F.ws + R_Y1);
    LAS bf16* Ks = (LAS bf16*)F.lds; LAS bf16* Vt = (LAS bf16*)(F.lds + ATT_K_BYTES);
    const int tid = F.tid, lane = F.lane, wave = F.wave, g = wave >> 1, half = wave & 1, qh = kvh * 4 + g, qi = lane & 31, hi = lane >> 5;
    const bool meta = qb < 0; const int q0 = meta ? 0 : 64 * qb;
#pragma unroll
    for (int i = 0; i < 4; ++i) {
        const int id = tid + 512 * i, key = id >> 3, ch = id & 7;
        if (key < 224) {
            int row = -1;
            if (key < 192) { const int sp = q0 - 128 + key; if (!meta && sp >= 0) row = b * SEQ + sp; }
            else if (key < 208) row = MR + (key - 192);
            v4u kv = (v4u){0u, 0u, 0u, 0u}, vv = (v4u){0u, 0u, 0u, 0u};
            if (row >= 0) { kv = *(const v4u*)(KB + (size_t)row * 128 + kvh * 64 + ch * 8); vv = *(const v4u*)(VB + (size_t)row * 128 + kvh * 64 + ch * 8); }
            *(LAS v4u*)(Ks + key * ATT_KS + ch * 8) = kv;
#pragma unroll
            for (int e = 0; e < 4; ++e) { Vt[(ch * 8 + 2 * e) * ATT_VS + key] = (bf16)(vv[e] & 0xffffu); Vt[(ch * 8 + 2 * e + 1) * ATT_VS + key] = (bf16)(vv[e] >> 16); }
        }
    }
    __syncthreads();
    int qrow; if (meta) { const int m = 32 * half + qi; qrow = MR + (m < NMETA ? m : NMETA - 1); } else qrow = b * SEQ + q0 + 32 * half + qi;
    bf16x8 qr[4];
#pragma unroll
    for (int k4 = 0; k4 < 4; ++k4) qr[k4] = *(const bf16x8*)(Q + (size_t)qrow * 512 + qh * 64 + 16 * k4 + 8 * hi);
    f32x16 sc[6];
#pragma unroll
    for (int i = 0; i < 6; ++i) {
        const int t = i < 5 ? half + i : 6;
        f32x16 a = (f32x16){0.f,0.f,0.f,0.f,0.f,0.f,0.f,0.f,0.f,0.f,0.f,0.f,0.f,0.f,0.f,0.f};
#pragma unroll
        for (int k4 = 0; k4 < 4; ++k4) { const bf16x8 kf = *(const LAS bf16x8*)(Ks + (32 * t + qi) * ATT_KS + 16 * k4 + 8 * hi); a = __builtin_amdgcn_mfma_f32_32x32x16_bf16(kf, qr[k4], a, 0, 0, 0); }
        sc[i] = a;
    }
    const float sink = sinks[qh]; float mx = sink;
    const int mq = 32 * half + qi;
#pragma unroll
    for (int i = 0; i < 6; ++i)
#pragma unroll
        for (int r = 0; r < 16; ++r) {
            const int kr = crow(r, hi); bool ok;
            if (i < 5) { const int dist = 128 - 32 * i + qi - kr; const int sp = q0 - 128 + 32 * (half + i) + kr; ok = !meta && dist >= 0 && dist < 128 && sp >= 0; }
            else ok = kr < NMETA && (!meta || kr <= mq);
            const float v = ok ? sc[i][r] * 0.125f : -1e30f; sc[i][r] = v; mx = fmaxf(mx, v);
        }
    mx = fmaxf(mx, __shfl_xor(mx, 32));
    float ls = 0.f;
#pragma unroll
    for (int i = 0; i < 6; ++i)
#pragma unroll
        for (int r = 0; r < 16; ++r) { const float p = __expf(sc[i][r] - mx); sc[i][r] = p; ls += p; }
    ls += __shfl_xor(ls, 32); ls += __expf(sink - mx);
    const float inv = 1.0f / ls;
    f32x16 o[2];
    o[0] = (f32x16){0.f,0.f,0.f,0.f,0.f,0.f,0.f,0.f,0.f,0.f,0.f,0.f,0.f,0.f,0.f,0.f}; o[1] = o[0];
#pragma unroll
    for (int i = 0; i < 6; ++i) {
        const int t = i < 5 ? half + i : 6;
#pragma unroll
        for (int s2 = 0; s2 < 2; ++s2) {
            v4u pw; pw.x = pg8::cvt_pk_bf16(sc[i][8 * s2 + 0], sc[i][8 * s2 + 1]); pw.y = pg8::cvt_pk_bf16(sc[i][8 * s2 + 2], sc[i][8 * s2 + 3]);
            pw.z = pg8::cvt_pk_bf16(sc[i][8 * s2 + 4], sc[i][8 * s2 + 5]); pw.w = pg8::cvt_pk_bf16(sc[i][8 * s2 + 6], sc[i][8 * s2 + 7]);
            const bf16x8 pa = __builtin_bit_cast(bf16x8, pw);
#pragma unroll
            for (int dt = 0; dt < 2; ++dt) {
                const LAS bf16* vp = Vt + (dt * 32 + qi) * ATT_VS + 32 * t + 16 * s2 + 4 * hi;
                const v2u lo = *(const LAS v2u*)vp, hh = *(const LAS v2u*)(vp + 8);
                const v4u vw = (v4u){lo.x, lo.y, hh.x, hh.y};
                o[dt] = __builtin_amdgcn_mfma_f32_32x32x16_bf16(pa, __builtin_bit_cast(bf16x8, vw), o[dt], 0, 0, 0);
            }
        }
    }
#pragma unroll
    for (int r = 0; r < 16; ++r) {
        const int qq = crow(r, hi); const float iv = __shfl(inv, qq);
        int orow; bool ok = true;
        if (meta) { const int m = 32 * half + qq; ok = m < NMETA; orow = MR + m; } else orow = b * SEQ + q0 + 32 * half + qq;
        if (ok) {
            Y1[(size_t)orow * DM + qh * 64 + qi] = (bf16)f2bf(o[0][r] * iv);
            Y1[(size_t)orow * DM + qh * 64 + 32 + qi] = (bf16)f2bf(o[1][r] * iv);
        }
    }
    __syncthreads();
}

constexpr int SC_PRL = 0;
constexpr int SC_XR = 15616, SC_XK = SC_XR + 4096, SC_XV = SC_XK + 4096;
constexpr int SC_TW = SC_XV + 4096, SC_XA = SC_TW + 2304, SC_SG = SC_XA + 2304;
constexpr int SC_LW = SC_SG + 4352, SC_LA = SC_LW + 4096, SC_LG = SC_LA + 4096;
constexpr int SC_SW = SC_LG + 4096, SC_SK = SC_SW + 4096, SC_SA = SC_SK + 4096, SC_SB = SC_SA + 4096;
constexpr int SC_YL = SC_SB + 4096, SC_RK = SC_YL + 4096, SC_END = SC_RK + 64;
static_assert(SC_END <= 131072 && (SC_TW % 16) == 0 && (SC_XA % 16) == 0 && (SC_SG % 16) == 0 && (SC_LW % 16) == 0, "scan lds map");
constexpr int PRS = 456;

__device__ __forceinline__ void rwkv_chain(Frame& F, CArgs& A, int b, int h) {
    const bf16* PR = (const bf16*)(F.ws + R_PR); bf16* Y1 = (bf16*)(F.ws + R_Y1);
    const bf16* w2t = (const bf16*)(F.ws + WS_LORA); const bf16* a2t = w2t + 512 * 64; const bf16* g2t = a2t + 512 * 64;
    const float* mu = A.in[13]; const float* w0 = A.in[14]; const float* a0 = A.in[16]; const float* k_k = A.in[19]; const float* k_a = A.in[20]; const float* r_k = A.in[21];
    const float* lnx_g = A.in[22]; const float* lnx_b = A.in[23];
    const int tid = F.tid, lane = F.lane, wave = F.wave;
    LAS unsigned char* L = F.lds;
    LAS bf16* PRL = (LAS bf16*)(L + SC_PRL);
    LAS float* XR = (LAS float*)(L + SC_XR); LAS float* XK = (LAS float*)(L + SC_XK); LAS float* XV = (LAS float*)(L + SC_XV);
    LAS bf16* TW = (LAS bf16*)(L + SC_TW); LAS bf16* XA = (LAS bf16*)(L + SC_XA); LAS bf16* SG = (LAS bf16*)(L + SC_SG);
    LAS float* LW = (LAS float*)(L + SC_LW); LAS float* LA = (LAS float*)(L + SC_LA); LAS float* LG = (LAS float*)(L + SC_LG);
    LAS float* SW = (LAS float*)(L + SC_SW); LAS float* SK = (LAS float*)(L + SC_SK); LAS float* SA = (LAS float*)(L + SC_SA); LAS float* SB = (LAS float*)(L + SC_SB);
    LAS float* YL = (LAS float*)(L + SC_YL); LAS float* RK = (LAS float*)(L + SC_RK);
    int ld_off[2], ld_lds[2]; bool ld_ok[2];
#pragma unroll
    for (int i = 0; i < 2; ++i) { const int q = tid + 512 * i, pr = q / 56, pc = q % 56; ld_ok[i] = q < 896;
        const int col = pc < 8 ? 64 * h + 8 * pc : pc < 16 ? 512 + 64 * h + 8 * (pc - 8) : pc < 24 ? 1024 + 64 * h + 8 * (pc - 16) : 1536 + 8 * (pc - 24);
        ld_off[i] = pr * PRW + col; ld_lds[i] = (1 + pr) * PRS + 8 * pc; }
    const int nb = wave & 3, grp = wave >> 2;
    bf16x8 bfr[4];
    if (grp == 0) {
        bfr[0] = *(const bf16x8*)(w2t + (size_t)(64 * h + 16 * nb + (lane & 15)) * 64 + 8 * (lane >> 4)); bfr[1] = *(const bf16x8*)(w2t + (size_t)(64 * h + 16 * nb + (lane & 15)) * 64 + 32 + 8 * (lane >> 4));
        bfr[2] = *(const bf16x8*)(a2t + (size_t)(64 * h + 16 * nb + (lane & 15)) * 64 + 8 * (lane >> 4)); bfr[3] = *(const bf16x8*)(a2t + (size_t)(64 * h + 16 * nb + (lane & 15)) * 64 + 32 + 8 * (lane >> 4));
    } else {
#pragma unroll
        for (int k = 0; k < 4; ++k) bfr[k] = *(const bf16x8*)(g2t + (size_t)(64 * h + 16 * nb + (lane & 15)) * 128 + 32 * k + 8 * (lane >> 4));
    }
    const int tt = tid >> 5, jp = tid & 31, j0 = 2 * jp, ch0 = 64 * h + j0;
    const f32x2 c_w0 = *(const f32x2*)(w0 + ch0), c_a0 = *(const f32x2*)(a0 + ch0), c_kk = *(const f32x2*)(k_k + ch0), c_ka = *(const f32x2*)(k_a + ch0), c_rk = *(const f32x2*)(r_k + ch0),
                c_lg = *(const f32x2*)(lnx_g + ch0), c_lb = *(const f32x2*)(lnx_b + ch0);
    const int rg = lane >> 4, cgp = lane & 15, i0 = 8 * wave + 2 * rg;
    float s0[4] = {0.f, 0.f, 0.f, 0.f}, s1[4] = {0.f, 0.f, 0.f, 0.f};
    if (tid < 228) ((LAS unsigned*)PRL)[tid] = 0u;
    v4u pf[2];
#pragma unroll
    for (int i = 0; i < 2; ++i) pf[i] = ld_ok[i] ? *(const v4u*)(PR + (size_t)MR * PRW + ld_off[i]) : (v4u){0u, 0u, 0u, 0u};
    __syncthreads();
    for (int n = 0; n <= 128; ++n) {
        const int r0 = n == 0 ? MR : b * SEQ + 16 * (n - 1);
#pragma unroll
        for (int i = 0; i < 2; ++i) if (ld_ok[i]) *(LAS v4u*)(PRL + ld_lds[i]) = pf[i];
        __syncthreads();
        if (n < 128) { const size_t nbase = (size_t)(b * SEQ + 16 * n) * PRW;
#pragma unroll
            for (int i = 0; i < 2; ++i) if (ld_ok[i]) pf[i] = *(const v4u*)(PR + nbase + ld_off[i]); }
        {
            const int t2 = tid >> 5, l32 = tid & 31;
#pragma unroll
            for (int i = 0; i < 14; ++i) {
                const int c = l32 + 32 * i;
                const float cur = bf2f(PRL[(1 + t2) * PRS + c]), prv = bf2f(PRL[t2 * PRS + c]);
                const int gcol = c < 64 ? 64 * h + c : c < 128 ? 512 + 64 * h + (c - 64) : c < 192 ? 1024 + 64 * h + (c - 128) : 1536 + (c - 192);
                const float x = cur + (prv - cur) * mu[gcol];
                if (c < 64) XR[t2 * 64 + c] = x; else if (c < 128) XK[t2 * 64 + c - 64] = x; else if (c < 192) XV[t2 * 64 + c - 128] = x;
                else if (c < 256) TW[t2 * 72 + c - 192] = (bf16)f2bf(tanhf(x)); else if (c < 320) XA[t2 * 72 + c - 256] = (bf16)f2bf(x); else SG[t2 * 136 + c - 320] = (bf16)f2bf(sigm(x));
            }
        }
        __syncthreads();
        if (tid < 228) ((LAS unsigned*)PRL)[tid] = ((LAS unsigned*)PRL)[16 * (PRS / 2) + tid];
        {
            const int ar = lane & 15, ak = 8 * (lane >> 4);
            pg8::f32x4 d0 = (pg8::f32x4){0.f, 0.f, 0.f, 0.f}, d1 = d0;
            if (grp == 0) {
#pragma unroll
                for (int k = 0; k < 2; ++k) { const bf16x8 af = *(const LAS bf16x8*)(TW + ar * 72 + 32 * k + ak); d0 = __builtin_amdgcn_mfma_f32_16x16x32_bf16(af, bfr[k], d0, 0, 0, 0); }
#pragma unroll
                for (int k = 0; k < 2; ++k) { const bf16x8 af = *(const LAS bf16x8*)(XA + ar * 72 + 32 * k + ak); d1 = __builtin_amdgcn_mfma_f32_16x16x32_bf16(af, bfr[2 + k], d1, 0, 0, 0); }
#pragma unroll
                for (int r = 0; r < 4; ++r) { LW[(4 * (lane >> 4) + r) * 64 + 16 * nb + (lane & 15)] = d0[r]; LA[(4 * (lane >> 4) + r) * 64 + 16 * nb + (lane & 15)] = d1[r]; }
            } else {
#pragma unroll
                for (int k = 0; k < 4; ++k) { const bf16x8 af = *(const LAS bf16x8*)(SG + ar * 136 + 32 * k + ak); d0 = __builtin_amdgcn_mfma_f32_16x16x32_bf16(af, bfr[k], d0, 0, 0, 0); }
#pragma unroll
                for (int r = 0; r < 4; ++r) LG[(4 * (lane >> 4) + r) * 64 + 16 * nb + (lane & 15)] = d0[r];
            }
        }
        __syncthreads();
        {
            const f32x2 lw = *(const LAS f32x2*)(LW + tt * 64 + j0), la = *(const LAS f32x2*)(LA + tt * 64 + j0);
            const f32x2 xr = *(const LAS f32x2*)(XR + tt * 64 + j0), xk = *(const LAS f32x2*)(XK + tt * 64 + j0);
            const float wd0 = __expf(-0.6065306597126334f * sigm(c_w0.x + lw.x)), wd1 = __expf(-0.6065306597126334f * sigm(c_w0.y + lw.y));
            const float al0 = sigm(c_a0.x + la.x), al1 = sigm(c_a0.y + la.y);
            const float q0 = xk.x * c_kk.x, q1 = xk.y * c_kk.y;
            const float nrm = sum32(q0 * q0 + q1 * q1); const float rn = 1.0f / fmaxf(sqrtf(nrm), 1e-12f);
            const float kk0 = q0 * rn, kk1 = q1 * rn;
            const float kn0 = xk.x * (1.0f + (al0 - 1.0f) * c_ka.x), kn1 = xk.y * (1.0f + (al1 - 1.0f) * c_ka.y);
            const float rkp = sum32(xr.x * kn0 * c_rk.x + xr.y * kn1 * c_rk.y);
            *(LAS f32x2*)(SW + tt * 64 + j0) = (f32x2){wd0, wd1}; *(LAS f32x2*)(SK + tt * 64 + j0) = (f32x2){kn0, kn1};
            *(LAS f32x2*)(SA + tt * 64 + j0) = (f32x2){-kk0, -kk1}; *(LAS f32x2*)(SB + tt * 64 + j0) = (f32x2){kk0 * al0, kk1 * al1};
            if (jp == 0) RK[tt] = rkp;
        }
        __syncthreads();
#pragma unroll 4
        for (int t = 0; t < 16; ++t) {
            const f32x4 w4 = *(const LAS f32x4*)(SW + t * 64 + 4 * cgp), k4 = *(const LAS f32x4*)(SK + t * 64 + 4 * cgp), a4 = *(const LAS f32x4*)(SA + t * 64 + 4 * cgp),
                        b4 = *(const LAS f32x4*)(SB + t * 64 + 4 * cgp), r4 = *(const LAS f32x4*)(XR + t * 64 + 4 * cgp);
            const f32x2 v2 = *(const LAS f32x2*)(XV + t * 64 + i0);
            float sa0 = (s0[0] * a4[0] + s0[1] * a4[1]) + (s0[2] * a4[2] + s0[3] * a4[3]);
            float sa1 = (s1[0] * a4[0] + s1[1] * a4[1]) + (s1[2] * a4[2] + s1[3] * a4[3]);
            sa0 = sum16(sa0); sa1 = sum16(sa1);
#pragma unroll
            for (int c = 0; c < 4; ++c) { s0[c] = s0[c] * w4[c] + (sa0 * b4[c] + v2.x * k4[c]); s1[c] = s1[c] * w4[c] + (sa1 * b4[c] + v2.y * k4[c]); }
            float y0 = (s0[0] * r4[0] + s0[1] * r4[1]) + (s0[2] * r4[2] + s0[3] * r4[3]);
            float y1 = (s1[0] * r4[0] + s1[1] * r4[1]) + (s1[2] * r4[2] + s1[3] * r4[3]);
            y0 = sum16(y0); y1 = sum16(y1);
            if (cgp == 0) *(LAS f32x2*)(YL + t * 64 + i0) = (f32x2){y0, y1};
        }
        __syncthreads();
        {
            const f32x2 y = *(const LAS f32x2*)(YL + tt * 64 + j0), xv = *(const LAS f32x2*)(XV + tt * 64 + j0), gg = *(const LAS f32x2*)(LG + tt * 64 + j0);
            const float mean = sum32(y.x + y.y) * (1.0f / 64.0f);
            const float dx = y.x - mean, dy = y.y - mean;
            const float var = sum32(dx * dx + dy * dy) * (1.0f / 64.0f); const float rs = rsqrtf(var + 64e-5f);
            const float rkv = RK[tt];
            const float o0 = (dx * rs * c_lg.x + c_lb.x + rkv * xv.x) * gg.x, o1 = (dy * rs * c_lg.y + c_lb.y + rkv * xv.y) * gg.y;
            if (n > 0 || b == 0) *(unsigned*)(Y1 + (size_t)(r0 + tt) * DM + 512 + ch0) = pk2(o0, o1);
        }
    }
    __syncthreads();
}

__device__ __forceinline__ void final_phase(Frame& F, CArgs& A) {
    const float* part = (const float*)(F.ws + WS_PART); const float* gf = A.in[4]; float* out = F.out;
    const int gw = F.wg * NWAVES + F.wave, NGW = F.G * NWAVES, lane = F.lane;
    f32x4 gv[4];
#pragma unroll
    for (int j = 0; j < 4; ++j) gv[j] = *(const f32x4*)(gf + j * 256 + lane * 4);
    for (int row = gw; row < MR; row += NGW) {
        const float rs = pg8::row_rstd(part, row);
#pragma unroll
        for (int j = 0; j < 4; ++j) { f32x4* p = (f32x4*)(out + (size_t)row * DM + j * 256 + lane * 4); *p = (*p) * rs * gv[j]; }
    }
}

#ifdef NO_SCAN
#define RWKV_CHAIN(b, h) do { } while (0)
#else
#define RWKV_CHAIN(b, h) rwkv_chain(F, A, (b), (h))
#endif
#ifdef NO_ATTN
#define ATTN_UNIT(b, k, q) do { } while (0)
#else
#define ATTN_UNIT(b, k, q) attn_unit(F, A.in[12], (b), (k), (q))
#endif
constexpr int N_PHASES = 20;
#ifndef DBGLAST
#define DBGLAST 6
#endif
#ifndef DBG15
#define DBG15 3
#endif
#define PD(k, l, c) ((k) | ((l) << 4) | ((c) << 5))
__constant__ int c_phase_tab[N_PHASES] = { PD(0,0,0), PD(1,0,0), PD(2,0,0), PD(3,0,0), PD(4,0,0), PD(5,0,0), PD(3,0,0), PD(4,0,1), PD(5,0,1), PD(3,0,1),
    PD(6,0,0), PD(7,0,0), PD(3,0,0), PD(4,1,0), PD(5,1,0), PD(3,1,0), PD(4,1,1), PD(5,1,1), PD(3,1,1), PD(8,0,0) };
#ifndef DBG_NPH
#define DBG_NPH 18
#endif
__global__ void __launch_bounds__(NTHR, 2) hyb_fwd(Args args) {
    extern __shared__ __attribute__((aligned(16))) unsigned char lds[];
    const int lo = args.ph_lo, hi = args.ph_hi;
    const int wave_s = __builtin_amdgcn_readfirstlane(threadIdx.x >> 6);
#pragma unroll 1
    for (int p = lo; p < hi; ++p) {
#define PHF() CArgs* ap_ = (CArgs*)__builtin_amdgcn_kernarg_segment_ptr(); asm volatile("" : "+s"(ap_)); CArgs& A = *ap_; \
        unsigned z_; asm volatile("s_mov_b32 %0, 0" : "=s"(z_)); \
        Frame F; F.tid = (wave_s << 6) | (int)__builtin_amdgcn_mbcnt_hi(~0u, __builtin_amdgcn_mbcnt_lo(~0u, z_)); asm volatile("" : "+v"(F.tid)); \
        F.lds = (LAS unsigned char*)lds; F.lane = F.tid & 63; F.wave = __builtin_amdgcn_readfirstlane(F.tid >> 6); F.G = gridDim.x; F.wg = blockIdx.x; F.out = A.out; F.ws = A.ws; \
        unsigned char* ws = A.ws; float* part = (float*)(ws + WS_PART); float* hmeta = (float*)(ws + WS_HMETA); pg8::bf16_t* Abuf = (pg8::bf16_t*)(ws + WS_A); (void)part; (void)hmeta; (void)Abuf
        int kind, layer = 0, ch = 0, sub = 2;
        switch (p) {
            case 0: kind = 0; break; case 1: kind = 1; break; case 2: kind = 2; break; case 3: kind = 3; sub = 0; break;
            case 4: kind = 4; break; case 5: kind = 5; break; case 6: kind = 3; break;
            case 7: kind = 4; ch = 1; break; case 8: kind = 5; ch = 1; break; case 9: kind = 3; ch = 1; break;
            case 10: kind = 6; break; case 11: kind = 7; break; case 12: kind = 3; sub = 1; break;
            case 13: kind = 4; layer = 1; break; case 14: kind = 5; layer = 1; break; case 15: kind = 3; layer = 1; break;
            case 16: kind = 4; layer = 1; ch = 1; break; case 17: kind = 5; layer = 1; ch = 1; break; case 18: kind = 3; layer = 1; ch = 1; break;
            default: kind = 8; break;
        }
        if (kind == 0) { PHF(); p0_prologue(F, A); }
        else if (kind == 1) { PHF(); pg8::Gemm g{Abuf, (const pg8::bf16_t*)(ws + W_IN0), MP, NIN, DM, DM, DM}; pg8::StaticOrder S; S.init(MP, NIN, F.G, F.wg);
            pg8::EpiIn0 E{(pg8::bf16_t*)(ws + R_U), (pg8::bf16_t*)(ws + R_WC), (pg8::bf16_t*)(ws + R_GB), part};
            pg8::gemm_phase<pg8::EpiIn0, pg8::StaticOrder, true, true>(F.lds, g, S, E, F.tid); }
        else if (kind == 2) { PHF(); conv0_phase(F, A); }
        else if (kind == 3) { PHF();
            const bool o0 = (sub == 0), o1 = (sub == 1), od = (sub == 2);
            const pg8::bf16_t* Aop = (const pg8::bf16_t*)(ws + (o0 ? R_Y0 : o1 ? R_Y1 : R_HM));
            const pg8::bf16_t* Bop = (const pg8::bf16_t*)(ws + (o0 ? W_OUT0 : o1 ? W_OUT1 : (layer ? W_DN1 : W_DN0))) + (od ? (size_t)ch * FCH : (size_t)0);
            const int Kd = od ? FCH : DM, ldbd = od ? DFF : DM, mode = od ? ch : 1;
            const float* base = o0 ? A.in[0] : (const float*)A.out;
            const pg8::Gemm g{Aop, Bop, MP, DM, Kd, Kd, ldbd};
            pg8::StaticOrder S; S.init(MP, DM, F.G, F.wg);
            pg8::EpiRes E{base, A.out, hmeta, Abuf, part, mode};
            pg8::gemm_phase<pg8::EpiRes, pg8::StaticOrder, true, true>(F.lds, g, S, E, F.tid); }
        else if (kind == 4) { PHF(); pg8::Gemm g{Abuf, (const pg8::bf16_t*)(ws + (layer ? W_UP1 : W_UP0)) + (size_t)ch * FCH * 2 * DM, MP, 2 * FCH, DM, DM, DM}; pg8::StaticOrder S; S.init(MP, 2 * FCH, F.G, F.wg);
            pg8::EpiUp E{(pg8::bf16_t*)(ws + R_G), (pg8::bf16_t*)(ws + R_V), part};
            pg8::gemm_phase<pg8::EpiUp, pg8::StaticOrder, true, true>(F.lds, g, S, E, F.tid); }
        else if (kind == 5) { PHF(); ffn_mid_phase(F, A, layer, ch); }
        else if (kind == 6) { PHF(); pg8::Gemm g{Abuf, (const pg8::bf16_t*)(ws + W_IN1), MP, NIN, DM, DM, DM}; pg8::StaticOrder S; S.init(MP, NIN, F.G, F.wg);
            pg8::EpiIn1 E{(pg8::bf16_t*)(ws + R_Q), (pg8::bf16_t*)(ws + R_KB), (pg8::bf16_t*)(ws + R_VB), (pg8::bf16_t*)(ws + R_PR), part, (const float*)(ws + WS_ROPE), (const float*)(ws + WS_ROPE) + TT * 32};
            pg8::gemm_phase<pg8::EpiIn1, pg8::StaticOrder, true, true>(F.lds, g, S, E, F.tid); }
        else if (kind == 7) { PHF();
            const int NCH = 64, NAW = F.G > NCH ? F.G - NCH : F.G;
            if (F.G > NCH && F.wg < NCH) { RWKV_CHAIN(F.wg >> 3, F.wg & 7); }
            else {
                if (F.G <= NCH) for (int c = F.wg; c < NCH; c += F.G) RWKV_CHAIN(c >> 3, c & 7);
                const int aw = F.G > NCH ? F.wg - NCH : F.wg;
                for (int id = aw; id < 514; id += NAW) { if (id < 512) ATTN_UNIT(id >> 6, (id >> 5) & 1, id & 31); else ATTN_UNIT(0, id - 512, -1); }
            }
        }
        else if (kind == 8) { PHF(); final_phase(F, A); }
#if MK_N_LAUNCHES == 1
        if (p + 1 < hi) cg::this_grid().sync();
#endif
    }
}

extern "C" void kernel_launch(void* const* d_in, const int* in_sizes, int n_in, void* d_out, int out_size, void* d_ws, size_t ws_size, hipStream_t stream) {
    static int grid = 0;
    if (grid == 0) {
        if (n_in != 29 || out_size != MR * DM || ws_size < WS_END) { fprintf(stderr, "kernel_launch: unexpected shapes (n_in %d out %d ws %zu)\n", n_in, out_size, ws_size); grid = -1; return; }
        int dev = 0, cus = 0, per_cu = 0;
        if (hipGetDevice(&dev) != hipSuccess || hipDeviceGetAttribute(&cus, hipDeviceAttributeMultiprocessorCount, dev) != hipSuccess) { grid = -1; return; }
        if (hipFuncSetAttribute((const void*)hyb_fwd, hipFuncAttributeMaxDynamicSharedMemorySize, LDS_BYTES) != hipSuccess) { fprintf(stderr, "kernel_launch: hipFuncSetAttribute failed\n"); grid = -1; return; }
        if (hipOccupancyMaxActiveBlocksPerMultiprocessor(&per_cu, (const void*)hyb_fwd, NTHR, LDS_BYTES) != hipSuccess || per_cu < 1) { fprintf(stderr, "kernel_launch: occupancy query says %d\n", per_cu); per_cu = 1; }
        (void)hipGetLastError();
        grid = cus;
    }
    if (grid < 0) return;
    Args a{};
    for (int i = 0; i < 29; ++i) a.in[i] = (const float*)d_in[i];
    a.out = (float*)d_out; a.ws = (unsigned char*)d_ws;
#if MK_N_LAUNCHES == 1
    a.ph_lo = 0; a.ph_hi = N_PHASES;
    void* kargs[] = {&a};
    hipError_t e = hipLaunchCooperativeKernel((const void*)hyb_fwd, dim3(grid), dim3(NTHR), kargs, LDS_BYTES, stream);
    if (e != hipSuccess) fprintf(stderr, "cooperative launch failed: %s (grid %d)\n", hipGetErrorString(e), grid);
#else
    for (int p = 0; p < N_PHASES; ++p) { a.ph_lo = p; a.ph_hi = p + 1; hipLaunchKernelGGL(hyb_fwd, dim3(grid), dim3(NTHR), LDS_BYTES, stream, a); }
#endif
}
```

```cpp
#include <hip/hip_runtime.h>
#include <hip/hip_cooperative_groups.h>
#include <cstdio>
#include <cstdint>
namespace cg = cooperative_groups;

#ifndef MK_N_LAUNCHES
#define MK_N_LAUNCHES 1
#endif

constexpr int NB = 8, SEQ = 2048, NMETA = 16, TT = SEQ + NMETA, DM = 1024;
constexpr int MR = NB * SEQ;
constexpr int MP = MR + 256;
constexpr int DFF = 2816, FCH = 1408;
constexpr int NIN = 2560;
constexpr int PRW = 1792;

namespace pg8 {
#define PG8_LAS __attribute__((address_space(3)))
typedef unsigned short bf16_t;
typedef short bf16x8 __attribute__((ext_vector_type(8)));
typedef float f32x4 __attribute__((ext_vector_type(4)));
typedef unsigned u32x4 __attribute__((ext_vector_type(4)));
constexpr int BM = 256, BK = 64, HALF = 128, HTB = HALF * BK * 2  , STAGE_BYTES = 8 * HTB, NXCD = 8, WGM = 8;

__host__ __device__ __forceinline__ int lds_byte(int r, int c) { const int st = (r >> 4) * 2 + (c >> 5), rr = r & 15, cc = c & 31, ob = rr * 64 + cc * 2; return st * 1024 + (ob ^ (((ob >> 9) & 1) << 5)); }
__host__ __device__ __forceinline__ void stage_rc(int b, int& R, int& C) { const int st = b / 1024, sb = b % 1024, swz = sb ^ (((sb >> 9) & 1) << 5); R = (st >> 1) * 16 + swz / 64; C = (st & 1) * 32 + (swz % 64) / 2; }
__host__ __device__ __forceinline__ int perm32(int rho) { const int n = rho >> 4, i = rho & 15; return 8 * (i >> 2) + 4 * n + (i & 3); }

struct Unit { int pm, pn; };
struct Gemm { const bf16_t* A; const bf16_t* Bt; int M, N, K, lda, ldb; };

struct StaticOrder {
    int nM, nN, nwg, G, c;
    __host__ __device__ void init(int M, int N, int G_, int c_) { nM = M / BM; nN = N / BM; nwg = nM * nN; G = G_; c = c_; }
    __host__ __device__ bool next(int i, Unit& u) const {
        const long L = (long)i * G + c; if (L >= nwg) return false;
        int wgid = (int)L; { const int q = nwg / NXCD, r = nwg % NXCD, xcd = wgid % NXCD, off = wgid / NXCD; wgid = (xcd < r ? xcd * (q + 1) : r * (q + 1) + (xcd - r) * q) + off; }
        const int nig = WGM * nN, gid = wgid / nig, fm = gid * WGM, gsz = (nM - fm) < WGM ? (nM - fm) : WGM;
        u.pm = fm + ((wgid % nig) % gsz); u.pn = (wgid % nig) / gsz; return true;
    }
    __device__ __forceinline__ void a_ready(const Unit&) const {}
    __device__ __forceinline__ void done(const Unit&) const {}
};

__device__ __forceinline__ unsigned cvt_pk_bf16(float lo, float hi) { unsigned r; asm volatile("v_cvt_pk_bf16_f32 %0, %1, %2" : "=v"(r) : "v"(lo), "v"(hi)); return r; }
__device__ __forceinline__ u32x4 pack8(const f32x4 a, const f32x4 b) { u32x4 w; w.x = cvt_pk_bf16(a[0], a[1]); w.y = cvt_pk_bf16(a[2], a[3]); w.z = cvt_pk_bf16(b[0], b[1]); w.w = cvt_pk_bf16(b[2], b[3]); return w; }
__device__ __forceinline__ float sigmoidf_(float x) { return __builtin_amdgcn_rcpf(1.0f + __expf(-x)); }
__device__ __forceinline__ f32x4 sig4(const f32x4 x) { return (f32x4){sigmoidf_(x[0]), sigmoidf_(x[1]), sigmoidf_(x[2]), sigmoidf_(x[3])}; }
__device__ __forceinline__ float row_rstd(const float* part, int row) {
    const f32x4* p = (const f32x4*)(part + (size_t)row * 16); const f32x4 a = p[0], b = p[1], c = p[2], d = p[3];
    const float s = ((a[0] + a[1]) + (a[2] + a[3])) + ((b[0] + b[1]) + (b[2] + b[3])) + ((c[0] + c[1]) + (c[2] + c[3])) + ((d[0] + d[1]) + (d[2] + d[3]));
    return rsqrtf(s * (1.0f / 1024.0f) + 1e-6f);
}
__device__ __forceinline__ int tpos_of_row(int row) { return row < MR ? (NMETA + (row & (SEQ - 1))) : (row < MR + NMETA ? row - MR : 0); }

struct EpiIn0 {
    static constexpr bool PERM = true, AFTER_DRAIN = false;
    bf16_t* U; bf16_t* WC; bf16_t* GB; const float* part;
    __device__ __forceinline__ void operator()(const f32x4 (&acc)[2][2][4][2], const Unit& u, int wr, int wc, int fr, int fq) const {
        const int row0 = u.pm * BM + wr * 64 + fr;
#pragma unroll
        for (int ai = 0; ai < 2; ++ai)
#pragma unroll
            for (int m = 0; m < 4; ++m) {
                const int row = row0 + ai * HALF + m * 16; const float rs = row_rstd(part, row);
                if (u.pn < 8) {
                    bf16_t* dst = (u.pn < 4 ? U : WC) + (size_t)row * 512 + (u.pn & 3) * 128 + wc * 32 + 8 * fq;
                    const f32x4 a0 = acc[ai][0][m][0] * rs, a1 = acc[ai][0][m][1] * rs, b0 = acc[ai][1][m][0] * rs, b1 = acc[ai][1][m][1] * rs;
                    f32x4 o0, o1;
                    if (u.pn < 4) { o0 = a0 * sig4(b0); o1 = a1 * sig4(b1); } else { o0 = a0 * b0; o1 = a1 * b1; }
                    *(u32x4*)dst = pack8(o0, o1);
                } else {
#pragma unroll
                    for (int bj = 0; bj < 2; ++bj) { bf16_t* dst = GB + (size_t)row * 512 + (u.pn - 8) * 256 + bj * HALF + wc * 32 + 8 * fq;
                        *(u32x4*)dst = pack8(acc[ai][bj][m][0] * rs, acc[ai][bj][m][1] * rs); }
                }
            }
    }
};
struct EpiRes {
    static constexpr bool PERM = true, AFTER_DRAIN = false;
    const float* base; float* out; float* hmeta; bf16_t* Abuf; float* part; int mode;
    __device__ __forceinline__ void operator()(const f32x4 (&acc)[2][2][4][2], const Unit& u, int wr, int wc, int fr, int fq) const {
        const float* bp = u.pm < 64 ? base + (size_t)u.pm * BM * DM : hmeta; float* op = u.pm < 64 ? out + (size_t)u.pm * BM * DM : hmeta;
#pragma unroll
        for (int ai = 0; ai < 2; ++ai)
#pragma unroll
            for (int m = 0; m < 4; ++m) {
                const int lr = wr * 64 + fr + ai * HALF + m * 16, row = u.pm * BM + lr; float ss = 0.f;
#pragma unroll
                for (int bj = 0; bj < 2; ++bj) { const int col = u.pn * BM + bj * HALF + wc * 32 + 8 * fq;
                    f32x4 h0 = *(const f32x4*)(bp + (size_t)lr * DM + col), h1 = *(const f32x4*)(bp + (size_t)lr * DM + col + 4);
                    h0 += acc[ai][bj][m][0]; h1 += acc[ai][bj][m][1];
                    *(f32x4*)(op + (size_t)lr * DM + col) = h0; *(f32x4*)(op + (size_t)lr * DM + col + 4) = h1;
                    if (mode) { ss += (h0[0] * h0[0] + h0[1] * h0[1]) + (h0[2] * h0[2] + h0[3] * h0[3]) + (h1[0] * h1[0] + h1[1] * h1[1]) + (h1[2] * h1[2] + h1[3] * h1[3]);
                        *(u32x4*)(Abuf + (size_t)row * DM + col) = pack8(h0, h1); } }
                if (mode) { ss += __shfl_xor(ss, 16); ss += __shfl_xor(ss, 32); if (fq == 0) part[(size_t)row * 16 + u.pn * 4 + wc] = ss; }
            }
    }
};
struct EpiUp {
    static constexpr bool PERM = true, AFTER_DRAIN = false;
    bf16_t* G; bf16_t* V; const float* part;
    __device__ __forceinline__ void operator()(const f32x4 (&acc)[2][2][4][2], const Unit& u, int wr, int wc, int fr, int fq) const {
        const int row0 = u.pm * BM + wr * 64 + fr;
#pragma unroll
        for (int ai = 0; ai < 2; ++ai)
#pragma unroll
            for (int m = 0; m < 4; ++m) {
                const int row = row0 + ai * HALF + m * 16; const float rs = row_rstd(part, row);
                const size_t off = (size_t)row * FCH + u.pn * 128 + wc * 32 + 8 * fq;
                *(u32x4*)(G + off) = pack8(acc[ai][0][m][0] * rs, acc[ai][0][m][1] * rs);
                *(u32x4*)(V + off) = pack8(acc[ai][1][m][0] * rs, acc[ai][1][m][1] * rs);
            }
    }
};
struct EpiIn1 {
    static constexpr bool PERM = true, AFTER_DRAIN = false;
    bf16_t* Q; bf16_t* KB; bf16_t* VB; bf16_t* PR; const float* part; const float* ropec; const float* ropes;
    __device__ __forceinline__ void operator()(const f32x4 (&acc)[2][2][4][2], const Unit& u, int wr, int wc, int fr, int fq) const {
        const int row0 = u.pm * BM + wr * 64 + fr;
#pragma unroll
        for (int ai = 0; ai < 2; ++ai)
#pragma unroll
            for (int m = 0; m < 4; ++m) {
                const int row = row0 + ai * HALF + m * 16; const float rs = row_rstd(part, row);
                if (u.pn >= 3) {
#pragma unroll
                    for (int bj = 0; bj < 2; ++bj) *(u32x4*)(PR + (size_t)row * PRW + (u.pn - 3) * 256 + bj * HALF + wc * 32 + 8 * fq) = pack8(acc[ai][bj][m][0] * rs, acc[ai][bj][m][1] * rs);
                } else {
                    const f32x4 a0 = acc[ai][0][m][0] * rs, a1 = acc[ai][0][m][1] * rs, b0 = acc[ai][1][m][0] * rs, b1 = acc[ai][1][m][1] * rs;
                    if (u.pn == 2 && wc >= 2) {
                        bf16_t* dst = VB + (size_t)row * 128 + (wc - 2) * 64 + 8 * fq;
                        *(u32x4*)dst = pack8(a0, a1); *(u32x4*)(dst + 32) = pack8(b0, b1);
                    } else {
                        const int t = tpos_of_row(row);
                        const f32x4 c0 = *(const f32x4*)(ropec + t * 32 + 8 * fq), c1 = *(const f32x4*)(ropec + t * 32 + 8 * fq + 4);
                        const f32x4 s0 = *(const f32x4*)(ropes + t * 32 + 8 * fq), s1 = *(const f32x4*)(ropes + t * 32 + 8 * fq + 4);
                        const f32x4 x0 = a0 * c0 - b0 * s0, x1 = a1 * c1 - b1 * s1, y0 = b0 * c0 + a0 * s0, y1 = b1 * c1 + a1 * s1;
                        bf16_t* dst = (u.pn == 2) ? KB + (size_t)row * 128 + wc * 64 + 8 * fq : Q + (size_t)row * 512 + (u.pn * 4 + wc) * 64 + 8 * fq;
                        *(u32x4*)dst = pack8(x0, x1); *(u32x4*)(dst + 32) = pack8(y0, y1);
                    }
                }
            }
    }
};

template <class Epi, class Sched, bool ALIGN_EPI = false, bool SP2 = false, int CK = 0, int CLDA = 0, int CLDB = 0>
__device__ __forceinline__ void gemm_phase(PG8_LAS unsigned char* lds, const Gemm g, const Sched& S, const Epi& E, const int tid_in) {
    int tid_ = tid_in; asm volatile("" : "+v"(tid_));
    const int tid = tid_, wid = __builtin_amdgcn_readfirstlane(tid >> 6), lane = tid & 63, wr = wid >> 2, wc = wid & 3, fr = lane & 15, fq = lane >> 4;
    const int K = CK ? CK : g.K, nt = K / BK; const int lda_ = CLDA ? CLDA : g.lda, ldb_ = CLDB ? CLDB : g.ldb;
    unsigned voffA[2], voffB[2];
#pragma unroll
    for (int i = 0; i < 2; ++i) { int R, C; stage_rc(tid * 16 + i * 8192, R, C); const int Rb = Epi::PERM ? ((R & ~31) + perm32(R & 31)) : R;
        voffA[i] = (unsigned)(R * lda_ + C) * 2u; voffB[i] = (unsigned)(Rb * ldb_ + C) * 2u; }
    const size_t kstep = (size_t)(BK * 2);
    const size_t hstepA = (size_t)HALF * lda_ * 2, hstepB = (size_t)HALF * ldb_ * 2;
    const size_t tstepA = 2 * hstepA, tstepB = 2 * hstepB;
    const unsigned ldsw = (unsigned)wid * 1024u;
    const int aoff = lds_byte(wr * 64 + fr, fq * 8), boff = lds_byte(wc * 32 + fr, fq * 8);
#define PG8_SA(b, h) (((b) * 2 + (h)) * HTB)
#define PG8_SB(b, h) ((4 + (b) * 2 + (h)) * HTB)
#define PG8_STAGE(bufoff, gbase, voff) do { _Pragma("unroll") for (int _i = 0; _i < 2; ++_i) \
        __builtin_amdgcn_global_load_lds((const unsigned*)((const char*)(gbase) + (voff)[_i]), (PG8_LAS unsigned*)(lds + (bufoff) + ldsw + _i * 8192), 16, 0, 0); } while (0)
#define PG8_LDA(dst, b, h) do { _Pragma("unroll") for (int m = 0; m < 4; ++m) _Pragma("unroll") for (int k = 0; k < 2; ++k) dst[m][k] = *(const PG8_LAS bf16x8*)(lds + PG8_SA(b, h) + aoff + m * 2048 + k * 1024); } while (0)
#define PG8_LDB(dst, b, h) do { _Pragma("unroll") for (int n = 0; n < 2; ++n) _Pragma("unroll") for (int k = 0; k < 2; ++k) dst[n][k] = *(const PG8_LAS bf16x8*)(lds + PG8_SB(b, h) + boff + n * 2048 + k * 1024); } while (0)
#define PG8_MMA(ai, bj, At, Bt) do { __builtin_amdgcn_s_setprio(1); _Pragma("unroll") for (int m = 0; m < 4; ++m) _Pragma("unroll") for (int n = 0; n < 2; ++n) _Pragma("unroll") for (int k = 0; k < 2; ++k) \
        acc[ai][bj][m][n] = __builtin_amdgcn_mfma_f32_16x16x32_bf16(Bt[n][k], At[m][k], acc[ai][bj][m][n], 0, 0, 0); __builtin_amdgcn_s_setprio(0); } while (0)
#define PG8_WAIT_V(n) asm volatile("s_waitcnt vmcnt(" #n ")" ::: "memory")
#define PG8_WAIT_L(n) asm volatile("s_waitcnt lgkmcnt(" #n ")" ::: "memory")
#define PG8_BAR __builtin_amdgcn_s_barrier()
#define PG8_SCHED __builtin_amdgcn_sched_barrier(0)
    Unit cur, nxt; int ui = 0;
    if (!S.next(0, cur)) return;
    f32x4 acc[2][2][4][2];
#pragma unroll
    for (int a = 0; a < 2; ++a)
#pragma unroll
        for (int b = 0; b < 2; ++b)
#pragma unroll
            for (int m = 0; m < 4; ++m)
#pragma unroll
                for (int n = 0; n < 2; ++n) acc[a][b][m][n] = (f32x4){0.f, 0.f, 0.f, 0.f};
    bf16x8 At[4][2], B0[2][2], B1[2][2];
    const char* cA = (const char*)g.A + (size_t)cur.pm * tstepA; const char* cB = (const char*)g.Bt + (size_t)cur.pn * tstepB;
    S.a_ready(cur);
    if constexpr (SP2) {
        PG8_STAGE(PG8_SB(0, 0), cB, voffB); PG8_STAGE(PG8_SB(0, 1), cB + hstepB, voffB); PG8_STAGE(PG8_SA(0, 0), cA, voffA); PG8_STAGE(PG8_SA(0, 1), cA + hstepA, voffA);
        if (wr == 1) PG8_BAR;
        PG8_WAIT_V(2); PG8_BAR;
        PG8_STAGE(PG8_SB(1, 0), cB + kstep, voffB); PG8_STAGE(PG8_SA(1, 0), cA + kstep, voffA); PG8_STAGE(PG8_SB(1, 1), cB + hstepB + kstep, voffB);
        PG8_WAIT_V(6); PG8_BAR;
    } else {
        PG8_STAGE(PG8_SB(0, 0), cB, voffB); PG8_STAGE(PG8_SA(0, 0), cA, voffA); PG8_STAGE(PG8_SB(0, 1), cB + hstepB, voffB); PG8_STAGE(PG8_SA(0, 1), cA + hstepA, voffA);
        if (wr == 1) PG8_BAR;
        PG8_WAIT_V(4); PG8_BAR;
        PG8_STAGE(PG8_SB(1, 0), cB + kstep, voffB); PG8_STAGE(PG8_SA(1, 0), cA + kstep, voffA); PG8_STAGE(PG8_SB(1, 1), cB + hstepB + kstep, voffB);
        PG8_WAIT_V(6); PG8_BAR;
    }
    for (;;) {
        const bool has_next = S.next(ui + 1, nxt);
        const char* nA = has_next ? (const char*)g.A + (size_t)nxt.pm * tstepA : cA; const char* nB = has_next ? (const char*)g.Bt + (size_t)nxt.pn * tstepB : cB;
        for (int t = 0; t < nt; t += 2) {
            const bool last = (t == nt - 2);
            const char* a1 = cA + (size_t)(t + 1) * kstep;
            const char* a2 = last ? nA : cA + (size_t)(t + 2) * kstep; const char* b2 = last ? nB : cB + (size_t)(t + 2) * kstep;
            const char* a3 = a2 + kstep; const char* b3 = b2 + kstep;
            if (last && has_next) S.a_ready(nxt);
            if constexpr (SP2) {
            PG8_LDB(B0, 0, 0); PG8_LDB(B1, 0, 1); PG8_SCHED; PG8_LDA(At, 0, 0); PG8_STAGE(PG8_SA(1, 1), a1 + hstepA, voffA);
            PG8_WAIT_V(8); PG8_WAIT_L(0); PG8_BAR; PG8_MMA(0, 0, At, B0); PG8_MMA(0, 1, At, B1); PG8_BAR; PG8_SCHED;
            PG8_LDA(At, 0, 1); PG8_STAGE(PG8_SB(0, 0), b2, voffB); PG8_STAGE(PG8_SB(0, 1), b2 + hstepB, voffB); PG8_STAGE(PG8_SA(0, 0), a2, voffA);
            PG8_WAIT_V(8); PG8_WAIT_L(0); PG8_BAR; PG8_MMA(1, 0, At, B0); PG8_MMA(1, 1, At, B1); PG8_BAR; PG8_SCHED;
            PG8_LDB(B0, 1, 0); PG8_LDB(B1, 1, 1); PG8_SCHED; PG8_LDA(At, 1, 0); PG8_STAGE(PG8_SA(0, 1), a2 + hstepA, voffA);
            PG8_WAIT_V(8); PG8_WAIT_L(0); PG8_BAR; PG8_MMA(0, 0, At, B0); PG8_MMA(0, 1, At, B1); PG8_BAR; PG8_SCHED;
            PG8_LDA(At, 1, 1); PG8_STAGE(PG8_SB(1, 0), b3, voffB); PG8_STAGE(PG8_SB(1, 1), b3 + hstepB, voffB); PG8_STAGE(PG8_SA(1, 0), a3, voffA);
            PG8_WAIT_V(8); PG8_WAIT_L(0); PG8_BAR; PG8_MMA(1, 0, At, B0); PG8_MMA(1, 1, At, B1); PG8_BAR; PG8_SCHED;
            } else {
            PG8_LDB(B0, 0, 0); PG8_SCHED; PG8_LDA(At, 0, 0); PG8_STAGE(PG8_SA(1, 1), a1 + hstepA, voffA);
            PG8_WAIT_L(8); PG8_BAR; PG8_WAIT_L(0); PG8_MMA(0, 0, At, B0); PG8_BAR; PG8_SCHED;
            PG8_LDB(B1, 0, 1); PG8_STAGE(PG8_SB(0, 0), b2, voffB);
            PG8_BAR; PG8_WAIT_L(0); PG8_MMA(0, 1, At, B1); PG8_BAR;
            PG8_LDA(At, 0, 1); PG8_STAGE(PG8_SA(0, 0), a2, voffA);
            PG8_BAR; PG8_WAIT_L(0); PG8_MMA(1, 0, At, B0); PG8_BAR; PG8_SCHED;
            PG8_STAGE(PG8_SB(0, 1), b2 + hstepB, voffB);
            PG8_WAIT_V(6); PG8_BAR; PG8_MMA(1, 1, At, B1); PG8_BAR;
            PG8_LDB(B0, 1, 0); PG8_SCHED; PG8_LDA(At, 1, 0); PG8_STAGE(PG8_SA(0, 1), a2 + hstepA, voffA);
            PG8_WAIT_L(8); PG8_BAR; PG8_WAIT_L(0); PG8_MMA(0, 0, At, B0); PG8_BAR; PG8_SCHED;
            PG8_LDB(B1, 1, 1); PG8_STAGE(PG8_SB(1, 0), b3, voffB);
            PG8_BAR; PG8_WAIT_L(0); PG8_MMA(0, 1, At, B1); PG8_BAR;
            PG8_LDA(At, 1, 1); PG8_STAGE(PG8_SA(1, 0), a3, voffA);
            PG8_BAR; PG8_WAIT_L(0); PG8_MMA(1, 0, At, B0); PG8_BAR; PG8_SCHED;
            PG8_STAGE(PG8_SB(1, 1), b3 + hstepB, voffB);
            PG8_WAIT_V(6); PG8_BAR; PG8_MMA(1, 1, At, B1); PG8_BAR;
            }
        }
        if constexpr (ALIGN_EPI) { if (wr == 0) PG8_BAR; }
        if constexpr (!Epi::AFTER_DRAIN) { E(acc, cur, wr, wc, fr, fq); S.done(cur); }
        if (!has_next) break;
#pragma unroll
        for (int a = 0; a < 2; ++a)
#pragma unroll
            for (int b = 0; b < 2; ++b)
#pragma unroll
                for (int m = 0; m < 4; ++m)
#pragma unroll
                    for (int n = 0; n < 2; ++n) acc[a][b][m][n] = (f32x4){0.f, 0.f, 0.f, 0.f};
        cur = nxt; cA = nA; cB = nB; ++ui;
        if constexpr (ALIGN_EPI) { if (wr == 1) PG8_BAR; }
    }
    PG8_WAIT_V(0);
    if constexpr (!ALIGN_EPI) { if (wr == 0) PG8_BAR; }
    PG8_BAR;
    if constexpr (Epi::AFTER_DRAIN) { E.fused(acc, cur, wr, wc, fr, fq, lds, wid, lane); S.done(cur); }
#undef PG8_SA
#undef PG8_SB
#undef PG8_STAGE
#undef PG8_LDA
#undef PG8_LDB
#undef PG8_MMA
#undef PG8_WAIT_V
#undef PG8_WAIT_L
#undef PG8_BAR
#undef PG8_SCHED
}
}

constexpr int NWAVES = 8, NTHR = 512;
constexpr int LDS_BYTES = 147456;
#define GAS __attribute__((address_space(1)))
#define LAS __attribute__((address_space(3)))
typedef unsigned short bf16;
typedef unsigned v4u __attribute__((ext_vector_type(4)));
typedef unsigned v2u __attribute__((ext_vector_type(2)));
typedef float f32x4 __attribute__((ext_vector_type(4)));
typedef float f32x2 __attribute__((ext_vector_type(2)));
typedef float f32x16 __attribute__((ext_vector_type(16)));
typedef short bf16x8 __attribute__((ext_vector_type(8)));
typedef short s16x4 __attribute__((ext_vector_type(4)));

constexpr size_t MiB = 1u << 20;
constexpr size_t WS_CTL = 0;
constexpr size_t WS_PART = 1 * MiB;
constexpr size_t WS_ROPE = 3 * MiB;
constexpr size_t WS_HMETA = 4 * MiB;
constexpr size_t WS_LORA = 5 * MiB;
constexpr size_t WS_W = 6 * MiB;
constexpr size_t W_IN0 = WS_W, W_OUT0 = W_IN0 + (size_t)NIN * DM * 2, W_UP0 = W_OUT0 + (size_t)DM * DM * 2, W_DN0 = W_UP0 + (size_t)2 * DFF * DM * 2,
                 W_IN1 = W_DN0 + (size_t)DM * DFF * 2, W_OUT1 = W_IN1 + (size_t)NIN * DM * 2, W_UP1 = W_OUT1 + (size_t)DM * DM * 2, W_DN1 = W_UP1 + (size_t)2 * DFF * DM * 2,
                 W_END = W_DN1 + (size_t)DM * DFF * 2;
constexpr size_t WS_A = 56 * MiB;
constexpr size_t WS_R = 89 * MiB;
static_assert(W_END <= WS_A && WS_A + (size_t)MP * DM * 2 <= WS_R, "ws map");
constexpr size_t R_U = WS_R, R_WC = R_U + (size_t)MP * 512 * 2, R_GB = R_WC + (size_t)MP * 512 * 2, R_Y0 = R_GB + (size_t)MP * 512 * 2;
constexpr size_t R_G = WS_R, R_V = R_G + (size_t)MP * FCH * 2, R_HM = R_V + (size_t)MP * FCH * 2, R_FFN_END = R_HM + (size_t)MP * FCH * 2;
constexpr size_t R_Q = WS_R, R_KB = R_Q + (size_t)MP * 512 * 2, R_VB = R_KB + (size_t)MP * 128 * 2, R_PR = R_VB + (size_t)MP * 128 * 2, R_Y1 = R_PR + (size_t)MP * PRW * 2, R_L1_END = R_Y1 + (size_t)MP * DM * 2;
constexpr size_t WS_END = 256 * MiB;
static_assert(R_FFN_END <= WS_END && R_L1_END <= WS_END && R_Y0 + (size_t)MP * DM * 2 <= WS_END, "ws map 2");

#define LDS_WAIT() asm volatile("s_waitcnt lgkmcnt(0)" ::: "memory")
__device__ __forceinline__ unsigned f2bf(float f) { unsigned u = __builtin_bit_cast(unsigned, f); return (u + 0x7fffu + ((u >> 16) & 1u)) >> 16; }
__device__ __forceinline__ unsigned pk2(float lo, float hi) { return f2bf(lo) | (f2bf(hi) << 16); }
__device__ __forceinline__ float bf2f(unsigned short v) { return __builtin_bit_cast(float, (unsigned)v << 16); }
__device__ __forceinline__ float bflo(unsigned w) { return __builtin_bit_cast(float, w << 16); }
__device__ __forceinline__ float bfhi(unsigned w) { return __builtin_bit_cast(float, w & 0xffff0000u); }
__device__ __forceinline__ float sigm(float x) { return __builtin_amdgcn_rcpf(1.0f + __expf(-x)); }
__device__ __forceinline__ float dppf(float x, int ctrl_sel) {
    const int v = __builtin_bit_cast(int, x); int r;
    if (ctrl_sel == 0) r = __builtin_amdgcn_update_dpp(v, v, 0xB1, 0xF, 0xF, false);
    else if (ctrl_sel == 1) r = __builtin_amdgcn_update_dpp(v, v, 0x4E, 0xF, 0xF, false);
    else if (ctrl_sel == 2) r = __builtin_amdgcn_update_dpp(v, v, 0x141, 0xF, 0xF, false);
    else r = __builtin_amdgcn_update_dpp(v, v, 0x140, 0xF, 0xF, false);
    return __builtin_bit_cast(float, r);
}
__device__ __forceinline__ float sum16(float x) { x += dppf(x, 0); x += dppf(x, 1); x += dppf(x, 2); x += dppf(x, 3); return x; }

__device__ __forceinline__ void sum16x2(float& x0, float& x1) {
    asm volatile("s_nop 1\n\t"
        "v_add_f32_dpp %0, %0, %0 quad_perm:[1,0,3,2] row_mask:0xf bank_mask:0xf\n\t"
        "v_add_f32_dpp %1, %1, %1 quad_perm:[1,0,3,2] row_mask:0xf bank_mask:0xf\n\t"
        "s_nop 0\n\t"
        "v_add_f32_dpp %0, %0, %0 quad_perm:[2,3,0,1] row_mask:0xf bank_mask:0xf\n\t"
        "v_add_f32_dpp %1, %1, %1 quad_perm:[2,3,0,1] row_mask:0xf bank_mask:0xf\n\t"
        "s_nop 0\n\t"
        "v_add_f32_dpp %0, %0, %0 row_half_mirror row_mask:0xf bank_mask:0xf\n\t"
        "v_add_f32_dpp %1, %1, %1 row_half_mirror row_mask:0xf bank_mask:0xf\n\t"
        "s_nop 0\n\t"
        "v_add_f32_dpp %0, %0, %0 row_mirror row_mask:0xf bank_mask:0xf\n\t"
        "v_add_f32_dpp %1, %1, %1 row_mirror row_mask:0xf bank_mask:0xf\n\t"
        "s_nop 1"
        : "+v"(x0), "+v"(x1));
}
__device__ __forceinline__ float sum32(float x) { x = sum16(x); x += __shfl_xor(x, 16); return x; }
__device__ __forceinline__ float wave_sum(float v) {
#pragma unroll
    for (int o = 1; o < 64; o <<= 1) v += __shfl_xor(v, o);
    return v;
}
__device__ __forceinline__ int row_of(int b, int t) { return t >= NMETA ? b * SEQ + (t - NMETA) : MR + t; }


#define XB_TMO      128
#define XB_XCNT(j)  (256  + 64 * (j))
#define XB_XSUB(j)  (1280 + 64 * (j))
#define XB_XGEN(j)  (2304 + 64 * (j))
#define XB_TOP      3328
#define XB_TOPGEN   3392
#define XCD_BAR_WORDS 3456
#define XB_SPIN_CAP (1u << 18)
constexpr int LDSCTL_OFF = 147328, MISC_OFF = LDSCTL_OFF;
__device__ __forceinline__ unsigned xb_ld(unsigned* p)              { return __hip_atomic_load(p, __ATOMIC_RELAXED, __HIP_MEMORY_SCOPE_AGENT); }
__device__ __forceinline__ unsigned xb_add(unsigned* p, unsigned v) { return __hip_atomic_fetch_add(p, v, __ATOMIC_RELAXED, __HIP_MEMORY_SCOPE_AGENT); }
__device__ __forceinline__ unsigned xb_xcc_id() { return (unsigned)__builtin_amdgcn_s_getreg((3 << 11) | 20) & 0xFu; }
#define XB_SPIN(cond, bar) do { unsigned _sp = 0; while (cond) { __builtin_amdgcn_s_sleep(1); \
    if ((++_sp & 255u) == 0u) { if (xb_ld(&(bar)[XB_TMO])) break; if (_sp > XB_SPIN_CAP) { atomicAdd(&(bar)[XB_TMO], 1u); break; } } } } while (0)
__device__ __forceinline__ void xcd_barrier_complete(unsigned* bar, unsigned x, unsigned& nloc, unsigned& nx) {
    const unsigned G = gridDim.x * gridDim.y * gridDim.z;
    unsigned sum, cnt, mine, sp = 0u;
    for (;;) {
        sum = 0u; cnt = 0u; mine = 0u;
#pragma unroll
        for (unsigned j = 0; j < 16; ++j) { const unsigned c = xb_ld(&bar[XB_XCNT(j)]); sum += c; cnt += (c > 0u) ? 1u : 0u; mine = (j == x) ? c : mine; }
        if (sum == G) break;
        __builtin_amdgcn_s_sleep(1);
        if ((++sp & 255u) == 0u) { if (xb_ld(&bar[XB_TMO])) break; if (sp > XB_SPIN_CAP) { atomicAdd(&bar[XB_TMO], 1u); break; } }
    }
    nloc = mine > 0u ? mine : 1u; nx = cnt > 0u ? cnt : 1u;
}
__device__ __forceinline__ void xcd_barrier(unsigned* bar, volatile LAS unsigned* st, bool t0) {
    asm volatile("s_waitcnt vmcnt(0)" ::: "memory");
    __syncthreads();
    if (t0) {
        const unsigned x = xb_xcc_id();
        __builtin_amdgcn_s_waitcnt(0);
        unsigned nloc = st[0], nx = st[1];
        if (nloc == 0u) { xcd_barrier_complete(bar, x, nloc, nx); st[0] = nloc; st[1] = nx; }
        const unsigned old = xb_add(&bar[XB_XSUB(x)], 1u);
        const unsigned gen = old / nloc;
        if (old + 1u == (gen + 1u) * nloc) {
            __builtin_amdgcn_fence(__ATOMIC_RELEASE, "agent");
            asm volatile("s_waitcnt vmcnt(0)" ::: "memory");
            const unsigned og = xb_add(&bar[XB_TOP], 1u);
            const unsigned tg = og / nx;
            if (og + 1u == (tg + 1u) * nx) xb_add(&bar[XB_TOPGEN], 1u);
            else XB_SPIN(xb_ld(&bar[XB_TOPGEN]) == tg, bar);
            __builtin_amdgcn_fence(__ATOMIC_ACQUIRE, "agent");
            xb_add(&bar[XB_XGEN(x)], 1u);
            asm volatile("s_waitcnt vmcnt(0)" ::: "memory");
        } else {
            XB_SPIN(xb_ld(&bar[XB_XGEN(x)]) == gen, bar);
            __builtin_amdgcn_fence(__ATOMIC_ACQUIRE, "agent");
            asm volatile("s_waitcnt vmcnt(0)" ::: "memory");
        }
    }
    __syncthreads();
}

struct Args { const float* in[29]; float* out; unsigned char* ws; int ph_lo, ph_hi; };
typedef const __attribute__((address_space(4))) Args CArgs;

struct Frame {
    LAS unsigned char* lds; int tid, lane, wave, G, wg;
    float* out; unsigned char* ws;
};

__device__ __forceinline__ int colmap(int kind, int d) {
    if (kind == 0) return d;
    const int tile = d >> 8, bj = (d >> 7) & 1, cc = d & 127;
    if (kind == 1) {
        if (tile < 4) return (bj ? 512 : 0) + 128 * tile + cc;
        if (tile < 8) return (bj ? 2048 : 1536) + 128 * (tile - 4) + cc;
        return 1024 + (d - 2048);
    }
    if (kind == 2) return (bj ? DFF : 0) + 128 * tile + cc;
    const int w = cc >> 5, dd = cc & 31;
    if (tile < 2) return 64 * (4 * tile + w) + 32 * bj + dd;
    if (tile == 2) return (w < 2 ? 512 + 64 * w : 640 + 64 * (w - 2)) + 32 * bj + dd;
    return d;
}
__device__ __forceinline__ void p0_transpose_item(const float* W, int K, int N, bf16* WT, const float* gvec, int kind, LAS float* scr, int item, int nblk, int lane) {
    const int kb = item / nblk, db = item % nblk, k0 = 64 * kb, d0 = 32 * db, n0 = colmap(kind, d0);
#pragma unroll 8
    for (int i = 0; i < 32; ++i) { const int kk = 2 * i + (lane >> 5); float v = W[(size_t)(k0 + kk) * N + n0 + (lane & 31)]; if (gvec) v *= gvec[k0 + kk]; scr[kk * 33 + (lane & 31)] = v; }
    LDS_WAIT(); asm volatile("" ::: "memory");
    const int c = lane & 7;
#pragma unroll
    for (int j = 0; j < 4; ++j) { const int n = (lane >> 3) + 8 * j; const LAS float* s = scr + (8 * c) * 33 + n;
        v4u o; o.x = pk2(s[0 * 33], s[1 * 33]); o.y = pk2(s[2 * 33], s[3 * 33]); o.z = pk2(s[4 * 33], s[5 * 33]); o.w = pk2(s[6 * 33], s[7 * 33]);
        *(GAS v4u*)(WT + (size_t)(d0 + n) * K + k0 + 8 * c) = o; }
    LDS_WAIT(); asm volatile("" ::: "memory");
}
__device__ __forceinline__ void p0_job(Frame& F, LAS float* scr, int gw, int NGW, int& base, const float* W, int K, int N, size_t dst, const float* g, int kind) {
    const int nblk = N / 32, nitems = (K / 64) * nblk;
    int it = gw - (base % NGW); if (it < 0) it += NGW;
    for (; it < nitems; it += NGW) p0_transpose_item(W, K, N, (bf16*)(F.ws + dst), g, kind, scr, it, nblk, F.lane);
    base += nitems;
}
__device__ __forceinline__ void p0_prologue(Frame& F, CArgs& A) {
    LAS float* scr = (LAS float*)(F.lds + F.wave * 16384);
    const int gw = F.wg * NWAVES + F.wave, NGW = F.G * NWAVES, lane = F.lane;
    unsigned char* ws = F.ws;
    const float* norm_mix = A.in[2]; const float* norm_ffn = A.in[3];
    int base = 0;
    p0_job(F, scr, gw, NGW, base, A.in[5], DM, NIN, W_IN0, norm_mix, 1);
    p0_job(F, scr, gw, NGW, base, A.in[10], DM, DM, W_OUT0, nullptr, 0);
    p0_job(F, scr, gw, NGW, base, A.in[25], DM, 2 * DFF, W_UP0, norm_ffn, 2);
    p0_job(F, scr, gw, NGW, base, A.in[28], DFF, DM, W_DN0, nullptr, 0);
    p0_job(F, scr, gw, NGW, base, A.in[11], DM, NIN, W_IN1, norm_mix + DM, 3);
    p0_job(F, scr, gw, NGW, base, A.in[24], DM, DM, W_OUT1, nullptr, 0);
    p0_job(F, scr, gw, NGW, base, A.in[25] + (size_t)DM * 2 * DFF, DM, 2 * DFF, W_UP1, norm_ffn + DM, 2);
    p0_job(F, scr, gw, NGW, base, A.in[28] + (size_t)DFF * DM, DFF, DM, W_DN1, nullptr, 0);
    p0_job(F, scr, gw, NGW, base, A.in[15], 64, 512, WS_LORA, nullptr, 0);
    p0_job(F, scr, gw, NGW, base, A.in[17], 64, 512, WS_LORA + 512 * 64 * 2, nullptr, 0);
    p0_job(F, scr, gw, NGW, base, A.in[18], 128, 512, WS_LORA + 2 * 512 * 64 * 2, nullptr, 0);
    const float* x = A.in[0]; const float* meta = A.in[1];
    bf16* A0 = (bf16*)(ws + WS_A); float* part = (float*)(ws + WS_PART); float* hmeta = (float*)(ws + WS_HMETA);
    for (int row = gw; row < MP; row += NGW) {
        float* pp = part + (size_t)row * 16;
        if (row < MR + NMETA) {
            const float* src = row < MR ? x + (size_t)row * DM : meta + (size_t)(row - MR) * DM;
            float ss = 0.f;
#pragma unroll
            for (int j = 0; j < 4; ++j) { const f32x4 v = *(const GAS f32x4*)(src + j * 256 + lane * 4); ss += (v[0] * v[0] + v[1] * v[1]) + (v[2] * v[2] + v[3] * v[3]);
                v2u o; o.x = pk2(v[0], v[1]); o.y = pk2(v[2], v[3]); *(GAS v2u*)(A0 + (size_t)row * DM + j * 256 + lane * 4) = o;
                if (row >= MR) *(GAS f32x4*)(hmeta + (size_t)(row - MR) * DM + j * 256 + lane * 4) = v; }
            ss = wave_sum(ss);
            if (lane < 16) pp[lane] = lane == 0 ? ss : 0.f;
        } else {
            if (lane < 16) pp[lane] = 0.f;
#pragma unroll
            for (int j = 0; j < 4; ++j) { float zf; asm volatile("v_mov_b32 %0, 0" : "=v"(zf)); *(GAS f32x4*)(hmeta + (size_t)(row - MR) * DM + j * 256 + lane * 4) = (f32x4){zf, zf, zf, zf}; }
        }
    }
    float* rc = (float*)(ws + WS_ROPE); float* rsn = rc + TT * 32;
    for (int i = gw * 64 + lane; i < TT * 32; i += NGW * 64) {
        const int t = i >> 5, d = i & 31;
        const float inv = exp2f(-(float)d * (13.287712379549449f / 32.0f));
        const float ang = (float)t * inv;
        const float rev = ang * 0.15915494309189535f; const float a = (rev - floorf(rev)) * 6.283185307179586f;
        rc[i] = __cosf(a); rsn[i] = __sinf(a);
    }
}

__device__ __forceinline__ void conv0_phase(Frame& F, CArgs& A) {
    const bf16* U = (const bf16*)(F.ws + R_U); const bf16* WC = (const bf16*)(F.ws + R_WC); const bf16* GB = (const bf16*)(F.ws + R_GB); bf16* Y0 = (bf16*)(F.ws + R_Y0);
    const float* conv_a = A.in[6]; const float* ln_g = A.in[7]; const float* ln_b = A.in[8]; const float* conv_b = A.in[9];
    const int half = F.tid >> 8, ht = F.tid & 255, c0 = 2 * ht;
    LAS float* tile = (LAS float*)(F.lds + half * 40960);
    LAS float* stats = (LAS float*)(F.lds + half * 40960 + 32768);
    float wa[31][2];
#pragma unroll
    for (int j = 0; j < 31; ++j) { const f32x2 w = *(const f32x2*)(conv_a + j * 512 + c0); wa[j][0] = w.x; wa[j][1] = w.y; }
    float wb[3][2];
#pragma unroll
    for (int j = 0; j < 3; ++j) { const f32x2 w = *(const f32x2*)(conv_b + j * 512 + c0); wb[j][0] = w.x; wb[j][1] = w.y; }
    const f32x2 lg = *(const f32x2*)(ln_g + c0), lb = *(const f32x2*)(ln_b + c0);
    const int NU = NB * 128 + 1;
    const int nhu = 2 * F.G;
    for (int u0 = 0; u0 < NU; u0 += nhu) {
        const int u = u0 + F.wg * 2 + half; const bool act = u < NU;
        int b = 0, t0 = 0; if (act) { if (u == NB * 128) { b = 0; t0 = 0; } else { b = u >> 7; t0 = 16 + 16 * (u & 127); } }
        if (act) {
            unsigned uin[46];
#pragma unroll
            for (int i = 0; i < 46; ++i) { const int t = t0 - 30 + i; uin[i] = t >= 0 ? *(const unsigned*)(U + (size_t)row_of(b, t) * 512 + c0) : 0u; }
#pragma unroll
            for (int o = 0; o < 16; ++o) { float a0 = 0.f, a1 = 0.f;
#pragma unroll
                for (int j = 0; j < 31; ++j) { a0 += wa[j][0] * bflo(uin[o + j]); a1 += wa[j][1] * bfhi(uin[o + j]); }
                *(LAS f32x2*)(tile + o * 512 + c0) = (f32x2){a0, a1}; }
        }
        __syncthreads();
        if (act) {
            const int tok = ht >> 4, q = ht & 15; float s = 0.f, ss = 0.f;
#pragma unroll
            for (int i = 0; i < 8; ++i) { const f32x4 v = *(const LAS f32x4*)(tile + tok * 512 + i * 64 + q * 4); s += (v[0] + v[1]) + (v[2] + v[3]); ss += (v[0] * v[0] + v[1] * v[1]) + (v[2] * v[2] + v[3] * v[3]); }
            s = sum16(s); ss = sum16(ss);
            if (q == 0) { const float mu = s * (1.f / 512.f); float var = ss * (1.f / 512.f) - mu * mu; var = var < 0.f ? 0.f : var; stats[tok * 2] = mu; stats[tok * 2 + 1] = rsqrtf(var + 1e-5f); }
        }
        __syncthreads();
        if (act) {
            unsigned win[18];
#pragma unroll
            for (int i = 0; i < 18; ++i) { const int t = t0 - 2 + i; win[i] = t >= 0 ? *(const unsigned*)(WC + (size_t)row_of(b, t) * 512 + c0) : 0u; }
#pragma unroll
            for (int o = 0; o < 16; ++o) {
                const int row = row_of(b, t0 + o);
                const f32x2 v = *(const LAS f32x2*)(tile + o * 512 + c0); const float mu = stats[o * 2], rs = stats[o * 2 + 1];
                float y0 = (v.x - mu) * rs * lg.x + lb.x, y1 = (v.y - mu) * rs * lg.y + lb.y; y0 *= sigm(y0); y1 *= sigm(y1);
                *(unsigned*)(Y0 + (size_t)row * DM + c0) = pk2(y0, y1);
                float z0 = 0.f, z1 = 0.f;
#pragma unroll
                for (int j = 0; j < 3; ++j) { z0 += wb[j][0] * bflo(win[o + j]); z1 += wb[j][1] * bfhi(win[o + j]); }
                const unsigned gbv = *(const unsigned*)(GB + (size_t)row * 512 + c0);
                *(unsigned*)(Y0 + (size_t)row * DM + 512 + c0) = pk2(z0 * bflo(gbv), z1 * bfhi(gbv));
            }
        }
        __syncthreads();
    }
}

__device__ __forceinline__ void ffn_mid_phase(Frame& F, CArgs& A, int layer, int chunk) {
    const bf16* G = (const bf16*)(F.ws + R_G); const bf16* V = (const bf16*)(F.ws + R_V); bf16* HM = (bf16*)(F.ws + R_HM);
    const float* cw = A.in[26] + (size_t)layer * 3 * DFF + chunk * FCH; const float* cb = A.in[27] + (size_t)layer * DFF + chunk * FCH;
    constexpr int NCG = FCH / 8;
    const int NITEM = (NB * 128 + 1) * NCG;
    for (int it = F.wg * NTHR + F.tid; it < NITEM; it += F.G * NTHR) {
        const int cgp = it % NCG, blk = it / NCG, c0 = cgp * 8;
        int b, t0; if (blk == NB * 128) { b = 0; t0 = 0; } else { b = blk >> 7; t0 = 16 + 16 * (blk & 127); }
        float w0[8], w1[8], w2[8], bb[8];
#pragma unroll
        for (int e = 0; e < 8; ++e) { w0[e] = cw[c0 + e]; w1[e] = cw[DFF + c0 + e]; w2[e] = cw[2 * DFF + c0 + e]; bb[e] = cb[c0 + e]; }
        float g2[8], g1[8];
#pragma unroll
        for (int e = 0; e < 8; ++e) { g2[e] = 0.f; g1[e] = 0.f; }
        if (t0 >= 2) { const v4u a = *(const v4u*)(G + (size_t)row_of(b, t0 - 2) * FCH + c0), c = *(const v4u*)(G + (size_t)row_of(b, t0 - 1) * FCH + c0);
#pragma unroll
            for (int e = 0; e < 4; ++e) { g2[2 * e] = bflo(a[e]); g2[2 * e + 1] = bfhi(a[e]); g1[2 * e] = bflo(c[e]); g1[2 * e + 1] = bfhi(c[e]); } }
#pragma unroll 4
        for (int o = 0; o < 16; ++o) {
            const size_t off = (size_t)row_of(b, t0 + o) * FCH + c0;
            const v4u gv = *(const v4u*)(G + off), vv = *(const v4u*)(V + off);
            float g0[8], vf[8];
#pragma unroll
            for (int e = 0; e < 4; ++e) { g0[2 * e] = bflo(gv[e]); g0[2 * e + 1] = bfhi(gv[e]); vf[2 * e] = bflo(vv[e]); vf[2 * e + 1] = bfhi(vv[e]); }
            float r[8];
#pragma unroll
            for (int e = 0; e < 8; ++e) { const float z = w0[e] * g2[e] + w1[e] * g1[e] + w2[e] * g0[e] + bb[e]; r[e] = z * sigm(z) * vf[e]; g2[e] = g1[e]; g1[e] = g0[e]; }
            v4u o4; o4.x = pk2(r[0], r[1]); o4.y = pk2(r[2], r[3]); o4.z = pk2(r[4], r[5]); o4.w = pk2(r[6], r[7]);
            *(v4u*)(HM + off) = o4;
        }
    }
}

__device__ __forceinline__ int crow(int r, int hi) { return (r & 3) + 8 * (r >> 2) + 4 * hi; }
constexpr int ATT_KS = 72, ATT_VS = 232, ATT_K_BYTES = 224 * ATT_KS * 2;
__device__ __forceinline__ void attn_unit(Frame& F, const float* sinks, int b, int kvh, int qb) {
    const bf16* Q = (const bf16*)(F.ws + R_Q); const bf16* KB = (const bf16*)(F.ws + R_KB); const bf16* VB = (const bf16*)(F.ws + R_VB); bf16* Y1 = (bf16*)(F.ws + R_Y1);
    LAS bf16* Ks = (LAS bf16*)F.lds; LAS bf16* Vt = (LAS bf16*)(F.lds + ATT_K_BYTES);
    const int tid = F.tid, lane = F.lane, wave = F.wave, g = wave >> 1, half = wave & 1, qh = kvh * 4 + g, qi = lane & 31, hi = lane >> 5;
    const bool meta = qb < 0; const int q0 = meta ? 0 : 64 * qb;
#pragma unroll
    for (int i = 0; i < 4; ++i) {
        const int id = tid + 512 * i, key = id >> 3, ch = id & 7;
        if (key < 224) {
            int row = -1;
            if (key < 192) { const int sp = q0 - 128 + key; if (!meta && sp >= 0) row = b * SEQ + sp; }
            else if (key < 208) row = MR + (key - 192);
            v4u kv = (v4u){0u, 0u, 0u, 0u}, vv = (v4u){0u, 0u, 0u, 0u};
            if (row >= 0) { kv = *(const v4u*)(KB + (size_t)row * 128 + kvh * 64 + ch * 8); vv = *(const v4u*)(VB + (size_t)row * 128 + kvh * 64 + ch * 8); }
            *(LAS v4u*)(Ks + key * ATT_KS + ch * 8) = kv;
#pragma unroll
            for (int e = 0; e < 4; ++e) { Vt[(ch * 8 + 2 * e) * ATT_VS + key] = (bf16)(vv[e] & 0xffffu); Vt[(ch * 8 + 2 * e + 1) * ATT_VS + key] = (bf16)(vv[e] >> 16); }
        }
    }
    __syncthreads();
    int qrow; if (meta) { const int m = 32 * half + qi; qrow = MR + (m < NMETA ? m : NMETA - 1); } else qrow = b * SEQ + q0 + 32 * half + qi;
    bf16x8 qr[4];
#pragma unroll
    for (int k4 = 0; k4 < 4; ++k4) qr[k4] = *(const bf16x8*)(Q + (size_t)qrow * 512 + qh * 64 + 16 * k4 + 8 * hi);
    f32x16 sc[6];
#pragma unroll
    for (int i = 0; i < 6; ++i) {
        const int t = i < 5 ? half + i : 6;
        f32x16 a = (f32x16){0.f,0.f,0.f,0.f,0.f,0.f,0.f,0.f,0.f,0.f,0.f,0.f,0.f,0.f,0.f,0.f};
#pragma unroll
        for (int k4 = 0; k4 < 4; ++k4) { const bf16x8 kf = *(const LAS bf16x8*)(Ks + (32 * t + qi) * ATT_KS + 16 * k4 + 8 * hi); a = __builtin_amdgcn_mfma_f32_32x32x16_bf16(kf, qr[k4], a, 0, 0, 0); }
        sc[i] = a;
    }
    const float sink = sinks[qh]; float mx = sink;
    const int mq = 32 * half + qi;
#pragma unroll
    for (int i = 0; i < 6; ++i)
#pragma unroll
        for (int r = 0; r < 16; ++r) {
            const int kr = crow(r, hi); bool ok;
            if (i < 5) { const int dist = 128 - 32 * i + qi - kr; const int sp = q0 - 128 + 32 * (half + i) + kr; ok = !meta && dist >= 0 && dist < 128 && sp >= 0; }
            else ok = kr < NMETA && (!meta || kr <= mq);
            const float v = ok ? sc[i][r] * 0.125f : -1e30f; sc[i][r] = v; mx = fmaxf(mx, v);
        }
    mx = fmaxf(mx, __shfl_xor(mx, 32));
    float ls = 0.f;
#pragma unroll
    for (int i = 0; i < 6; ++i)
#pragma unroll
        for (int r = 0; r < 16; ++r) { const float p = __expf(sc[i][r] - mx); sc[i][r] = p; ls += p; }
    ls += __shfl_xor(ls, 32); ls += __expf(sink - mx);
    const float inv = 1.0f / ls;
    f32x16 o[2];
    o[0] = (f32x16){0.f,0.f,0.f,0.f,0.f,0.f,0.f,0.f,0.f,0.f,0.f,0.f,0.f,0.f,0.f,0.f}; o[1] = o[0];
#pragma unroll
    for (int i = 0; i < 6; ++i) {
        const int t = i < 5 ? half + i : 6;
#pragma unroll
        for (int s2 = 0; s2 < 2; ++s2) {
            v4u pw; pw.x = pg8::cvt_pk_bf16(sc[i][8 * s2 + 0], sc[i][8 * s2 + 1]); pw.y = pg8::cvt_pk_bf16(sc[i][8 * s2 + 2], sc[i][8 * s2 + 3]);
            pw.z = pg8::cvt_pk_bf16(sc[i][8 * s2 + 4], sc[i][8 * s2 + 5]); pw.w = pg8::cvt_pk_bf16(sc[i][8 * s2 + 6], sc[i][8 * s2 + 7]);
            const bf16x8 pa = __builtin_bit_cast(bf16x8, pw);
#pragma unroll
            for (int dt = 0; dt < 2; ++dt) {
                const LAS bf16* vp = Vt + (dt * 32 + qi) * ATT_VS + 32 * t + 16 * s2 + 4 * hi;
                const v2u lo = *(const LAS v2u*)vp, hh = *(const LAS v2u*)(vp + 8);
                const v4u vw = (v4u){lo.x, lo.y, hh.x, hh.y};
                o[dt] = __builtin_amdgcn_mfma_f32_32x32x16_bf16(pa, __builtin_bit_cast(bf16x8, vw), o[dt], 0, 0, 0);
            }
        }
    }
#pragma unroll
    for (int r = 0; r < 16; ++r) {
        const int qq = crow(r, hi); const float iv = __shfl(inv, qq);
        int orow; bool ok = true;
        if (meta) { const int m = 32 * half + qq; ok = m < NMETA; orow = MR + m; } else orow = b * SEQ + q0 + 32 * half + qq;
        if (ok) {
            Y1[(size_t)orow * DM + qh * 64 + qi] = (bf16)f2bf(o[0][r] * iv);
            Y1[(size_t)orow * DM + qh * 64 + 32 + qi] = (bf16)f2bf(o[1][r] * iv);
        }
    }
    __syncthreads();
}

constexpr int IMG_PT = 0, IMG_BK = 4096, IMG_VT = 8192, IMG_QT = 10240, IMG_W16 = 11264, IMG_BYTES = 11520;
constexpr int NBLK = 129, NBLK_H1 = 65;
constexpr size_t WS_IMG = 203 * MiB;
constexpr size_t WS_G = WS_A, WS_RK = WS_A + 17 * MiB, WS_ZS = WS_A + 18 * MiB;
static_assert(WS_IMG >= R_L1_END && WS_IMG + (size_t)64 * NBLK_H1 * IMG_BYTES <= WS_END, "image region");
constexpr int P_PRL = 0, P_XR = 15616, P_XK = P_XR + 4096, P_XV = P_XK + 4096, P_TW = P_XV + 4096, P_XA = P_TW + 2304, P_SG = P_XA + 2304,
              P_LW = P_SG + 4352, P_LA = P_LW + 4096, P_LG = P_LA + 4096, P_FW = P_LG + 4096, P_FK = P_FW + 4096, P_FA = P_FK + 4096, P_FB = P_FA + 4096,
              P_WC = P_FB + 4096, P_E1 = P_WC + 4096, P_E2 = P_E1 + 4608, P_ATF = P_E2 + 4608, P_RTF = P_ATF + 4096, P_M = P_RTF + 4096, P_T = P_M + 4224, P_PTF = P_T + 1088,
              P_QF = P_PTF + 4096, P_IMG = P_QF + 1088, P_END = P_IMG + IMG_BYTES;
static_assert(P_END <= 131072 && (P_IMG % 16) == 0 && (P_E1 % 16) == 0 && (P_E2 % 16) == 0, "prep lds map");
constexpr int PRS = 456;
__device__ __forceinline__ float wsum64(float x) { x = sum16(x); x += __shfl_xor(x, 16); x += __shfl_xor(x, 32); return x; }

__device__ __forceinline__ void rwkv_prep_unit(Frame& F, CArgs& A, int chain, int n) {
    const int b = chain >> 3, h = chain & 7;
    const bf16* PR = (const bf16*)(F.ws + R_PR);
    const bf16* w2t = (const bf16*)(F.ws + WS_LORA); const bf16* a2t = w2t + 512 * 64; const bf16* g2t = a2t + 512 * 64;
    const float* mu = A.in[13]; const float* w0 = A.in[14]; const float* a0 = A.in[16]; const float* k_k = A.in[19]; const float* k_a = A.in[20]; const float* r_k = A.in[21];
    const int tid = F.tid, lane = F.lane, wave = F.wave;
    LAS unsigned char* L = F.lds;
    LAS bf16* PRL = (LAS bf16*)(L + P_PRL);
    LAS float* XR = (LAS float*)(L + P_XR); LAS float* XK = (LAS float*)(L + P_XK); LAS float* XV = (LAS float*)(L + P_XV);
    LAS bf16* TW = (LAS bf16*)(L + P_TW); LAS bf16* XA = (LAS bf16*)(L + P_XA); LAS bf16* SG = (LAS bf16*)(L + P_SG);
    LAS float* LW = (LAS float*)(L + P_LW); LAS float* LA = (LAS float*)(L + P_LA); LAS float* LG = (LAS float*)(L + P_LG);
    LAS float* FW = (LAS float*)(L + P_FW); LAS float* FK = (LAS float*)(L + P_FK); LAS float* FA = (LAS float*)(L + P_FA); LAS float* FB = (LAS float*)(L + P_FB);
    LAS float* WC = (LAS float*)(L + P_WC); LAS bf16* E1 = (LAS bf16*)(L + P_E1); LAS bf16* E2 = (LAS bf16*)(L + P_E2);
    LAS float* ATF = (LAS float*)(L + P_ATF); LAS float* RTF = (LAS float*)(L + P_RTF); LAS float* M = (LAS float*)(L + P_M); LAS float* T = (LAS float*)(L + P_T);
    LAS float* PTF = (LAS float*)(L + P_PTF); LAS float* QF = (LAS float*)(L + P_QF);
    LAS bf16* I_PT = (LAS bf16*)(L + P_IMG + IMG_PT); LAS bf16* I_BK = (LAS bf16*)(L + P_IMG + IMG_BK); LAS bf16* I_VT = (LAS bf16*)(L + P_IMG + IMG_VT);
    LAS bf16* I_QT = (LAS bf16*)(L + P_IMG + IMG_QT); LAS float* I_W16 = (LAS float*)(L + P_IMG + IMG_W16);
    const int r0 = n == 0 ? MR : b * SEQ + 16 * (n - 1);
#pragma unroll
    for (int i = 0; i < 2; ++i) { const int q = tid + 512 * i; if (q < 952) { const int pr = q / 56, pc = q % 56;
        const int col = pc < 8 ? 64 * h + 8 * pc : pc < 16 ? 512 + 64 * h + 8 * (pc - 8) : pc < 24 ? 1024 + 64 * h + 8 * (pc - 16) : 1536 + 8 * (pc - 24);
        const int gr = n == 0 ? (pr == 0 ? -1 : MR + pr - 1) : n == 1 ? (pr == 0 ? MR + NMETA - 1 : b * SEQ + pr - 1) : b * SEQ + 16 * (n - 1) - 1 + pr;
        const v4u v = gr >= 0 ? *(const v4u*)(PR + (size_t)gr * PRW + col) : (v4u){0u, 0u, 0u, 0u};
        *(LAS v4u*)(PRL + pr * PRS + 8 * pc) = v; } }
    __syncthreads();
    {
        const int t2 = tid >> 5, l32 = tid & 31;
#pragma unroll
        for (int i = 0; i < 14; ++i) {
            const int c = l32 + 32 * i;
            const float cur = bf2f(PRL[(1 + t2) * PRS + c]), prv = bf2f(PRL[t2 * PRS + c]);
            const int gcol = c < 64 ? 64 * h + c : c < 128 ? 512 + 64 * h + (c - 64) : c < 192 ? 1024 + 64 * h + (c - 128) : 1536 + (c - 192);
            const float x = cur + (prv - cur) * mu[gcol];
            if (c < 64) XR[t2 * 64 + c] = x; else if (c < 128) XK[t2 * 64 + c - 64] = x; else if (c < 192) XV[t2 * 64 + c - 128] = x;
            else if (c < 256) { const float e = __expf(2.0f * x); TW[t2 * 72 + c - 192] = (bf16)f2bf(1.0f - 2.0f * __builtin_amdgcn_rcpf(e + 1.0f)); }
            else if (c < 320) XA[t2 * 72 + c - 256] = (bf16)f2bf(x); else SG[t2 * 136 + c - 320] = (bf16)f2bf(sigm(x));
        }
    }
    __syncthreads();
    {
        const int nb = wave & 3, grp = wave >> 2, ar = lane & 15, ak = 8 * (lane >> 4);
        pg8::f32x4 d0 = (pg8::f32x4){0.f, 0.f, 0.f, 0.f}, d1 = d0;
        if (grp == 0) {
#pragma unroll
            for (int k = 0; k < 2; ++k) { const bf16x8 af = *(const LAS bf16x8*)(TW + ar * 72 + 32 * k + ak); const bf16x8 bw = *(const bf16x8*)(w2t + (size_t)(64 * h + 16 * nb + ar) * 64 + 32 * k + ak); d0 = __builtin_amdgcn_mfma_f32_16x16x32_bf16(af, bw, d0, 0, 0, 0); }
#pragma unroll
            for (int k = 0; k < 2; ++k) { const bf16x8 af = *(const LAS bf16x8*)(XA + ar * 72 + 32 * k + ak); const bf16x8 bw = *(const bf16x8*)(a2t + (size_t)(64 * h + 16 * nb + ar) * 64 + 32 * k + ak); d1 = __builtin_amdgcn_mfma_f32_16x16x32_bf16(af, bw, d1, 0, 0, 0); }
#pragma unroll
            for (int r = 0; r < 4; ++r) { LW[(4 * (lane >> 4) + r) * 64 + 16 * nb + ar] = d0[r]; LA[(4 * (lane >> 4) + r) * 64 + 16 * nb + ar] = d1[r]; }
        } else {
#pragma unroll
            for (int k = 0; k < 4; ++k) { const bf16x8 af = *(const LAS bf16x8*)(SG + ar * 136 + 32 * k + ak); const bf16x8 bw = *(const bf16x8*)(g2t + (size_t)(64 * h + 16 * nb + ar) * 128 + 32 * k + ak); d0 = __builtin_amdgcn_mfma_f32_16x16x32_bf16(af, bw, d0, 0, 0, 0); }
#pragma unroll
            for (int r = 0; r < 4; ++r) LG[(4 * (lane >> 4) + r) * 64 + 16 * nb + ar] = d0[r];
        }
    }
    __syncthreads();
    const int tt = tid >> 5, jp = tid & 31, j0 = 2 * jp, ch0 = 64 * h + j0;
    {
        const f32x2 c_w0 = *(const f32x2*)(w0 + ch0), c_a0 = *(const f32x2*)(a0 + ch0), c_kk = *(const f32x2*)(k_k + ch0), c_ka = *(const f32x2*)(k_a + ch0), c_rk = *(const f32x2*)(r_k + ch0);
        const f32x2 lw = *(const LAS f32x2*)(LW + tt * 64 + j0), la = *(const LAS f32x2*)(LA + tt * 64 + j0), lg = *(const LAS f32x2*)(LG + tt * 64 + j0);
        const f32x2 xr = *(const LAS f32x2*)(XR + tt * 64 + j0), xk = *(const LAS f32x2*)(XK + tt * 64 + j0), xv = *(const LAS f32x2*)(XV + tt * 64 + j0);
        const float wd0 = __expf(-0.6065306597126334f * sigm(c_w0.x + lw.x)), wd1 = __expf(-0.6065306597126334f * sigm(c_w0.y + lw.y));
        const float al0 = sigm(c_a0.x + la.x), al1 = sigm(c_a0.y + la.y);
        const float q0 = xk.x * c_kk.x, q1 = xk.y * c_kk.y;
        const float nrm = sum32(q0 * q0 + q1 * q1); const float rn = 1.0f / fmaxf(sqrtf(nrm), 1e-12f);
        const float kk0 = q0 * rn, kk1 = q1 * rn;
        const float kn0 = xk.x * (1.0f + (al0 - 1.0f) * c_ka.x), kn1 = xk.y * (1.0f + (al1 - 1.0f) * c_ka.y);
        const float rkp = sum32(xr.x * kn0 * c_rk.x + xr.y * kn1 * c_rk.y);
        *(LAS f32x2*)(FW + tt * 64 + j0) = (f32x2){wd0, wd1}; *(LAS f32x2*)(FK + tt * 64 + j0) = (f32x2){kn0, kn1};
        *(LAS f32x2*)(FA + tt * 64 + j0) = (f32x2){-kk0, -kk1}; *(LAS f32x2*)(FB + tt * 64 + j0) = (f32x2){kk0 * al0, kk1 * al1};
        I_VT[j0 * 16 + tt] = (bf16)f2bf(xv.x); I_VT[(j0 + 1) * 16 + tt] = (bf16)f2bf(xv.y);
        if (n > 0 || b == 0) {
            *(unsigned*)((bf16*)(F.ws + WS_G) + (size_t)(r0 + tt) * 512 + ch0) = pk2(lg.x, lg.y);
            if (jp == 0) ((float*)(F.ws + WS_RK))[(size_t)(r0 + tt) * 8 + h] = rkp;
        }
    }
    __syncthreads();
    if (tid < 64) { float wc = 1.0f;
#pragma unroll
        for (int s = 0; s < 16; ++s) { wc *= FW[s * 64 + tid]; WC[s * 64 + tid] = wc; } }
    __syncthreads();
    {
        const int s = tt;
#pragma unroll
        for (int e = 0; e < 2; ++e) { const int j = j0 + e;
            const float wp = s > 0 ? WC[(s - 1) * 64 + j] : 1.0f, wcv = WC[s * 64 + j], w16 = WC[15 * 64 + j], iw = 1.0f / wcv;
            const float at = wp * FA[s * 64 + j], rt = wcv * XR[s * 64 + j], bh = FB[s * 64 + j] * iw, kh = FK[s * 64 + j] * iw;
            E1[s * 72 + j] = (bf16)f2bf(bh); E1[(16 + s) * 72 + j] = (bf16)f2bf(kh); E2[s * 72 + j] = (bf16)f2bf(at); E2[(16 + s) * 72 + j] = (bf16)f2bf(rt);
            ATF[s * 64 + j] = at; RTF[s * 64 + j] = rt;
            I_BK[j * 32 + s] = (bf16)f2bf(bh * w16); I_BK[j * 32 + 16 + s] = (bf16)f2bf(kh * w16);
            if (s == 0) { const int jt = j >> 5, jj = j & 31, hi_ = (jj >> 2) & 1, r_ = (jj & 3) + 4 * (jj >> 3); I_W16[hi_ * 32 + jt * 16 + r_] = w16; }
        }
    }
    __syncthreads();
    if (wave == 0) {
        const int m = lane & 31, hh = lane >> 5;
        f32x16 d = (f32x16){0.f,0.f,0.f,0.f,0.f,0.f,0.f,0.f,0.f,0.f,0.f,0.f,0.f,0.f,0.f,0.f};
#pragma unroll
        for (int ks = 0; ks < 4; ++ks) { const bf16x8 af = *(const LAS bf16x8*)(E1 + m * 72 + 16 * ks + 8 * hh), bfv = *(const LAS bf16x8*)(E2 + m * 72 + 16 * ks + 8 * hh); d = __builtin_amdgcn_mfma_f32_32x32x16_bf16(af, bfv, d, 0, 0, 0); }
#pragma unroll
        for (int r = 0; r < 16; ++r) { const int mr = crow(r, hh), nc = m; const int u = mr & 15, s = nc & 15; const bool keep = (nc < 16) ? (u < s) : (u <= s);
            M[mr * 33 + nc] = keep ? d[r] : 0.0f; }
    }
    __syncthreads();
    if (tid < 16) { float t[16];
#pragma unroll
        for (int s = 0; s < 16; ++s) { float acc = (tid == s) ? 1.0f : 0.0f;
#pragma unroll
            for (int u = 0; u < s; ++u) acc += t[u] * M[u * 33 + s];
            t[s] = acc; }
#pragma unroll
        for (int s = 0; s < 16; ++s) T[tid * 17 + s] = t[s]; }
    __syncthreads();
    {
        const int s = tt; float p0 = 0.f, p1 = 0.f;
#pragma unroll
        for (int u = 0; u < 16; ++u) { const float tv = T[u * 17 + s]; const f32x2 av = *(const LAS f32x2*)(ATF + u * 64 + j0); p0 += tv * av.x; p1 += tv * av.y; }
        *(LAS f32x2*)(PTF + s * 64 + j0) = (f32x2){p0, p1}; *(LAS unsigned*)(I_PT + s * 64 + j0) = pk2(p0, p1);
        if (tid < 256) { const int u = tid >> 4, sq = tid & 15; float q = 0.f;
#pragma unroll
            for (int x = 0; x < 16; ++x) q += M[(16 + u) * 33 + x] * T[x * 17 + sq];
            QF[u * 17 + sq] = q; I_QT[sq * 16 + u] = (bf16)f2bf(q); }
    }
    __syncthreads();
    {
        const int s = tt; const f32x2 rv = *(const LAS f32x2*)(RTF + s * 64 + j0); float p0 = rv.x, p1 = rv.y;
#pragma unroll
        for (int u = 0; u < 16; ++u) { const float mv = M[u * 33 + 16 + s]; const f32x2 pv = *(const LAS f32x2*)(PTF + u * 64 + j0); p0 += mv * pv.x; p1 += mv * pv.y; }
        *(LAS unsigned*)(I_PT + (16 + s) * 64 + j0) = pk2(p0, p1);
        if (tid < 256) { const int u = tid >> 4, sq = tid & 15; float q = M[(16 + u) * 33 + 16 + sq];
#pragma unroll
            for (int x = 0; x < 16; ++x) q += QF[u * 17 + x] * M[x * 33 + 16 + sq];
            I_QT[(16 + sq) * 16 + u] = (bf16)f2bf(q); }
    }
    __syncthreads();
    {
        const int nl = n < NBLK_H1 ? n : n - NBLK_H1;
        unsigned char* dst = F.ws + WS_IMG + ((size_t)chain * NBLK_H1 + nl) * IMG_BYTES;
        for (int q = tid; q < IMG_BYTES / 16; q += NTHR) *(v4u*)(dst + q * 16) = *(const LAS v4u*)(L + P_IMG + q * 16);
    }
    __syncthreads();
}

constexpr int SL_PT = 0, SL_BK = 4352, SL_VT = SL_BK + 5120, SL_QT = SL_VT + 3072, SL_W16 = SL_QT + 1536, SL_BUF = SL_W16 + 256;
constexpr int SL_YL = 2 * SL_BUF, SL_END = SL_YL + 2 * 4096;
static_assert((SL_BUF % 16) == 0 && SL_END <= 131072, "scan lds map");

__device__ __forceinline__ void rwkv_scan(Frame& F, CArgs& A, int chain, int nlo, int nhi) {
    const int b = chain >> 3, h = chain & 7;
    const int tid = F.tid, lane = F.lane, wave = F.wave;
    LAS unsigned char* L = F.lds;
    const unsigned char* img0 = F.ws + WS_IMG + (size_t)chain * NBLK_H1 * IMG_BYTES;
    const int cnt = nhi - nlo;
#define S3_BAR() asm volatile("s_waitcnt lgkmcnt(0)\n\ts_barrier" ::: "memory")
    if (wave >= 2) {
        bf16* Y1 = (bf16*)(F.ws + R_Y1);
        const int ht = tid - 128;
        int lsrc[2], ldst[2]; bool lok[2];
#pragma unroll
        for (int i = 0; i < 2; ++i) { const int q = ht + 384 * i; lok[i] = q < IMG_BYTES / 16; lsrc[i] = lok[i] ? q * 16 : 0; int d;
            if (q < 256) d = SL_PT + (q >> 3) * 136 + (q & 7) * 16;
            else if (q < 512) d = SL_BK + ((q - 256) >> 2) * 80 + ((q - 256) & 3) * 16;
            else if (q < 640) d = SL_VT + ((q - 512) >> 1) * 48 + ((q - 512) & 1) * 16;
            else if (q < 704) d = SL_QT + ((q - 640) >> 1) * 48 + ((q - 640) & 1) * 16;
            else d = SL_W16 + (q - 704) * 16;
            ldst[i] = d; }
        const float c_lg = A.in[22][64 * h + lane], c_lb = A.in[23][64 * h + lane];
        const bf16* Gp = (const bf16*)(F.ws + WS_G) + 64 * h + lane; const float* RKp = (const float*)(F.ws + WS_RK) + h;
        const int tk0 = wave - 2, tk1 = wave + 4, tk2 = (wave + 10) < 16 ? wave + 10 : 15; const bool ok2 = (wave + 10) < 16;
#define S3_LOAD(m, pf) do { const int mm_ = (m) < cnt ? (m) : cnt - 1; const unsigned char* ip_ = img0 + (size_t)mm_ * IMG_BYTES; pf[0] = *(const v4u*)(ip_ + lsrc[0]); pf[1] = *(const v4u*)(ip_ + lsrc[1]); } while (0)
#define S3_LAND(buf, pf) do { *(LAS v4u*)(L + (buf) * SL_BUF + ldst[0]) = pf[0]; if (lok[1]) *(LAS v4u*)(L + (buf) * SL_BUF + ldst[1]) = pf[1]; } while (0)
#define S3_PLOAD(m, gg, xv, rk) do { const int mm_ = (m) < cnt ? (m) : cnt - 1; const int nn_ = nlo + mm_; const size_t r0_ = nn_ == 0 ? (size_t)MR : (size_t)(b * SEQ + 16 * (nn_ - 1)); \
        const unsigned char* vt_ = img0 + (size_t)mm_ * IMG_BYTES + IMG_VT + lane * 32; \
        gg[0] = bf2f(Gp[(r0_ + tk0) * 512]); gg[1] = bf2f(Gp[(r0_ + tk1) * 512]); gg[2] = bf2f(Gp[(r0_ + tk2) * 512]); \
        xv[0] = bf2f(*(const bf16*)(vt_ + tk0 * 2)); xv[1] = bf2f(*(const bf16*)(vt_ + tk1 * 2)); xv[2] = bf2f(*(const bf16*)(vt_ + tk2 * 2)); \
        rk[0] = RKp[(r0_ + tk0) * 8]; rk[1] = RKp[(r0_ + tk1) * 8]; rk[2] = RKp[(r0_ + tk2) * 8]; } while (0)
#define S3_POST1(t, gg, xv, rk, k) do { const float y = YL[(t) * 64 + lane]; \
        const float mean = wsum64(y) * (1.0f / 64.0f); const float d = y - mean; const float var = wsum64(d * d) * (1.0f / 64.0f); \
        const float o = (d * rsqrtf(var + 64e-5f) * c_lg + c_lb + rk[k] * xv[k]) * gg[k]; \
        if (wr_) Y1[(size_t)(r0 + (t)) * DM + 512 + 64 * h + lane] = (bf16)f2bf(o); } while (0)
#define S3_HELP(m, pfN, ggC, xvC, rkC) do { \
        const int cb = (m) & 1; \
        if ((m) + 1 < cnt) S3_LAND(cb ^ 1, pfN); \
        S3_LOAD((m) + 3, pfN); \
        S3_BAR(); \
        { const LAS float* YL = (const LAS float*)(L + SL_YL + cb * 4096); \
          const int nn_ = nlo + (m); const int r0 = nn_ == 0 ? MR : b * SEQ + 16 * (nn_ - 1); const bool wr_ = nn_ > 0 || b == 0; \
          S3_POST1(tk0, ggC, xvC, rkC, 0); S3_POST1(tk1, ggC, xvC, rkC, 1); if (ok2) S3_POST1(tk2, ggC, xvC, rkC, 2); } \
        S3_PLOAD((m) + 2, ggC, xvC, rkC); \
    } while (0)
        v4u pfA[2], pfB[2]; float ggA[3], xvA[3], rkA[3], ggB[3], xvB[3], rkB[3];
        S3_LOAD(0, pfA); S3_LAND(0, pfA); S3_LOAD(1, pfB); S3_LOAD(2, pfA);
        S3_PLOAD(0, ggA, xvA, rkA); S3_PLOAD(1, ggB, xvB, rkB);
        S3_BAR();
#pragma unroll 1
        for (int m = 0; m < cnt; m += 2) {
            S3_HELP(m, pfB, ggA, xvA, rkA);
            if (m + 1 < cnt) S3_HELP(m + 1, pfA, ggB, xvB, rkB);
        }
#undef S3_LOAD
#undef S3_LAND
#undef S3_PLOAD
#undef S3_POST1
#undef S3_HELP
    } else {
        const int it = wave, qi = lane & 31, hi = lane >> 5;
        f32x16 z0 = (f32x16){0.f,0.f,0.f,0.f,0.f,0.f,0.f,0.f,0.f,0.f,0.f,0.f,0.f,0.f,0.f,0.f}, z1 = z0;
        float* zs = (float*)(F.ws + WS_ZS) + ((size_t)(chain * 2 + it) * 2 * 64 + lane) * 16;
        if (nlo > 0) { z0 = *(const f32x16*)zs; z1 = *(const f32x16*)(zs + 64 * 16); }
        S3_BAR();
#define S3_PK(dst, zz, o) do { dst.x = pg8::cvt_pk_bf16(zz[o + 0], zz[o + 1]); dst.y = pg8::cvt_pk_bf16(zz[o + 2], zz[o + 3]); dst.z = pg8::cvt_pk_bf16(zz[o + 4], zz[o + 5]); dst.w = pg8::cvt_pk_bf16(zz[o + 6], zz[o + 7]); } while (0)
#pragma unroll 1
        for (int m = 0; m < cnt; ++m) {
            const int cb = m & 1;
            const LAS unsigned char* B_ = L + cb * SL_BUF;
            v4u zb[4]; S3_PK(zb[0], z0, 0); S3_PK(zb[1], z0, 8); S3_PK(zb[2], z1, 0); S3_PK(zb[3], z1, 8);
            const bf16x8 vfr = *(const LAS bf16x8*)(B_ + SL_VT + (32 * it + qi) * 48 + hi * 16);
            f32x16 acc = (f32x16){0.f,0.f,0.f,0.f,0.f,0.f,0.f,0.f,0.f,0.f,0.f,0.f,0.f,0.f,0.f,0.f};
            { const bf16x8 qf = *(const LAS bf16x8*)(B_ + SL_QT + qi * 48 + hi * 16); acc = __builtin_amdgcn_mfma_f32_32x32x16_bf16(qf, vfr, acc, 0, 0, 0); }
#pragma unroll
            for (int ks = 0; ks < 4; ++ks) {
                const LAS unsigned char* pp = B_ + SL_PT + qi * 136 + (16 * ks + 4 * hi) * 2;
                const v2u lo = *(const LAS v2u*)pp, hh = *(const LAS v2u*)(pp + 16);
                const v4u aw = (v4u){lo.x, lo.y, hh.x, hh.y};
                acc = __builtin_amdgcn_mfma_f32_32x32x16_bf16(__builtin_bit_cast(bf16x8, aw), __builtin_bit_cast(bf16x8, zb[ks]), acc, 0, 0, 0);
            }
            { LAS float* YL = (LAS float*)(L + SL_YL + cb * 4096);
#pragma unroll
              for (int r = 8; r < 16; ++r) YL[(crow(r, hi) - 16) * 64 + 32 * it + qi] = acc[r]; }
            v4u sab; S3_PK(sab, acc, 0);
            const LAS float* w16 = (const LAS float*)(B_ + SL_W16) + hi * 32;
#pragma unroll
            for (int jt = 0; jt < 2; ++jt) {
                f32x16 zn;
#pragma unroll
                for (int r4 = 0; r4 < 4; ++r4) { const f32x4 wv = *(const LAS f32x4*)(w16 + jt * 16 + 4 * r4);
#pragma unroll
                    for (int e = 0; e < 4; ++e) zn[4 * r4 + e] = (jt == 0 ? z0[4 * r4 + e] : z1[4 * r4 + e]) * wv[e]; }
                const LAS unsigned char* bp = B_ + SL_BK + (32 * jt + qi) * 80;
                const v2u lo = *(const LAS v2u*)(bp + 8 * hi), hh = *(const LAS v2u*)(bp + 16 + 8 * hi);
                const v4u bw = (v4u){lo.x, lo.y, hh.x, hh.y};
                zn = __builtin_amdgcn_mfma_f32_32x32x16_bf16(__builtin_bit_cast(bf16x8, bw), __builtin_bit_cast(bf16x8, sab), zn, 0, 0, 0);
                const bf16x8 kf = *(const LAS bf16x8*)(bp + 32 + 16 * hi);
                zn = __builtin_amdgcn_mfma_f32_32x32x16_bf16(kf, vfr, zn, 0, 0, 0);
                if (jt == 0) z0 = zn; else z1 = zn;
            }
            S3_BAR();
        }
        if (nhi < NBLK) { *(f32x16*)zs = z0; *(f32x16*)(zs + 64 * 16) = z1; }
#undef S3_PK
    }
#undef S3_BAR
    __syncthreads();
}

__device__ __forceinline__ void final_phase(Frame& F, CArgs& A) {
    const float* part = (const float*)(F.ws + WS_PART); const float* gf = A.in[4]; float* out = F.out;
    const int gw = F.wg * NWAVES + F.wave, NGW = F.G * NWAVES, lane = F.lane;
    f32x4 gv[4];
#pragma unroll
    for (int j = 0; j < 4; ++j) gv[j] = *(const f32x4*)(gf + j * 256 + lane * 4);
    for (int row = gw; row < MR; row += NGW) {
        const float rs = pg8::row_rstd(part, row);
#pragma unroll
        for (int j = 0; j < 4; ++j) { f32x4* p = (f32x4*)(out + (size_t)row * DM + j * 256 + lane * 4); *p = (*p) * rs * gv[j]; }
    }
}


__device__ __forceinline__ void meta_res_gemm(Frame& F, const bf16* Aop, int lda, const bf16* Bop, int ldb, int K, float* hmeta, bf16* Abuf, float* part, int mode, int g) {
    const int lane = F.lane, wave = F.wave, nb = wave & 3, kh = wave >> 2, kq = 8 * (lane >> 4), r16 = lane & 15;
    const int khalf = K / 2, k0 = kh * khalf, nks = khalf / 32;
    const bf16* ap = Aop + (size_t)(MR + r16) * lda + k0 + kq;
    const bf16* bp = Bop + (size_t)(64 * g + 16 * nb + r16) * ldb + k0 + kq;
    pg8::f32x4 d = (pg8::f32x4){0.f, 0.f, 0.f, 0.f};
#pragma unroll 4
    for (int k = 0; k < nks; ++k) { const bf16x8 af = *(const bf16x8*)(ap + 32 * k); const bf16x8 bfv = *(const bf16x8*)(bp + 32 * k); d = __builtin_amdgcn_mfma_f32_16x16x32_bf16(af, bfv, d, 0, 0, 0); }
    LAS float* red = (LAS float*)F.lds;
    if (kh == 1) *(LAS pg8::f32x4*)(red + (nb * 64 + lane) * 4) = d;
    __syncthreads();
    if (kh == 0) {
        const pg8::f32x4 o = *(const LAS pg8::f32x4*)(red + (nb * 64 + lane) * 4); d += o;
        const int col = 64 * g + 16 * nb + r16;
#pragma unroll
        for (int r = 0; r < 4; ++r) { const int row = 4 * (lane >> 4) + r; float h = hmeta[(size_t)row * DM + col] + d[r]; hmeta[(size_t)row * DM + col] = h; d[r] = h;
            if (mode) Abuf[(size_t)(MR + row) * DM + col] = (bf16)f2bf(h); }
    }
    __syncthreads();
    if (mode) {
        if (kh == 0) {
#pragma unroll
            for (int r = 0; r < 4; ++r) { const float ss = sum16(d[r] * d[r]); if (r16 == 0) red[(4 * (lane >> 4) + r) * 4 + nb] = ss; }
        }
        __syncthreads();
        if (F.tid < 16) { const pg8::f32x4 v = *(const LAS pg8::f32x4*)(red + F.tid * 4); part[(size_t)(MR + F.tid) * 16 + g] = (v[0] + v[1]) + (v[2] + v[3]); }
        __syncthreads();
    }
}

#ifdef NO_ATTN
#define ATTN_UNIT(b, k, q) do { } while (0)
#else
#define ATTN_UNIT(b, k, q) attn_unit(F, A.in[12], (b), (k), (q))
#endif
constexpr int N_PHASES = 23;
#ifndef RES_SP2
#define RES_SP2 false
#endif
#ifndef DBGLAST
#define DBGLAST 6
#endif
#ifndef DBG15
#define DBG15 3
#endif
#define PD(k, l, c) ((k) | ((l) << 4) | ((c) << 5))
__constant__ int c_phase_tab[N_PHASES] = { PD(0,0,0), PD(1,0,0), PD(2,0,0), PD(3,0,0), PD(4,0,0), PD(5,0,0), PD(3,0,0), PD(4,0,1), PD(5,0,1), PD(3,0,1),
    PD(6,0,0), PD(7,0,0), PD(3,0,0), PD(4,1,0), PD(5,1,0), PD(3,1,0), PD(4,1,1), PD(5,1,1), PD(3,1,1), PD(8,0,0) };
#ifndef DBG_NPH
#define DBG_NPH 18
#endif
__global__ void __launch_bounds__(NTHR, 2) hyb_fwd(Args args) {
    extern __shared__ __attribute__((aligned(16))) unsigned char lds[];
    const int lo = args.ph_lo, hi = args.ph_hi;
#if MK_N_LAUNCHES == 1
    {
        for (int u = threadIdx.x; u < (LDS_BYTES - LDSCTL_OFF) / 4; u += NTHR) ((LAS unsigned*)((LAS unsigned char*)lds + LDSCTL_OFF))[u] = 0u;
        __syncthreads();
        if (threadIdx.x == 0) (void)xb_add(&((unsigned*)(args.ws + WS_CTL))[1024 + XB_XCNT(xb_xcc_id())], 1u);
    }
#endif
    const int wave_s = __builtin_amdgcn_readfirstlane(threadIdx.x >> 6);
#ifndef PROBE_MASK
#define PROBE_MASK 0u
#endif
#pragma unroll 1
    for (int pq = 2 * lo; pq < 2 * hi; ++pq) {
        const int p = pq >> 1; if ((pq & 1) && !((PROBE_MASK >> p) & 1u)) continue;
#define PHF() CArgs* ap_ = (CArgs*)__builtin_amdgcn_kernarg_segment_ptr(); asm volatile("" : "+s"(ap_)); CArgs& A = *ap_; \
        unsigned z_; asm volatile("s_mov_b32 %0, 0" : "=s"(z_)); \
        Frame F; F.tid = (wave_s << 6) | (int)__builtin_amdgcn_mbcnt_hi(~0u, __builtin_amdgcn_mbcnt_lo(~0u, z_)); asm volatile("" : "+v"(F.tid)); \
        F.lds = (LAS unsigned char*)lds; F.lane = F.tid & 63; F.wave = __builtin_amdgcn_readfirstlane(F.tid >> 6); F.G = gridDim.x; F.wg = blockIdx.x; F.out = A.out; F.ws = A.ws; \
        unsigned char* ws = A.ws; float* part = (float*)(ws + WS_PART); float* hmeta = (float*)(ws + WS_HMETA); pg8::bf16_t* Abuf = (pg8::bf16_t*)(ws + WS_A); (void)part; (void)hmeta; (void)Abuf
        int kind, layer = 0, ch = 0, sub = 2;
        switch (p) {
            case 0: kind = 0; break; case 1: kind = 1; break; case 2: kind = 2; break; case 3: kind = 3; sub = 0; break;
            case 4: kind = 4; break; case 5: kind = 5; break; case 6: kind = 3; break;
            case 7: kind = 4; ch = 1; break; case 8: kind = 5; ch = 1; break; case 9: kind = 3; ch = 1; break;
            case 10: kind = 6; break; case 11: kind = 7; break; case 12: kind = 9; break; case 13: kind = 7; ch = 1; break; case 14: kind = 9; ch = 1; break;
            case 15: kind = 3; sub = 1; break;
            case 16: kind = 4; layer = 1; break; case 17: kind = 5; layer = 1; break; case 18: kind = 3; layer = 1; break;
            case 19: kind = 4; layer = 1; ch = 1; break; case 20: kind = 5; layer = 1; ch = 1; break; case 21: kind = 3; layer = 1; ch = 1; break;
            default: kind = 8; break;
        }
        if (kind == 0) { PHF(); p0_prologue(F, A); }
        else if (kind == 1) { PHF(); pg8::Gemm g{Abuf, (const pg8::bf16_t*)(ws + W_IN0), MP, NIN, DM, DM, DM}; pg8::StaticOrder S; S.init(MP, NIN, F.G, F.wg);
            pg8::EpiIn0 E{(pg8::bf16_t*)(ws + R_U), (pg8::bf16_t*)(ws + R_WC), (pg8::bf16_t*)(ws + R_GB), part};
            pg8::gemm_phase<pg8::EpiIn0, pg8::StaticOrder, true, true, DM, DM, DM>(F.lds, g, S, E, F.tid); }
        else if (kind == 2) { PHF(); conv0_phase(F, A); }
        else if (kind == 3) { PHF();
            const bool o0 = (sub == 0), o1 = (sub == 1), od = (sub == 2);
            const pg8::bf16_t* Aop = (const pg8::bf16_t*)(ws + (o0 ? R_Y0 : o1 ? R_Y1 : R_HM));
            const pg8::bf16_t* Bop = (const pg8::bf16_t*)(ws + (o0 ? W_OUT0 : o1 ? W_OUT1 : (layer ? W_DN1 : W_DN0))) + (od ? (size_t)ch * FCH : (size_t)0);
            const int Kd = od ? FCH : DM, ldbd = od ? DFF : DM;
            const float* base = o0 ? A.in[0] : (const float*)A.out;
            const pg8::Gemm g{Aop, Bop, MP, DM, Kd, Kd, ldbd};
            pg8::StaticOrder S; S.init(MR, DM, F.G, F.wg);
            pg8::EpiRes E{base, A.out, hmeta, Abuf, part, od ? ch : 1};
            if (od) pg8::gemm_phase<pg8::EpiRes, pg8::StaticOrder, true, RES_SP2, FCH, FCH, DFF>(F.lds, g, S, E, F.tid);
            else pg8::gemm_phase<pg8::EpiRes, pg8::StaticOrder, true, RES_SP2, DM, DM, DM>(F.lds, g, S, E, F.tid);
            if (blockIdx.x < 16) {
                CArgs* am_ = (CArgs*)__builtin_amdgcn_kernarg_segment_ptr(); asm volatile("" : "+s"(am_)); unsigned char* wsm = am_->ws;
                unsigned zm_; asm volatile("s_mov_b32 %0, 0" : "=s"(zm_));
                Frame Fm; Fm.tid = (wave_s << 6) | (int)__builtin_amdgcn_mbcnt_hi(~0u, __builtin_amdgcn_mbcnt_lo(~0u, zm_)); asm volatile("" : "+v"(Fm.tid));
                Fm.lds = (LAS unsigned char*)lds; Fm.lane = Fm.tid & 63; Fm.wave = __builtin_amdgcn_readfirstlane(Fm.tid >> 6); Fm.G = gridDim.x; Fm.wg = blockIdx.x; Fm.out = nullptr; Fm.ws = wsm;
                const bf16* Am = (const bf16*)(wsm + (o0 ? R_Y0 : o1 ? R_Y1 : R_HM));
                const bf16* Bm = (const bf16*)(wsm + (o0 ? W_OUT0 : o1 ? W_OUT1 : (layer ? W_DN1 : W_DN0))) + (od ? (size_t)ch * FCH : (size_t)0);
                meta_res_gemm(Fm, Am, od ? FCH : DM, Bm, od ? DFF : DM, od ? FCH : DM, (float*)(wsm + WS_HMETA), (bf16*)(wsm + WS_A), (float*)(wsm + WS_PART), od ? ch : 1, (int)blockIdx.x);
            } }
        else if (kind == 4) { PHF(); pg8::Gemm g{Abuf, (const pg8::bf16_t*)(ws + (layer ? W_UP1 : W_UP0)) + (size_t)ch * FCH * 2 * DM, MP, 2 * FCH, DM, DM, DM}; pg8::StaticOrder S; S.init(MP, 2 * FCH, F.G, F.wg);
            pg8::EpiUp E{(pg8::bf16_t*)(ws + R_G), (pg8::bf16_t*)(ws + R_V), part};
            pg8::gemm_phase<pg8::EpiUp, pg8::StaticOrder, true, true, DM, DM, DM>(F.lds, g, S, E, F.tid); }
        else if (kind == 5) { PHF(); ffn_mid_phase(F, A, layer, ch); }
        else if (kind == 6) { PHF(); pg8::Gemm g{Abuf, (const pg8::bf16_t*)(ws + W_IN1), MP, NIN, DM, DM, DM}; pg8::StaticOrder S; S.init(MP, NIN, F.G, F.wg);
            pg8::EpiIn1 E{(pg8::bf16_t*)(ws + R_Q), (pg8::bf16_t*)(ws + R_KB), (pg8::bf16_t*)(ws + R_VB), (pg8::bf16_t*)(ws + R_PR), part, (const float*)(ws + WS_ROPE), (const float*)(ws + WS_ROPE) + TT * 32};
            pg8::gemm_phase<pg8::EpiIn1, pg8::StaticOrder, true, true, DM, DM, DM>(F.lds, g, S, E, F.tid); }
        else if (kind == 7) { PHF();
            const int cnt = ch == 0 ? NBLK_H1 : NBLK - NBLK_H1, nbase = ch == 0 ? 0 : NBLK_H1;
            for (int id = F.wg; id < 64 * cnt; id += F.G) rwkv_prep_unit(F, A, id & 63, nbase + (id >> 6));
        }
        else if (kind == 9) { PHF();
            const int NCH = 64;
            if (F.G > NCH && F.wg < NCH) rwkv_scan(F, A, F.wg, ch == 0 ? 0 : NBLK_H1, ch == 0 ? NBLK_H1 : NBLK);
            else {
                if (F.G <= NCH) for (int c = F.wg; c < NCH; c += F.G) rwkv_scan(F, A, c, ch == 0 ? 0 : NBLK_H1, ch == 0 ? NBLK_H1 : NBLK);
                if (ch == 0) { const int NAW = F.G > NCH ? F.G - NCH : F.G, aw = F.G > NCH ? F.wg - NCH : F.wg;
                    for (int id = aw; id < 514; id += NAW) { if (id < 512) ATTN_UNIT(id >> 6, (id >> 5) & 1, id & 31); else ATTN_UNIT(0, id - 512, -1); } }
            }
        }
        else if (kind == 8) { PHF(); final_phase(F, A); }
#if MK_N_LAUNCHES == 1
        if (pq + 1 < 2 * hi) {
            if (hi > 1000) cg::this_grid().sync();
            CArgs* ab_ = (CArgs*)__builtin_amdgcn_kernarg_segment_ptr(); asm volatile("" : "+s"(ab_));
            unsigned zb_; asm volatile("s_mov_b32 %0, 0" : "=s"(zb_));
            const bool t0 = (wave_s == 0) && (__builtin_amdgcn_mbcnt_hi(~0u, __builtin_amdgcn_mbcnt_lo(~0u, zb_)) == 0u);
            xcd_barrier((unsigned*)(ab_->ws + WS_CTL) + 1024, (volatile LAS unsigned*)((LAS unsigned char*)lds + MISC_OFF) + 8, t0);
        }
#endif
    }
}

extern "C" void kernel_launch(void* const* d_in, const int* in_sizes, int n_in, void* d_out, int out_size, void* d_ws, size_t ws_size, hipStream_t stream) {
    static int grid = 0;
    if (grid == 0) {
        if (n_in != 29 || out_size != MR * DM || ws_size < WS_END) { fprintf(stderr, "kernel_launch: unexpected shapes (n_in %d out %d ws %zu)\n", n_in, out_size, ws_size); grid = -1; return; }
        int dev = 0, cus = 0, per_cu = 0;
        if (hipGetDevice(&dev) != hipSuccess || hipDeviceGetAttribute(&cus, hipDeviceAttributeMultiprocessorCount, dev) != hipSuccess) { grid = -1; return; }
        if (hipFuncSetAttribute((const void*)hyb_fwd, hipFuncAttributeMaxDynamicSharedMemorySize, LDS_BYTES) != hipSuccess) { fprintf(stderr, "kernel_launch: hipFuncSetAttribute failed\n"); grid = -1; return; }
        if (hipOccupancyMaxActiveBlocksPerMultiprocessor(&per_cu, (const void*)hyb_fwd, NTHR, LDS_BYTES) != hipSuccess || per_cu < 1) { fprintf(stderr, "kernel_launch: occupancy query says %d\n", per_cu); per_cu = 1; }
        (void)hipGetLastError();
        grid = cus;
    }
    if (grid < 0) return;
    Args a{};
    for (int i = 0; i < 29; ++i) a.in[i] = (const float*)d_in[i];
    a.out = (float*)d_out; a.ws = (unsigned char*)d_ws;
#if MK_N_LAUNCHES == 1
    if (hipMemsetAsync((char*)d_ws + WS_CTL, 0, 65536, stream) != hipSuccess) { fprintf(stderr, "kernel_launch: memset failed\n"); return; }
    a.ph_lo = 0; a.ph_hi = N_PHASES;
    void* kargs[] = {&a};
    hipError_t e = hipLaunchCooperativeKernel((const void*)hyb_fwd, dim3(grid), dim3(NTHR), kargs, LDS_BYTES, stream);
    if (e != hipSuccess) fprintf(stderr, "cooperative launch failed: %s (grid %d)\n", hipGetErrorString(e), grid);
#else
    for (int p = 0; p < N_PHASES; ++p) { a.ph_lo = p; a.ph_hi = p + 1; hipLaunchKernelGGL(hyb_fwd, dim3(grid), dim3(NTHR), LDS_BYTES, stream, a); }
#endif
}
```

```cpp
#include <hip/hip_runtime.h>
#include <hip/hip_cooperative_groups.h>
#include <cstdio>
#include <cstdint>
namespace cg = cooperative_groups;

#ifndef MK_N_LAUNCHES
#define MK_N_LAUNCHES 1
#endif

constexpr int NB = 8, SEQ = 2048, NMETA = 16, TT = SEQ + NMETA, DM = 1024;
constexpr int MR = NB * SEQ;
constexpr int MP = MR + 256;
constexpr int DFF = 2816, FCH = 1408;
constexpr int NIN = 2560;
constexpr int PRW = 1792;

namespace pg8 {
#define PG8_LAS __attribute__((address_space(3)))
typedef unsigned short bf16_t;
typedef short bf16x8 __attribute__((ext_vector_type(8)));
typedef float f32x4 __attribute__((ext_vector_type(4)));
typedef unsigned u32x4 __attribute__((ext_vector_type(4)));
constexpr int BM = 256, BK = 64, HALF = 128, HTB = HALF * BK * 2  , STAGE_BYTES = 8 * HTB, NXCD = 8, WGM = 8;

__host__ __device__ __forceinline__ int lds_byte(int r, int c) { const int st = (r >> 4) * 2 + (c >> 5), rr = r & 15, cc = c & 31, ob = rr * 64 + cc * 2; return st * 1024 + (ob ^ (((ob >> 9) & 1) << 5)); }
__host__ __device__ __forceinline__ void stage_rc(int b, int& R, int& C) { const int st = b / 1024, sb = b % 1024, swz = sb ^ (((sb >> 9) & 1) << 5); R = (st >> 1) * 16 + swz / 64; C = (st & 1) * 32 + (swz % 64) / 2; }
__host__ __device__ __forceinline__ int perm32(int rho) { const int n = rho >> 4, i = rho & 15; return 8 * (i >> 2) + 4 * n + (i & 3); }

struct Unit { int pm, pn; };
struct Gemm { const bf16_t* A; const bf16_t* Bt; int M, N, K, lda, ldb; };

struct StaticOrder {
    int nM, nN, nwg, G, c;
    __host__ __device__ void init(int M, int N, int G_, int c_) { nM = M / BM; nN = N / BM; nwg = nM * nN; G = G_; c = c_; }
    __host__ __device__ bool next(int i, Unit& u) const {
        const long L = (long)i * G + c; if (L >= nwg) return false;
        int wgid = (int)L; { const int q = nwg / NXCD, r = nwg % NXCD, xcd = wgid % NXCD, off = wgid / NXCD; wgid = (xcd < r ? xcd * (q + 1) : r * (q + 1) + (xcd - r) * q) + off; }
        const int nig = WGM * nN, gid = wgid / nig, fm = gid * WGM, gsz = (nM - fm) < WGM ? (nM - fm) : WGM;
        u.pm = fm + ((wgid % nig) % gsz); u.pn = (wgid % nig) / gsz; return true;
    }
    __device__ __forceinline__ void a_ready(const Unit&) const {}
    __device__ __forceinline__ void done(const Unit&) const {}
};

__device__ __forceinline__ unsigned cvt_pk_bf16(float lo, float hi) { unsigned r; asm volatile("v_cvt_pk_bf16_f32 %0, %1, %2" : "=v"(r) : "v"(lo), "v"(hi)); return r; }
__device__ __forceinline__ u32x4 pack8(const f32x4 a, const f32x4 b) { u32x4 w; w.x = cvt_pk_bf16(a[0], a[1]); w.y = cvt_pk_bf16(a[2], a[3]); w.z = cvt_pk_bf16(b[0], b[1]); w.w = cvt_pk_bf16(b[2], b[3]); return w; }
__device__ __forceinline__ float sigmoidf_(float x) { return __builtin_amdgcn_rcpf(1.0f + __expf(-x)); }
__device__ __forceinline__ f32x4 sig4(const f32x4 x) { return (f32x4){sigmoidf_(x[0]), sigmoidf_(x[1]), sigmoidf_(x[2]), sigmoidf_(x[3])}; }
__device__ __forceinline__ float row_rstd(const float* part, int row) {
    const f32x4* p = (const f32x4*)(part + (size_t)row * 16); const f32x4 a = p[0], b = p[1], c = p[2], d = p[3];
    const float s = ((a[0] + a[1]) + (a[2] + a[3])) + ((b[0] + b[1]) + (b[2] + b[3])) + ((c[0] + c[1]) + (c[2] + c[3])) + ((d[0] + d[1]) + (d[2] + d[3]));
    return rsqrtf(s * (1.0f / 1024.0f) + 1e-6f);
}
__device__ __forceinline__ int tpos_of_row(int row) { return row < MR ? (NMETA + (row & (SEQ - 1))) : (row < MR + NMETA ? row - MR : 0); }

struct EpiIn0 {
    static constexpr bool PERM = true, AFTER_DRAIN = false;
    bf16_t* U; bf16_t* WC; bf16_t* GB; const float* part;
    __device__ __forceinline__ void operator()(const f32x4 (&acc)[2][2][4][2], const Unit& u, int wr, int wc, int fr, int fq) const {
        const int row0 = u.pm * BM + wr * 64 + fr;
#pragma unroll
        for (int ai = 0; ai < 2; ++ai)
#pragma unroll
            for (int m = 0; m < 4; ++m) {
                const int row = row0 + ai * HALF + m * 16; const float rs = row_rstd(part, row);
                if (u.pn < 8) {
                    bf16_t* dst = (u.pn < 4 ? U : WC) + (size_t)row * 512 + (u.pn & 3) * 128 + wc * 32 + 8 * fq;
                    const f32x4 a0 = acc[ai][0][m][0] * rs, a1 = acc[ai][0][m][1] * rs, b0 = acc[ai][1][m][0] * rs, b1 = acc[ai][1][m][1] * rs;
                    f32x4 o0, o1;
                    if (u.pn < 4) { o0 = a0 * sig4(b0); o1 = a1 * sig4(b1); } else { o0 = a0 * b0; o1 = a1 * b1; }
                    *(u32x4*)dst = pack8(o0, o1);
                } else {
#pragma unroll
                    for (int bj = 0; bj < 2; ++bj) { bf16_t* dst = GB + (size_t)row * 512 + (u.pn - 8) * 256 + bj * HALF + wc * 32 + 8 * fq;
                        *(u32x4*)dst = pack8(acc[ai][bj][m][0] * rs, acc[ai][bj][m][1] * rs); }
                }
            }
    }
};
struct EpiRes {
    static constexpr bool PERM = true, AFTER_DRAIN = false;
    const float* base; float* out; float* hmeta; bf16_t* Abuf; float* part; int mode;
    __device__ __forceinline__ void operator()(const f32x4 (&acc)[2][2][4][2], const Unit& u, int wr, int wc, int fr, int fq) const {
        const float* bp = u.pm < 64 ? base + (size_t)u.pm * BM * DM : hmeta; float* op = u.pm < 64 ? out + (size_t)u.pm * BM * DM : hmeta;
#pragma unroll
        for (int ai = 0; ai < 2; ++ai)
#pragma unroll
            for (int m = 0; m < 4; ++m) {
                const int lr = wr * 64 + fr + ai * HALF + m * 16, row = u.pm * BM + lr; float ss = 0.f;
#pragma unroll
                for (int bj = 0; bj < 2; ++bj) { const int col = u.pn * BM + bj * HALF + wc * 32 + 8 * fq;
                    f32x4 h0 = *(const f32x4*)(bp + (size_t)lr * DM + col), h1 = *(const f32x4*)(bp + (size_t)lr * DM + col + 4);
                    h0 += acc[ai][bj][m][0]; h1 += acc[ai][bj][m][1];
                    *(f32x4*)(op + (size_t)lr * DM + col) = h0; *(f32x4*)(op + (size_t)lr * DM + col + 4) = h1;
                    if (mode) { ss += (h0[0] * h0[0] + h0[1] * h0[1]) + (h0[2] * h0[2] + h0[3] * h0[3]) + (h1[0] * h1[0] + h1[1] * h1[1]) + (h1[2] * h1[2] + h1[3] * h1[3]);
                        *(u32x4*)(Abuf + (size_t)row * DM + col) = pack8(h0, h1); } }
                if (mode) { ss += __shfl_xor(ss, 16); ss += __shfl_xor(ss, 32); if (fq == 0) part[(size_t)row * 16 + u.pn * 4 + wc] = ss; }
            }
    }
};
struct EpiUp {
    static constexpr bool PERM = true, AFTER_DRAIN = false;
    bf16_t* G; bf16_t* V; const float* part;
    __device__ __forceinline__ void operator()(const f32x4 (&acc)[2][2][4][2], const Unit& u, int wr, int wc, int fr, int fq) const {
        const int row0 = u.pm * BM + wr * 64 + fr;
#pragma unroll
        for (int ai = 0; ai < 2; ++ai)
#pragma unroll
            for (int m = 0; m < 4; ++m) {
                const int row = row0 + ai * HALF + m * 16; const float rs = row_rstd(part, row);
                const size_t off = (size_t)row * FCH + u.pn * 128 + wc * 32 + 8 * fq;
                *(u32x4*)(G + off) = pack8(acc[ai][0][m][0] * rs, acc[ai][0][m][1] * rs);
                *(u32x4*)(V + off) = pack8(acc[ai][1][m][0] * rs, acc[ai][1][m][1] * rs);
            }
    }
};
struct EpiIn1 {
    static constexpr bool PERM = true, AFTER_DRAIN = false;
    bf16_t* Q; bf16_t* KB; bf16_t* VB; bf16_t* PR; const float* part; const float* ropec; const float* ropes;
    __device__ __forceinline__ void operator()(const f32x4 (&acc)[2][2][4][2], const Unit& u, int wr, int wc, int fr, int fq) const {
        const int row0 = u.pm * BM + wr * 64 + fr;
#pragma unroll
        for (int ai = 0; ai < 2; ++ai)
#pragma unroll
            for (int m = 0; m < 4; ++m) {
                const int row = row0 + ai * HALF + m * 16; const float rs = row_rstd(part, row);
                if (u.pn >= 3) {
#pragma unroll
                    for (int bj = 0; bj < 2; ++bj) *(u32x4*)(PR + (size_t)row * PRW + (u.pn - 3) * 256 + bj * HALF + wc * 32 + 8 * fq) = pack8(acc[ai][bj][m][0] * rs, acc[ai][bj][m][1] * rs);
                } else {
                    const f32x4 a0 = acc[ai][0][m][0] * rs, a1 = acc[ai][0][m][1] * rs, b0 = acc[ai][1][m][0] * rs, b1 = acc[ai][1][m][1] * rs;
                    if (u.pn == 2 && wc >= 2) {
                        bf16_t* dst = VB + (size_t)row * 128 + (wc - 2) * 64 + 8 * fq;
                        *(u32x4*)dst = pack8(a0, a1); *(u32x4*)(dst + 32) = pack8(b0, b1);
                    } else {
                        const int t = tpos_of_row(row);
                        const f32x4 c0 = *(const f32x4*)(ropec + t * 32 + 8 * fq), c1 = *(const f32x4*)(ropec + t * 32 + 8 * fq + 4);
                        const f32x4 s0 = *(const f32x4*)(ropes + t * 32 + 8 * fq), s1 = *(const f32x4*)(ropes + t * 32 + 8 * fq + 4);
                        const f32x4 x0 = a0 * c0 - b0 * s0, x1 = a1 * c1 - b1 * s1, y0 = b0 * c0 + a0 * s0, y1 = b1 * c1 + a1 * s1;
                        bf16_t* dst = (u.pn == 2) ? KB + (size_t)row * 128 + wc * 64 + 8 * fq : Q + (size_t)row * 512 + (u.pn * 4 + wc) * 64 + 8 * fq;
                        *(u32x4*)dst = pack8(x0, x1); *(u32x4*)(dst + 32) = pack8(y0, y1);
                    }
                }
            }
    }
};

template <class Epi, class Sched, bool ALIGN_EPI = false, bool SP2 = false, int CK = 0, int CLDA = 0, int CLDB = 0>
__device__ __forceinline__ void gemm_phase(PG8_LAS unsigned char* lds, const Gemm g, const Sched& S, const Epi& E, const int tid_in) {
    int tid_ = tid_in; asm volatile("" : "+v"(tid_));
    const int tid = tid_, wid = __builtin_amdgcn_readfirstlane(tid >> 6), lane = tid & 63, wr = wid >> 2, wc = wid & 3, fr = lane & 15, fq = lane >> 4;
    const int K = CK ? CK : g.K, nt = K / BK; const int lda_ = CLDA ? CLDA : g.lda, ldb_ = CLDB ? CLDB : g.ldb;
    unsigned voffA[2], voffB[2];
#pragma unroll
    for (int i = 0; i < 2; ++i) { int R, C; stage_rc(tid * 16 + i * 8192, R, C); const int Rb = Epi::PERM ? ((R & ~31) + perm32(R & 31)) : R;
        voffA[i] = (unsigned)(R * lda_ + C) * 2u; voffB[i] = (unsigned)(Rb * ldb_ + C) * 2u; }
    const size_t kstep = (size_t)(BK * 2);
    const size_t hstepA = (size_t)HALF * lda_ * 2, hstepB = (size_t)HALF * ldb_ * 2;
    const size_t tstepA = 2 * hstepA, tstepB = 2 * hstepB;
    const unsigned ldsw = (unsigned)wid * 1024u;
    const int aoff = lds_byte(wr * 64 + fr, fq * 8), boff = lds_byte(wc * 32 + fr, fq * 8);
#define PG8_SA(b, h) (((b) * 2 + (h)) * HTB)
#define PG8_SB(b, h) ((4 + (b) * 2 + (h)) * HTB)
#define PG8_STAGE(bufoff, gbase, voff) do { _Pragma("unroll") for (int _i = 0; _i < 2; ++_i) \
        __builtin_amdgcn_global_load_lds((const unsigned*)((const char*)(gbase) + (voff)[_i]), (PG8_LAS unsigned*)(lds + (bufoff) + ldsw + _i * 8192), 16, 0, 0); } while (0)
#define PG8_LDA(dst, b, h) do { _Pragma("unroll") for (int m = 0; m < 4; ++m) _Pragma("unroll") for (int k = 0; k < 2; ++k) dst[m][k] = *(const PG8_LAS bf16x8*)(lds + PG8_SA(b, h) + aoff + m * 2048 + k * 1024); } while (0)
#define PG8_LDB(dst, b, h) do { _Pragma("unroll") for (int n = 0; n < 2; ++n) _Pragma("unroll") for (int k = 0; k < 2; ++k) dst[n][k] = *(const PG8_LAS bf16x8*)(lds + PG8_SB(b, h) + boff + n * 2048 + k * 1024); } while (0)
#define PG8_MMA(ai, bj, At, Bt) do { __builtin_amdgcn_s_setprio(1); _Pragma("unroll") for (int m = 0; m < 4; ++m) _Pragma("unroll") for (int n = 0; n < 2; ++n) _Pragma("unroll") for (int k = 0; k < 2; ++k) \
        acc[ai][bj][m][n] = __builtin_amdgcn_mfma_f32_16x16x32_bf16(Bt[n][k], At[m][k], acc[ai][bj][m][n], 0, 0, 0); __builtin_amdgcn_s_setprio(0); } while (0)
#define PG8_WAIT_V(n) asm volatile("s_waitcnt vmcnt(" #n ")" ::: "memory")
#define PG8_WAIT_L(n) asm volatile("s_waitcnt lgkmcnt(" #n ")" ::: "memory")
#define PG8_BAR __builtin_amdgcn_s_barrier()
#define PG8_SCHED __builtin_amdgcn_sched_barrier(0)
    Unit cur, nxt; int ui = 0;
    if (!S.next(0, cur)) return;
    f32x4 acc[2][2][4][2];
#pragma unroll
    for (int a = 0; a < 2; ++a)
#pragma unroll
        for (int b = 0; b < 2; ++b)
#pragma unroll
            for (int m = 0; m < 4; ++m)
#pragma unroll
                for (int n = 0; n < 2; ++n) acc[a][b][m][n] = (f32x4){0.f, 0.f, 0.f, 0.f};
    bf16x8 At[4][2], B0[2][2], B1[2][2];
    const char* cA = (const char*)g.A + (size_t)cur.pm * tstepA; const char* cB = (const char*)g.Bt + (size_t)cur.pn * tstepB;
    S.a_ready(cur);
    if constexpr (SP2) {
        PG8_STAGE(PG8_SB(0, 0), cB, voffB); PG8_STAGE(PG8_SB(0, 1), cB + hstepB, voffB); PG8_STAGE(PG8_SA(0, 0), cA, voffA); PG8_STAGE(PG8_SA(0, 1), cA + hstepA, voffA);
        if (wr == 1) PG8_BAR;
        PG8_WAIT_V(2); PG8_BAR;
        PG8_STAGE(PG8_SB(1, 0), cB + kstep, voffB); PG8_STAGE(PG8_SA(1, 0), cA + kstep, voffA); PG8_STAGE(PG8_SB(1, 1), cB + hstepB + kstep, voffB);
        PG8_WAIT_V(6); PG8_BAR;
    } else {
        PG8_STAGE(PG8_SB(0, 0), cB, voffB); PG8_STAGE(PG8_SA(0, 0), cA, voffA); PG8_STAGE(PG8_SB(0, 1), cB + hstepB, voffB); PG8_STAGE(PG8_SA(0, 1), cA + hstepA, voffA);
        if (wr == 1) PG8_BAR;
        PG8_WAIT_V(4); PG8_BAR;
        PG8_STAGE(PG8_SB(1, 0), cB + kstep, voffB); PG8_STAGE(PG8_SA(1, 0), cA + kstep, voffA); PG8_STAGE(PG8_SB(1, 1), cB + hstepB + kstep, voffB);
        PG8_WAIT_V(6); PG8_BAR;
    }
    for (;;) {
        const bool has_next = S.next(ui + 1, nxt);
        const char* nA = has_next ? (const char*)g.A + (size_t)nxt.pm * tstepA : cA; const char* nB = has_next ? (const char*)g.Bt + (size_t)nxt.pn * tstepB : cB;
        for (int t = 0; t < nt; t += 2) {
            const bool last = (t == nt - 2);
            const char* a1 = cA + (size_t)(t + 1) * kstep;
            const char* a2 = last ? nA : cA + (size_t)(t + 2) * kstep; const char* b2 = last ? nB : cB + (size_t)(t + 2) * kstep;
            const char* a3 = a2 + kstep; const char* b3 = b2 + kstep;
            if (last && has_next) S.a_ready(nxt);
            if constexpr (SP2) {
            PG8_LDB(B0, 0, 0); PG8_LDB(B1, 0, 1); PG8_SCHED; PG8_LDA(At, 0, 0); PG8_STAGE(PG8_SA(1, 1), a1 + hstepA, voffA);
            PG8_WAIT_V(8); PG8_WAIT_L(0); PG8_BAR; PG8_MMA(0, 0, At, B0); PG8_MMA(0, 1, At, B1); PG8_BAR; PG8_SCHED;
            PG8_LDA(At, 0, 1); PG8_STAGE(PG8_SB(0, 0), b2, voffB); PG8_STAGE(PG8_SB(0, 1), b2 + hstepB, voffB); PG8_STAGE(PG8_SA(0, 0), a2, voffA);
            PG8_WAIT_V(8); PG8_WAIT_L(0); PG8_BAR; PG8_MMA(1, 0, At, B0); PG8_MMA(1, 1, At, B1); PG8_BAR; PG8_SCHED;
            PG8_LDB(B0, 1, 0); PG8_LDB(B1, 1, 1); PG8_SCHED; PG8_LDA(At, 1, 0); PG8_STAGE(PG8_SA(0, 1), a2 + hstepA, voffA);
            PG8_WAIT_V(8); PG8_WAIT_L(0); PG8_BAR; PG8_MMA(0, 0, At, B0); PG8_MMA(0, 1, At, B1); PG8_BAR; PG8_SCHED;
            PG8_LDA(At, 1, 1); PG8_STAGE(PG8_SB(1, 0), b3, voffB); PG8_STAGE(PG8_SB(1, 1), b3 + hstepB, voffB); PG8_STAGE(PG8_SA(1, 0), a3, voffA);
            PG8_WAIT_V(8); PG8_WAIT_L(0); PG8_BAR; PG8_MMA(1, 0, At, B0); PG8_MMA(1, 1, At, B1); PG8_BAR; PG8_SCHED;
            } else {
            PG8_LDB(B0, 0, 0); PG8_SCHED; PG8_LDA(At, 0, 0); PG8_STAGE(PG8_SA(1, 1), a1 + hstepA, voffA);
            PG8_WAIT_L(8); PG8_BAR; PG8_WAIT_L(0); PG8_MMA(0, 0, At, B0); PG8_BAR; PG8_SCHED;
            PG8_LDB(B1, 0, 1); PG8_STAGE(PG8_SB(0, 0), b2, voffB);
            PG8_BAR; PG8_WAIT_L(0); PG8_MMA(0, 1, At, B1); PG8_BAR;
            PG8_LDA(At, 0, 1); PG8_STAGE(PG8_SA(0, 0), a2, voffA);
            PG8_BAR; PG8_WAIT_L(0); PG8_MMA(1, 0, At, B0); PG8_BAR; PG8_SCHED;
            PG8_STAGE(PG8_SB(0, 1), b2 + hstepB, voffB);
            PG8_WAIT_V(6); PG8_BAR; PG8_MMA(1, 1, At, B1); PG8_BAR;
            PG8_LDB(B0, 1, 0); PG8_SCHED; PG8_LDA(At, 1, 0); PG8_STAGE(PG8_SA(0, 1), a2 + hstepA, voffA);
            PG8_WAIT_L(8); PG8_BAR; PG8_WAIT_L(0); PG8_MMA(0, 0, At, B0); PG8_BAR; PG8_SCHED;
            PG8_LDB(B1, 1, 1); PG8_STAGE(PG8_SB(1, 0), b3, voffB);
            PG8_BAR; PG8_WAIT_L(0); PG8_MMA(0, 1, At, B1); PG8_BAR;
            PG8_LDA(At, 1, 1); PG8_STAGE(PG8_SA(1, 0), a3, voffA);
            PG8_BAR; PG8_WAIT_L(0); PG8_MMA(1, 0, At, B0); PG8_BAR; PG8_SCHED;
            PG8_STAGE(PG8_SB(1, 1), b3 + hstepB, voffB);
            PG8_WAIT_V(6); PG8_BAR; PG8_MMA(1, 1, At, B1); PG8_BAR;
            }
        }
        if constexpr (ALIGN_EPI) { if (wr == 0) PG8_BAR; }
        if constexpr (!Epi::AFTER_DRAIN) { E(acc, cur, wr, wc, fr, fq); S.done(cur); }
        if (!has_next) break;
#pragma unroll
        for (int a = 0; a < 2; ++a)
#pragma unroll
            for (int b = 0; b < 2; ++b)
#pragma unroll
                for (int m = 0; m < 4; ++m)
#pragma unroll
                    for (int n = 0; n < 2; ++n) acc[a][b][m][n] = (f32x4){0.f, 0.f, 0.f, 0.f};
        cur = nxt; cA = nA; cB = nB; ++ui;
        if constexpr (ALIGN_EPI) { if (wr == 1) PG8_BAR; }
    }
    PG8_WAIT_V(0);
    if constexpr (!ALIGN_EPI) { if (wr == 0) PG8_BAR; }
    PG8_BAR;
    if constexpr (Epi::AFTER_DRAIN) { E.fused(acc, cur, wr, wc, fr, fq, lds, wid, lane); S.done(cur); }
#undef PG8_SA
#undef PG8_SB
#undef PG8_STAGE
#undef PG8_LDA
#undef PG8_LDB
#undef PG8_MMA
#undef PG8_WAIT_V
#undef PG8_WAIT_L
#undef PG8_BAR
#undef PG8_SCHED
}
}

constexpr int NWAVES = 8, NTHR = 512;
constexpr int LDS_BYTES = 147456;
#define GAS __attribute__((address_space(1)))
#define LAS __attribute__((address_space(3)))
typedef unsigned short bf16;
typedef unsigned v4u __attribute__((ext_vector_type(4)));
typedef unsigned v2u __attribute__((ext_vector_type(2)));
typedef float f32x4 __attribute__((ext_vector_type(4)));
typedef float f32x2 __attribute__((ext_vector_type(2)));
typedef float f32x16 __attribute__((ext_vector_type(16)));
typedef short bf16x8 __attribute__((ext_vector_type(8)));
typedef short s16x4 __attribute__((ext_vector_type(4)));

constexpr size_t MiB = 1u << 20;
constexpr size_t WS_CTL = 0;
constexpr size_t WS_PART = 1 * MiB;
constexpr size_t WS_ROPE = 3 * MiB;
constexpr size_t WS_HMETA = 4 * MiB;
constexpr size_t WS_LORA = 5 * MiB;
constexpr size_t WS_W = 6 * MiB;
constexpr size_t W_IN0 = WS_W, W_OUT0 = W_IN0 + (size_t)NIN * DM * 2, W_UP0 = W_OUT0 + (size_t)DM * DM * 2, W_DN0 = W_UP0 + (size_t)2 * DFF * DM * 2,
                 W_IN1 = W_DN0 + (size_t)DM * DFF * 2, W_OUT1 = W_IN1 + (size_t)NIN * DM * 2, W_UP1 = W_OUT1 + (size_t)DM * DM * 2, W_DN1 = W_UP1 + (size_t)2 * DFF * DM * 2,
                 W_END = W_DN1 + (size_t)DM * DFF * 2;
constexpr size_t WS_A = 56 * MiB;
constexpr size_t WS_R = 89 * MiB;
static_assert(W_END <= WS_A && WS_A + (size_t)MP * DM * 2 <= WS_R, "ws map");
constexpr size_t R_U = WS_R, R_WC = R_U + (size_t)MP * 512 * 2, R_GB = R_WC + (size_t)MP * 512 * 2, R_Y0 = R_GB + (size_t)MP * 512 * 2;
constexpr size_t R_G = WS_R, R_V = R_G + (size_t)MP * FCH * 2, R_HM = R_V + (size_t)MP * FCH * 2, R_FFN_END = R_HM + (size_t)MP * FCH * 2;
constexpr size_t R_Q = WS_R, R_KB = R_Q + (size_t)MP * 512 * 2, R_VB = R_KB + (size_t)MP * 128 * 2, R_PR = R_VB + (size_t)MP * 128 * 2, R_Y1 = R_PR + (size_t)MP * PRW * 2, R_L1_END = R_Y1 + (size_t)MP * DM * 2;
constexpr size_t WS_END = 256 * MiB;
static_assert(R_FFN_END <= WS_END && R_L1_END <= WS_END && R_Y0 + (size_t)MP * DM * 2 <= WS_END, "ws map 2");

#define LDS_WAIT() asm volatile("s_waitcnt lgkmcnt(0)" ::: "memory")
__device__ __forceinline__ unsigned f2bf(float f) { unsigned u = __builtin_bit_cast(unsigned, f); return (u + 0x7fffu + ((u >> 16) & 1u)) >> 16; }
__device__ __forceinline__ unsigned pk2(float lo, float hi) { return f2bf(lo) | (f2bf(hi) << 16); }
__device__ __forceinline__ float bf2f(unsigned short v) { return __builtin_bit_cast(float, (unsigned)v << 16); }
__device__ __forceinline__ float bflo(unsigned w) { return __builtin_bit_cast(float, w << 16); }
__device__ __forceinline__ float bfhi(unsigned w) { return __builtin_bit_cast(float, w & 0xffff0000u); }
__device__ __forceinline__ float sigm(float x) { return __builtin_amdgcn_rcpf(1.0f + __expf(-x)); }
__device__ __forceinline__ float dppf(float x, int ctrl_sel) {
    const int v = __builtin_bit_cast(int, x); int r;
    if (ctrl_sel == 0) r = __builtin_amdgcn_update_dpp(v, v, 0xB1, 0xF, 0xF, false);
    else if (ctrl_sel == 1) r = __builtin_amdgcn_update_dpp(v, v, 0x4E, 0xF, 0xF, false);
    else if (ctrl_sel == 2) r = __builtin_amdgcn_update_dpp(v, v, 0x141, 0xF, 0xF, false);
    else r = __builtin_amdgcn_update_dpp(v, v, 0x140, 0xF, 0xF, false);
    return __builtin_bit_cast(float, r);
}
__device__ __forceinline__ float sum16(float x) { x += dppf(x, 0); x += dppf(x, 1); x += dppf(x, 2); x += dppf(x, 3); return x; }

__device__ __forceinline__ void sum16x2(float& x0, float& x1) {
    asm volatile("s_nop 1\n\t"
        "v_add_f32_dpp %0, %0, %0 quad_perm:[1,0,3,2] row_mask:0xf bank_mask:0xf\n\t"
        "v_add_f32_dpp %1, %1, %1 quad_perm:[1,0,3,2] row_mask:0xf bank_mask:0xf\n\t"
        "s_nop 0\n\t"
        "v_add_f32_dpp %0, %0, %0 quad_perm:[2,3,0,1] row_mask:0xf bank_mask:0xf\n\t"
        "v_add_f32_dpp %1, %1, %1 quad_perm:[2,3,0,1] row_mask:0xf bank_mask:0xf\n\t"
        "s_nop 0\n\t"
        "v_add_f32_dpp %0, %0, %0 row_half_mirror row_mask:0xf bank_mask:0xf\n\t"
        "v_add_f32_dpp %1, %1, %1 row_half_mirror row_mask:0xf bank_mask:0xf\n\t"
        "s_nop 0\n\t"
        "v_add_f32_dpp %0, %0, %0 row_mirror row_mask:0xf bank_mask:0xf\n\t"
        "v_add_f32_dpp %1, %1, %1 row_mirror row_mask:0xf bank_mask:0xf\n\t"
        "s_nop 1"
        : "+v"(x0), "+v"(x1));
}
__device__ __forceinline__ float sum32(float x) { x = sum16(x); x += __shfl_xor(x, 16); return x; }
__device__ __forceinline__ float wave_sum(float v) {
#pragma unroll
    for (int o = 1; o < 64; o <<= 1) v += __shfl_xor(v, o);
    return v;
}
__device__ __forceinline__ int row_of(int b, int t) { return t >= NMETA ? b * SEQ + (t - NMETA) : MR + t; }


#define XB_TMO      128
#define XB_XCNT(j)  (256  + 64 * (j))
#define XB_XSUB(j)  (1280 + 64 * (j))
#define XB_XGEN(j)  (2304 + 64 * (j))
#define XB_TOP      3328
#define XB_TOPGEN   3392
#define XCD_BAR_WORDS 3456
#define XB_SPIN_CAP (1u << 18)
constexpr int LDSCTL_OFF = 147328, MISC_OFF = LDSCTL_OFF;
__device__ __forceinline__ unsigned xb_ld(unsigned* p)              { return __hip_atomic_load(p, __ATOMIC_RELAXED, __HIP_MEMORY_SCOPE_AGENT); }
__device__ __forceinline__ unsigned xb_add(unsigned* p, unsigned v) { return __hip_atomic_fetch_add(p, v, __ATOMIC_RELAXED, __HIP_MEMORY_SCOPE_AGENT); }
__device__ __forceinline__ unsigned xb_xcc_id() { return (unsigned)__builtin_amdgcn_s_getreg((3 << 11) | 20) & 0xFu; }
#define XB_SPIN(cond, bar) do { unsigned _sp = 0; while (cond) { __builtin_amdgcn_s_sleep(1); \
    if ((++_sp & 255u) == 0u) { if (xb_ld(&(bar)[XB_TMO])) break; if (_sp > XB_SPIN_CAP) { atomicAdd(&(bar)[XB_TMO], 1u); break; } } } } while (0)
__device__ __forceinline__ void xcd_barrier_complete(unsigned* bar, unsigned x, unsigned& nloc, unsigned& nx) {
    const unsigned G = gridDim.x * gridDim.y * gridDim.z;
    unsigned sum, cnt, mine, sp = 0u;
    for (;;) {
        sum = 0u; cnt = 0u; mine = 0u;
#pragma unroll
        for (unsigned j = 0; j < 16; ++j) { const unsigned c = xb_ld(&bar[XB_XCNT(j)]); sum += c; cnt += (c > 0u) ? 1u : 0u; mine = (j == x) ? c : mine; }
        if (sum == G) break;
        __builtin_amdgcn_s_sleep(1);
        if ((++sp & 255u) == 0u) { if (xb_ld(&bar[XB_TMO])) break; if (sp > XB_SPIN_CAP) { atomicAdd(&bar[XB_TMO], 1u); break; } }
    }
    nloc = mine > 0u ? mine : 1u; nx = cnt > 0u ? cnt : 1u;
}
__device__ __forceinline__ void xcd_barrier(unsigned* bar, volatile LAS unsigned* st, bool t0) {
    asm volatile("s_waitcnt vmcnt(0)" ::: "memory");
    __syncthreads();
    if (t0) {
        const unsigned x = xb_xcc_id();
        __builtin_amdgcn_s_waitcnt(0);
        unsigned nloc = st[0], nx = st[1];
        if (nloc == 0u) { xcd_barrier_complete(bar, x, nloc, nx); st[0] = nloc; st[1] = nx; }
        const unsigned old = xb_add(&bar[XB_XSUB(x)], 1u);
        const unsigned gen = old / nloc;
        if (old + 1u == (gen + 1u) * nloc) {
            __builtin_amdgcn_fence(__ATOMIC_RELEASE, "agent");
            asm volatile("s_waitcnt vmcnt(0)" ::: "memory");
            const unsigned og = xb_add(&bar[XB_TOP], 1u);
            const unsigned tg = og / nx;
            if (og + 1u == (tg + 1u) * nx) xb_add(&bar[XB_TOPGEN], 1u);
            else XB_SPIN(xb_ld(&bar[XB_TOPGEN]) == tg, bar);
            __builtin_amdgcn_fence(__ATOMIC_ACQUIRE, "agent");
            xb_add(&bar[XB_XGEN(x)], 1u);
            asm volatile("s_waitcnt vmcnt(0)" ::: "memory");
        } else {
            XB_SPIN(xb_ld(&bar[XB_XGEN(x)]) == gen, bar);
            __builtin_amdgcn_fence(__ATOMIC_ACQUIRE, "agent");
            asm volatile("s_waitcnt vmcnt(0)" ::: "memory");
        }
    }
    __syncthreads();
}

struct Args { const float* in[29]; float* out; unsigned char* ws; int ph_lo, ph_hi; };
typedef const __attribute__((address_space(4))) Args CArgs;

struct Frame {
    LAS unsigned char* lds; int tid, lane, wave, G, wg;
    float* out; unsigned char* ws;
};

__device__ __forceinline__ int colmap(int kind, int d) {
    if (kind == 0) return d;
    const int tile = d >> 8, bj = (d >> 7) & 1, cc = d & 127;
    if (kind == 1) {
        if (tile < 4) return (bj ? 512 : 0) + 128 * tile + cc;
        if (tile < 8) return (bj ? 2048 : 1536) + 128 * (tile - 4) + cc;
        return 1024 + (d - 2048);
    }
    if (kind == 2) return (bj ? DFF : 0) + 128 * tile + cc;
    const int w = cc >> 5, dd = cc & 31;
    if (tile < 2) return 64 * (4 * tile + w) + 32 * bj + dd;
    if (tile == 2) return (w < 2 ? 512 + 64 * w : 640 + 64 * (w - 2)) + 32 * bj + dd;
    return d;
}
__device__ __forceinline__ void p0_transpose_item(const float* W, int K, int N, bf16* WT, const float* gvec, int kind, LAS float* scr, int item, int nblk, int lane) {
    const int kb = item / nblk, db = item % nblk, k0 = 64 * kb, d0 = 32 * db, n0 = colmap(kind, d0);
#pragma unroll 8
    for (int i = 0; i < 32; ++i) { const int kk = 2 * i + (lane >> 5); float v = W[(size_t)(k0 + kk) * N + n0 + (lane & 31)]; if (gvec) v *= gvec[k0 + kk]; scr[kk * 33 + (lane & 31)] = v; }
    LDS_WAIT(); asm volatile("" ::: "memory");
    const int c = lane & 7;
#pragma unroll
    for (int j = 0; j < 4; ++j) { const int n = (lane >> 3) + 8 * j; const LAS float* s = scr + (8 * c) * 33 + n;
        v4u o; o.x = pk2(s[0 * 33], s[1 * 33]); o.y = pk2(s[2 * 33], s[3 * 33]); o.z = pk2(s[4 * 33], s[5 * 33]); o.w = pk2(s[6 * 33], s[7 * 33]);
        *(GAS v4u*)(WT + (size_t)(d0 + n) * K + k0 + 8 * c) = o; }
    LDS_WAIT(); asm volatile("" ::: "memory");
}
__device__ __forceinline__ void p0_job(Frame& F, LAS float* scr, int gw, int NGW, int& base, const float* W, int K, int N, size_t dst, const float* g, int kind) {
    const int nblk = N / 32, nitems = (K / 64) * nblk;
    int it = gw - (base % NGW); if (it < 0) it += NGW;
    for (; it < nitems; it += NGW) p0_transpose_item(W, K, N, (bf16*)(F.ws + dst), g, kind, scr, it, nblk, F.lane);
    base += nitems;
}
__device__ __forceinline__ void p0_prologue(Frame& F, CArgs& A) {
    LAS float* scr = (LAS float*)(F.lds + F.wave * 16384);
    const int gw = F.wg * NWAVES + F.wave, NGW = F.G * NWAVES, lane = F.lane;
    unsigned char* ws = F.ws;
    const float* norm_mix = A.in[2]; const float* norm_ffn = A.in[3];
    int base = 0;
    p0_job(F, scr, gw, NGW, base, A.in[5], DM, NIN, W_IN0, norm_mix, 1);
    p0_job(F, scr, gw, NGW, base, A.in[10], DM, DM, W_OUT0, nullptr, 0);
    p0_job(F, scr, gw, NGW, base, A.in[25], DM, 2 * DFF, W_UP0, norm_ffn, 2);
    p0_job(F, scr, gw, NGW, base, A.in[28], DFF, DM, W_DN0, nullptr, 0);
    p0_job(F, scr, gw, NGW, base, A.in[11], DM, NIN, W_IN1, norm_mix + DM, 3);
    p0_job(F, scr, gw, NGW, base, A.in[24], DM, DM, W_OUT1, nullptr, 0);
    p0_job(F, scr, gw, NGW, base, A.in[25] + (size_t)DM * 2 * DFF, DM, 2 * DFF, W_UP1, norm_ffn + DM, 2);
    p0_job(F, scr, gw, NGW, base, A.in[28] + (size_t)DFF * DM, DFF, DM, W_DN1, nullptr, 0);
    p0_job(F, scr, gw, NGW, base, A.in[15], 64, 512, WS_LORA, nullptr, 0);
    p0_job(F, scr, gw, NGW, base, A.in[17], 64, 512, WS_LORA + 512 * 64 * 2, nullptr, 0);
    p0_job(F, scr, gw, NGW, base, A.in[18], 128, 512, WS_LORA + 2 * 512 * 64 * 2, nullptr, 0);
    const float* x = A.in[0]; const float* meta = A.in[1];
    bf16* A0 = (bf16*)(ws + WS_A); float* part = (float*)(ws + WS_PART); float* hmeta = (float*)(ws + WS_HMETA);
    for (int row = gw; row < MP; row += NGW) {
        float* pp = part + (size_t)row * 16;
        if (row < MR + NMETA) {
            const float* src = row < MR ? x + (size_t)row * DM : meta + (size_t)(row - MR) * DM;
            float ss = 0.f;
#pragma unroll
            for (int j = 0; j < 4; ++j) { const f32x4 v = *(const GAS f32x4*)(src + j * 256 + lane * 4); ss += (v[0] * v[0] + v[1] * v[1]) + (v[2] * v[2] + v[3] * v[3]);
                v2u o; o.x = pk2(v[0], v[1]); o.y = pk2(v[2], v[3]); *(GAS v2u*)(A0 + (size_t)row * DM + j * 256 + lane * 4) = o;
                if (row >= MR) *(GAS f32x4*)(hmeta + (size_t)(row - MR) * DM + j * 256 + lane * 4) = v; }
            ss = wave_sum(ss);
            if (lane < 16) pp[lane] = lane == 0 ? ss : 0.f;
        } else {
            if (lane < 16) pp[lane] = 0.f;
#pragma unroll
            for (int j = 0; j < 4; ++j) { float zf; asm volatile("v_mov_b32 %0, 0" : "=v"(zf)); *(GAS f32x4*)(hmeta + (size_t)(row - MR) * DM + j * 256 + lane * 4) = (f32x4){zf, zf, zf, zf}; }
        }
    }
    float* rc = (float*)(ws + WS_ROPE); float* rsn = rc + TT * 32;
    for (int i = gw * 64 + lane; i < TT * 32; i += NGW * 64) {
        const int t = i >> 5, d = i & 31;
        const float inv = exp2f(-(float)d * (13.287712379549449f / 32.0f));
        const float ang = (float)t * inv;
        const float rev = ang * 0.15915494309189535f; const float a = (rev - floorf(rev)) * 6.283185307179586f;
        rc[i] = __cosf(a); rsn[i] = __sinf(a);
    }
}

__device__ __forceinline__ void conv0_phase(Frame& F, CArgs& A) {
    const bf16* U = (const bf16*)(F.ws + R_U); const bf16* WC = (const bf16*)(F.ws + R_WC); const bf16* GB = (const bf16*)(F.ws + R_GB); bf16* Y0 = (bf16*)(F.ws + R_Y0);
    const float* conv_a = A.in[6]; const float* ln_g = A.in[7]; const float* ln_b = A.in[8]; const float* conv_b = A.in[9];
    const int half = F.tid >> 8, ht = F.tid & 255, c0 = 2 * ht;
    LAS float* tile = (LAS float*)(F.lds + half * 40960);
    LAS float* stats = (LAS float*)(F.lds + half * 40960 + 32768);
    float wa[31][2];
#pragma unroll
    for (int j = 0; j < 31; ++j) { const f32x2 w = *(const f32x2*)(conv_a + j * 512 + c0); wa[j][0] = w.x; wa[j][1] = w.y; }
    float wb[3][2];
#pragma unroll
    for (int j = 0; j < 3; ++j) { const f32x2 w = *(const f32x2*)(conv_b + j * 512 + c0); wb[j][0] = w.x; wb[j][1] = w.y; }
    const f32x2 lg = *(const f32x2*)(ln_g + c0), lb = *(const f32x2*)(ln_b + c0);
    const int NU = NB * 128 + 1;
    const int nhu = 2 * F.G;
    for (int u0 = 0; u0 < NU; u0 += nhu) {
        const int u = u0 + F.wg * 2 + half; const bool act = u < NU;
        int b = 0, t0 = 0; if (act) { if (u == NB * 128) { b = 0; t0 = 0; } else { b = u >> 7; t0 = 16 + 16 * (u & 127); } }
        if (act) {
            unsigned uin[46];
#pragma unroll
            for (int i = 0; i < 46; ++i) { const int t = t0 - 30 + i; uin[i] = t >= 0 ? *(const unsigned*)(U + (size_t)row_of(b, t) * 512 + c0) : 0u; }
#pragma unroll
            for (int o = 0; o < 16; ++o) { float a0 = 0.f, a1 = 0.f;
#pragma unroll
                for (int j = 0; j < 31; ++j) { a0 += wa[j][0] * bflo(uin[o + j]); a1 += wa[j][1] * bfhi(uin[o + j]); }
                *(LAS f32x2*)(tile + o * 512 + c0) = (f32x2){a0, a1}; }
        }
        __syncthreads();
        if (act) {
            const int tok = ht >> 4, q = ht & 15; float s = 0.f, ss = 0.f;
#pragma unroll
            for (int i = 0; i < 8; ++i) { const f32x4 v = *(const LAS f32x4*)(tile + tok * 512 + i * 64 + q * 4); s += (v[0] + v[1]) + (v[2] + v[3]); ss += (v[0] * v[0] + v[1] * v[1]) + (v[2] * v[2] + v[3] * v[3]); }
            s = sum16(s); ss = sum16(ss);
            if (q == 0) { const float mu = s * (1.f / 512.f); float var = ss * (1.f / 512.f) - mu * mu; var = var < 0.f ? 0.f : var; stats[tok * 2] = mu; stats[tok * 2 + 1] = rsqrtf(var + 1e-5f); }
        }
        __syncthreads();
        if (act) {
            unsigned win[18];
#pragma unroll
            for (int i = 0; i < 18; ++i) { const int t = t0 - 2 + i; win[i] = t >= 0 ? *(const unsigned*)(WC + (size_t)row_of(b, t) * 512 + c0) : 0u; }
#pragma unroll
            for (int o = 0; o < 16; ++o) {
                const int row = row_of(b, t0 + o);
                const f32x2 v = *(const LAS f32x2*)(tile + o * 512 + c0); const float mu = stats[o * 2], rs = stats[o * 2 + 1];
                float y0 = (v.x - mu) * rs * lg.x + lb.x, y1 = (v.y - mu) * rs * lg.y + lb.y; y0 *= sigm(y0); y1 *= sigm(y1);
                *(unsigned*)(Y0 + (size_t)row * DM + c0) = pk2(y0, y1);
                float z0 = 0.f, z1 = 0.f;
#pragma unroll
                for (int j = 0; j < 3; ++j) { z0 += wb[j][0] * bflo(win[o + j]); z1 += wb[j][1] * bfhi(win[o + j]); }
                const unsigned gbv = *(const unsigned*)(GB + (size_t)row * 512 + c0);
                *(unsigned*)(Y0 + (size_t)row * DM + 512 + c0) = pk2(z0 * bflo(gbv), z1 * bfhi(gbv));
            }
        }
        __syncthreads();
    }
}

__device__ __forceinline__ void ffn_mid_phase(Frame& F, CArgs& A, int layer, int chunk) {
    const bf16* G = (const bf16*)(F.ws + R_G); const bf16* V = (const bf16*)(F.ws + R_V); bf16* HM = (bf16*)(F.ws + R_HM);
    const float* cw = A.in[26] + (size_t)layer * 3 * DFF + chunk * FCH; const float* cb = A.in[27] + (size_t)layer * DFF + chunk * FCH;
    constexpr int NCG = FCH / 8;
    const int NITEM = (NB * 128 + 1) * NCG;
    for (int it = F.wg * NTHR + F.tid; it < NITEM; it += F.G * NTHR) {
        const int cgp = it % NCG, blk = it / NCG, c0 = cgp * 8;
        int b, t0; if (blk == NB * 128) { b = 0; t0 = 0; } else { b = blk >> 7; t0 = 16 + 16 * (blk & 127); }
        float w0[8], w1[8], w2[8], bb[8];
#pragma unroll
        for (int e = 0; e < 8; ++e) { w0[e] = cw[c0 + e]; w1[e] = cw[DFF + c0 + e]; w2[e] = cw[2 * DFF + c0 + e]; bb[e] = cb[c0 + e]; }
        float g2[8], g1[8];
#pragma unroll
        for (int e = 0; e < 8; ++e) { g2[e] = 0.f; g1[e] = 0.f; }
        if (t0 >= 2) { const v4u a = *(const v4u*)(G + (size_t)row_of(b, t0 - 2) * FCH + c0), c = *(const v4u*)(G + (size_t)row_of(b, t0 - 1) * FCH + c0);
#pragma unroll
            for (int e = 0; e < 4; ++e) { g2[2 * e] = bflo(a[e]); g2[2 * e + 1] = bfhi(a[e]); g1[2 * e] = bflo(c[e]); g1[2 * e + 1] = bfhi(c[e]); } }
#pragma unroll 4
        for (int o = 0; o < 16; ++o) {
            const size_t off = (size_t)row_of(b, t0 + o) * FCH + c0;
            const v4u gv = *(const v4u*)(G + off), vv = *(const v4u*)(V + off);
            float g0[8], vf[8];
#pragma unroll
            for (int e = 0; e < 4; ++e) { g0[2 * e] = bflo(gv[e]); g0[2 * e + 1] = bfhi(gv[e]); vf[2 * e] = bflo(vv[e]); vf[2 * e + 1] = bfhi(vv[e]); }
            float r[8];
#pragma unroll
            for (int e = 0; e < 8; ++e) { const float z = w0[e] * g2[e] + w1[e] * g1[e] + w2[e] * g0[e] + bb[e]; r[e] = z * sigm(z) * vf[e]; g2[e] = g1[e]; g1[e] = g0[e]; }
            v4u o4; o4.x = pk2(r[0], r[1]); o4.y = pk2(r[2], r[3]); o4.z = pk2(r[4], r[5]); o4.w = pk2(r[6], r[7]);
            *(v4u*)(HM + off) = o4;
        }
    }
}

__device__ __forceinline__ int crow(int r, int hi) { return (r & 3) + 8 * (r >> 2) + 4 * hi; }
constexpr int ATT_KS = 72, ATT_VS = 232, ATT_K_BYTES = 224 * ATT_KS * 2;
__device__ __forceinline__ void attn_unit(Frame& F, const float* sinks, int b, int kvh, int qb) {
    const bf16* Q = (const bf16*)(F.ws + R_Q); const bf16* KB = (const bf16*)(F.ws + R_KB); const bf16* VB = (const bf16*)(F.ws + R_VB); bf16* Y1 = (bf16*)(F.ws + R_Y1);
    LAS bf16* Ks = (LAS bf16*)F.lds; LAS bf16* Vt = (LAS bf16*)(F.lds + ATT_K_BYTES);
    const int tid = F.tid, lane = F.lane, wave = F.wave, g = wave >> 1, half = wave & 1, qh = kvh * 4 + g, qi = lane & 31, hi = lane >> 5;
    const bool meta = qb < 0; const int q0 = meta ? 0 : 64 * qb;
#pragma unroll
    for (int i = 0; i < 4; ++i) {
        const int id = tid + 512 * i, key = id >> 3, ch = id & 7;
        if (key < 224) {
            int row = -1;
            if (key < 192) { const int sp = q0 - 128 + key; if (!meta && sp >= 0) row = b * SEQ + sp; }
            else if (key < 208) row = MR + (key - 192);
            v4u kv = (v4u){0u, 0u, 0u, 0u}, vv = (v4u){0u, 0u, 0u, 0u};
            if (row >= 0) { kv = *(const v4u*)(KB + (size_t)row * 128 + kvh * 64 + ch * 8); vv = *(const v4u*)(VB + (size_t)row * 128 + kvh * 64 + ch * 8); }
            *(LAS v4u*)(Ks + key * ATT_KS + ch * 8) = kv;
#pragma unroll
            for (int e = 0; e < 4; ++e) { Vt[(ch * 8 + 2 * e) * ATT_VS + key] = (bf16)(vv[e] & 0xffffu); Vt[(ch * 8 + 2 * e + 1) * ATT_VS + key] = (bf16)(vv[e] >> 16); }
        }
    }
    __syncthreads();
    int qrow; if (meta) { const int m = 32 * half + qi; qrow = MR + (m < NMETA ? m : NMETA - 1); } else qrow = b * SEQ + q0 + 32 * half + qi;
    bf16x8 qr[4];
#pragma unroll
    for (int k4 = 0; k4 < 4; ++k4) qr[k4] = *(const bf16x8*)(Q + (size_t)qrow * 512 + qh * 64 + 16 * k4 + 8 * hi);
    f32x16 sc[6];
#pragma unroll
    for (int i = 0; i < 6; ++i) {
        const int t = i < 5 ? half + i : 6;
        f32x16 a = (f32x16){0.f,0.f,0.f,0.f,0.f,0.f,0.f,0.f,0.f,0.f,0.f,0.f,0.f,0.f,0.f,0.f};
#pragma unroll
        for (int k4 = 0; k4 < 4; ++k4) { const bf16x8 kf = *(const LAS bf16x8*)(Ks + (32 * t + qi) * ATT_KS + 16 * k4 + 8 * hi); a = __builtin_amdgcn_mfma_f32_32x32x16_bf16(kf, qr[k4], a, 0, 0, 0); }
        sc[i] = a;
    }
    const float sink = sinks[qh]; float mx = sink;
    const int mq = 32 * half + qi;
#pragma unroll
    for (int i = 0; i < 6; ++i)
#pragma unroll
        for (int r = 0; r < 16; ++r) {
            const int kr = crow(r, hi); bool ok;
            if (i < 5) { const int dist = 128 - 32 * i + qi - kr; const int sp = q0 - 128 + 32 * (half + i) + kr; ok = !meta && dist >= 0 && dist < 128 && sp >= 0; }
            else ok = kr < NMETA && (!meta || kr <= mq);
            const float v = ok ? sc[i][r] * 0.125f : -1e30f; sc[i][r] = v; mx = fmaxf(mx, v);
        }
    mx = fmaxf(mx, __shfl_xor(mx, 32));
    float ls = 0.f;
#pragma unroll
    for (int i = 0; i < 6; ++i)
#pragma unroll
        for (int r = 0; r < 16; ++r) { const float p = __expf(sc[i][r] - mx); sc[i][r] = p; ls += p; }
    ls += __shfl_xor(ls, 32); ls += __expf(sink - mx);
    const float inv = 1.0f / ls;
    f32x16 o[2];
    o[0] = (f32x16){0.f,0.f,0.f,0.f,0.f,0.f,0.f,0.f,0.f,0.f,0.f,0.f,0.f,0.f,0.f,0.f}; o[1] = o[0];
#pragma unroll
    for (int i = 0; i < 6; ++i) {
        const int t = i < 5 ? half + i : 6;
#pragma unroll
        for (int s2 = 0; s2 < 2; ++s2) {
            v4u pw; pw.x = pg8::cvt_pk_bf16(sc[i][8 * s2 + 0], sc[i][8 * s2 + 1]); pw.y = pg8::cvt_pk_bf16(sc[i][8 * s2 + 2], sc[i][8 * s2 + 3]);
            pw.z = pg8::cvt_pk_bf16(sc[i][8 * s2 + 4], sc[i][8 * s2 + 5]); pw.w = pg8::cvt_pk_bf16(sc[i][8 * s2 + 6], sc[i][8 * s2 + 7]);
            const bf16x8 pa = __builtin_bit_cast(bf16x8, pw);
#pragma unroll
            for (int dt = 0; dt < 2; ++dt) {
                const LAS bf16* vp = Vt + (dt * 32 + qi) * ATT_VS + 32 * t + 16 * s2 + 4 * hi;
                const v2u lo = *(const LAS v2u*)vp, hh = *(const LAS v2u*)(vp + 8);
                const v4u vw = (v4u){lo.x, lo.y, hh.x, hh.y};
                o[dt] = __builtin_amdgcn_mfma_f32_32x32x16_bf16(pa, __builtin_bit_cast(bf16x8, vw), o[dt], 0, 0, 0);
            }
        }
    }
#pragma unroll
    for (int r = 0; r < 16; ++r) {
        const int qq = crow(r, hi); const float iv = __shfl(inv, qq);
        int orow; bool ok = true;
        if (meta) { const int m = 32 * half + qq; ok = m < NMETA; orow = MR + m; } else orow = b * SEQ + q0 + 32 * half + qq;
        if (ok) {
            Y1[(size_t)orow * DM + qh * 64 + qi] = (bf16)f2bf(o[0][r] * iv);
            Y1[(size_t)orow * DM + qh * 64 + 32 + qi] = (bf16)f2bf(o[1][r] * iv);
        }
    }
    __syncthreads();
}

constexpr int IMG_PT = 0, IMG_BK = 4096, IMG_VT = 8192, IMG_QT = 10240, IMG_W16 = 11264, IMG_BYTES = 11520;
constexpr int NBLK = 129, NBLK_H1 = 65;
constexpr size_t WS_IMG = 203 * MiB;
constexpr size_t WS_G = WS_A, WS_RK = WS_A + 17 * MiB, WS_ZS = WS_A + 18 * MiB;
static_assert(WS_IMG >= R_L1_END && WS_IMG + (size_t)64 * NBLK_H1 * IMG_BYTES <= WS_END, "image region");
constexpr int P_PRL = 0, P_XR = 15616, P_XK = P_XR + 4096, P_XV = P_XK + 4096, P_TW = P_XV + 4096, P_XA = P_TW + 2304, P_SG = P_XA + 2304,
              P_LW = P_SG + 4352, P_LA = P_LW + 4096, P_LG = P_LA + 4096, P_FW = P_LG + 4096, P_FK = P_FW + 4096, P_FA = P_FK + 4096, P_FB = P_FA + 4096,
              P_WC = P_FB + 4096, P_E1 = P_WC + 4096, P_E2 = P_E1 + 4608, P_ATF = P_E2 + 4608, P_RTF = P_ATF + 4096, P_M = P_RTF + 4096, P_T = P_M + 4224, P_PTF = P_T + 1088,
              P_QF = P_PTF + 4096, P_IMG = P_QF + 1088, P_END = P_IMG + IMG_BYTES;
static_assert(P_END <= 131072 && (P_IMG % 16) == 0 && (P_E1 % 16) == 0 && (P_E2 % 16) == 0, "prep lds map");
constexpr int PRS = 456;
__device__ __forceinline__ float wsum64(float x) { x = sum16(x); x += __shfl_xor(x, 16); x += __shfl_xor(x, 32); return x; }

__device__ __forceinline__ void rwkv_prep_phase(Frame& F, CArgs& A, int nbase, int cnt) {
    const bf16* PR = (const bf16*)(F.ws + R_PR);
    const bf16* w2t = (const bf16*)(F.ws + WS_LORA); const bf16* a2t = w2t + 512 * 64; const bf16* g2t = a2t + 512 * 64;
    const int tid = F.tid, lane = F.lane, wave = F.wave;
    LAS unsigned char* L = F.lds;
    LAS bf16* PRL = (LAS bf16*)(L + P_PRL);
    LAS float* XR = (LAS float*)(L + P_XR); LAS float* XK = (LAS float*)(L + P_XK); LAS float* XV = (LAS float*)(L + P_XV);
    LAS bf16* TW = (LAS bf16*)(L + P_TW); LAS bf16* XA = (LAS bf16*)(L + P_XA); LAS bf16* SG = (LAS bf16*)(L + P_SG);
    LAS float* LW = (LAS float*)(L + P_LW); LAS float* LA = (LAS float*)(L + P_LA); LAS float* LG = (LAS float*)(L + P_LG);
    LAS float* FW = (LAS float*)(L + P_FW); LAS float* FK = (LAS float*)(L + P_FK); LAS float* FA = (LAS float*)(L + P_FA); LAS float* FB = (LAS float*)(L + P_FB);
    LAS float* WC = (LAS float*)(L + P_WC); LAS bf16* E1 = (LAS bf16*)(L + P_E1); LAS bf16* E2 = (LAS bf16*)(L + P_E2);
    LAS float* ATF = (LAS float*)(L + P_ATF); LAS float* RTF = (LAS float*)(L + P_RTF); LAS float* M = (LAS float*)(L + P_M); LAS float* T = (LAS float*)(L + P_T);
    LAS float* PTF = (LAS float*)(L + P_PTF); LAS float* QF = (LAS float*)(L + P_QF);
    LAS bf16* I_PT = (LAS bf16*)(L + P_IMG + IMG_PT); LAS bf16* I_BK = (LAS bf16*)(L + P_IMG + IMG_BK); LAS bf16* I_VT = (LAS bf16*)(L + P_IMG + IMG_VT);
    LAS bf16* I_QT = (LAS bf16*)(L + P_IMG + IMG_QT); LAS float* I_W16 = (LAS float*)(L + P_IMG + IMG_W16);
    const int nunits = 64 * cnt;
    if (F.wg >= nunits) return;
    int ld_pr[2], ld_pc[2]; bool ld_ok[2];
#pragma unroll
    for (int i = 0; i < 2; ++i) { const int q = tid + 512 * i; ld_ok[i] = q < 952; ld_pr[i] = ld_ok[i] ? q / 56 : 0; ld_pc[i] = ld_ok[i] ? q % 56 : 0; }
#define PP_LOAD(id_, dst) do { const int ch_ = (id_) & 63, n_ = nbase + ((id_) >> 6), b_ = ch_ >> 3, h_ = ch_ & 7; \
        _Pragma("unroll") for (int i_ = 0; i_ < 2; ++i_) { const int pr = ld_pr[i_], pc = ld_pc[i_]; \
            const int col = pc < 8 ? 64 * h_ + 8 * pc : pc < 16 ? 512 + 64 * h_ + 8 * (pc - 8) : pc < 24 ? 1024 + 64 * h_ + 8 * (pc - 16) : 1536 + 8 * (pc - 24); \
            int gr = n_ == 0 ? MR + pr - 1 : n_ == 1 ? (pr == 0 ? MR + NMETA - 1 : b_ * SEQ + pr - 1) : b_ * SEQ + 16 * (n_ - 1) - 1 + pr; \
            const bool zero_ = (n_ == 0 && pr == 0); if (zero_) gr = MR; \
            v4u v_ = *(const v4u*)(PR + (size_t)gr * PRW + col); if (zero_) v_ = (v4u){0u, 0u, 0u, 0u}; dst[i_] = v_; } } while (0)
    v4u pf[2];
    PP_LOAD(F.wg, pf);
    int cur_chain = -1;
    float c_mu[14]; bf16x8 c_bfr[4]; f32x2 c_w0 = (f32x2){0.f, 0.f}, c_a0 = c_w0, c_kk = c_w0, c_ka = c_w0, c_rk = c_w0;
#pragma unroll
    for (int i = 0; i < 14; ++i) c_mu[i] = 0.f;
#pragma unroll
    for (int i = 0; i < 4; ++i) c_bfr[i] = (bf16x8){0, 0, 0, 0, 0, 0, 0, 0};
    const int tt = tid >> 5, jp = tid & 31, j0 = 2 * jp;
#pragma unroll 1
    for (int id = F.wg; id < nunits; id += F.G) {
    const int chain = id & 63, n = nbase + (id >> 6);
    const int b = chain >> 3, h = chain & 7, ch0 = 64 * h + j0;
    if (chain != cur_chain) {
        cur_chain = chain;
        const float* mu = A.in[13];
#pragma unroll
        for (int i = 0; i < 14; ++i) { const int c = (tid & 31) + 32 * i; const int gcol = c < 64 ? 64 * h + c : c < 128 ? 512 + 64 * h + (c - 64) : c < 192 ? 1024 + 64 * h + (c - 128) : 1536 + (c - 192); c_mu[i] = mu[gcol]; }
        { const int nb = wave & 3, grp = wave >> 2, ar = lane & 15, ak = 8 * (lane >> 4);
          if (grp == 0) { c_bfr[0] = *(const bf16x8*)(w2t + (size_t)(64 * h + 16 * nb + ar) * 64 + ak); c_bfr[1] = *(const bf16x8*)(w2t + (size_t)(64 * h + 16 * nb + ar) * 64 + 32 + ak);
                          c_bfr[2] = *(const bf16x8*)(a2t + (size_t)(64 * h + 16 * nb + ar) * 64 + ak); c_bfr[3] = *(const bf16x8*)(a2t + (size_t)(64 * h + 16 * nb + ar) * 64 + 32 + ak); }
          else {
#pragma unroll
              for (int k = 0; k < 4; ++k) c_bfr[k] = *(const bf16x8*)(g2t + (size_t)(64 * h + 16 * nb + ar) * 128 + 32 * k + ak); } }
        c_w0 = *(const f32x2*)(A.in[14] + ch0); c_a0 = *(const f32x2*)(A.in[16] + ch0); c_kk = *(const f32x2*)(A.in[19] + ch0); c_ka = *(const f32x2*)(A.in[20] + ch0); c_rk = *(const f32x2*)(A.in[21] + ch0);
    }
    const int r0 = n == 0 ? MR : b * SEQ + 16 * (n - 1);
#pragma unroll
    for (int i = 0; i < 2; ++i) if (ld_ok[i]) *(LAS v4u*)(PRL + ld_pr[i] * PRS + 8 * ld_pc[i]) = pf[i];
    if (id + F.G < nunits) PP_LOAD(id + F.G, pf);
    __syncthreads();
    {
        const int t2 = tid >> 5, l32 = tid & 31;
#pragma unroll
        for (int i = 0; i < 14; ++i) {
            const int c = l32 + 32 * i;
            const float cur = bf2f(PRL[(1 + t2) * PRS + c]), prv = bf2f(PRL[t2 * PRS + c]);
            const float x = cur + (prv - cur) * c_mu[i];
            if (c < 64) XR[t2 * 64 + c] = x; else if (c < 128) XK[t2 * 64 + c - 64] = x; else if (c < 192) XV[t2 * 64 + c - 128] = x;
            else if (c < 256) { const float e = __expf(2.0f * x); TW[t2 * 72 + c - 192] = (bf16)f2bf(1.0f - 2.0f * __builtin_amdgcn_rcpf(e + 1.0f)); }
            else if (c < 320) XA[t2 * 72 + c - 256] = (bf16)f2bf(x); else SG[t2 * 136 + c - 320] = (bf16)f2bf(sigm(x));
        }
    }
    __syncthreads();
    {
        const int nb = wave & 3, grp = wave >> 2, ar = lane & 15, ak = 8 * (lane >> 4);
        pg8::f32x4 d0 = (pg8::f32x4){0.f, 0.f, 0.f, 0.f}, d1 = d0;
        if (grp == 0) {
#pragma unroll
            for (int k = 0; k < 2; ++k) { const bf16x8 af = *(const LAS bf16x8*)(TW + ar * 72 + 32 * k + ak); d0 = __builtin_amdgcn_mfma_f32_16x16x32_bf16(af, c_bfr[k], d0, 0, 0, 0); }
#pragma unroll
            for (int k = 0; k < 2; ++k) { const bf16x8 af = *(const LAS bf16x8*)(XA + ar * 72 + 32 * k + ak); d1 = __builtin_amdgcn_mfma_f32_16x16x32_bf16(af, c_bfr[2 + k], d1, 0, 0, 0); }
#pragma unroll
            for (int r = 0; r < 4; ++r) { LW[(4 * (lane >> 4) + r) * 64 + 16 * nb + ar] = d0[r]; LA[(4 * (lane >> 4) + r) * 64 + 16 * nb + ar] = d1[r]; }
        } else {
#pragma unroll
            for (int k = 0; k < 4; ++k) { const bf16x8 af = *(const LAS bf16x8*)(SG + ar * 136 + 32 * k + ak); d0 = __builtin_amdgcn_mfma_f32_16x16x32_bf16(af, c_bfr[k], d0, 0, 0, 0); }
#pragma unroll
            for (int r = 0; r < 4; ++r) LG[(4 * (lane >> 4) + r) * 64 + 16 * nb + ar] = d0[r];
        }
    }
    __syncthreads();
    {
        const f32x2 lw = *(const LAS f32x2*)(LW + tt * 64 + j0), la = *(const LAS f32x2*)(LA + tt * 64 + j0), lg = *(const LAS f32x2*)(LG + tt * 64 + j0);
        const f32x2 xr = *(const LAS f32x2*)(XR + tt * 64 + j0), xk = *(const LAS f32x2*)(XK + tt * 64 + j0), xv = *(const LAS f32x2*)(XV + tt * 64 + j0);
        const float wd0 = __expf(-0.6065306597126334f * sigm(c_w0.x + lw.x)), wd1 = __expf(-0.6065306597126334f * sigm(c_w0.y + lw.y));
        const float al0 = sigm(c_a0.x + la.x), al1 = sigm(c_a0.y + la.y);
        const float q0 = xk.x * c_kk.x, q1 = xk.y * c_kk.y;
        const float nrm = sum32(q0 * q0 + q1 * q1); const float rn = 1.0f / fmaxf(sqrtf(nrm), 1e-12f);
        const float kk0 = q0 * rn, kk1 = q1 * rn;
        const float kn0 = xk.x * (1.0f + (al0 - 1.0f) * c_ka.x), kn1 = xk.y * (1.0f + (al1 - 1.0f) * c_ka.y);
        const float rkp = sum32(xr.x * kn0 * c_rk.x + xr.y * kn1 * c_rk.y);
        *(LAS f32x2*)(FW + tt * 64 + j0) = (f32x2){wd0, wd1}; *(LAS f32x2*)(FK + tt * 64 + j0) = (f32x2){kn0, kn1};
        *(LAS f32x2*)(FA + tt * 64 + j0) = (f32x2){-kk0, -kk1}; *(LAS f32x2*)(FB + tt * 64 + j0) = (f32x2){kk0 * al0, kk1 * al1};
        I_VT[j0 * 16 + tt] = (bf16)f2bf(xv.x); I_VT[(j0 + 1) * 16 + tt] = (bf16)f2bf(xv.y);
        if (n > 0 || b == 0) {
            *(unsigned*)((bf16*)(F.ws + WS_G) + (size_t)(r0 + tt) * 512 + ch0) = pk2(lg.x, lg.y);
            if (jp == 0) ((float*)(F.ws + WS_RK))[(size_t)(r0 + tt) * 8 + h] = rkp;
        }
    }
    __syncthreads();
    if (tid < 64) { float wc = 1.0f;
#pragma unroll
        for (int s = 0; s < 16; ++s) { wc *= FW[s * 64 + tid]; WC[s * 64 + tid] = wc; } }
    __syncthreads();
    {
        const int s = tt;
#pragma unroll
        for (int e = 0; e < 2; ++e) { const int j = j0 + e;
            const float wp = s > 0 ? WC[(s - 1) * 64 + j] : 1.0f, wcv = WC[s * 64 + j], w16 = WC[15 * 64 + j], iw = 1.0f / wcv;
            const float at = wp * FA[s * 64 + j], rt = wcv * XR[s * 64 + j], bh = FB[s * 64 + j] * iw, kh = FK[s * 64 + j] * iw;
            E1[s * 72 + j] = (bf16)f2bf(bh); E1[(16 + s) * 72 + j] = (bf16)f2bf(kh); E2[s * 72 + j] = (bf16)f2bf(at); E2[(16 + s) * 72 + j] = (bf16)f2bf(rt);
            ATF[s * 64 + j] = at; RTF[s * 64 + j] = rt;
            I_BK[j * 32 + s] = (bf16)f2bf(bh * w16); I_BK[j * 32 + 16 + s] = (bf16)f2bf(kh * w16);
            if (s == 0) { const int jt = j >> 5, jj = j & 31, hi_ = (jj >> 2) & 1, r_ = (jj & 3) + 4 * (jj >> 3); I_W16[hi_ * 32 + jt * 16 + r_] = w16; }
        }
    }
    __syncthreads();
    if (wave == 0) {
        const int m = lane & 31, hh = lane >> 5;
        f32x16 d = (f32x16){0.f,0.f,0.f,0.f,0.f,0.f,0.f,0.f,0.f,0.f,0.f,0.f,0.f,0.f,0.f,0.f};
#pragma unroll
        for (int ks = 0; ks < 4; ++ks) { const bf16x8 af = *(const LAS bf16x8*)(E1 + m * 72 + 16 * ks + 8 * hh), bfv = *(const LAS bf16x8*)(E2 + m * 72 + 16 * ks + 8 * hh); d = __builtin_amdgcn_mfma_f32_32x32x16_bf16(af, bfv, d, 0, 0, 0); }
#pragma unroll
        for (int r = 0; r < 16; ++r) { const int mr = crow(r, hh), nc = m; const int u = mr & 15, s = nc & 15; const bool keep = (nc < 16) ? (u < s) : (u <= s);
            M[mr * 33 + nc] = keep ? d[r] : 0.0f; }
    }
    __syncthreads();
    if (tid < 16) { float t[16];
#pragma unroll
        for (int s = 0; s < 16; ++s) { float acc = (tid == s) ? 1.0f : 0.0f;
#pragma unroll
            for (int u = 0; u < s; ++u) acc += t[u] * M[u * 33 + s];
            t[s] = acc; }
#pragma unroll
        for (int s = 0; s < 16; ++s) T[tid * 17 + s] = t[s]; }
    __syncthreads();
    {
        const int s = tt; float p0 = 0.f, p1 = 0.f;
#pragma unroll
        for (int u = 0; u < 16; ++u) { const float tv = T[u * 17 + s]; const f32x2 av = *(const LAS f32x2*)(ATF + u * 64 + j0); p0 += tv * av.x; p1 += tv * av.y; }
        *(LAS f32x2*)(PTF + s * 64 + j0) = (f32x2){p0, p1}; *(LAS unsigned*)(I_PT + s * 64 + j0) = pk2(p0, p1);
        if (tid < 256) { const int u = tid >> 4, sq = tid & 15; float q = 0.f;
#pragma unroll
            for (int x = 0; x < 16; ++x) q += M[(16 + u) * 33 + x] * T[x * 17 + sq];
            QF[u * 17 + sq] = q; I_QT[sq * 16 + u] = (bf16)f2bf(q); }
    }
    __syncthreads();
    {
        const int s = tt; const f32x2 rv = *(const LAS f32x2*)(RTF + s * 64 + j0); float p0 = rv.x, p1 = rv.y;
#pragma unroll
        for (int u = 0; u < 16; ++u) { const float mv = M[u * 33 + 16 + s]; const f32x2 pv = *(const LAS f32x2*)(PTF + u * 64 + j0); p0 += mv * pv.x; p1 += mv * pv.y; }
        *(LAS unsigned*)(I_PT + (16 + s) * 64 + j0) = pk2(p0, p1);
        if (tid < 256) { const int u = tid >> 4, sq = tid & 15; float q = M[(16 + u) * 33 + 16 + sq];
#pragma unroll
            for (int x = 0; x < 16; ++x) q += QF[u * 17 + x] * M[x * 33 + 16 + sq];
            I_QT[(16 + sq) * 16 + u] = (bf16)f2bf(q); }
    }
    __syncthreads();
    {
        const int nl = n - nbase;
        unsigned char* dst = F.ws + WS_IMG + ((size_t)chain * NBLK_H1 + nl) * IMG_BYTES;
        for (int q = tid; q < IMG_BYTES / 16; q += NTHR) *(v4u*)(dst + q * 16) = *(const LAS v4u*)(L + P_IMG + q * 16);
    }
    asm volatile("s_waitcnt lgkmcnt(0)\n\ts_barrier" ::: "memory");
    }
#undef PP_LOAD
}

constexpr int SL_PT = 0, SL_BK = 4352, SL_VT = SL_BK + 5120, SL_QT = SL_VT + 3072, SL_W16 = SL_QT + 1536, SL_BUF = SL_W16 + 256;
constexpr int SL_YL = 2 * SL_BUF, SL_END = SL_YL + 2 * 4096;
static_assert((SL_BUF % 16) == 0 && SL_END <= 131072, "scan lds map");

__device__ __forceinline__ void rwkv_scan(Frame& F, CArgs& A, int chain, int nlo, int nhi) {
    const int b = chain >> 3, h = chain & 7;
    const int tid = F.tid, lane = F.lane, wave = F.wave;
    LAS unsigned char* L = F.lds;
    const unsigned char* img0 = F.ws + WS_IMG + (size_t)chain * NBLK_H1 * IMG_BYTES;
    const int cnt = nhi - nlo;
#define S3_BAR() asm volatile("s_waitcnt lgkmcnt(0)\n\ts_barrier" ::: "memory")
    if (wave >= 2) {
        bf16* Y1 = (bf16*)(F.ws + R_Y1);
        const int ht = tid - 128;
        int lsrc[2], ldst[2]; bool lok[2];
#pragma unroll
        for (int i = 0; i < 2; ++i) { const int q = ht + 384 * i; lok[i] = q < IMG_BYTES / 16; lsrc[i] = lok[i] ? q * 16 : 0; int d;
            if (q < 256) d = SL_PT + (q >> 3) * 136 + (q & 7) * 16;
            else if (q < 512) d = SL_BK + ((q - 256) >> 2) * 80 + ((q - 256) & 3) * 16;
            else if (q < 640) d = SL_VT + ((q - 512) >> 1) * 48 + ((q - 512) & 1) * 16;
            else if (q < 704) d = SL_QT + ((q - 640) >> 1) * 48 + ((q - 640) & 1) * 16;
            else d = SL_W16 + (q - 704) * 16;
            ldst[i] = d; }
        const bool pw = wave < 6; const int pt = 4 * ((wave - 2) & 3) + (lane >> 4), pc = 4 * (lane & 15);
        const f32x4 c_lg = *(const f32x4*)(A.in[22] + 64 * h + pc), c_lb = *(const f32x4*)(A.in[23] + 64 * h + pc);
        const bf16* Gp = (const bf16*)(F.ws + WS_G) + 64 * h + pc; const float* RKp = (const float*)(F.ws + WS_RK) + h;
#define S3_LOAD(m, pf) do { const int mm_ = (m) < cnt ? (m) : cnt - 1; const unsigned char* ip_ = img0 + (size_t)mm_ * IMG_BYTES; pf[0] = *(const v4u*)(ip_ + lsrc[0]); pf[1] = *(const v4u*)(ip_ + lsrc[1]); } while (0)
#define S3_LAND(buf, pf) do { *(LAS v4u*)(L + (buf) * SL_BUF + ldst[0]) = pf[0]; if (lok[1]) *(LAS v4u*)(L + (buf) * SL_BUF + ldst[1]) = pf[1]; } while (0)
#define S3_PLOAD(m, gg, xv, rk) do { const int mm_ = (m) < cnt ? (m) : cnt - 1; const int nn_ = nlo + mm_; const size_t r0_ = nn_ == 0 ? (size_t)MR : (size_t)(b * SEQ + 16 * (nn_ - 1)); \
        const unsigned char* vt_ = img0 + (size_t)mm_ * IMG_BYTES + IMG_VT + pc * 32 + pt * 2; \
        gg = *(const v2u*)(Gp + (r0_ + pt) * 512); rk = RKp[(r0_ + pt) * 8]; \
        xv[0] = bf2f(*(const bf16*)(vt_)); xv[1] = bf2f(*(const bf16*)(vt_ + 32)); xv[2] = bf2f(*(const bf16*)(vt_ + 64)); xv[3] = bf2f(*(const bf16*)(vt_ + 96)); } while (0)
#define S3_HELP(m, pfN, ggC, xvC, rkC) do { \
        const int cb = (m) & 1; \
        if ((m) + 1 < cnt) S3_LAND(cb ^ 1, pfN); \
        S3_LOAD((m) + 3, pfN); \
        S3_BAR(); \
        if (pw) { const f32x4 y = *(const LAS f32x4*)(L + SL_YL + cb * 4096 + (pt * 64 + pc) * 4); \
          const int nn_ = nlo + (m); const int r0 = nn_ == 0 ? MR : b * SEQ + 16 * (nn_ - 1); \
          const float mean = sum16((y[0] + y[1]) + (y[2] + y[3])) * (1.0f / 64.0f); const f32x4 d = y - mean; \
          const float var = sum16((d[0] * d[0] + d[1] * d[1]) + (d[2] * d[2] + d[3] * d[3])) * (1.0f / 64.0f); const float rs = rsqrtf(var + 64e-5f); \
          const float g0 = bflo(ggC.x), g1 = bfhi(ggC.x), g2 = bflo(ggC.y), g3 = bfhi(ggC.y); \
          const float o0 = (d[0] * rs * c_lg[0] + c_lb[0] + rkC * xvC[0]) * g0, o1 = (d[1] * rs * c_lg[1] + c_lb[1] + rkC * xvC[1]) * g1, \
                      o2 = (d[2] * rs * c_lg[2] + c_lb[2] + rkC * xvC[2]) * g2, o3 = (d[3] * rs * c_lg[3] + c_lb[3] + rkC * xvC[3]) * g3; \
          if (nn_ > 0 || b == 0) { v2u ov; ov.x = pk2(o0, o1); ov.y = pk2(o2, o3); *(v2u*)(Y1 + (size_t)(r0 + pt) * DM + 512 + 64 * h + pc) = ov; } } \
        S3_PLOAD((m) + 2, ggC, xvC, rkC); \
    } while (0)
        v4u pfA[2], pfB[2]; v2u ggA, ggB; float xvA[4], xvB[4], rkA, rkB;
        S3_LOAD(0, pfA); S3_LAND(0, pfA); S3_LOAD(1, pfB); S3_LOAD(2, pfA);
        S3_PLOAD(0, ggA, xvA, rkA); S3_PLOAD(1, ggB, xvB, rkB);
        S3_BAR();
#pragma unroll 1
        for (int m = 0; m < cnt; m += 2) {
            S3_HELP(m, pfB, ggA, xvA, rkA);
            if (m + 1 < cnt) S3_HELP(m + 1, pfA, ggB, xvB, rkB);
        }
#undef S3_LOAD
#undef S3_LAND
#undef S3_PLOAD
#undef S3_HELP
    } else {
        const int it = wave, qi = lane & 31, hi = lane >> 5;
        f32x16 z0 = (f32x16){0.f,0.f,0.f,0.f,0.f,0.f,0.f,0.f,0.f,0.f,0.f,0.f,0.f,0.f,0.f,0.f}, z1 = z0;
        float* zs = (float*)(F.ws + WS_ZS) + ((size_t)(chain * 2 + it) * 2 * 64 + lane) * 16;
        if (nlo > 0) { z0 = *(const f32x16*)zs; z1 = *(const f32x16*)(zs + 64 * 16); }
        S3_BAR();
#define S3_PK(dst, zz, o) do { dst.x = pg8::cvt_pk_bf16(zz[o + 0], zz[o + 1]); dst.y = pg8::cvt_pk_bf16(zz[o + 2], zz[o + 3]); dst.z = pg8::cvt_pk_bf16(zz[o + 4], zz[o + 5]); dst.w = pg8::cvt_pk_bf16(zz[o + 6], zz[o + 7]); } while (0)
#pragma unroll 1
        for (int m = 0; m < cnt; ++m) {
            const int cb = m & 1;
            const LAS unsigned char* B_ = L + cb * SL_BUF;
            const bf16x8 vfr = *(const LAS bf16x8*)(B_ + SL_VT + (32 * it + qi) * 48 + hi * 16);
            const bf16x8 qf = *(const LAS bf16x8*)(B_ + SL_QT + qi * 48 + hi * 16);
            v4u aw[4];
#pragma unroll
            for (int ks = 0; ks < 4; ++ks) {
                const LAS unsigned char* pp = B_ + SL_PT + qi * 136 + (16 * ks + 4 * hi) * 2;
                const v2u lo = *(const LAS v2u*)pp, hh = *(const LAS v2u*)(pp + 16); aw[ks] = (v4u){lo.x, lo.y, hh.x, hh.y}; }
            v4u bw[2]; bf16x8 kf[2]; f32x4 wv[2][4];
            const LAS float* w16 = (const LAS float*)(B_ + SL_W16) + hi * 32;
#pragma unroll
            for (int jt = 0; jt < 2; ++jt) { const LAS unsigned char* bp = B_ + SL_BK + (32 * jt + qi) * 80;
                const v2u lo = *(const LAS v2u*)(bp + 8 * hi), hh = *(const LAS v2u*)(bp + 16 + 8 * hi); bw[jt] = (v4u){lo.x, lo.y, hh.x, hh.y};
                kf[jt] = *(const LAS bf16x8*)(bp + 32 + 16 * hi);
#pragma unroll
                for (int r4 = 0; r4 < 4; ++r4) wv[jt][r4] = *(const LAS f32x4*)(w16 + jt * 16 + 4 * r4); }
            __builtin_amdgcn_sched_barrier(0);
            v4u zb[4]; S3_PK(zb[0], z0, 0); S3_PK(zb[1], z0, 8); S3_PK(zb[2], z1, 0); S3_PK(zb[3], z1, 8);
            f32x16 acc = (f32x16){0.f,0.f,0.f,0.f,0.f,0.f,0.f,0.f,0.f,0.f,0.f,0.f,0.f,0.f,0.f,0.f};
            acc = __builtin_amdgcn_mfma_f32_32x32x16_bf16(qf, vfr, acc, 0, 0, 0);
#pragma unroll
            for (int ks = 0; ks < 4; ++ks) acc = __builtin_amdgcn_mfma_f32_32x32x16_bf16(__builtin_bit_cast(bf16x8, aw[ks]), __builtin_bit_cast(bf16x8, zb[ks]), acc, 0, 0, 0);
            f32x16 zn0, zn1;
#pragma unroll
            for (int r4 = 0; r4 < 4; ++r4)
#pragma unroll
                for (int e = 0; e < 4; ++e) { zn0[4 * r4 + e] = z0[4 * r4 + e] * wv[0][r4][e]; zn1[4 * r4 + e] = z1[4 * r4 + e] * wv[1][r4][e]; }
            { LAS float* YL = (LAS float*)(L + SL_YL + cb * 4096);
#pragma unroll
              for (int r = 8; r < 16; ++r) YL[(crow(r, hi) - 16) * 64 + 32 * it + qi] = acc[r]; }
            v4u sab; S3_PK(sab, acc, 0);
            zn0 = __builtin_amdgcn_mfma_f32_32x32x16_bf16(kf[0], vfr, zn0, 0, 0, 0);
            zn1 = __builtin_amdgcn_mfma_f32_32x32x16_bf16(kf[1], vfr, zn1, 0, 0, 0);
            zn0 = __builtin_amdgcn_mfma_f32_32x32x16_bf16(__builtin_bit_cast(bf16x8, bw[0]), __builtin_bit_cast(bf16x8, sab), zn0, 0, 0, 0);
            zn1 = __builtin_amdgcn_mfma_f32_32x32x16_bf16(__builtin_bit_cast(bf16x8, bw[1]), __builtin_bit_cast(bf16x8, sab), zn1, 0, 0, 0);
            z0 = zn0; z1 = zn1;
            S3_BAR();
        }
        if (nhi < NBLK) { *(f32x16*)zs = z0; *(f32x16*)(zs + 64 * 16) = z1; }
#undef S3_PK
    }
#undef S3_BAR
    __syncthreads();
}

__device__ __forceinline__ void final_phase(Frame& F, CArgs& A) {
    const float* part = (const float*)(F.ws + WS_PART); const float* gf = A.in[4]; float* out = F.out;
    const int gw = F.wg * NWAVES + F.wave, NGW = F.G * NWAVES, lane = F.lane;
    f32x4 gv[4];
#pragma unroll
    for (int j = 0; j < 4; ++j) gv[j] = *(const f32x4*)(gf + j * 256 + lane * 4);
    for (int row = gw; row < MR; row += NGW) {
        const float rs = pg8::row_rstd(part, row);
#pragma unroll
        for (int j = 0; j < 4; ++j) { f32x4* p = (f32x4*)(out + (size_t)row * DM + j * 256 + lane * 4); *p = (*p) * rs * gv[j]; }
    }
}


__device__ __forceinline__ void meta_res_gemm(Frame& F, const bf16* Aop, int lda, const bf16* Bop, int ldb, int K, float* hmeta, bf16* Abuf, float* part, int mode, int g) {
    const int lane = F.lane, wave = F.wave, nb = wave & 3, kh = wave >> 2, kq = 8 * (lane >> 4), r16 = lane & 15;
    const int khalf = K / 2, k0 = kh * khalf, nks = khalf / 32;
    const bf16* ap = Aop + (size_t)(MR + r16) * lda + k0 + kq;
    const bf16* bp = Bop + (size_t)(64 * g + 16 * nb + r16) * ldb + k0 + kq;
    pg8::f32x4 d = (pg8::f32x4){0.f, 0.f, 0.f, 0.f};
#pragma unroll 4
    for (int k = 0; k < nks; ++k) { const bf16x8 af = *(const bf16x8*)(ap + 32 * k); const bf16x8 bfv = *(const bf16x8*)(bp + 32 * k); d = __builtin_amdgcn_mfma_f32_16x16x32_bf16(af, bfv, d, 0, 0, 0); }
    LAS float* red = (LAS float*)F.lds;
    if (kh == 1) *(LAS pg8::f32x4*)(red + (nb * 64 + lane) * 4) = d;
    __syncthreads();
    if (kh == 0) {
        const pg8::f32x4 o = *(const LAS pg8::f32x4*)(red + (nb * 64 + lane) * 4); d += o;
        const int col = 64 * g + 16 * nb + r16;
#pragma unroll
        for (int r = 0; r < 4; ++r) { const int row = 4 * (lane >> 4) + r; float h = hmeta[(size_t)row * DM + col] + d[r]; hmeta[(size_t)row * DM + col] = h; d[r] = h;
            if (mode) Abuf[(size_t)(MR + row) * DM + col] = (bf16)f2bf(h); }
    }
    __syncthreads();
    if (mode) {
        if (kh == 0) {
#pragma unroll
            for (int r = 0; r < 4; ++r) { const float ss = sum16(d[r] * d[r]); if (r16 == 0) red[(4 * (lane >> 4) + r) * 4 + nb] = ss; }
        }
        __syncthreads();
        if (F.tid < 16) { const pg8::f32x4 v = *(const LAS pg8::f32x4*)(red + F.tid * 4); part[(size_t)(MR + F.tid) * 16 + g] = (v[0] + v[1]) + (v[2] + v[3]); }
        __syncthreads();
    }
}

#ifdef NO_ATTN
#define ATTN_UNIT(b, k, q) do { } while (0)
#else
#define ATTN_UNIT(b, k, q) attn_unit(F, A.in[12], (b), (k), (q))
#endif
constexpr int N_PHASES = 23;
#ifndef RES_SP2
#define RES_SP2 false
#endif
#ifndef DBGLAST
#define DBGLAST 6
#endif
#ifndef DBG15
#define DBG15 3
#endif
#define PD(k, l, c) ((k) | ((l) << 4) | ((c) << 5))
__constant__ int c_phase_tab[N_PHASES] = { PD(0,0,0), PD(1,0,0), PD(2,0,0), PD(3,0,0), PD(4,0,0), PD(5,0,0), PD(3,0,0), PD(4,0,1), PD(5,0,1), PD(3,0,1),
    PD(6,0,0), PD(7,0,0), PD(3,0,0), PD(4,1,0), PD(5,1,0), PD(3,1,0), PD(4,1,1), PD(5,1,1), PD(3,1,1), PD(8,0,0) };
#ifndef DBG_NPH
#define DBG_NPH 18
#endif
__global__ void __launch_bounds__(NTHR, 2) hyb_fwd(Args args) {
    extern __shared__ __attribute__((aligned(16))) unsigned char lds[];
    const int lo = args.ph_lo, hi = args.ph_hi;
#if MK_N_LAUNCHES == 1
    {
        for (int u = threadIdx.x; u < (LDS_BYTES - LDSCTL_OFF) / 4; u += NTHR) ((LAS unsigned*)((LAS unsigned char*)lds + LDSCTL_OFF))[u] = 0u;
        __syncthreads();
        if (threadIdx.x == 0) (void)xb_add(&((unsigned*)(args.ws + WS_CTL))[1024 + XB_XCNT(xb_xcc_id())], 1u);
    }
#endif
    const int wave_s = __builtin_amdgcn_readfirstlane(threadIdx.x >> 6);
#ifndef PROBE_MASK
#define PROBE_MASK 0u
#endif
#pragma unroll 1
    for (int pq = 2 * lo; pq < 2 * hi; ++pq) {
        const int p = pq >> 1; if ((pq & 1) && !((PROBE_MASK >> p) & 1u)) continue;
#define PHF() CArgs* ap_ = (CArgs*)__builtin_amdgcn_kernarg_segment_ptr(); asm volatile("" : "+s"(ap_)); CArgs& A = *ap_; \
        unsigned z_; asm volatile("s_mov_b32 %0, 0" : "=s"(z_)); \
        Frame F; F.tid = (wave_s << 6) | (int)__builtin_amdgcn_mbcnt_hi(~0u, __builtin_amdgcn_mbcnt_lo(~0u, z_)); asm volatile("" : "+v"(F.tid)); \
        F.lds = (LAS unsigned char*)lds; F.lane = F.tid & 63; F.wave = __builtin_amdgcn_readfirstlane(F.tid >> 6); F.G = gridDim.x; F.wg = blockIdx.x; F.out = A.out; F.ws = A.ws; \
        unsigned char* ws = A.ws; float* part = (float*)(ws + WS_PART); float* hmeta = (float*)(ws + WS_HMETA); pg8::bf16_t* Abuf = (pg8::bf16_t*)(ws + WS_A); (void)part; (void)hmeta; (void)Abuf
        int kind, layer = 0, ch = 0, sub = 2;
        switch (p) {
            case 0: kind = 0; break; case 1: kind = 1; break; case 2: kind = 2; break; case 3: kind = 3; sub = 0; break;
            case 4: kind = 4; break; case 5: kind = 5; break; case 6: kind = 3; break;
            case 7: kind = 4; ch = 1; break; case 8: kind = 5; ch = 1; break; case 9: kind = 3; ch = 1; break;
            case 10: kind = 6; break; case 11: kind = 7; break; case 12: kind = 9; break; case 13: kind = 7; ch = 1; break; case 14: kind = 9; ch = 1; break;
            case 15: kind = 3; sub = 1; break;
            case 16: kind = 4; layer = 1; break; case 17: kind = 5; layer = 1; break; case 18: kind = 3; layer = 1; break;
            case 19: kind = 4; layer = 1; ch = 1; break; case 20: kind = 5; layer = 1; ch = 1; break; case 21: kind = 3; layer = 1; ch = 1; break;
            default: kind = 8; break;
        }
        if (kind == 0) { PHF(); p0_prologue(F, A); }
        else if (kind == 1) { PHF(); pg8::Gemm g{Abuf, (const pg8::bf16_t*)(ws + W_IN0), MP, NIN, DM, DM, DM}; pg8::StaticOrder S; S.init(MP, NIN, F.G, F.wg);
            pg8::EpiIn0 E{(pg8::bf16_t*)(ws + R_U), (pg8::bf16_t*)(ws + R_WC), (pg8::bf16_t*)(ws + R_GB), part};
            pg8::gemm_phase<pg8::EpiIn0, pg8::StaticOrder, true, true, DM, DM, DM>(F.lds, g, S, E, F.tid); }
        else if (kind == 2) { PHF(); conv0_phase(F, A); }
        else if (kind == 3) { PHF();
            const bool o0 = (sub == 0), o1 = (sub == 1), od = (sub == 2);
            const pg8::bf16_t* Aop = (const pg8::bf16_t*)(ws + (o0 ? R_Y0 : o1 ? R_Y1 : R_HM));
            const pg8::bf16_t* Bop = (const pg8::bf16_t*)(ws + (o0 ? W_OUT0 : o1 ? W_OUT1 : (layer ? W_DN1 : W_DN0))) + (od ? (size_t)ch * FCH : (size_t)0);
            const int Kd = od ? FCH : DM, ldbd = od ? DFF : DM;
            const float* base = o0 ? A.in[0] : (const float*)A.out;
            const pg8::Gemm g{Aop, Bop, MP, DM, Kd, Kd, ldbd};
            pg8::StaticOrder S; S.init(MR, DM, F.G, F.wg);
            pg8::EpiRes E{base, A.out, hmeta, Abuf, part, od ? ch : 1};
            if (od) pg8::gemm_phase<pg8::EpiRes, pg8::StaticOrder, true, RES_SP2, FCH, FCH, DFF>(F.lds, g, S, E, F.tid);
            else pg8::gemm_phase<pg8::EpiRes, pg8::StaticOrder, true, RES_SP2, DM, DM, DM>(F.lds, g, S, E, F.tid);
            if (blockIdx.x < 16) {
                CArgs* am_ = (CArgs*)__builtin_amdgcn_kernarg_segment_ptr(); asm volatile("" : "+s"(am_)); unsigned char* wsm = am_->ws;
                unsigned zm_; asm volatile("s_mov_b32 %0, 0" : "=s"(zm_));
                Frame Fm; Fm.tid = (wave_s << 6) | (int)__builtin_amdgcn_mbcnt_hi(~0u, __builtin_amdgcn_mbcnt_lo(~0u, zm_)); asm volatile("" : "+v"(Fm.tid));
                Fm.lds = (LAS unsigned char*)lds; Fm.lane = Fm.tid & 63; Fm.wave = __builtin_amdgcn_readfirstlane(Fm.tid >> 6); Fm.G = gridDim.x; Fm.wg = blockIdx.x; Fm.out = nullptr; Fm.ws = wsm;
                const bf16* Am = (const bf16*)(wsm + (o0 ? R_Y0 : o1 ? R_Y1 : R_HM));
                const bf16* Bm = (const bf16*)(wsm + (o0 ? W_OUT0 : o1 ? W_OUT1 : (layer ? W_DN1 : W_DN0))) + (od ? (size_t)ch * FCH : (size_t)0);
                meta_res_gemm(Fm, Am, od ? FCH : DM, Bm, od ? DFF : DM, od ? FCH : DM, (float*)(wsm + WS_HMETA), (bf16*)(wsm + WS_A), (float*)(wsm + WS_PART), od ? ch : 1, (int)blockIdx.x);
            } }
        else if (kind == 4) { PHF(); pg8::Gemm g{Abuf, (const pg8::bf16_t*)(ws + (layer ? W_UP1 : W_UP0)) + (size_t)ch * FCH * 2 * DM, MP, 2 * FCH, DM, DM, DM}; pg8::StaticOrder S; S.init(MP, 2 * FCH, F.G, F.wg);
            pg8::EpiUp E{(pg8::bf16_t*)(ws + R_G), (pg8::bf16_t*)(ws + R_V), part};
            pg8::gemm_phase<pg8::EpiUp, pg8::StaticOrder, true, true, DM, DM, DM>(F.lds, g, S, E, F.tid); }
        else if (kind == 5) { PHF(); ffn_mid_phase(F, A, layer, ch); }
        else if (kind == 6) { PHF(); pg8::Gemm g{Abuf, (const pg8::bf16_t*)(ws + W_IN1), MP, NIN, DM, DM, DM}; pg8::StaticOrder S; S.init(MP, NIN, F.G, F.wg);
            pg8::EpiIn1 E{(pg8::bf16_t*)(ws + R_Q), (pg8::bf16_t*)(ws + R_KB), (pg8::bf16_t*)(ws + R_VB), (pg8::bf16_t*)(ws + R_PR), part, (const float*)(ws + WS_ROPE), (const float*)(ws + WS_ROPE) + TT * 32};
            pg8::gemm_phase<pg8::EpiIn1, pg8::StaticOrder, true, true, DM, DM, DM>(F.lds, g, S, E, F.tid); }
        else if (kind == 7) { PHF();
            const int cnt = ch == 0 ? NBLK_H1 : NBLK - NBLK_H1, nbase = ch == 0 ? 0 : NBLK_H1;
            rwkv_prep_phase(F, A, nbase, cnt);
        }
        else if (kind == 9) { PHF();
            const int NCH = 64;
            if (F.G > NCH && F.wg < NCH) rwkv_scan(F, A, F.wg, ch == 0 ? 0 : NBLK_H1, ch == 0 ? NBLK_H1 : NBLK);
            else {
                if (F.G <= NCH) for (int c = F.wg; c < NCH; c += F.G) rwkv_scan(F, A, c, ch == 0 ? 0 : NBLK_H1, ch == 0 ? NBLK_H1 : NBLK);
                if (ch == 0) { const int NAW = F.G > NCH ? F.G - NCH : F.G, aw = F.G > NCH ? F.wg - NCH : F.wg;
                    for (int id = aw; id < 514; id += NAW) { if (id < 512) ATTN_UNIT(id >> 6, (id >> 5) & 1, id & 31); else ATTN_UNIT(0, id - 512, -1); } }
            }
        }
        else if (kind == 8) { PHF(); final_phase(F, A); }
#if MK_N_LAUNCHES == 1
        if (pq + 1 < 2 * hi) {
            if (hi > 1000) cg::this_grid().sync();
            CArgs* ab_ = (CArgs*)__builtin_amdgcn_kernarg_segment_ptr(); asm volatile("" : "+s"(ab_));
            unsigned zb_; asm volatile("s_mov_b32 %0, 0" : "=s"(zb_));
            const bool t0 = (wave_s == 0) && (__builtin_amdgcn_mbcnt_hi(~0u, __builtin_amdgcn_mbcnt_lo(~0u, zb_)) == 0u);
            xcd_barrier((unsigned*)(ab_->ws + WS_CTL) + 1024, (volatile LAS unsigned*)((LAS unsigned char*)lds + MISC_OFF) + 8, t0);
        }
#endif
    }
}

extern "C" void kernel_launch(void* const* d_in, const int* in_sizes, int n_in, void* d_out, int out_size, void* d_ws, size_t ws_size, hipStream_t stream) {
    static int grid = 0;
    if (grid == 0) {
        if (n_in != 29 || out_size != MR * DM || ws_size < WS_END) { fprintf(stderr, "kernel_launch: unexpected shapes (n_in %d out %d ws %zu)\n", n_in, out_size, ws_size); grid = -1; return; }
        int dev = 0, cus = 0, per_cu = 0;
        if (hipGetDevice(&dev) != hipSuccess || hipDeviceGetAttribute(&cus, hipDeviceAttributeMultiprocessorCount, dev) != hipSuccess) { grid = -1; return; }
        if (hipFuncSetAttribute((const void*)hyb_fwd, hipFuncAttributeMaxDynamicSharedMemorySize, LDS_BYTES) != hipSuccess) { fprintf(stderr, "kernel_launch: hipFuncSetAttribute failed\n"); grid = -1; return; }
        if (hipOccupancyMaxActiveBlocksPerMultiprocessor(&per_cu, (const void*)hyb_fwd, NTHR, LDS_BYTES) != hipSuccess || per_cu < 1) { fprintf(stderr, "kernel_launch: occupancy query says %d\n", per_cu); per_cu = 1; }
        (void)hipGetLastError();
        grid = cus;
    }
    if (grid < 0) return;
    Args a{};
    for (int i = 0; i < 29; ++i) a.in[i] = (const float*)d_in[i];
    a.out = (float*)d_out; a.ws = (unsigned char*)d_ws;
#if MK_N_LAUNCHES == 1
    if (hipMemsetAsync((char*)d_ws + WS_CTL, 0, 65536, stream) != hipSuccess) { fprintf(stderr, "kernel_launch: memset failed\n"); return; }
    a.ph_lo = 0; a.ph_hi = N_PHASES;
    void* kargs[] = {&a};
    hipError_t e = hipLaunchCooperativeKernel((const void*)hyb_fwd, dim3(grid), dim3(NTHR), kargs, LDS_BYTES, stream);
    if (e != hipSuccess) fprintf(stderr, "cooperative launch failed: %s (grid %d)\n", hipGetErrorString(e), grid);
#else
    for (int p = 0; p < N_PHASES; ++p) { a.ph_lo = p; a.ph_hi = p + 1; hipLaunchKernelGGL(hyb_fwd, dim3(grid), dim3(NTHR), LDS_BYTES, stream, a); }
#endif
}
```

```cpp
#include <hip/hip_runtime.h>
#include <hip/hip_cooperative_groups.h>
#include <cstdio>
#include <cstdint>
namespace cg = cooperative_groups;

#ifndef MK_N_LAUNCHES
#define MK_N_LAUNCHES 1
#endif

constexpr int NB = 8, SEQ = 2048, NMETA = 16, TT = SEQ + NMETA, DM = 1024;
constexpr int MR = NB * SEQ;
constexpr int MP = MR + 256;
constexpr int DFF = 2816, FCH = 1408;
constexpr int NIN = 2560;
constexpr int PRW = 1792;

constexpr size_t EO_PART = (size_t)1 << 20, EO_HM = (size_t)89 << 20, EO_EDGE_G = EO_HM + (size_t)MP * DFF * 2, EO_EDGE_V = EO_EDGE_G + (size_t)65 * 2 * DFF * 4, EO_HALO = EO_EDGE_V + (size_t)65 * 2 * DFF * 4;
namespace pg8 {
#define PG8_LAS __attribute__((address_space(3)))
typedef unsigned short bf16_t;
typedef short bf16x8 __attribute__((ext_vector_type(8)));
typedef float f32x4 __attribute__((ext_vector_type(4)));
typedef unsigned u32x4 __attribute__((ext_vector_type(4)));
constexpr int BM = 256, BK = 64, HALF = 128, HTB = HALF * BK * 2  , STAGE_BYTES = 8 * HTB, NXCD = 8, WGM = 8;

__host__ __device__ __forceinline__ int lds_byte(int r, int c) { const int st = (r >> 4) * 2 + (c >> 5), rr = r & 15, cc = c & 31, ob = rr * 64 + cc * 2; return st * 1024 + (ob ^ (((ob >> 9) & 1) << 5)); }
__host__ __device__ __forceinline__ void stage_rc(int b, int& R, int& C) { const int st = b / 1024, sb = b % 1024, swz = sb ^ (((sb >> 9) & 1) << 5); R = (st >> 1) * 16 + swz / 64; C = (st & 1) * 32 + (swz % 64) / 2; }
__host__ __device__ __forceinline__ int perm32(int rho) { const int n = rho >> 4, i = rho & 15; return 8 * (i >> 2) + 4 * n + (i & 3); }

struct Unit { int pm, pn; };
struct Gemm { const bf16_t* A; const bf16_t* Bt; int M, N, K, lda, ldb; };

struct StaticOrder {
    int nM, nN, nwg, G, c;
    __host__ __device__ void init(int M, int N, int G_, int c_) { nM = M / BM; nN = N / BM; nwg = nM * nN; G = G_; c = c_; }
    __host__ __device__ bool next(int i, Unit& u) const {
        const long L = (long)i * G + c; if (L >= nwg) return false;
        int wgid = (int)L; { const int q = nwg / NXCD, r = nwg % NXCD, xcd = wgid % NXCD, off = wgid / NXCD; wgid = (xcd < r ? xcd * (q + 1) : r * (q + 1) + (xcd - r) * q) + off; }
        const int nig = WGM * nN, gid = wgid / nig, fm = gid * WGM, gsz = (nM - fm) < WGM ? (nM - fm) : WGM;
        u.pm = fm + ((wgid % nig) % gsz); u.pn = (wgid % nig) / gsz; return true;
    }
    __device__ __forceinline__ void a_ready(const Unit&) const {}
    __device__ __forceinline__ void done(const Unit&) const {}
};

__device__ __forceinline__ unsigned cvt_pk_bf16(float lo, float hi) { unsigned r; asm volatile("v_cvt_pk_bf16_f32 %0, %1, %2" : "=v"(r) : "v"(lo), "v"(hi)); return r; }
__device__ __forceinline__ u32x4 pack8(const f32x4 a, const f32x4 b) { u32x4 w; w.x = cvt_pk_bf16(a[0], a[1]); w.y = cvt_pk_bf16(a[2], a[3]); w.z = cvt_pk_bf16(b[0], b[1]); w.w = cvt_pk_bf16(b[2], b[3]); return w; }
__device__ __forceinline__ float sigmoidf_(float x) { return __builtin_amdgcn_rcpf(1.0f + __expf(-x)); }
__device__ __forceinline__ f32x4 sig4(const f32x4 x) { return (f32x4){sigmoidf_(x[0]), sigmoidf_(x[1]), sigmoidf_(x[2]), sigmoidf_(x[3])}; }
__device__ __forceinline__ float row_rstd(const float* part, int row) {
    const f32x4* p = (const f32x4*)(part + (size_t)row * 16); const f32x4 a = p[0], b = p[1], c = p[2], d = p[3];
    const float s = ((a[0] + a[1]) + (a[2] + a[3])) + ((b[0] + b[1]) + (b[2] + b[3])) + ((c[0] + c[1]) + (c[2] + c[3])) + ((d[0] + d[1]) + (d[2] + d[3]));
    return rsqrtf(s * (1.0f / 1024.0f) + 1e-6f);
}
__device__ __forceinline__ int tpos_of_row(int row) { return row < MR ? (NMETA + (row & (SEQ - 1))) : (row < MR + NMETA ? row - MR : 0); }

struct EpiIn0 {
    static constexpr bool PERM = true, AFTER_DRAIN = false;
    bf16_t* U; bf16_t* WC; bf16_t* GB; const float* part;
    __device__ __forceinline__ void operator()(const f32x4 (&acc)[2][2][4][2], const Unit& u, int wr, int wc, int fr, int fq) const {
        const int row0 = u.pm * BM + wr * 64 + fr;
#pragma unroll
        for (int ai = 0; ai < 2; ++ai)
#pragma unroll
            for (int m = 0; m < 4; ++m) {
                const int row = row0 + ai * HALF + m * 16; const float rs = row_rstd(part, row);
                if (u.pn < 8) {
                    bf16_t* dst = (u.pn < 4 ? U : WC) + (size_t)row * 512 + (u.pn & 3) * 128 + wc * 32 + 8 * fq;
                    const f32x4 a0 = acc[ai][0][m][0] * rs, a1 = acc[ai][0][m][1] * rs, b0 = acc[ai][1][m][0] * rs, b1 = acc[ai][1][m][1] * rs;
                    f32x4 o0, o1;
                    if (u.pn < 4) { o0 = a0 * sig4(b0); o1 = a1 * sig4(b1); } else { o0 = a0 * b0; o1 = a1 * b1; }
                    *(u32x4*)dst = pack8(o0, o1);
                } else {
#pragma unroll
                    for (int bj = 0; bj < 2; ++bj) { bf16_t* dst = GB + (size_t)row * 512 + (u.pn - 8) * 256 + bj * HALF + wc * 32 + 8 * fq;
                        *(u32x4*)dst = pack8(acc[ai][bj][m][0] * rs, acc[ai][bj][m][1] * rs); }
                }
            }
    }
};
struct EpiRes {
    static constexpr bool PERM = true, AFTER_DRAIN = false;
    const float* base; float* out; float* hmeta; bf16_t* Abuf; float* part; int mode;
    __device__ __forceinline__ void operator()(const f32x4 (&acc)[2][2][4][2], const Unit& u, int wr, int wc, int fr, int fq) const {
        const float* bp = u.pm < 64 ? base + (size_t)u.pm * BM * DM : hmeta; float* op = u.pm < 64 ? out + (size_t)u.pm * BM * DM : hmeta;
#pragma unroll
        for (int ai = 0; ai < 2; ++ai)
#pragma unroll
            for (int m = 0; m < 4; ++m) {
                const int lr = wr * 64 + fr + ai * HALF + m * 16, row = u.pm * BM + lr; float ss = 0.f;
#pragma unroll
                for (int bj = 0; bj < 2; ++bj) { const int col = u.pn * BM + bj * HALF + wc * 32 + 8 * fq;
                    f32x4 h0 = *(const f32x4*)(bp + (size_t)lr * DM + col), h1 = *(const f32x4*)(bp + (size_t)lr * DM + col + 4);
                    h0 += acc[ai][bj][m][0]; h1 += acc[ai][bj][m][1];
                    *(f32x4*)(op + (size_t)lr * DM + col) = h0; *(f32x4*)(op + (size_t)lr * DM + col + 4) = h1;
                    if (mode) { ss += (h0[0] * h0[0] + h0[1] * h0[1]) + (h0[2] * h0[2] + h0[3] * h0[3]) + (h1[0] * h1[0] + h1[1] * h1[1]) + (h1[2] * h1[2] + h1[3] * h1[3]);
                        *(u32x4*)(Abuf + (size_t)row * DM + col) = pack8(h0, h1); } }
                if (mode) { ss += __shfl_xor(ss, 16); ss += __shfl_xor(ss, 32); if (fq == 0) part[(size_t)row * 16 + u.pn * 4 + wc] = ss; }
            }
    }
};
__device__ __forceinline__ float dpp_ror1(float x) { return __builtin_bit_cast(float, __builtin_amdgcn_update_dpp(0, __builtin_bit_cast(int, x), 0x121, 0xF, 0xF, false)); }
__device__ __forceinline__ float dpp_ror2(float x) { return __builtin_bit_cast(float, __builtin_amdgcn_update_dpp(0, __builtin_bit_cast(int, x), 0x122, 0xF, 0xF, false)); }
__device__ __forceinline__ f32x4 ror1_4(const f32x4 v) { return (f32x4){dpp_ror1(v[0]), dpp_ror1(v[1]), dpp_ror1(v[2]), dpp_ror1(v[3])}; }
__device__ __forceinline__ f32x4 ror2_4(const f32x4 v) { return (f32x4){dpp_ror2(v[0]), dpp_ror2(v[1]), dpp_ror2(v[2]), dpp_ror2(v[3])}; }
__device__ __forceinline__ f32x4 silu4(const f32x4 z) { return z * sig4(z); }
struct EpiUpConv {
    static constexpr bool PERM = true, AFTER_DRAIN = false;
    unsigned char* ws; const float* cw; const float* cb;
    __device__ __forceinline__ void operator()(const f32x4 (&acc)[2][2][4][2], const Unit& u, int wr, int wc, int fr, int fq) const {
        bf16_t* HM = (bf16_t*)(ws + EO_HM); float* EDGE_G = (float*)(ws + EO_EDGE_G); float* EDGE_V = (float*)(ws + EO_EDGE_V); float* HALO = (float*)(ws + EO_HALO); const float* part = (const float*)(ws + EO_PART);
        const int c0 = u.pn * 128 + wc * 32 + 8 * fq, row0 = u.pm * BM + wr * 64 + fr;
        PG8_LAS f32x4* X = (PG8_LAS f32x4*)131072;
        if (fr >= 14) {
#pragma unroll
            for (int ai = 0; ai < 2; ++ai) { const float rs = row_rstd(part, row0 + ai * HALF + 48); const int sidx = ((((2 * ai + wr) * 2 + (fr - 14)) * 4 + wc) * 4 + fq) * 2; X[sidx] = acc[ai][0][3][0] * rs; X[sidx + 1] = acc[ai][0][3][1] * rs;
                if (ai == 1 && u.pm < 64 && wr == 1) { float* hp = HALO + ((size_t)(u.pm * 2 + (fr - 14))) * 2816 + c0; *(f32x4*)hp = acc[1][0][3][0] * rs; *(f32x4*)(hp + 4) = acc[1][0][3][1] * rs; } }
            if (u.pm == 64 && wr == 0) { const float rs = row_rstd(part, row0); float* hp = HALO + ((size_t)(64 * 2 + (fr - 14))) * 2816 + c0; *(f32x4*)hp = acc[0][0][0][0] * rs; *(f32x4*)(hp + 4) = acc[0][0][0][1] * rs; }
        }
        asm volatile("s_waitcnt lgkmcnt(0)\n\ts_barrier" ::: "memory");
        const f32x4 w0a = *(const f32x4*)(cw + c0), w0b = *(const f32x4*)(cw + c0 + 4), w1a = *(const f32x4*)(cw + 2816 + c0), w1b = *(const f32x4*)(cw + 2816 + c0 + 4),
                    w2a = *(const f32x4*)(cw + 5632 + c0), w2b = *(const f32x4*)(cw + 5632 + c0 + 4), bba = *(const f32x4*)(cb + c0), bbb = *(const f32x4*)(cb + c0 + 4);
#pragma unroll
        for (int ai = 0; ai < 2; ++ai) {
            const int sg = 2 * ai + wr;
            f32x4 x15a = (f32x4){0.f, 0.f, 0.f, 0.f}, x15b = x15a, x14a = x15a, x14b = x15a;
            if (sg > 0 && fr < 2) { const int b15 = ((((sg - 1) * 2 + 1) * 4 + wc) * 4 + fq) * 2, b14 = ((((sg - 1) * 2 + 0) * 4 + wc) * 4 + fq) * 2; x15a = X[b15]; x15b = X[b15 + 1]; x14a = X[b14]; x14b = X[b14 + 1]; }
            f32x4 q1a = x15a, q1b = x15b, q2a = x14a, q2b = x14b;
#pragma unroll
            for (int m = 0; m < 4; ++m) {
                const int row = row0 + ai * HALF + m * 16; const float rs = row_rstd(part, row);
                const f32x4 ga = acc[ai][0][m][0] * rs, gb = acc[ai][0][m][1] * rs;
                const f32x4 r1a = ror1_4(ga), r1b = ror1_4(gb), r2a = ror2_4(ga), r2b = ror2_4(gb);
                f32x4 p1a = r1a, p1b = r1b, p2a = r2a, p2b = r2b;
                if (m > 0) { if (fr < 1) { p1a = q1a; p1b = q1b; } if (fr < 2) { p2a = q2a; p2b = q2b; } }
                else { if (fr == 0) { p1a = x15a; p1b = x15b; p2a = x14a; p2b = x14b; } else if (fr == 1) { p2a = x15a; p2b = x15b; } }
                q1a = r1a; q1b = r1b; q2a = r2a; q2b = r2b;
                const f32x4 va = acc[ai][1][m][0] * rs, vb = acc[ai][1][m][1] * rs;
                if (sg == 0 && m == 0 && fr < 2) {
                    float* eg = EDGE_G + ((size_t)(u.pm * 2 + fr)) * 2816 + c0; float* ev = EDGE_V + ((size_t)(u.pm * 2 + fr)) * 2816 + c0;
                    *(f32x4*)eg = ga; *(f32x4*)(eg + 4) = gb; *(f32x4*)ev = va; *(f32x4*)(ev + 4) = vb;
                } else {
                    const f32x4 za = w0a * p2a + w1a * p1a + w2a * ga + bba, zb = w0b * p2b + w1b * p1b + w2b * gb + bbb;
                    *(u32x4*)(HM + (size_t)row * 2816 + c0) = pack8(silu4(za) * va, silu4(zb) * vb);
                }
                asm volatile("" ::: "memory");
            }
        }
    }
};
struct EpiIn1 {
    static constexpr bool PERM = true, AFTER_DRAIN = false;
    bf16_t* Q; bf16_t* KB; bf16_t* VB; bf16_t* PR; const float* part; const float* ropec; const float* ropes;
    __device__ __forceinline__ void operator()(const f32x4 (&acc)[2][2][4][2], const Unit& u, int wr, int wc, int fr, int fq) const {
        const int row0 = u.pm * BM + wr * 64 + fr;
#pragma unroll
        for (int ai = 0; ai < 2; ++ai)
#pragma unroll
            for (int m = 0; m < 4; ++m) {
                const int row = row0 + ai * HALF + m * 16; const float rs = row_rstd(part, row);
                if (u.pn >= 3) {
#pragma unroll
                    for (int bj = 0; bj < 2; ++bj) *(u32x4*)(PR + (size_t)row * PRW + (u.pn - 3) * 256 + bj * HALF + wc * 32 + 8 * fq) = pack8(acc[ai][bj][m][0] * rs, acc[ai][bj][m][1] * rs);
                } else {
                    const f32x4 a0 = acc[ai][0][m][0] * rs, a1 = acc[ai][0][m][1] * rs, b0 = acc[ai][1][m][0] * rs, b1 = acc[ai][1][m][1] * rs;
                    if (u.pn == 2 && wc >= 2) {
                        bf16_t* dst = VB + (size_t)row * 128 + (wc - 2) * 64 + 8 * fq;
                        *(u32x4*)dst = pack8(a0, a1); *(u32x4*)(dst + 32) = pack8(b0, b1);
                    } else {
                        const int t = tpos_of_row(row);
                        const f32x4 c0 = *(const f32x4*)(ropec + t * 32 + 8 * fq), c1 = *(const f32x4*)(ropec + t * 32 + 8 * fq + 4);
                        const f32x4 s0 = *(const f32x4*)(ropes + t * 32 + 8 * fq), s1 = *(const f32x4*)(ropes + t * 32 + 8 * fq + 4);
                        const f32x4 x0 = a0 * c0 - b0 * s0, x1 = a1 * c1 - b1 * s1, y0 = b0 * c0 + a0 * s0, y1 = b1 * c1 + a1 * s1;
                        bf16_t* dst = (u.pn == 2) ? KB + (size_t)row * 128 + wc * 64 + 8 * fq : Q + (size_t)row * 512 + (u.pn * 4 + wc) * 64 + 8 * fq;
                        *(u32x4*)dst = pack8(x0, x1); *(u32x4*)(dst + 32) = pack8(y0, y1);
                    }
                }
            }
    }
};

template <class Epi, class Sched, bool ALIGN_EPI = false, bool SP2 = false, int CK = 0, int CLDA = 0, int CLDB = 0>
__device__ __forceinline__ void gemm_phase(PG8_LAS unsigned char* lds, const Gemm g, const Sched& S, const Epi& E, const int tid_in) {
    int tid_ = tid_in; asm volatile("" : "+v"(tid_));
    const int tid = tid_, wid = __builtin_amdgcn_readfirstlane(tid >> 6), lane = tid & 63, wr = wid >> 2, wc = wid & 3, fr = lane & 15, fq = lane >> 4;
    const int K = CK ? CK : g.K, nt = K / BK; const int lda_ = CLDA ? CLDA : g.lda, ldb_ = CLDB ? CLDB : g.ldb;
    unsigned voffA[2], voffB[2];
#pragma unroll
    for (int i = 0; i < 2; ++i) { int R, C; stage_rc(tid * 16 + i * 8192, R, C); const int Rb = Epi::PERM ? ((R & ~31) + perm32(R & 31)) : R;
        voffA[i] = (unsigned)(R * lda_ + C) * 2u; voffB[i] = (unsigned)(Rb * ldb_ + C) * 2u; }
    const size_t kstep = (size_t)(BK * 2);
    const size_t hstepA = (size_t)HALF * lda_ * 2, hstepB = (size_t)HALF * ldb_ * 2;
    const size_t tstepA = 2 * hstepA, tstepB = 2 * hstepB;
    const unsigned ldsw = (unsigned)wid * 1024u;
    const int aoff = lds_byte(wr * 64 + fr, fq * 8), boff = lds_byte(wc * 32 + fr, fq * 8);
#define PG8_SA(b, h) (((b) * 2 + (h)) * HTB)
#define PG8_SB(b, h) ((4 + (b) * 2 + (h)) * HTB)
#define PG8_STAGE(bufoff, gbase, voff) do { _Pragma("unroll") for (int _i = 0; _i < 2; ++_i) \
        __builtin_amdgcn_global_load_lds((const unsigned*)((const char*)(gbase) + (voff)[_i]), (PG8_LAS unsigned*)(lds + (bufoff) + ldsw + _i * 8192), 16, 0, 0); } while (0)
#define PG8_LDA(dst, b, h) do { _Pragma("unroll") for (int m = 0; m < 4; ++m) _Pragma("unroll") for (int k = 0; k < 2; ++k) dst[m][k] = *(const PG8_LAS bf16x8*)(lds + PG8_SA(b, h) + aoff + m * 2048 + k * 1024); } while (0)
#define PG8_LDB(dst, b, h) do { _Pragma("unroll") for (int n = 0; n < 2; ++n) _Pragma("unroll") for (int k = 0; k < 2; ++k) dst[n][k] = *(const PG8_LAS bf16x8*)(lds + PG8_SB(b, h) + boff + n * 2048 + k * 1024); } while (0)
#define PG8_MMA(ai, bj, At, Bt) do { __builtin_amdgcn_s_setprio(1); _Pragma("unroll") for (int m = 0; m < 4; ++m) _Pragma("unroll") for (int n = 0; n < 2; ++n) _Pragma("unroll") for (int k = 0; k < 2; ++k) \
        acc[ai][bj][m][n] = __builtin_amdgcn_mfma_f32_16x16x32_bf16(Bt[n][k], At[m][k], acc[ai][bj][m][n], 0, 0, 0); __builtin_amdgcn_s_setprio(0); } while (0)
#define PG8_WAIT_V(n) asm volatile("s_waitcnt vmcnt(" #n ")" ::: "memory")
#define PG8_WAIT_L(n) asm volatile("s_waitcnt lgkmcnt(" #n ")" ::: "memory")
#define PG8_BAR __builtin_amdgcn_s_barrier()
#define PG8_SCHED __builtin_amdgcn_sched_barrier(0)
    Unit cur, nxt; int ui = 0;
    if (!S.next(0, cur)) return;
    f32x4 acc[2][2][4][2];
#pragma unroll
    for (int a = 0; a < 2; ++a)
#pragma unroll
        for (int b = 0; b < 2; ++b)
#pragma unroll
            for (int m = 0; m < 4; ++m)
#pragma unroll
                for (int n = 0; n < 2; ++n) acc[a][b][m][n] = (f32x4){0.f, 0.f, 0.f, 0.f};
    bf16x8 At[4][2], B0[2][2], B1[2][2];
    const char* cA = (const char*)g.A + (size_t)cur.pm * tstepA; const char* cB = (const char*)g.Bt + (size_t)cur.pn * tstepB;
    S.a_ready(cur);
    if constexpr (SP2) {
        PG8_STAGE(PG8_SB(0, 0), cB, voffB); PG8_STAGE(PG8_SB(0, 1), cB + hstepB, voffB); PG8_STAGE(PG8_SA(0, 0), cA, voffA); PG8_STAGE(PG8_SA(0, 1), cA + hstepA, voffA);
        if (wr == 1) PG8_BAR;
        PG8_WAIT_V(2); PG8_BAR;
        PG8_STAGE(PG8_SB(1, 0), cB + kstep, voffB); PG8_STAGE(PG8_SA(1, 0), cA + kstep, voffA); PG8_STAGE(PG8_SB(1, 1), cB + hstepB + kstep, voffB);
        PG8_WAIT_V(6); PG8_BAR;
    } else {
        PG8_STAGE(PG8_SB(0, 0), cB, voffB); PG8_STAGE(PG8_SA(0, 0), cA, voffA); PG8_STAGE(PG8_SB(0, 1), cB + hstepB, voffB); PG8_STAGE(PG8_SA(0, 1), cA + hstepA, voffA);
        if (wr == 1) PG8_BAR;
        PG8_WAIT_V(4); PG8_BAR;
        PG8_STAGE(PG8_SB(1, 0), cB + kstep, voffB); PG8_STAGE(PG8_SA(1, 0), cA + kstep, voffA); PG8_STAGE(PG8_SB(1, 1), cB + hstepB + kstep, voffB);
        PG8_WAIT_V(6); PG8_BAR;
    }
    for (;;) {
        const bool has_next = S.next(ui + 1, nxt);
        const char* nA = has_next ? (const char*)g.A + (size_t)nxt.pm * tstepA : cA; const char* nB = has_next ? (const char*)g.Bt + (size_t)nxt.pn * tstepB : cB;
        for (int t = 0; t < nt; t += 2) {
            const bool last = (t == nt - 2);
            const char* a1 = cA + (size_t)(t + 1) * kstep;
            const char* a2 = last ? nA : cA + (size_t)(t + 2) * kstep; const char* b2 = last ? nB : cB + (size_t)(t + 2) * kstep;
            const char* a3 = a2 + kstep; const char* b3 = b2 + kstep;
            if (last && has_next) S.a_ready(nxt);
            if constexpr (SP2) {
            PG8_LDB(B0, 0, 0); PG8_LDB(B1, 0, 1); PG8_SCHED; PG8_LDA(At, 0, 0); PG8_STAGE(PG8_SA(1, 1), a1 + hstepA, voffA);
            PG8_WAIT_V(8); PG8_WAIT_L(0); PG8_BAR; PG8_MMA(0, 0, At, B0); PG8_MMA(0, 1, At, B1); PG8_BAR; PG8_SCHED;
            PG8_LDA(At, 0, 1); PG8_STAGE(PG8_SB(0, 0), b2, voffB); PG8_STAGE(PG8_SB(0, 1), b2 + hstepB, voffB); PG8_STAGE(PG8_SA(0, 0), a2, voffA);
            PG8_WAIT_V(8); PG8_WAIT_L(0); PG8_BAR; PG8_MMA(1, 0, At, B0); PG8_MMA(1, 1, At, B1); PG8_BAR; PG8_SCHED;
            PG8_LDB(B0, 1, 0); PG8_LDB(B1, 1, 1); PG8_SCHED; PG8_LDA(At, 1, 0); PG8_STAGE(PG8_SA(0, 1), a2 + hstepA, voffA);
            PG8_WAIT_V(8); PG8_WAIT_L(0); PG8_BAR; PG8_MMA(0, 0, At, B0); PG8_MMA(0, 1, At, B1); PG8_BAR; PG8_SCHED;
            PG8_LDA(At, 1, 1); PG8_STAGE(PG8_SB(1, 0), b3, voffB); PG8_STAGE(PG8_SB(1, 1), b3 + hstepB, voffB); PG8_STAGE(PG8_SA(1, 0), a3, voffA);
            PG8_WAIT_V(8); PG8_WAIT_L(0); PG8_BAR; PG8_MMA(1, 0, At, B0); PG8_MMA(1, 1, At, B1); PG8_BAR; PG8_SCHED;
            } else {
            PG8_LDB(B0, 0, 0); PG8_SCHED; PG8_LDA(At, 0, 0); PG8_STAGE(PG8_SA(1, 1), a1 + hstepA, voffA);
            PG8_WAIT_L(8); PG8_BAR; PG8_WAIT_L(0); PG8_MMA(0, 0, At, B0); PG8_BAR; PG8_SCHED;
            PG8_LDB(B1, 0, 1); PG8_STAGE(PG8_SB(0, 0), b2, voffB);
            PG8_BAR; PG8_WAIT_L(0); PG8_MMA(0, 1, At, B1); PG8_BAR;
            PG8_LDA(At, 0, 1); PG8_STAGE(PG8_SA(0, 0), a2, voffA);
            PG8_BAR; PG8_WAIT_L(0); PG8_MMA(1, 0, At, B0); PG8_BAR; PG8_SCHED;
            PG8_STAGE(PG8_SB(0, 1), b2 + hstepB, voffB);
            PG8_WAIT_V(6); PG8_BAR; PG8_MMA(1, 1, At, B1); PG8_BAR;
            PG8_LDB(B0, 1, 0); PG8_SCHED; PG8_LDA(At, 1, 0); PG8_STAGE(PG8_SA(0, 1), a2 + hstepA, voffA);
            PG8_WAIT_L(8); PG8_BAR; PG8_WAIT_L(0); PG8_MMA(0, 0, At, B0); PG8_BAR; PG8_SCHED;
            PG8_LDB(B1, 1, 1); PG8_STAGE(PG8_SB(1, 0), b3, voffB);
            PG8_BAR; PG8_WAIT_L(0); PG8_MMA(0, 1, At, B1); PG8_BAR;
            PG8_LDA(At, 1, 1); PG8_STAGE(PG8_SA(1, 0), a3, voffA);
            PG8_BAR; PG8_WAIT_L(0); PG8_MMA(1, 0, At, B0); PG8_BAR; PG8_SCHED;
            PG8_STAGE(PG8_SB(1, 1), b3 + hstepB, voffB);
            PG8_WAIT_V(6); PG8_BAR; PG8_MMA(1, 1, At, B1); PG8_BAR;
            }
        }
        if constexpr (ALIGN_EPI) { if (wr == 0) PG8_BAR; }
        if constexpr (!Epi::AFTER_DRAIN) { E(acc, cur, wr, wc, fr, fq); S.done(cur); }
        if (!has_next) break;
#pragma unroll
        for (int a = 0; a < 2; ++a)
#pragma unroll
            for (int b = 0; b < 2; ++b)
#pragma unroll
                for (int m = 0; m < 4; ++m)
#pragma unroll
                    for (int n = 0; n < 2; ++n) acc[a][b][m][n] = (f32x4){0.f, 0.f, 0.f, 0.f};
        cur = nxt; cA = nA; cB = nB; ++ui;
        if constexpr (ALIGN_EPI) { if (wr == 1) PG8_BAR; }
    }
    PG8_WAIT_V(0);
    if constexpr (!ALIGN_EPI) { if (wr == 0) PG8_BAR; }
    PG8_BAR;
    if constexpr (Epi::AFTER_DRAIN) { E.fused(acc, cur, wr, wc, fr, fq, lds, wid, lane); S.done(cur); }
#undef PG8_SA
#undef PG8_SB
#undef PG8_STAGE
#undef PG8_LDA
#undef PG8_LDB
#undef PG8_MMA
#undef PG8_WAIT_V
#undef PG8_WAIT_L
#undef PG8_BAR
#undef PG8_SCHED
}
}

constexpr int NWAVES = 8, NTHR = 512;
constexpr int LDS_BYTES = 147456;
#define GAS __attribute__((address_space(1)))
#define LAS __attribute__((address_space(3)))
typedef unsigned short bf16;
typedef unsigned v4u __attribute__((ext_vector_type(4)));
typedef unsigned v2u __attribute__((ext_vector_type(2)));
typedef float f32x4 __attribute__((ext_vector_type(4)));
typedef float f32x2 __attribute__((ext_vector_type(2)));
typedef float f32x16 __attribute__((ext_vector_type(16)));
typedef short bf16x8 __attribute__((ext_vector_type(8)));
typedef short s16x4 __attribute__((ext_vector_type(4)));

constexpr size_t MiB = 1u << 20;
constexpr size_t WS_CTL = 0;
constexpr size_t WS_PART = 1 * MiB;
constexpr size_t WS_ROPE = 3 * MiB;
constexpr size_t WS_HMETA = 4 * MiB;
constexpr size_t WS_LORA = 5 * MiB;
constexpr size_t WS_W = 6 * MiB;
constexpr size_t W_IN0 = WS_W, W_OUT0 = W_IN0 + (size_t)NIN * DM * 2, W_UP0 = W_OUT0 + (size_t)DM * DM * 2, W_DN0 = W_UP0 + (size_t)2 * DFF * DM * 2,
                 W_IN1 = W_DN0 + (size_t)DM * DFF * 2, W_OUT1 = W_IN1 + (size_t)NIN * DM * 2, W_UP1 = W_OUT1 + (size_t)DM * DM * 2, W_DN1 = W_UP1 + (size_t)2 * DFF * DM * 2,
                 W_END = W_DN1 + (size_t)DM * DFF * 2;
constexpr size_t WS_A = 56 * MiB;
constexpr size_t WS_R = 89 * MiB;
static_assert(W_END <= WS_A && WS_A + (size_t)MP * DM * 2 <= WS_R, "ws map");
constexpr size_t R_U = WS_R, R_WC = R_U + (size_t)MP * 512 * 2, R_GB = R_WC + (size_t)MP * 512 * 2, R_Y0 = R_GB + (size_t)MP * 512 * 2;
constexpr size_t R_HM = WS_R, R_EDGE_G = R_HM + (size_t)MP * DFF * 2, R_EDGE_V = R_EDGE_G + (size_t)65 * 2 * DFF * 4, R_HALO = R_EDGE_V + (size_t)65 * 2 * DFF * 4, R_FFN_END = R_HALO + (size_t)65 * 2 * DFF * 4;
constexpr size_t R_Q = WS_R, R_KB = R_Q + (size_t)MP * 512 * 2, R_VB = R_KB + (size_t)MP * 128 * 2, R_PR = R_VB + (size_t)MP * 128 * 2, R_Y1 = R_PR + (size_t)MP * PRW * 2, R_L1_END = R_Y1 + (size_t)MP * DM * 2;
constexpr size_t WS_END = 256 * MiB;
static_assert(EO_PART == WS_PART && EO_HM == R_HM && EO_EDGE_G == R_EDGE_G && EO_EDGE_V == R_EDGE_V && EO_HALO == R_HALO, "epilogue offsets");
static_assert(R_FFN_END <= WS_END && R_L1_END <= WS_END && R_Y0 + (size_t)MP * DM * 2 <= WS_END, "ws map 2");

#define LDS_WAIT() asm volatile("s_waitcnt lgkmcnt(0)" ::: "memory")
__device__ __forceinline__ unsigned f2bf(float f) { unsigned u = __builtin_bit_cast(unsigned, f); return (u + 0x7fffu + ((u >> 16) & 1u)) >> 16; }
__device__ __forceinline__ unsigned pk2(float lo, float hi) { return f2bf(lo) | (f2bf(hi) << 16); }
__device__ __forceinline__ float bf2f(unsigned short v) { return __builtin_bit_cast(float, (unsigned)v << 16); }
__device__ __forceinline__ float bflo(unsigned w) { return __builtin_bit_cast(float, w << 16); }
__device__ __forceinline__ float bfhi(unsigned w) { return __builtin_bit_cast(float, w & 0xffff0000u); }
__device__ __forceinline__ float sigm(float x) { return __builtin_amdgcn_rcpf(1.0f + __expf(-x)); }
__device__ __forceinline__ float dppf(float x, int ctrl_sel) {
    const int v = __builtin_bit_cast(int, x); int r;
    if (ctrl_sel == 0) r = __builtin_amdgcn_update_dpp(v, v, 0xB1, 0xF, 0xF, false);
    else if (ctrl_sel == 1) r = __builtin_amdgcn_update_dpp(v, v, 0x4E, 0xF, 0xF, false);
    else if (ctrl_sel == 2) r = __builtin_amdgcn_update_dpp(v, v, 0x141, 0xF, 0xF, false);
    else r = __builtin_amdgcn_update_dpp(v, v, 0x140, 0xF, 0xF, false);
    return __builtin_bit_cast(float, r);
}
__device__ __forceinline__ float sum16(float x) { x += dppf(x, 0); x += dppf(x, 1); x += dppf(x, 2); x += dppf(x, 3); return x; }

__device__ __forceinline__ void sum16x2(float& x0, float& x1) {
    asm volatile("s_nop 1\n\t"
        "v_add_f32_dpp %0, %0, %0 quad_perm:[1,0,3,2] row_mask:0xf bank_mask:0xf\n\t"
        "v_add_f32_dpp %1, %1, %1 quad_perm:[1,0,3,2] row_mask:0xf bank_mask:0xf\n\t"
        "s_nop 0\n\t"
        "v_add_f32_dpp %0, %0, %0 quad_perm:[2,3,0,1] row_mask:0xf bank_mask:0xf\n\t"
        "v_add_f32_dpp %1, %1, %1 quad_perm:[2,3,0,1] row_mask:0xf bank_mask:0xf\n\t"
        "s_nop 0\n\t"
        "v_add_f32_dpp %0, %0, %0 row_half_mirror row_mask:0xf bank_mask:0xf\n\t"
        "v_add_f32_dpp %1, %1, %1 row_half_mirror row_mask:0xf bank_mask:0xf\n\t"
        "s_nop 0\n\t"
        "v_add_f32_dpp %0, %0, %0 row_mirror row_mask:0xf bank_mask:0xf\n\t"
        "v_add_f32_dpp %1, %1, %1 row_mirror row_mask:0xf bank_mask:0xf\n\t"
        "s_nop 1"
        : "+v"(x0), "+v"(x1));
}
__device__ __forceinline__ float sum32(float x) { x = sum16(x); x += __shfl_xor(x, 16); return x; }
__device__ __forceinline__ float wave_sum(float v) {
#pragma unroll
    for (int o = 1; o < 64; o <<= 1) v += __shfl_xor(v, o);
    return v;
}
__device__ __forceinline__ int row_of(int b, int t) { return t >= NMETA ? b * SEQ + (t - NMETA) : MR + t; }


#define XB_TMO      128
#define XB_XCNT(j)  (256  + 64 * (j))
#define XB_XSUB(j)  (1280 + 64 * (j))
#define XB_XGEN(j)  (2304 + 64 * (j))
#define XB_TOP      3328
#define XB_TOPGEN   3392
#define XCD_BAR_WORDS 3456
#define XB_SPIN_CAP (1u << 18)
constexpr int LDSCTL_OFF = 147328, MISC_OFF = LDSCTL_OFF;
__device__ __forceinline__ unsigned xb_ld(unsigned* p)              { return __hip_atomic_load(p, __ATOMIC_RELAXED, __HIP_MEMORY_SCOPE_AGENT); }
__device__ __forceinline__ unsigned xb_add(unsigned* p, unsigned v) { return __hip_atomic_fetch_add(p, v, __ATOMIC_RELAXED, __HIP_MEMORY_SCOPE_AGENT); }
__device__ __forceinline__ unsigned xb_xcc_id() { return (unsigned)__builtin_amdgcn_s_getreg((3 << 11) | 20) & 0xFu; }
#define XB_SPIN(cond, bar) do { unsigned _sp = 0; while (cond) { __builtin_amdgcn_s_sleep(1); \
    if ((++_sp & 255u) == 0u) { if (xb_ld(&(bar)[XB_TMO])) break; if (_sp > XB_SPIN_CAP) { atomicAdd(&(bar)[XB_TMO], 1u); break; } } } } while (0)
__device__ __forceinline__ void xcd_barrier_complete(unsigned* bar, unsigned x, unsigned& nloc, unsigned& nx) {
    const unsigned G = gridDim.x * gridDim.y * gridDim.z;
    unsigned sum, cnt, mine, sp = 0u;
    for (;;) {
        sum = 0u; cnt = 0u; mine = 0u;
#pragma unroll
        for (unsigned j = 0; j < 16; ++j) { const unsigned c = xb_ld(&bar[XB_XCNT(j)]); sum += c; cnt += (c > 0u) ? 1u : 0u; mine = (j == x) ? c : mine; }
        if (sum == G) break;
        __builtin_amdgcn_s_sleep(1);
        if ((++sp & 255u) == 0u) { if (xb_ld(&bar[XB_TMO])) break; if (sp > XB_SPIN_CAP) { atomicAdd(&bar[XB_TMO], 1u); break; } }
    }
    nloc = mine > 0u ? mine : 1u; nx = cnt > 0u ? cnt : 1u;
}
__device__ __forceinline__ void xcd_barrier(unsigned* bar, volatile LAS unsigned* st, bool t0) {
    asm volatile("s_waitcnt vmcnt(0)" ::: "memory");
    __syncthreads();
    if (t0) {
        const unsigned x = xb_xcc_id();
        __builtin_amdgcn_s_waitcnt(0);
        unsigned nloc = st[0], nx = st[1];
        if (nloc == 0u) { xcd_barrier_complete(bar, x, nloc, nx); st[0] = nloc; st[1] = nx; }
        const unsigned old = xb_add(&bar[XB_XSUB(x)], 1u);
        const unsigned gen = old / nloc;
        if (old + 1u == (gen + 1u) * nloc) {
            __builtin_amdgcn_fence(__ATOMIC_RELEASE, "agent");
            asm volatile("s_waitcnt vmcnt(0)" ::: "memory");
            const unsigned og = xb_add(&bar[XB_TOP], 1u);
            const unsigned tg = og / nx;
            if (og + 1u == (tg + 1u) * nx) xb_add(&bar[XB_TOPGEN], 1u);
            else XB_SPIN(xb_ld(&bar[XB_TOPGEN]) == tg, bar);
            __builtin_amdgcn_fence(__ATOMIC_ACQUIRE, "agent");
            xb_add(&bar[XB_XGEN(x)], 1u);
            asm volatile("s_waitcnt vmcnt(0)" ::: "memory");
        } else {
            XB_SPIN(xb_ld(&bar[XB_XGEN(x)]) == gen, bar);
            __builtin_amdgcn_fence(__ATOMIC_ACQUIRE, "agent");
            asm volatile("s_waitcnt vmcnt(0)" ::: "memory");
        }
    }
    __syncthreads();
}

struct Args { const float* in[29]; float* out; unsigned char* ws; int ph_lo, ph_hi; };
typedef const __attribute__((address_space(4))) Args CArgs;

struct Frame {
    LAS unsigned char* lds; int tid, lane, wave, G, wg;
    float* out; unsigned char* ws;
};

__device__ __forceinline__ int colmap(int kind, int d) {
    if (kind == 0) return d;
    const int tile = d >> 8, bj = (d >> 7) & 1, cc = d & 127;
    if (kind == 1) {
        if (tile < 4) return (bj ? 512 : 0) + 128 * tile + cc;
        if (tile < 8) return (bj ? 2048 : 1536) + 128 * (tile - 4) + cc;
        return 1024 + (d - 2048);
    }
    if (kind == 2) return (bj ? DFF : 0) + 128 * tile + cc;
    const int w = cc >> 5, dd = cc & 31;
    if (tile < 2) return 64 * (4 * tile + w) + 32 * bj + dd;
    if (tile == 2) return (w < 2 ? 512 + 64 * w : 640 + 64 * (w - 2)) + 32 * bj + dd;
    return d;
}
__device__ __forceinline__ void p0_transpose_item(const float* W, int K, int N, bf16* WT, const float* gvec, int kind, LAS float* scr, int item, int nblk, int lane) {
    const int kb = item / nblk, db = item % nblk, k0 = 64 * kb, d0 = 32 * db, n0 = colmap(kind, d0);
#pragma unroll 8
    for (int i = 0; i < 32; ++i) { const int kk = 2 * i + (lane >> 5); float v = W[(size_t)(k0 + kk) * N + n0 + (lane & 31)]; if (gvec) v *= gvec[k0 + kk]; scr[kk * 33 + (lane & 31)] = v; }
    LDS_WAIT(); asm volatile("" ::: "memory");
    const int c = lane & 7;
#pragma unroll
    for (int j = 0; j < 4; ++j) { const int n = (lane >> 3) + 8 * j; const LAS float* s = scr + (8 * c) * 33 + n;
        v4u o; o.x = pk2(s[0 * 33], s[1 * 33]); o.y = pk2(s[2 * 33], s[3 * 33]); o.z = pk2(s[4 * 33], s[5 * 33]); o.w = pk2(s[6 * 33], s[7 * 33]);
        *(GAS v4u*)(WT + (size_t)(d0 + n) * K + k0 + 8 * c) = o; }
    LDS_WAIT(); asm volatile("" ::: "memory");
}
__device__ __forceinline__ void p0_job(Frame& F, LAS float* scr, int gw, int NGW, int& base, const float* W, int K, int N, size_t dst, const float* g, int kind) {
    const int nblk = N / 32, nitems = (K / 64) * nblk;
    int it = gw - (base % NGW); if (it < 0) it += NGW;
    for (; it < nitems; it += NGW) p0_transpose_item(W, K, N, (bf16*)(F.ws + dst), g, kind, scr, it, nblk, F.lane);
    base += nitems;
}
__device__ __forceinline__ void p0_prologue(Frame& F, CArgs& A) {
    LAS float* scr = (LAS float*)(F.lds + F.wave * 16384);
    const int gw = F.wg * NWAVES + F.wave, NGW = F.G * NWAVES, lane = F.lane;
    unsigned char* ws = F.ws;
    const float* norm_mix = A.in[2]; const float* norm_ffn = A.in[3];
    int base = 0;
    p0_job(F, scr, gw, NGW, base, A.in[5], DM, NIN, W_IN0, norm_mix, 1);
    p0_job(F, scr, gw, NGW, base, A.in[10], DM, DM, W_OUT0, nullptr, 0);
    p0_job(F, scr, gw, NGW, base, A.in[25], DM, 2 * DFF, W_UP0, norm_ffn, 2);
    p0_job(F, scr, gw, NGW, base, A.in[28], DFF, DM, W_DN0, nullptr, 0);
    p0_job(F, scr, gw, NGW, base, A.in[11], DM, NIN, W_IN1, norm_mix + DM, 3);
    p0_job(F, scr, gw, NGW, base, A.in[24], DM, DM, W_OUT1, nullptr, 0);
    p0_job(F, scr, gw, NGW, base, A.in[25] + (size_t)DM * 2 * DFF, DM, 2 * DFF, W_UP1, norm_ffn + DM, 2);
    p0_job(F, scr, gw, NGW, base, A.in[28] + (size_t)DFF * DM, DFF, DM, W_DN1, nullptr, 0);
    p0_job(F, scr, gw, NGW, base, A.in[15], 64, 512, WS_LORA, nullptr, 0);
    p0_job(F, scr, gw, NGW, base, A.in[17], 64, 512, WS_LORA + 512 * 64 * 2, nullptr, 0);
    p0_job(F, scr, gw, NGW, base, A.in[18], 128, 512, WS_LORA + 2 * 512 * 64 * 2, nullptr, 0);
    const float* x = A.in[0]; const float* meta = A.in[1];
    bf16* A0 = (bf16*)(ws + WS_A); float* part = (float*)(ws + WS_PART); float* hmeta = (float*)(ws + WS_HMETA);
    for (int row = gw; row < MP; row += NGW) {
        float* pp = part + (size_t)row * 16;
        if (row < MR + NMETA) {
            const float* src = row < MR ? x + (size_t)row * DM : meta + (size_t)(row - MR) * DM;
            float ss = 0.f;
#pragma unroll
            for (int j = 0; j < 4; ++j) { const f32x4 v = *(const GAS f32x4*)(src + j * 256 + lane * 4); ss += (v[0] * v[0] + v[1] * v[1]) + (v[2] * v[2] + v[3] * v[3]);
                v2u o; o.x = pk2(v[0], v[1]); o.y = pk2(v[2], v[3]); *(GAS v2u*)(A0 + (size_t)row * DM + j * 256 + lane * 4) = o;
                if (row >= MR) *(GAS f32x4*)(hmeta + (size_t)(row - MR) * DM + j * 256 + lane * 4) = v; }
            ss = wave_sum(ss);
            if (lane < 16) pp[lane] = lane == 0 ? ss : 0.f;
        } else {
            if (lane < 16) pp[lane] = 0.f;
#pragma unroll
            for (int j = 0; j < 4; ++j) { float zf; asm volatile("v_mov_b32 %0, 0" : "=v"(zf)); *(GAS f32x4*)(hmeta + (size_t)(row - MR) * DM + j * 256 + lane * 4) = (f32x4){zf, zf, zf, zf}; }
        }
    }
    float* rc = (float*)(ws + WS_ROPE); float* rsn = rc + TT * 32;
    for (int i = gw * 64 + lane; i < TT * 32; i += NGW * 64) {
        const int t = i >> 5, d = i & 31;
        const float inv = exp2f(-(float)d * (13.287712379549449f / 32.0f));
        const float ang = (float)t * inv;
        const float rev = ang * 0.15915494309189535f; const float a = (rev - floorf(rev)) * 6.283185307179586f;
        rc[i] = __cosf(a); rsn[i] = __sinf(a);
    }
}

__device__ __forceinline__ void conv0_phase(Frame& F, CArgs& A) {
    const bf16* U = (const bf16*)(F.ws + R_U); const bf16* WC = (const bf16*)(F.ws + R_WC); const bf16* GB = (const bf16*)(F.ws + R_GB); bf16* Y0 = (bf16*)(F.ws + R_Y0);
    const float* conv_a = A.in[6]; const float* ln_g = A.in[7]; const float* ln_b = A.in[8]; const float* conv_b = A.in[9];
    const int half = F.tid >> 8, ht = F.tid & 255, c0 = 2 * ht;
    LAS float* tile = (LAS float*)(F.lds + half * 40960);
    LAS float* stats = (LAS float*)(F.lds + half * 40960 + 32768);
    float wa[31][2];
#pragma unroll
    for (int j = 0; j < 31; ++j) { const f32x2 w = *(const f32x2*)(conv_a + j * 512 + c0); wa[j][0] = w.x; wa[j][1] = w.y; }
    float wb[3][2];
#pragma unroll
    for (int j = 0; j < 3; ++j) { const f32x2 w = *(const f32x2*)(conv_b + j * 512 + c0); wb[j][0] = w.x; wb[j][1] = w.y; }
    const f32x2 lg = *(const f32x2*)(ln_g + c0), lb = *(const f32x2*)(ln_b + c0);
    const int NU = NB * 128 + 1;
    const int nhu = 2 * F.G;
    for (int u0 = 0; u0 < NU; u0 += nhu) {
        const int u = u0 + F.wg * 2 + half; const bool act = u < NU;
        int b = 0, t0 = 0; if (act) { if (u == NB * 128) { b = 0; t0 = 0; } else { b = u >> 7; t0 = 16 + 16 * (u & 127); } }
        if (act) {
            unsigned uin[46];
#pragma unroll
            for (int i = 0; i < 46; ++i) { const int t = t0 - 30 + i; uin[i] = t >= 0 ? *(const unsigned*)(U + (size_t)row_of(b, t) * 512 + c0) : 0u; }
#pragma unroll
            for (int o = 0; o < 16; ++o) { float a0 = 0.f, a1 = 0.f;
#pragma unroll
                for (int j = 0; j < 31; ++j) { a0 += wa[j][0] * bflo(uin[o + j]); a1 += wa[j][1] * bfhi(uin[o + j]); }
                *(LAS f32x2*)(tile + o * 512 + c0) = (f32x2){a0, a1}; }
        }
        __syncthreads();
        if (act) {
            const int tok = ht >> 4, q = ht & 15; float s = 0.f, ss = 0.f;
#pragma unroll
            for (int i = 0; i < 8; ++i) { const f32x4 v = *(const LAS f32x4*)(tile + tok * 512 + i * 64 + q * 4); s += (v[0] + v[1]) + (v[2] + v[3]); ss += (v[0] * v[0] + v[1] * v[1]) + (v[2] * v[2] + v[3] * v[3]); }
            s = sum16(s); ss = sum16(ss);
            if (q == 0) { const float mu = s * (1.f / 512.f); float var = ss * (1.f / 512.f) - mu * mu; var = var < 0.f ? 0.f : var; stats[tok * 2] = mu; stats[tok * 2 + 1] = rsqrtf(var + 1e-5f); }
        }
        __syncthreads();
        if (act) {
            unsigned win[18];
#pragma unroll
            for (int i = 0; i < 18; ++i) { const int t = t0 - 2 + i; win[i] = t >= 0 ? *(const unsigned*)(WC + (size_t)row_of(b, t) * 512 + c0) : 0u; }
#pragma unroll
            for (int o = 0; o < 16; ++o) {
                const int row = row_of(b, t0 + o);
                const f32x2 v = *(const LAS f32x2*)(tile + o * 512 + c0); const float mu = stats[o * 2], rs = stats[o * 2 + 1];
                float y0 = (v.x - mu) * rs * lg.x + lb.x, y1 = (v.y - mu) * rs * lg.y + lb.y; y0 *= sigm(y0); y1 *= sigm(y1);
                *(unsigned*)(Y0 + (size_t)row * DM + c0) = pk2(y0, y1);
                float z0 = 0.f, z1 = 0.f;
#pragma unroll
                for (int j = 0; j < 3; ++j) { z0 += wb[j][0] * bflo(win[o + j]); z1 += wb[j][1] * bfhi(win[o + j]); }
                const unsigned gbv = *(const unsigned*)(GB + (size_t)row * 512 + c0);
                *(unsigned*)(Y0 + (size_t)row * DM + 512 + c0) = pk2(z0 * bflo(gbv), z1 * bfhi(gbv));
            }
        }
        __syncthreads();
    }
}

__device__ __forceinline__ void ffn_fix_phase(Frame& F, CArgs& A, int layer) {
    bf16* HM = (bf16*)(F.ws + R_HM); const float* EG = (const float*)(F.ws + R_EDGE_G); const float* EV = (const float*)(F.ws + R_EDGE_V); const float* HL = (const float*)(F.ws + R_HALO);
    const float* cw = A.in[26] + (size_t)layer * 3 * DFF; const float* cb = A.in[27] + (size_t)layer * DFF;
    const int NIT = 65 * 2 * (DFF / 4);
    for (int it = F.wg * NTHR + F.tid; it < NIT; it += F.G * NTHR) {
        const int c = (it % (DFF / 4)) * 4, pl = it / (DFF / 4), pm = pl >> 1, lr = pl & 1;
        const f32x4 g0 = *(const f32x4*)(EG + (size_t)(pm * 2 + lr) * DFF + c), v = *(const f32x4*)(EV + (size_t)(pm * 2 + lr) * DFF + c);
        f32x4 a254 = (f32x4){0.f, 0.f, 0.f, 0.f}, a255 = a254;
        if (pm < 64) { const int src = (pm & 7) == 0 ? 64 : pm - 1; a254 = *(const f32x4*)(HL + (size_t)(src * 2 + 0) * DFF + c); a255 = *(const f32x4*)(HL + (size_t)(src * 2 + 1) * DFF + c); }
        const f32x4 g1 = lr == 0 ? a255 : *(const f32x4*)(EG + (size_t)(pm * 2) * DFF + c), g2 = lr == 0 ? a254 : a255;
        const f32x4 z = *(const f32x4*)(cw + c) * g2 + *(const f32x4*)(cw + DFF + c) * g1 + *(const f32x4*)(cw + 2 * DFF + c) * g0 + *(const f32x4*)(cb + c);
        const f32x4 o = z * (f32x4){sigm(z[0]), sigm(z[1]), sigm(z[2]), sigm(z[3])} * v;
        v2u ov; ov.x = pk2(o[0], o[1]); ov.y = pk2(o[2], o[3]);
        *(v2u*)(HM + (size_t)(pm * 256 + lr) * DFF + c) = ov;
    }
}

__device__ __forceinline__ int crow(int r, int hi) { return (r & 3) + 8 * (r >> 2) + 4 * hi; }
constexpr int ATT_KS = 72, ATT_VS = 232, ATT_K_BYTES = 224 * ATT_KS * 2;
__device__ __forceinline__ void attn_unit(Frame& F, const float* sinks, int b, int kvh, int qb) {
    const bf16* Q = (const bf16*)(F.ws + R_Q); const bf16* KB = (const bf16*)(F.ws + R_KB); const bf16* VB = (const bf16*)(F.ws + R_VB); bf16* Y1 = (bf16*)(F.ws + R_Y1);
    LAS bf16* Ks = (LAS bf16*)F.lds; LAS bf16* Vt = (LAS bf16*)(F.lds + ATT_K_BYTES);
    const int tid = F.tid, lane = F.lane, wave = F.wave, g = wave >> 1, half = wave & 1, qh = kvh * 4 + g, qi = lane & 31, hi = lane >> 5;
    const bool meta = qb < 0; const int q0 = meta ? 0 : 64 * qb;
#pragma unroll
    for (int i = 0; i < 4; ++i) {
        const int id = tid + 512 * i, key = id >> 3, ch = id & 7;
        if (key < 224) {
            int row = -1;
            if (key < 192) { const int sp = q0 - 128 + key; if (!meta && sp >= 0) row = b * SEQ + sp; }
            else if (key < 208) row = MR + (key - 192);
            v4u kv = (v4u){0u, 0u, 0u, 0u}, vv = (v4u){0u, 0u, 0u, 0u};
            if (row >= 0) { kv = *(const v4u*)(KB + (size_t)row * 128 + kvh * 64 + ch * 8); vv = *(const v4u*)(VB + (size_t)row * 128 + kvh * 64 + ch * 8); }
            *(LAS v4u*)(Ks + key * ATT_KS + ch * 8) = kv;
#pragma unroll
            for (int e = 0; e < 4; ++e) { Vt[(ch * 8 + 2 * e) * ATT_VS + key] = (bf16)(vv[e] & 0xffffu); Vt[(ch * 8 + 2 * e + 1) * ATT_VS + key] = (bf16)(vv[e] >> 16); }
        }
    }
    __syncthreads();
    int qrow; if (meta) { const int m = 32 * half + qi; qrow = MR + (m < NMETA ? m : NMETA - 1); } else qrow = b * SEQ + q0 + 32 * half + qi;
    bf16x8 qr[4];
#pragma unroll
    for (int k4 = 0; k4 < 4; ++k4) qr[k4] = *(const bf16x8*)(Q + (size_t)qrow * 512 + qh * 64 + 16 * k4 + 8 * hi);
    f32x16 sc[6];
#pragma unroll
    for (int i = 0; i < 6; ++i) {
        const int t = i < 5 ? half + i : 6;
        f32x16 a = (f32x16){0.f,0.f,0.f,0.f,0.f,0.f,0.f,0.f,0.f,0.f,0.f,0.f,0.f,0.f,0.f,0.f};
#pragma unroll
        for (int k4 = 0; k4 < 4; ++k4) { const bf16x8 kf = *(const LAS bf16x8*)(Ks + (32 * t + qi) * ATT_KS + 16 * k4 + 8 * hi); a = __builtin_amdgcn_mfma_f32_32x32x16_bf16(kf, qr[k4], a, 0, 0, 0); }
        sc[i] = a;
    }
    const float sink = sinks[qh]; float mx = sink;
    const int mq = 32 * half + qi;
#pragma unroll
    for (int i = 0; i < 6; ++i)
#pragma unroll
        for (int r = 0; r < 16; ++r) {
            const int kr = crow(r, hi); bool ok;
            if (i < 5) { const int dist = 128 - 32 * i + qi - kr; const int sp = q0 - 128 + 32 * (half + i) + kr; ok = !meta && dist >= 0 && dist < 128 && sp >= 0; }
            else ok = kr < NMETA && (!meta || kr <= mq);
            const float v = ok ? sc[i][r] * 0.125f : -1e30f; sc[i][r] = v; mx = fmaxf(mx, v);
        }
    mx = fmaxf(mx, __shfl_xor(mx, 32));
    float ls = 0.f;
#pragma unroll
    for (int i = 0; i < 6; ++i)
#pragma unroll
        for (int r = 0; r < 16; ++r) { const float p = __expf(sc[i][r] - mx); sc[i][r] = p; ls += p; }
    ls += __shfl_xor(ls, 32); ls += __expf(sink - mx);
    const float inv = 1.0f / ls;
    f32x16 o[2];
    o[0] = (f32x16){0.f,0.f,0.f,0.f,0.f,0.f,0.f,0.f,0.f,0.f,0.f,0.f,0.f,0.f,0.f,0.f}; o[1] = o[0];
#pragma unroll
    for (int i = 0; i < 6; ++i) {
        const int t = i < 5 ? half + i : 6;
#pragma unroll
        for (int s2 = 0; s2 < 2; ++s2) {
            v4u pw; pw.x = pg8::cvt_pk_bf16(sc[i][8 * s2 + 0], sc[i][8 * s2 + 1]); pw.y = pg8::cvt_pk_bf16(sc[i][8 * s2 + 2], sc[i][8 * s2 + 3]);
            pw.z = pg8::cvt_pk_bf16(sc[i][8 * s2 + 4], sc[i][8 * s2 + 5]); pw.w = pg8::cvt_pk_bf16(sc[i][8 * s2 + 6], sc[i][8 * s2 + 7]);
            const bf16x8 pa = __builtin_bit_cast(bf16x8, pw);
#pragma unroll
            for (int dt = 0; dt < 2; ++dt) {
                const LAS bf16* vp = Vt + (dt * 32 + qi) * ATT_VS + 32 * t + 16 * s2 + 4 * hi;
                const v2u lo = *(const LAS v2u*)vp, hh = *(const LAS v2u*)(vp + 8);
                const v4u vw = (v4u){lo.x, lo.y, hh.x, hh.y};
                o[dt] = __builtin_amdgcn_mfma_f32_32x32x16_bf16(pa, __builtin_bit_cast(bf16x8, vw), o[dt], 0, 0, 0);
            }
        }
    }
#pragma unroll
    for (int r = 0; r < 16; ++r) {
        const int qq = crow(r, hi); const float iv = __shfl(inv, qq);
        int orow; bool ok = true;
        if (meta) { const int m = 32 * half + qq; ok = m < NMETA; orow = MR + m; } else orow = b * SEQ + q0 + 32 * half + qq;
        if (ok) {
            Y1[(size_t)orow * DM + qh * 64 + qi] = (bf16)f2bf(o[0][r] * iv);
            Y1[(size_t)orow * DM + qh * 64 + 32 + qi] = (bf16)f2bf(o[1][r] * iv);
        }
    }
    __syncthreads();
}

constexpr int IMG_PT = 0, IMG_BK = 4096, IMG_VT = 8192, IMG_QT = 10240, IMG_W16 = 11264, IMG_BYTES = 11520;
constexpr int NBLK = 129, NBLK_H1 = 65;
constexpr size_t WS_IMG = 203 * MiB;
constexpr size_t WS_G = WS_A, WS_RK = WS_A + 17 * MiB, WS_ZS = WS_A + 18 * MiB;
static_assert(WS_IMG >= R_L1_END && WS_IMG + (size_t)64 * NBLK_H1 * IMG_BYTES <= WS_END, "image region");
constexpr int P_PRL = 0, P_XR = 15616, P_XK = P_XR + 4096, P_XV = P_XK + 4096, P_TW = P_XV + 4096, P_XA = P_TW + 2304, P_SG = P_XA + 2304,
              P_LW = P_SG + 4352, P_LA = P_LW + 4096, P_LG = P_LA + 4096, P_FW = P_LG + 4096, P_FK = P_FW + 4096, P_FA = P_FK + 4096, P_FB = P_FA + 4096,
              P_WC = P_FB + 4096, P_E1 = P_WC + 4096, P_E2 = P_E1 + 4608, P_ATF = P_E2 + 4608, P_RTF = P_ATF + 4096, P_M = P_RTF + 4096, P_T = P_M + 4224, P_PTF = P_T + 1088,
              P_QF = P_PTF + 4096, P_IMG = P_QF + 1088, P_END = P_IMG + IMG_BYTES;
static_assert(P_END <= 131072 && (P_IMG % 16) == 0 && (P_E1 % 16) == 0 && (P_E2 % 16) == 0, "prep lds map");
constexpr int PRS = 456;
__device__ __forceinline__ float wsum64(float x) { x = sum16(x); x += __shfl_xor(x, 16); x += __shfl_xor(x, 32); return x; }

__device__ __forceinline__ void rwkv_prep_phase(Frame& F, CArgs& A, int nbase, int cnt) {
    const bf16* PR = (const bf16*)(F.ws + R_PR);
    const bf16* w2t = (const bf16*)(F.ws + WS_LORA); const bf16* a2t = w2t + 512 * 64; const bf16* g2t = a2t + 512 * 64;
    const int tid = F.tid, lane = F.lane, wave = F.wave;
    LAS unsigned char* L = F.lds;
    LAS bf16* PRL = (LAS bf16*)(L + P_PRL);
    LAS float* XR = (LAS float*)(L + P_XR); LAS float* XK = (LAS float*)(L + P_XK); LAS float* XV = (LAS float*)(L + P_XV);
    LAS bf16* TW = (LAS bf16*)(L + P_TW); LAS bf16* XA = (LAS bf16*)(L + P_XA); LAS bf16* SG = (LAS bf16*)(L + P_SG);
    LAS float* LW = (LAS float*)(L + P_LW); LAS float* LA = (LAS float*)(L + P_LA); LAS float* LG = (LAS float*)(L + P_LG);
    LAS float* FW = (LAS float*)(L + P_FW); LAS float* FK = (LAS float*)(L + P_FK); LAS float* FA = (LAS float*)(L + P_FA); LAS float* FB = (LAS float*)(L + P_FB);
    LAS float* WC = (LAS float*)(L + P_WC); LAS bf16* E1 = (LAS bf16*)(L + P_E1); LAS bf16* E2 = (LAS bf16*)(L + P_E2);
    LAS float* ATF = (LAS float*)(L + P_ATF); LAS float* RTF = (LAS float*)(L + P_RTF); LAS float* M = (LAS float*)(L + P_M); LAS float* T = (LAS float*)(L + P_T);
    LAS float* PTF = (LAS float*)(L + P_PTF); LAS float* QF = (LAS float*)(L + P_QF);
    LAS bf16* I_PT = (LAS bf16*)(L + P_IMG + IMG_PT); LAS bf16* I_BK = (LAS bf16*)(L + P_IMG + IMG_BK); LAS bf16* I_VT = (LAS bf16*)(L + P_IMG + IMG_VT);
    LAS bf16* I_QT = (LAS bf16*)(L + P_IMG + IMG_QT); LAS float* I_W16 = (LAS float*)(L + P_IMG + IMG_W16);
    const int nunits = 64 * cnt;
    if (F.wg >= nunits) return;
    int ld_pr[2], ld_pc[2]; bool ld_ok[2];
#pragma unroll
    for (int i = 0; i < 2; ++i) { const int q = tid + 512 * i; ld_ok[i] = q < 952; ld_pr[i] = ld_ok[i] ? q / 56 : 0; ld_pc[i] = ld_ok[i] ? q % 56 : 0; }
#define PP_LOAD(id_, dst) do { const int ch_ = (id_) & 63, n_ = nbase + ((id_) >> 6), b_ = ch_ >> 3, h_ = ch_ & 7; \
        _Pragma("unroll") for (int i_ = 0; i_ < 2; ++i_) { const int pr = ld_pr[i_], pc = ld_pc[i_]; \
            const int col = pc < 8 ? 64 * h_ + 8 * pc : pc < 16 ? 512 + 64 * h_ + 8 * (pc - 8) : pc < 24 ? 1024 + 64 * h_ + 8 * (pc - 16) : 1536 + 8 * (pc - 24); \
            int gr = n_ == 0 ? MR + pr - 1 : n_ == 1 ? (pr == 0 ? MR + NMETA - 1 : b_ * SEQ + pr - 1) : b_ * SEQ + 16 * (n_ - 1) - 1 + pr; \
            const bool zero_ = (n_ == 0 && pr == 0); if (zero_) gr = MR; \
            v4u v_ = *(const v4u*)(PR + (size_t)gr * PRW + col); if (zero_) v_ = (v4u){0u, 0u, 0u, 0u}; dst[i_] = v_; } } while (0)
    v4u pf[2];
    PP_LOAD(F.wg, pf);
    int cur_chain = -1;
    float c_mu[14]; bf16x8 c_bfr[4]; f32x2 c_w0 = (f32x2){0.f, 0.f}, c_a0 = c_w0, c_kk = c_w0, c_ka = c_w0, c_rk = c_w0;
#pragma unroll
    for (int i = 0; i < 14; ++i) c_mu[i] = 0.f;
#pragma unroll
    for (int i = 0; i < 4; ++i) c_bfr[i] = (bf16x8){0, 0, 0, 0, 0, 0, 0, 0};
    const int tt = tid >> 5, jp = tid & 31, j0 = 2 * jp;
#pragma unroll 1
    for (int id = F.wg; id < nunits; id += F.G) {
    const int chain = id & 63, n = nbase + (id >> 6);
    const int b = chain >> 3, h = chain & 7, ch0 = 64 * h + j0;
    if (chain != cur_chain) {
        cur_chain = chain;
        const float* mu = A.in[13];
#pragma unroll
        for (int i = 0; i < 14; ++i) { const int c = (tid & 31) + 32 * i; const int gcol = c < 64 ? 64 * h + c : c < 128 ? 512 + 64 * h + (c - 64) : c < 192 ? 1024 + 64 * h + (c - 128) : 1536 + (c - 192); c_mu[i] = mu[gcol]; }
        { const int nb = wave & 3, grp = wave >> 2, ar = lane & 15, ak = 8 * (lane >> 4);
          if (grp == 0) { c_bfr[0] = *(const bf16x8*)(w2t + (size_t)(64 * h + 16 * nb + ar) * 64 + ak); c_bfr[1] = *(const bf16x8*)(w2t + (size_t)(64 * h + 16 * nb + ar) * 64 + 32 + ak);
                          c_bfr[2] = *(const bf16x8*)(a2t + (size_t)(64 * h + 16 * nb + ar) * 64 + ak); c_bfr[3] = *(const bf16x8*)(a2t + (size_t)(64 * h + 16 * nb + ar) * 64 + 32 + ak); }
          else {
#pragma unroll
              for (int k = 0; k < 4; ++k) c_bfr[k] = *(const bf16x8*)(g2t + (size_t)(64 * h + 16 * nb + ar) * 128 + 32 * k + ak); } }
        c_w0 = *(const f32x2*)(A.in[14] + ch0); c_a0 = *(const f32x2*)(A.in[16] + ch0); c_kk = *(const f32x2*)(A.in[19] + ch0); c_ka = *(const f32x2*)(A.in[20] + ch0); c_rk = *(const f32x2*)(A.in[21] + ch0);
    }
    const int r0 = n == 0 ? MR : b * SEQ + 16 * (n - 1);
#pragma unroll
    for (int i = 0; i < 2; ++i) if (ld_ok[i]) *(LAS v4u*)(PRL + ld_pr[i] * PRS + 8 * ld_pc[i]) = pf[i];
    if (id + F.G < nunits) PP_LOAD(id + F.G, pf);
    __syncthreads();
    {
        const int t2 = tid >> 5, l32 = tid & 31;
#pragma unroll
        for (int i = 0; i < 14; ++i) {
            const int c = l32 + 32 * i;
            const float cur = bf2f(PRL[(1 + t2) * PRS + c]), prv = bf2f(PRL[t2 * PRS + c]);
            const float x = cur + (prv - cur) * c_mu[i];
            if (c < 64) XR[t2 * 64 + c] = x; else if (c < 128) XK[t2 * 64 + c - 64] = x; else if (c < 192) XV[t2 * 64 + c - 128] = x;
            else if (c < 256) { const float e = __expf(2.0f * x); TW[t2 * 72 + c - 192] = (bf16)f2bf(1.0f - 2.0f * __builtin_amdgcn_rcpf(e + 1.0f)); }
            else if (c < 320) XA[t2 * 72 + c - 256] = (bf16)f2bf(x); else SG[t2 * 136 + c - 320] = (bf16)f2bf(sigm(x));
        }
    }
    __syncthreads();
    {
        const int nb = wave & 3, grp = wave >> 2, ar = lane & 15, ak = 8 * (lane >> 4);
        pg8::f32x4 d0 = (pg8::f32x4){0.f, 0.f, 0.f, 0.f}, d1 = d0;
        if (grp == 0) {
#pragma unroll
            for (int k = 0; k < 2; ++k) { const bf16x8 af = *(const LAS bf16x8*)(TW + ar * 72 + 32 * k + ak); d0 = __builtin_amdgcn_mfma_f32_16x16x32_bf16(af, c_bfr[k], d0, 0, 0, 0); }
#pragma unroll
            for (int k = 0; k < 2; ++k) { const bf16x8 af = *(const LAS bf16x8*)(XA + ar * 72 + 32 * k + ak); d1 = __builtin_amdgcn_mfma_f32_16x16x32_bf16(af, c_bfr[2 + k], d1, 0, 0, 0); }
#pragma unroll
            for (int r = 0; r < 4; ++r) { LW[(4 * (lane >> 4) + r) * 64 + 16 * nb + ar] = d0[r]; LA[(4 * (lane >> 4) + r) * 64 + 16 * nb + ar] = d1[r]; }
        } else {
#pragma unroll
            for (int k = 0; k < 4; ++k) { const bf16x8 af = *(const LAS bf16x8*)(SG + ar * 136 + 32 * k + ak); d0 = __builtin_amdgcn_mfma_f32_16x16x32_bf16(af, c_bfr[k], d0, 0, 0, 0); }
#pragma unroll
            for (int r = 0; r < 4; ++r) LG[(4 * (lane >> 4) + r) * 64 + 16 * nb + ar] = d0[r];
        }
    }
    __syncthreads();
    {
        const f32x2 lw = *(const LAS f32x2*)(LW + tt * 64 + j0), la = *(const LAS f32x2*)(LA + tt * 64 + j0), lg = *(const LAS f32x2*)(LG + tt * 64 + j0);
        const f32x2 xr = *(const LAS f32x2*)(XR + tt * 64 + j0), xk = *(const LAS f32x2*)(XK + tt * 64 + j0), xv = *(const LAS f32x2*)(XV + tt * 64 + j0);
        const float wd0 = __expf(-0.6065306597126334f * sigm(c_w0.x + lw.x)), wd1 = __expf(-0.6065306597126334f * sigm(c_w0.y + lw.y));
        const float al0 = sigm(c_a0.x + la.x), al1 = sigm(c_a0.y + la.y);
        const float q0 = xk.x * c_kk.x, q1 = xk.y * c_kk.y;
        const float nrm = sum32(q0 * q0 + q1 * q1); const float rn = 1.0f / fmaxf(sqrtf(nrm), 1e-12f);
        const float kk0 = q0 * rn, kk1 = q1 * rn;
        const float kn0 = xk.x * (1.0f + (al0 - 1.0f) * c_ka.x), kn1 = xk.y * (1.0f + (al1 - 1.0f) * c_ka.y);
        const float rkp = sum32(xr.x * kn0 * c_rk.x + xr.y * kn1 * c_rk.y);
        *(LAS f32x2*)(FW + tt * 64 + j0) = (f32x2){wd0, wd1}; *(LAS f32x2*)(FK + tt * 64 + j0) = (f32x2){kn0, kn1};
        *(LAS f32x2*)(FA + tt * 64 + j0) = (f32x2){-kk0, -kk1}; *(LAS f32x2*)(FB + tt * 64 + j0) = (f32x2){kk0 * al0, kk1 * al1};
        I_VT[j0 * 16 + tt] = (bf16)f2bf(xv.x); I_VT[(j0 + 1) * 16 + tt] = (bf16)f2bf(xv.y);
        if (n > 0 || b == 0) {
            *(unsigned*)((bf16*)(F.ws + WS_G) + (size_t)(r0 + tt) * 512 + ch0) = pk2(lg.x, lg.y);
            if (jp == 0) ((float*)(F.ws + WS_RK))[(size_t)(r0 + tt) * 8 + h] = rkp;
        }
    }
    __syncthreads();
    if (tid < 64) { float wc = 1.0f;
#pragma unroll
        for (int s = 0; s < 16; ++s) { wc *= FW[s * 64 + tid]; WC[s * 64 + tid] = wc; } }
    __syncthreads();
    {
        const int s = tt;
#pragma unroll
        for (int e = 0; e < 2; ++e) { const int j = j0 + e;
            const float wp = s > 0 ? WC[(s - 1) * 64 + j] : 1.0f, wcv = WC[s * 64 + j], w16 = WC[15 * 64 + j], iw = 1.0f / wcv;
            const float at = wp * FA[s * 64 + j], rt = wcv * XR[s * 64 + j], bh = FB[s * 64 + j] * iw, kh = FK[s * 64 + j] * iw;
            E1[s * 72 + j] = (bf16)f2bf(bh); E1[(16 + s) * 72 + j] = (bf16)f2bf(kh); E2[s * 72 + j] = (bf16)f2bf(at); E2[(16 + s) * 72 + j] = (bf16)f2bf(rt);
            ATF[s * 64 + j] = at; RTF[s * 64 + j] = rt;
            I_BK[j * 32 + s] = (bf16)f2bf(bh * w16); I_BK[j * 32 + 16 + s] = (bf16)f2bf(kh * w16);
            if (s == 0) { const int jt = j >> 5, jj = j & 31, hi_ = (jj >> 2) & 1, r_ = (jj & 3) + 4 * (jj >> 3); I_W16[hi_ * 32 + jt * 16 + r_] = w16; }
        }
    }
    __syncthreads();
    if (wave == 0) {
        const int m = lane & 31, hh = lane >> 5;
        f32x16 d = (f32x16){0.f,0.f,0.f,0.f,0.f,0.f,0.f,0.f,0.f,0.f,0.f,0.f,0.f,0.f,0.f,0.f};
#pragma unroll
        for (int ks = 0; ks < 4; ++ks) { const bf16x8 af = *(const LAS bf16x8*)(E1 + m * 72 + 16 * ks + 8 * hh), bfv = *(const LAS bf16x8*)(E2 + m * 72 + 16 * ks + 8 * hh); d = __builtin_amdgcn_mfma_f32_32x32x16_bf16(af, bfv, d, 0, 0, 0); }
#pragma unroll
        for (int r = 0; r < 16; ++r) { const int mr = crow(r, hh), nc = m; const int u = mr & 15, s = nc & 15; const bool keep = (nc < 16) ? (u < s) : (u <= s);
            M[mr * 33 + nc] = keep ? d[r] : 0.0f; }
    }
    __syncthreads();
    if (tid < 16) { float t[16];
#pragma unroll
        for (int s = 0; s < 16; ++s) { float acc = (tid == s) ? 1.0f : 0.0f;
#pragma unroll
            for (int u = 0; u < s; ++u) acc += t[u] * M[u * 33 + s];
            t[s] = acc; }
#pragma unroll
        for (int s = 0; s < 16; ++s) T[tid * 17 + s] = t[s]; }
    __syncthreads();
    {
        const int s = tt; float p0 = 0.f, p1 = 0.f;
#pragma unroll
        for (int u = 0; u < 16; ++u) { const float tv = T[u * 17 + s]; const f32x2 av = *(const LAS f32x2*)(ATF + u * 64 + j0); p0 += tv * av.x; p1 += tv * av.y; }
        *(LAS f32x2*)(PTF + s * 64 + j0) = (f32x2){p0, p1}; *(LAS unsigned*)(I_PT + s * 64 + j0) = pk2(p0, p1);
        if (tid < 256) { const int u = tid >> 4, sq = tid & 15; float q = 0.f;
#pragma unroll
            for (int x = 0; x < 16; ++x) q += M[(16 + u) * 33 + x] * T[x * 17 + sq];
            QF[u * 17 + sq] = q; I_QT[sq * 16 + u] = (bf16)f2bf(q); }
    }
    __syncthreads();
    {
        const int s = tt; const f32x2 rv = *(const LAS f32x2*)(RTF + s * 64 + j0); float p0 = rv.x, p1 = rv.y;
#pragma unroll
        for (int u = 0; u < 16; ++u) { const float mv = M[u * 33 + 16 + s]; const f32x2 pv = *(const LAS f32x2*)(PTF + u * 64 + j0); p0 += mv * pv.x; p1 += mv * pv.y; }
        *(LAS unsigned*)(I_PT + (16 + s) * 64 + j0) = pk2(p0, p1);
        if (tid < 256) { const int u = tid >> 4, sq = tid & 15; float q = M[(16 + u) * 33 + 16 + sq];
#pragma unroll
            for (int x = 0; x < 16; ++x) q += QF[u * 17 + x] * M[x * 33 + 16 + sq];
            I_QT[(16 + sq) * 16 + u] = (bf16)f2bf(q); }
    }
    __syncthreads();
    {
        const int nl = n - nbase;
        unsigned char* dst = F.ws + WS_IMG + ((size_t)chain * NBLK_H1 + nl) * IMG_BYTES;
        for (int q = tid; q < IMG_BYTES / 16; q += NTHR) *(v4u*)(dst + q * 16) = *(const LAS v4u*)(L + P_IMG + q * 16);
    }
    asm volatile("s_waitcnt lgkmcnt(0)\n\ts_barrier" ::: "memory");
    }
#undef PP_LOAD
}

constexpr int SL_PT = 0, SL_BK = 4352, SL_VT = SL_BK + 5120, SL_QT = SL_VT + 3072, SL_W16 = SL_QT + 1536, SL_BUF = SL_W16 + 256;
constexpr int SL_YL = 2 * SL_BUF, SL_END = SL_YL + 2 * 4096;
static_assert((SL_BUF % 16) == 0 && SL_END <= 131072, "scan lds map");

__device__ __forceinline__ void rwkv_scan(Frame& F, CArgs& A, int chain, int nlo, int nhi) {
    const int b = chain >> 3, h = chain & 7;
    const int tid = F.tid, lane = F.lane, wave = F.wave;
    LAS unsigned char* L = F.lds;
    const unsigned char* img0 = F.ws + WS_IMG + (size_t)chain * NBLK_H1 * IMG_BYTES;
    const int cnt = nhi - nlo;
#define S3_BAR() asm volatile("s_waitcnt lgkmcnt(0)\n\ts_barrier" ::: "memory")
    if (wave >= 2) {
        bf16* Y1 = (bf16*)(F.ws + R_Y1);
        const int ht = tid - 128;
        int lsrc[2], ldst[2]; bool lok[2];
#pragma unroll
        for (int i = 0; i < 2; ++i) { const int q = ht + 384 * i; lok[i] = q < IMG_BYTES / 16; lsrc[i] = lok[i] ? q * 16 : 0; int d;
            if (q < 256) d = SL_PT + (q >> 3) * 136 + (q & 7) * 16;
            else if (q < 512) d = SL_BK + ((q - 256) >> 2) * 80 + ((q - 256) & 3) * 16;
            else if (q < 640) d = SL_VT + ((q - 512) >> 1) * 48 + ((q - 512) & 1) * 16;
            else if (q < 704) d = SL_QT + ((q - 640) >> 1) * 48 + ((q - 640) & 1) * 16;
            else d = SL_W16 + (q - 704) * 16;
            ldst[i] = d; }
        const bool pw = wave < 6; const int pt = 4 * ((wave - 2) & 3) + (lane >> 4), pc = 4 * (lane & 15);
        const f32x4 c_lg = *(const f32x4*)(A.in[22] + 64 * h + pc), c_lb = *(const f32x4*)(A.in[23] + 64 * h + pc);
        const bf16* Gp = (const bf16*)(F.ws + WS_G) + 64 * h + pc; const float* RKp = (const float*)(F.ws + WS_RK) + h;
#define S3_LOAD(m, pf) do { const int mm_ = (m) < cnt ? (m) : cnt - 1; const unsigned char* ip_ = img0 + (size_t)mm_ * IMG_BYTES; pf[0] = *(const v4u*)(ip_ + lsrc[0]); pf[1] = *(const v4u*)(ip_ + lsrc[1]); } while (0)
#define S3_LAND(buf, pf) do { *(LAS v4u*)(L + (buf) * SL_BUF + ldst[0]) = pf[0]; if (lok[1]) *(LAS v4u*)(L + (buf) * SL_BUF + ldst[1]) = pf[1]; } while (0)
#define S3_PLOAD(m, gg, xv, rk) do { const int mm_ = (m) < cnt ? (m) : cnt - 1; const int nn_ = nlo + mm_; const size_t r0_ = nn_ == 0 ? (size_t)MR : (size_t)(b * SEQ + 16 * (nn_ - 1)); \
        const unsigned char* vt_ = img0 + (size_t)mm_ * IMG_BYTES + IMG_VT + pc * 32 + pt * 2; \
        gg = *(const v2u*)(Gp + (r0_ + pt) * 512); rk = RKp[(r0_ + pt) * 8]; \
        xv[0] = bf2f(*(const bf16*)(vt_)); xv[1] = bf2f(*(const bf16*)(vt_ + 32)); xv[2] = bf2f(*(const bf16*)(vt_ + 64)); xv[3] = bf2f(*(const bf16*)(vt_ + 96)); } while (0)
#define S3_HELP(m, pfN, ggC, xvC, rkC) do { \
        const int cb = (m) & 1; \
        if ((m) + 1 < cnt) S3_LAND(cb ^ 1, pfN); \
        S3_LOAD((m) + 3, pfN); \
        S3_BAR(); \
        if (pw) { const f32x4 y = *(const LAS f32x4*)(L + SL_YL + cb * 4096 + (pt * 64 + pc) * 4); \
          const int nn_ = nlo + (m); const int r0 = nn_ == 0 ? MR : b * SEQ + 16 * (nn_ - 1); \
          const float mean = sum16((y[0] + y[1]) + (y[2] + y[3])) * (1.0f / 64.0f); const f32x4 d = y - mean; \
          const float var = sum16((d[0] * d[0] + d[1] * d[1]) + (d[2] * d[2] + d[3] * d[3])) * (1.0f / 64.0f); const float rs = rsqrtf(var + 64e-5f); \
          const float g0 = bflo(ggC.x), g1 = bfhi(ggC.x), g2 = bflo(ggC.y), g3 = bfhi(ggC.y); \
          const float o0 = (d[0] * rs * c_lg[0] + c_lb[0] + rkC * xvC[0]) * g0, o1 = (d[1] * rs * c_lg[1] + c_lb[1] + rkC * xvC[1]) * g1, \
                      o2 = (d[2] * rs * c_lg[2] + c_lb[2] + rkC * xvC[2]) * g2, o3 = (d[3] * rs * c_lg[3] + c_lb[3] + rkC * xvC[3]) * g3; \
          if (nn_ > 0 || b == 0) { v2u ov; ov.x = pk2(o0, o1); ov.y = pk2(o2, o3); *(v2u*)(Y1 + (size_t)(r0 + pt) * DM + 512 + 64 * h + pc) = ov; } } \
        S3_PLOAD((m) + 2, ggC, xvC, rkC); \
    } while (0)
        v4u pfA[2], pfB[2]; v2u ggA, ggB; float xvA[4], xvB[4], rkA, rkB;
        S3_LOAD(0, pfA); S3_LAND(0, pfA); S3_LOAD(1, pfB); S3_LOAD(2, pfA);
        S3_PLOAD(0, ggA, xvA, rkA); S3_PLOAD(1, ggB, xvB, rkB);
        S3_BAR();
#pragma unroll 1
        for (int m = 0; m < cnt; m += 2) {
            S3_HELP(m, pfB, ggA, xvA, rkA);
            if (m + 1 < cnt) S3_HELP(m + 1, pfA, ggB, xvB, rkB);
        }
#undef S3_LOAD
#undef S3_LAND
#undef S3_PLOAD
#undef S3_HELP
    } else {
        const int it = wave, qi = lane & 31, hi = lane >> 5;
        f32x16 z0 = (f32x16){0.f,0.f,0.f,0.f,0.f,0.f,0.f,0.f,0.f,0.f,0.f,0.f,0.f,0.f,0.f,0.f}, z1 = z0;
        float* zs = (float*)(F.ws + WS_ZS) + ((size_t)(chain * 2 + it) * 2 * 64 + lane) * 16;
        if (nlo > 0) { z0 = *(const f32x16*)zs; z1 = *(const f32x16*)(zs + 64 * 16); }
        S3_BAR();
#define S3_PK(dst, zz, o) do { dst.x = pg8::cvt_pk_bf16(zz[o + 0], zz[o + 1]); dst.y = pg8::cvt_pk_bf16(zz[o + 2], zz[o + 3]); dst.z = pg8::cvt_pk_bf16(zz[o + 4], zz[o + 5]); dst.w = pg8::cvt_pk_bf16(zz[o + 6], zz[o + 7]); } while (0)
#pragma unroll 1
        for (int m = 0; m < cnt; ++m) {
            const int cb = m & 1;
            const LAS unsigned char* B_ = L + cb * SL_BUF;
            const bf16x8 vfr = *(const LAS bf16x8*)(B_ + SL_VT + (32 * it + qi) * 48 + hi * 16);
            const bf16x8 qf = *(const LAS bf16x8*)(B_ + SL_QT + qi * 48 + hi * 16);
            v4u aw[4];
#pragma unroll
            for (int ks = 0; ks < 4; ++ks) {
                const LAS unsigned char* pp = B_ + SL_PT + qi * 136 + (16 * ks + 4 * hi) * 2;
                const v2u lo = *(const LAS v2u*)pp, hh = *(const LAS v2u*)(pp + 16); aw[ks] = (v4u){lo.x, lo.y, hh.x, hh.y}; }
            v4u bw[2]; bf16x8 kf[2]; f32x4 wv[2][4];
            const LAS float* w16 = (const LAS float*)(B_ + SL_W16) + hi * 32;
#pragma unroll
            for (int jt = 0; jt < 2; ++jt) { const LAS unsigned char* bp = B_ + SL_BK + (32 * jt + qi) * 80;
                const v2u lo = *(const LAS v2u*)(bp + 8 * hi), hh = *(const LAS v2u*)(bp + 16 + 8 * hi); bw[jt] = (v4u){lo.x, lo.y, hh.x, hh.y};
                kf[jt] = *(const LAS bf16x8*)(bp + 32 + 16 * hi);
#pragma unroll
                for (int r4 = 0; r4 < 4; ++r4) wv[jt][r4] = *(const LAS f32x4*)(w16 + jt * 16 + 4 * r4); }
            __builtin_amdgcn_sched_barrier(0);
            v4u zb[4]; S3_PK(zb[0], z0, 0); S3_PK(zb[1], z0, 8); S3_PK(zb[2], z1, 0); S3_PK(zb[3], z1, 8);
            f32x16 acc = (f32x16){0.f,0.f,0.f,0.f,0.f,0.f,0.f,0.f,0.f,0.f,0.f,0.f,0.f,0.f,0.f,0.f};
            acc = __builtin_amdgcn_mfma_f32_32x32x16_bf16(qf, vfr, acc, 0, 0, 0);
#pragma unroll
            for (int ks = 0; ks < 4; ++ks) acc = __builtin_amdgcn_mfma_f32_32x32x16_bf16(__builtin_bit_cast(bf16x8, aw[ks]), __builtin_bit_cast(bf16x8, zb[ks]), acc, 0, 0, 0);
            f32x16 zn0, zn1;
#pragma unroll
            for (int r4 = 0; r4 < 4; ++r4)
#pragma unroll
                for (int e = 0; e < 4; ++e) { zn0[4 * r4 + e] = z0[4 * r4 + e] * wv[0][r4][e]; zn1[4 * r4 + e] = z1[4 * r4 + e] * wv[1][r4][e]; }
            { LAS float* YL = (LAS float*)(L + SL_YL + cb * 4096);
#pragma unroll
              for (int r = 8; r < 16; ++r) YL[(crow(r, hi) - 16) * 64 + 32 * it + qi] = acc[r]; }
            v4u sab; S3_PK(sab, acc, 0);
            zn0 = __builtin_amdgcn_mfma_f32_32x32x16_bf16(kf[0], vfr, zn0, 0, 0, 0);
            zn1 = __builtin_amdgcn_mfma_f32_32x32x16_bf16(kf[1], vfr, zn1, 0, 0, 0);
            zn0 = __builtin_amdgcn_mfma_f32_32x32x16_bf16(__builtin_bit_cast(bf16x8, bw[0]), __builtin_bit_cast(bf16x8, sab), zn0, 0, 0, 0);
            zn1 = __builtin_amdgcn_mfma_f32_32x32x16_bf16(__builtin_bit_cast(bf16x8, bw[1]), __builtin_bit_cast(bf16x8, sab), zn1, 0, 0, 0);
            z0 = zn0; z1 = zn1;
            S3_BAR();
        }
        if (nhi < NBLK) { *(f32x16*)zs = z0; *(f32x16*)(zs + 64 * 16) = z1; }
#undef S3_PK
    }
#undef S3_BAR
    __syncthreads();
}

__device__ __forceinline__ void final_phase(Frame& F, CArgs& A) {
    const float* part = (const float*)(F.ws + WS_PART); const float* gf = A.in[4]; float* out = F.out;
    const int gw = F.wg * NWAVES + F.wave, NGW = F.G * NWAVES, lane = F.lane;
    f32x4 gv[4];
#pragma unroll
    for (int j = 0; j < 4; ++j) gv[j] = *(const f32x4*)(gf + j * 256 + lane * 4);
    for (int row = gw; row < MR; row += NGW) {
        const float rs = pg8::row_rstd(part, row);
#pragma unroll
        for (int j = 0; j < 4; ++j) { f32x4* p = (f32x4*)(out + (size_t)row * DM + j * 256 + lane * 4); *p = (*p) * rs * gv[j]; }
    }
}


__device__ __forceinline__ void meta_res_gemm(Frame& F, const bf16* Aop, int lda, const bf16* Bop, int ldb, int K, float* hmeta, bf16* Abuf, float* part, int mode, int g) {
    const int lane = F.lane, wave = F.wave, nb = wave & 3, kh = wave >> 2, kq = 8 * (lane >> 4), r16 = lane & 15;
    const int khalf = K / 2, k0 = kh * khalf, nks = khalf / 32;
    const bf16* ap = Aop + (size_t)(MR + r16) * lda + k0 + kq;
    const bf16* bp = Bop + (size_t)(64 * g + 16 * nb + r16) * ldb + k0 + kq;
    pg8::f32x4 d = (pg8::f32x4){0.f, 0.f, 0.f, 0.f};
#pragma unroll 4
    for (int k = 0; k < nks; ++k) { const bf16x8 af = *(const bf16x8*)(ap + 32 * k); const bf16x8 bfv = *(const bf16x8*)(bp + 32 * k); d = __builtin_amdgcn_mfma_f32_16x16x32_bf16(af, bfv, d, 0, 0, 0); }
    LAS float* red = (LAS float*)F.lds;
    if (kh == 1) *(LAS pg8::f32x4*)(red + (nb * 64 + lane) * 4) = d;
    __syncthreads();
    if (kh == 0) {
        const pg8::f32x4 o = *(const LAS pg8::f32x4*)(red + (nb * 64 + lane) * 4); d += o;
        const int col = 64 * g + 16 * nb + r16;
#pragma unroll
        for (int r = 0; r < 4; ++r) { const int row = 4 * (lane >> 4) + r; float h = hmeta[(size_t)row * DM + col] + d[r]; hmeta[(size_t)row * DM + col] = h; d[r] = h;
            if (mode) Abuf[(size_t)(MR + row) * DM + col] = (bf16)f2bf(h); }
    }
    __syncthreads();
    if (mode) {
        if (kh == 0) {
#pragma unroll
            for (int r = 0; r < 4; ++r) { const float ss = sum16(d[r] * d[r]); if (r16 == 0) red[(4 * (lane >> 4) + r) * 4 + nb] = ss; }
        }
        __syncthreads();
        if (F.tid < 16) { const pg8::f32x4 v = *(const LAS pg8::f32x4*)(red + F.tid * 4); part[(size_t)(MR + F.tid) * 16 + g] = (v[0] + v[1]) + (v[2] + v[3]); }
        __syncthreads();
    }
}

#ifdef NO_ATTN
#define ATTN_UNIT(b, k, q) do { } while (0)
#else
#define ATTN_UNIT(b, k, q) attn_unit(F, A.in[12], (b), (k), (q))
#endif
constexpr int N_PHASES = 17;
#ifndef RES_SP2
#define RES_SP2 false
#endif
#ifndef DBGLAST
#define DBGLAST 6
#endif
#ifndef DBG15
#define DBG15 3
#endif
#ifndef DBG_NPH
#define DBG_NPH 18
#endif
__global__ void __launch_bounds__(NTHR, 2) hyb_fwd(Args args) {
    extern __shared__ __attribute__((aligned(16))) unsigned char lds[];
    const int lo = args.ph_lo, hi = args.ph_hi;
#if MK_N_LAUNCHES == 1
    {
        for (int u = threadIdx.x; u < (LDS_BYTES - LDSCTL_OFF) / 4; u += NTHR) ((LAS unsigned*)((LAS unsigned char*)lds + LDSCTL_OFF))[u] = 0u;
        __syncthreads();
        if (threadIdx.x == 0) (void)xb_add(&((unsigned*)(args.ws + WS_CTL))[1024 + XB_XCNT(xb_xcc_id())], 1u);
    }
#endif
    const int wave_s = __builtin_amdgcn_readfirstlane(threadIdx.x >> 6);
#ifndef PROBE_MASK
#define PROBE_MASK 0u
#endif
#pragma unroll 1
    for (int pq = 2 * lo; pq < 2 * hi; ++pq) {
        const int p = pq >> 1; if ((pq & 1) && !((PROBE_MASK >> p) & 1u)) continue;
#define PHF() CArgs* ap_ = (CArgs*)__builtin_amdgcn_kernarg_segment_ptr(); asm volatile("" : "+s"(ap_)); CArgs& A = *ap_; \
        unsigned z_; asm volatile("s_mov_b32 %0, 0" : "=s"(z_)); \
        Frame F; F.tid = (wave_s << 6) | (int)__builtin_amdgcn_mbcnt_hi(~0u, __builtin_amdgcn_mbcnt_lo(~0u, z_)); asm volatile("" : "+v"(F.tid)); \
        F.lds = (LAS unsigned char*)lds; F.lane = F.tid & 63; F.wave = __builtin_amdgcn_readfirstlane(F.tid >> 6); F.G = gridDim.x; F.wg = blockIdx.x; F.out = A.out; F.ws = A.ws; \
        unsigned char* ws = A.ws; float* part = (float*)(ws + WS_PART); float* hmeta = (float*)(ws + WS_HMETA); pg8::bf16_t* Abuf = (pg8::bf16_t*)(ws + WS_A); (void)part; (void)hmeta; (void)Abuf
        int kind, layer = 0, ch = 0, sub = 2;
        switch (p) {
            case 0: kind = 0; break; case 1: kind = 1; break; case 2: kind = 2; break; case 3: kind = 3; sub = 0; break;
            case 4: kind = 4; break; case 5: kind = 5; break; case 6: kind = 3; break;
            case 7: kind = 6; break; case 8: kind = 7; break; case 9: kind = 9; break; case 10: kind = 7; ch = 1; break; case 11: kind = 9; ch = 1; break;
            case 12: kind = 3; sub = 1; break;
            case 13: kind = 4; layer = 1; break; case 14: kind = 5; layer = 1; break; case 15: kind = 3; layer = 1; break;
            default: kind = 8; break;
        }
        if (kind == 0) { PHF(); p0_prologue(F, A); }
        else if (kind == 1) { PHF(); pg8::Gemm g{Abuf, (const pg8::bf16_t*)(ws + W_IN0), MP, NIN, DM, DM, DM}; pg8::StaticOrder S; S.init(MP, NIN, F.G, F.wg);
            pg8::EpiIn0 E{(pg8::bf16_t*)(ws + R_U), (pg8::bf16_t*)(ws + R_WC), (pg8::bf16_t*)(ws + R_GB), part};
            pg8::gemm_phase<pg8::EpiIn0, pg8::StaticOrder, true, true, DM, DM, DM>(F.lds, g, S, E, F.tid); }
        else if (kind == 2) { PHF(); conv0_phase(F, A); }
        else if (kind == 3) { PHF();
            const bool o0 = (sub == 0), o1 = (sub == 1), od = (sub == 2);
            const pg8::bf16_t* Aop = (const pg8::bf16_t*)(ws + (o0 ? R_Y0 : o1 ? R_Y1 : R_HM));
            const pg8::bf16_t* Bop = (const pg8::bf16_t*)(ws + (o0 ? W_OUT0 : o1 ? W_OUT1 : (layer ? W_DN1 : W_DN0)));
            const int Kd = od ? DFF : DM, ldbd = od ? DFF : DM;
            const float* base = o0 ? A.in[0] : (const float*)A.out;
            const pg8::Gemm g{Aop, Bop, MP, DM, Kd, Kd, ldbd};
            pg8::StaticOrder S; S.init(MR, DM, F.G, F.wg);
            pg8::EpiRes E{base, A.out, hmeta, Abuf, part, 1};
            if (od) pg8::gemm_phase<pg8::EpiRes, pg8::StaticOrder, true, RES_SP2, DFF, DFF, DFF>(F.lds, g, S, E, F.tid);
            else pg8::gemm_phase<pg8::EpiRes, pg8::StaticOrder, true, RES_SP2, DM, DM, DM>(F.lds, g, S, E, F.tid);
            if (blockIdx.x < 16) {
                CArgs* am_ = (CArgs*)__builtin_amdgcn_kernarg_segment_ptr(); asm volatile("" : "+s"(am_)); unsigned char* wsm = am_->ws;
                unsigned zm_; asm volatile("s_mov_b32 %0, 0" : "=s"(zm_));
                Frame Fm; Fm.tid = (wave_s << 6) | (int)__builtin_amdgcn_mbcnt_hi(~0u, __builtin_amdgcn_mbcnt_lo(~0u, zm_)); asm volatile("" : "+v"(Fm.tid));
                Fm.lds = (LAS unsigned char*)lds; Fm.lane = Fm.tid & 63; Fm.wave = __builtin_amdgcn_readfirstlane(Fm.tid >> 6); Fm.G = gridDim.x; Fm.wg = blockIdx.x; Fm.out = nullptr; Fm.ws = wsm;
                const bf16* Am = (const bf16*)(wsm + (o0 ? R_Y0 : o1 ? R_Y1 : R_HM));
                const bf16* Bm = (const bf16*)(wsm + (o0 ? W_OUT0 : o1 ? W_OUT1 : (layer ? W_DN1 : W_DN0)));
                meta_res_gemm(Fm, Am, od ? DFF : DM, Bm, od ? DFF : DM, od ? DFF : DM, (float*)(wsm + WS_HMETA), (bf16*)(wsm + WS_A), (float*)(wsm + WS_PART), 1, (int)blockIdx.x);
            } }
        else if (kind == 4) { PHF(); pg8::Gemm g{Abuf, (const pg8::bf16_t*)(ws + (layer ? W_UP1 : W_UP0)), MP, 2 * DFF, DM, DM, DM}; pg8::StaticOrder S; S.init(MP, 2 * DFF, F.G, F.wg);
            pg8::EpiUpConv E{ws, A.in[26] + (size_t)layer * 3 * DFF, A.in[27] + (size_t)layer * DFF};
            pg8::gemm_phase<pg8::EpiUpConv, pg8::StaticOrder, true, true, DM, DM, DM>(F.lds, g, S, E, F.tid); }
        else if (kind == 5) { PHF(); ffn_fix_phase(F, A, layer); }
        else if (kind == 6) { PHF(); pg8::Gemm g{Abuf, (const pg8::bf16_t*)(ws + W_IN1), MP, NIN, DM, DM, DM}; pg8::StaticOrder S; S.init(MP, NIN, F.G, F.wg);
            pg8::EpiIn1 E{(pg8::bf16_t*)(ws + R_Q), (pg8::bf16_t*)(ws + R_KB), (pg8::bf16_t*)(ws + R_VB), (pg8::bf16_t*)(ws + R_PR), part, (const float*)(ws + WS_ROPE), (const float*)(ws + WS_ROPE) + TT * 32};
            pg8::gemm_phase<pg8::EpiIn1, pg8::StaticOrder, true, true, DM, DM, DM>(F.lds, g, S, E, F.tid); }
        else if (kind == 7) { PHF();
            const int cnt = ch == 0 ? NBLK_H1 : NBLK - NBLK_H1, nbase = ch == 0 ? 0 : NBLK_H1;
            rwkv_prep_phase(F, A, nbase, cnt);
        }
        else if (kind == 9) { PHF();
            const int NCH = 64;
            if (F.G > NCH && F.wg < NCH) rwkv_scan(F, A, F.wg, ch == 0 ? 0 : NBLK_H1, ch == 0 ? NBLK_H1 : NBLK);
            else {
                if (F.G <= NCH) for (int c = F.wg; c < NCH; c += F.G) rwkv_scan(F, A, c, ch == 0 ? 0 : NBLK_H1, ch == 0 ? NBLK_H1 : NBLK);
                if (ch == 0) { const int NAW = F.G > NCH ? F.G - NCH : F.G, aw = F.G > NCH ? F.wg - NCH : F.wg;
                    for (int id = aw; id < 514; id += NAW) { if (id < 512) ATTN_UNIT(id >> 6, (id >> 5) & 1, id & 31); else ATTN_UNIT(0, id - 512, -1); } }
            }
        }
        else if (kind == 8) { PHF(); final_phase(F, A); }
#if MK_N_LAUNCHES == 1
        if (pq + 1 < 2 * hi) {
            if (hi > 1000) cg::this_grid().sync();
            CArgs* ab_ = (CArgs*)__builtin_amdgcn_kernarg_segment_ptr(); asm volatile("" : "+s"(ab_));
            unsigned zb_; asm volatile("s_mov_b32 %0, 0" : "=s"(zb_));
            const bool t0 = (wave_s == 0) && (__builtin_amdgcn_mbcnt_hi(~0u, __builtin_amdgcn_mbcnt_lo(~0u, zb_)) == 0u);
            xcd_barrier((unsigned*)(ab_->ws + WS_CTL) + 1024, (volatile LAS unsigned*)((LAS unsigned char*)lds + MISC_OFF) + 8, t0);
        }
#endif
    }
}

extern "C" void kernel_launch(void* const* d_in, const int* in_sizes, int n_in, void* d_out, int out_size, void* d_ws, size_t ws_size, hipStream_t stream) {
    static int grid = 0;
    if (grid == 0) {
        if (n_in != 29 || out_size != MR * DM || ws_size < WS_END) { fprintf(stderr, "kernel_launch: unexpected shapes (n_in %d out %d ws %zu)\n", n_in, out_size, ws_size); grid = -1; return; }
        int dev = 0, cus = 0, per_cu = 0;
        if (hipGetDevice(&dev) != hipSuccess || hipDeviceGetAttribute(&cus, hipDeviceAttributeMultiprocessorCount, dev) != hipSuccess) { grid = -1; return; }
        if (hipFuncSetAttribute((const void*)hyb_fwd, hipFuncAttributeMaxDynamicSharedMemorySize, LDS_BYTES) != hipSuccess) { fprintf(stderr, "kernel_launch: hipFuncSetAttribute failed\n"); grid = -1; return; }
        if (hipOccupancyMaxActiveBlocksPerMultiprocessor(&per_cu, (const void*)hyb_fwd, NTHR, LDS_BYTES) != hipSuccess || per_cu < 1) { fprintf(stderr, "kernel_launch: occupancy query says %d\n", per_cu); per_cu = 1; }
        (void)hipGetLastError();
        grid = cus;
    }
    if (grid < 0) return;
    Args a{};
    for (int i = 0; i < 29; ++i) a.in[i] = (const float*)d_in[i];
    a.out = (float*)d_out; a.ws = (unsigned char*)d_ws;
#if MK_N_LAUNCHES == 1
    if (hipMemsetAsync((char*)d_ws + WS_CTL, 0, 65536, stream) != hipSuccess) { fprintf(stderr, "kernel_launch: memset failed\n"); return; }
    a.ph_lo = 0; a.ph_hi = N_PHASES;
    void* kargs[] = {&a};
    hipError_t e = hipLaunchCooperativeKernel((const void*)hyb_fwd, dim3(grid), dim3(NTHR), kargs, LDS_BYTES, stream);
    if (e != hipSuccess) fprintf(stderr, "cooperative launch failed: %s (grid %d)\n", hipGetErrorString(e), grid);
#else
    for (int p = 0; p < N_PHASES; ++p) { a.ph_lo = p; a.ph_hi = p + 1; hipLaunchKernelGGL(hyb_fwd, dim3(grid), dim3(NTHR), LDS_BYTES, stream, a); }
#endif
}
```

```cpp
#include <hip/hip_runtime.h>
#include <hip/hip_cooperative_groups.h>
#include <cstdio>
#include <cstdint>
namespace cg = cooperative_groups;

#ifndef MK_N_LAUNCHES
#define MK_N_LAUNCHES 1
#endif

constexpr int NB = 8, SEQ = 2048, NMETA = 16, TT = SEQ + NMETA, DM = 1024;
constexpr int MR = NB * SEQ;
constexpr int MP = MR + 256;
constexpr int DFF = 2816, FCH = 1408;
constexpr int NIN = 2560;
constexpr int PRW = 1792;

constexpr size_t EO_PART = (size_t)1 << 20, EO_HM = (size_t)89 << 20, EO_EDGE_G = EO_HM + (size_t)MP * DFF * 2, EO_EDGE_V = EO_EDGE_G + (size_t)65 * 2 * DFF * 4, EO_HALO = EO_EDGE_V + (size_t)65 * 2 * DFF * 4;
namespace pg8 {
#define PG8_LAS __attribute__((address_space(3)))
typedef unsigned short bf16_t;
typedef short bf16x8 __attribute__((ext_vector_type(8)));
typedef float f32x4 __attribute__((ext_vector_type(4)));
typedef unsigned u32x4 __attribute__((ext_vector_type(4)));
constexpr int BM = 256, BK = 64, HALF = 128, HTB = HALF * BK * 2  , STAGE_BYTES = 8 * HTB, NXCD = 8, WGM = 8;

__host__ __device__ __forceinline__ int lds_byte(int r, int c) { const int st = (r >> 4) * 2 + (c >> 5), rr = r & 15, cc = c & 31, ob = rr * 64 + cc * 2; return st * 1024 + (ob ^ (((ob >> 9) & 1) << 5)); }
__host__ __device__ __forceinline__ void stage_rc(int b, int& R, int& C) { const int st = b / 1024, sb = b % 1024, swz = sb ^ (((sb >> 9) & 1) << 5); R = (st >> 1) * 16 + swz / 64; C = (st & 1) * 32 + (swz % 64) / 2; }
__host__ __device__ __forceinline__ int perm32(int rho) { const int n = rho >> 4, i = rho & 15; return 8 * (i >> 2) + 4 * n + (i & 3); }

struct Unit { int pm, pn; };
struct Gemm { const bf16_t* A; const bf16_t* Bt; int M, N, K, lda, ldb; };

struct StaticOrder {
    int nM, nN, nwg, G, c;
    __host__ __device__ void init(int M, int N, int G_, int c_) { nM = M / BM; nN = N / BM; nwg = nM * nN; G = G_; c = c_; }
    __host__ __device__ bool next(int i, Unit& u) const {
        const long L = (long)i * G + c; if (L >= nwg) return false;
        int wgid = (int)L; { const int q = nwg / NXCD, r = nwg % NXCD, xcd = wgid % NXCD, off = wgid / NXCD; wgid = (xcd < r ? xcd * (q + 1) : r * (q + 1) + (xcd - r) * q) + off; }
        const int nig = WGM * nN, gid = wgid / nig, fm = gid * WGM, gsz = (nM - fm) < WGM ? (nM - fm) : WGM;
        u.pm = fm + ((wgid % nig) % gsz); u.pn = (wgid % nig) / gsz; return true;
    }
    __device__ __forceinline__ void a_ready(const Unit&) const {}
    __device__ __forceinline__ void done(const Unit&) const {}
};

__device__ __forceinline__ unsigned cvt_pk_bf16(float lo, float hi) { unsigned r; asm volatile("v_cvt_pk_bf16_f32 %0, %1, %2" : "=v"(r) : "v"(lo), "v"(hi)); return r; }
__device__ __forceinline__ u32x4 pack8(const f32x4 a, const f32x4 b) { u32x4 w; w.x = cvt_pk_bf16(a[0], a[1]); w.y = cvt_pk_bf16(a[2], a[3]); w.z = cvt_pk_bf16(b[0], b[1]); w.w = cvt_pk_bf16(b[2], b[3]); return w; }
__device__ __forceinline__ float sigmoidf_(float x) { return __builtin_amdgcn_rcpf(1.0f + __expf(-x)); }
__device__ __forceinline__ f32x4 sig4(const f32x4 x) { return (f32x4){sigmoidf_(x[0]), sigmoidf_(x[1]), sigmoidf_(x[2]), sigmoidf_(x[3])}; }
__device__ __forceinline__ float row_rstd(const float* part, int row) {
    const f32x4* p = (const f32x4*)(part + (size_t)row * 16); const f32x4 a = p[0], b = p[1], c = p[2], d = p[3];
    const float s = ((a[0] + a[1]) + (a[2] + a[3])) + ((b[0] + b[1]) + (b[2] + b[3])) + ((c[0] + c[1]) + (c[2] + c[3])) + ((d[0] + d[1]) + (d[2] + d[3]));
    return rsqrtf(s * (1.0f / 1024.0f) + 1e-6f);
}
__device__ __forceinline__ int tpos_of_row(int row) { return row < MR ? (NMETA + (row & (SEQ - 1))) : (row < MR + NMETA ? row - MR : 0); }

struct EpiIn0 {
    static constexpr bool PERM = true, AFTER_DRAIN = false;
    bf16_t* U; bf16_t* WC; bf16_t* GB; const float* part;
    __device__ __forceinline__ void operator()(const f32x4 (&acc)[2][2][4][2], const Unit& u, int wr, int wc, int fr, int fq) const {
        const int row0 = u.pm * BM + wr * 64 + fr;
#pragma unroll
        for (int ai = 0; ai < 2; ++ai)
#pragma unroll
            for (int m = 0; m < 4; ++m) {
                const int row = row0 + ai * HALF + m * 16; const float rs = row_rstd(part, row);
                if (u.pn < 8) {
                    bf16_t* dst = (u.pn < 4 ? U : WC) + (size_t)row * 512 + (u.pn & 3) * 128 + wc * 32 + 8 * fq;
                    const f32x4 a0 = acc[ai][0][m][0] * rs, a1 = acc[ai][0][m][1] * rs, b0 = acc[ai][1][m][0] * rs, b1 = acc[ai][1][m][1] * rs;
                    f32x4 o0, o1;
                    if (u.pn < 4) { o0 = a0 * sig4(b0); o1 = a1 * sig4(b1); } else { o0 = a0 * b0; o1 = a1 * b1; }
                    *(u32x4*)dst = pack8(o0, o1);
                } else {
#pragma unroll
                    for (int bj = 0; bj < 2; ++bj) { bf16_t* dst = GB + (size_t)row * 512 + (u.pn - 8) * 256 + bj * HALF + wc * 32 + 8 * fq;
                        *(u32x4*)dst = pack8(acc[ai][bj][m][0] * rs, acc[ai][bj][m][1] * rs); }
                }
            }
    }
};
struct EpiRes {
    static constexpr bool PERM = true, AFTER_DRAIN = false;
    const float* base; float* out; float* hmeta; bf16_t* Abuf; float* part; int mode; int in_nat, out_nat;
    __device__ __forceinline__ void operator()(const f32x4 (&acc)[2][2][4][2], const Unit& u, int wr, int wc, int fr, int fq) const {
        const size_t tb = (size_t)(u.pm * 4 + u.pn) * 65536; const int wl = ((wr * 4 + wc) * 64 + fq * 16 + fr) * 8;
#pragma unroll
        for (int ai = 0; ai < 2; ++ai)
#pragma unroll
            for (int m = 0; m < 4; ++m) {
                const int lr = wr * 64 + fr + ai * HALF + m * 16, row = u.pm * BM + lr; float ss = 0.f;
#pragma unroll
                for (int bj = 0; bj < 2; ++bj) { const int col = u.pn * BM + bj * HALF + wc * 32 + 8 * fq;
                    const size_t nat = (size_t)row * DM + col, blk = tb + (size_t)(((ai * 4 + m) * 2 + bj) * 4096) + wl;
                    const float* ip = base + (in_nat ? nat : blk); float* op = out + (out_nat ? nat : blk);
                    f32x4 h0 = *(const f32x4*)ip, h1 = *(const f32x4*)(ip + 4);
                    h0 += acc[ai][bj][m][0]; h1 += acc[ai][bj][m][1];
                    *(f32x4*)op = h0; *(f32x4*)(op + 4) = h1;
                    if (mode) { ss += (h0[0] * h0[0] + h0[1] * h0[1]) + (h0[2] * h0[2] + h0[3] * h0[3]) + (h1[0] * h1[0] + h1[1] * h1[1]) + (h1[2] * h1[2] + h1[3] * h1[3]);
                        *(u32x4*)(Abuf + (size_t)row * DM + col) = pack8(h0, h1); } }
                if (mode) { ss += __shfl_xor(ss, 16); ss += __shfl_xor(ss, 32); if (fq == 0) part[(size_t)row * 16 + u.pn * 4 + wc] = ss; }
            }
    }
};
__device__ __forceinline__ float dpp_ror1(float x) { return __builtin_bit_cast(float, __builtin_amdgcn_update_dpp(0, __builtin_bit_cast(int, x), 0x121, 0xF, 0xF, false)); }
__device__ __forceinline__ float dpp_ror2(float x) { return __builtin_bit_cast(float, __builtin_amdgcn_update_dpp(0, __builtin_bit_cast(int, x), 0x122, 0xF, 0xF, false)); }
__device__ __forceinline__ f32x4 ror1_4(const f32x4 v) { return (f32x4){dpp_ror1(v[0]), dpp_ror1(v[1]), dpp_ror1(v[2]), dpp_ror1(v[3])}; }
__device__ __forceinline__ f32x4 ror2_4(const f32x4 v) { return (f32x4){dpp_ror2(v[0]), dpp_ror2(v[1]), dpp_ror2(v[2]), dpp_ror2(v[3])}; }
__device__ __forceinline__ f32x4 silu4(const f32x4 z) { return z * sig4(z); }
struct EpiUpConv {
    static constexpr bool PERM = true, AFTER_DRAIN = false;
    unsigned char* ws; const float* cw; const float* cb;
    __device__ __forceinline__ void operator()(const f32x4 (&acc)[2][2][4][2], const Unit& u, int wr, int wc, int fr, int fq) const {
        bf16_t* HM = (bf16_t*)(ws + EO_HM); float* EDGE_G = (float*)(ws + EO_EDGE_G); float* EDGE_V = (float*)(ws + EO_EDGE_V); float* HALO = (float*)(ws + EO_HALO); const float* part = (const float*)(ws + EO_PART);
        const int c0 = u.pn * 128 + wc * 32 + 8 * fq, row0 = u.pm * BM + wr * 64 + fr;
        PG8_LAS f32x4* X = (PG8_LAS f32x4*)131072;
        if (fr >= 14) {
#pragma unroll
            for (int ai = 0; ai < 2; ++ai) { const float rs = row_rstd(part, row0 + ai * HALF + 48); const int sidx = ((((2 * ai + wr) * 2 + (fr - 14)) * 4 + wc) * 4 + fq) * 2; X[sidx] = acc[ai][0][3][0] * rs; X[sidx + 1] = acc[ai][0][3][1] * rs;
                if (ai == 1 && u.pm < 64 && wr == 1) { float* hp = HALO + ((size_t)(u.pm * 2 + (fr - 14))) * 2816 + c0; *(f32x4*)hp = acc[1][0][3][0] * rs; *(f32x4*)(hp + 4) = acc[1][0][3][1] * rs; } }
            if (u.pm == 64 && wr == 0) { const float rs = row_rstd(part, row0); float* hp = HALO + ((size_t)(64 * 2 + (fr - 14))) * 2816 + c0; *(f32x4*)hp = acc[0][0][0][0] * rs; *(f32x4*)(hp + 4) = acc[0][0][0][1] * rs; }
        }
        asm volatile("s_waitcnt lgkmcnt(0)\n\ts_barrier" ::: "memory");
        const f32x4 w0a = *(const f32x4*)(cw + c0), w0b = *(const f32x4*)(cw + c0 + 4), w1a = *(const f32x4*)(cw + 2816 + c0), w1b = *(const f32x4*)(cw + 2816 + c0 + 4),
                    w2a = *(const f32x4*)(cw + 5632 + c0), w2b = *(const f32x4*)(cw + 5632 + c0 + 4), bba = *(const f32x4*)(cb + c0), bbb = *(const f32x4*)(cb + c0 + 4);
#pragma unroll
        for (int ai = 0; ai < 2; ++ai) {
            const int sg = 2 * ai + wr;
            f32x4 x15a = (f32x4){0.f, 0.f, 0.f, 0.f}, x15b = x15a, x14a = x15a, x14b = x15a;
            if (sg > 0 && fr < 2) { const int b15 = ((((sg - 1) * 2 + 1) * 4 + wc) * 4 + fq) * 2, b14 = ((((sg - 1) * 2 + 0) * 4 + wc) * 4 + fq) * 2; x15a = X[b15]; x15b = X[b15 + 1]; x14a = X[b14]; x14b = X[b14 + 1]; }
            f32x4 q1a = x15a, q1b = x15b, q2a = x14a, q2b = x14b;
#pragma unroll
            for (int m = 0; m < 4; ++m) {
                const int row = row0 + ai * HALF + m * 16; const float rs = row_rstd(part, row);
                const f32x4 ga = acc[ai][0][m][0] * rs, gb = acc[ai][0][m][1] * rs;
                const f32x4 r1a = ror1_4(ga), r1b = ror1_4(gb), r2a = ror2_4(ga), r2b = ror2_4(gb);
                f32x4 p1a = r1a, p1b = r1b, p2a = r2a, p2b = r2b;
                if (m > 0) { if (fr < 1) { p1a = q1a; p1b = q1b; } if (fr < 2) { p2a = q2a; p2b = q2b; } }
                else { if (fr == 0) { p1a = x15a; p1b = x15b; p2a = x14a; p2b = x14b; } else if (fr == 1) { p2a = x15a; p2b = x15b; } }
                q1a = r1a; q1b = r1b; q2a = r2a; q2b = r2b;
                const f32x4 va = acc[ai][1][m][0] * rs, vb = acc[ai][1][m][1] * rs;
                if (sg == 0 && m == 0 && fr < 2) {
                    float* eg = EDGE_G + ((size_t)(u.pm * 2 + fr)) * 2816 + c0; float* ev = EDGE_V + ((size_t)(u.pm * 2 + fr)) * 2816 + c0;
                    *(f32x4*)eg = ga; *(f32x4*)(eg + 4) = gb; *(f32x4*)ev = va; *(f32x4*)(ev + 4) = vb;
                } else {
                    const f32x4 za = w0a * p2a + w1a * p1a + w2a * ga + bba, zb = w0b * p2b + w1b * p1b + w2b * gb + bbb;
                    *(u32x4*)(HM + (size_t)row * 2816 + c0) = pack8(silu4(za) * va, silu4(zb) * vb);
                }
                asm volatile("" ::: "memory");
            }
        }
    }
};
struct EpiIn1 {
    static constexpr bool PERM = true, AFTER_DRAIN = false;
    bf16_t* Q; bf16_t* KB; bf16_t* VB; bf16_t* PR; const float* part; const float* ropec; const float* ropes;
    __device__ __forceinline__ void operator()(const f32x4 (&acc)[2][2][4][2], const Unit& u, int wr, int wc, int fr, int fq) const {
        const int row0 = u.pm * BM + wr * 64 + fr;
#pragma unroll
        for (int ai = 0; ai < 2; ++ai)
#pragma unroll
            for (int m = 0; m < 4; ++m) {
                const int row = row0 + ai * HALF + m * 16; const float rs = row_rstd(part, row);
                if (u.pn >= 3) {
#pragma unroll
                    for (int bj = 0; bj < 2; ++bj) *(u32x4*)(PR + (size_t)row * PRW + (u.pn - 3) * 256 + bj * HALF + wc * 32 + 8 * fq) = pack8(acc[ai][bj][m][0] * rs, acc[ai][bj][m][1] * rs);
                } else {
                    const f32x4 a0 = acc[ai][0][m][0] * rs, a1 = acc[ai][0][m][1] * rs, b0 = acc[ai][1][m][0] * rs, b1 = acc[ai][1][m][1] * rs;
                    if (u.pn == 2 && wc >= 2) {
                        bf16_t* dst = VB + (size_t)row * 128 + (wc - 2) * 64 + 8 * fq;
                        *(u32x4*)dst = pack8(a0, a1); *(u32x4*)(dst + 32) = pack8(b0, b1);
                    } else {
                        const int t = tpos_of_row(row);
                        const f32x4 c0 = *(const f32x4*)(ropec + t * 32 + 8 * fq), c1 = *(const f32x4*)(ropec + t * 32 + 8 * fq + 4);
                        const f32x4 s0 = *(const f32x4*)(ropes + t * 32 + 8 * fq), s1 = *(const f32x4*)(ropes + t * 32 + 8 * fq + 4);
                        const f32x4 x0 = a0 * c0 - b0 * s0, x1 = a1 * c1 - b1 * s1, y0 = b0 * c0 + a0 * s0, y1 = b1 * c1 + a1 * s1;
                        bf16_t* dst = (u.pn == 2) ? KB + (size_t)row * 128 + wc * 64 + 8 * fq : Q + (size_t)row * 512 + (u.pn * 4 + wc) * 64 + 8 * fq;
                        *(u32x4*)dst = pack8(x0, x1); *(u32x4*)(dst + 32) = pack8(y0, y1);
                    }
                }
            }
    }
};

template <class Epi, class Sched, bool ALIGN_EPI = false, bool SP2 = false, int CK = 0, int CLDA = 0, int CLDB = 0>
__device__ __forceinline__ void gemm_phase(PG8_LAS unsigned char* lds, const Gemm g, const Sched& S, const Epi& E, const int tid_in) {
    int tid_ = tid_in; asm volatile("" : "+v"(tid_));
    const int tid = tid_, wid = __builtin_amdgcn_readfirstlane(tid >> 6), lane = tid & 63, wr = wid >> 2, wc = wid & 3, fr = lane & 15, fq = lane >> 4;
    const int K = CK ? CK : g.K, nt = K / BK; const int lda_ = CLDA ? CLDA : g.lda, ldb_ = CLDB ? CLDB : g.ldb;
    unsigned voffA[2], voffB[2];
#pragma unroll
    for (int i = 0; i < 2; ++i) { int R, C; stage_rc(tid * 16 + i * 8192, R, C); const int Rb = Epi::PERM ? ((R & ~31) + perm32(R & 31)) : R;
        voffA[i] = (unsigned)(R * lda_ + C) * 2u; voffB[i] = (unsigned)(Rb * ldb_ + C) * 2u; }
    const size_t kstep = (size_t)(BK * 2);
    const size_t hstepA = (size_t)HALF * lda_ * 2, hstepB = (size_t)HALF * ldb_ * 2;
    const size_t tstepA = 2 * hstepA, tstepB = 2 * hstepB;
    const unsigned ldsw = (unsigned)wid * 1024u;
    const int aoff = lds_byte(wr * 64 + fr, fq * 8), boff = lds_byte(wc * 32 + fr, fq * 8);
#define PG8_SA(b, h) (((b) * 2 + (h)) * HTB)
#define PG8_SB(b, h) ((4 + (b) * 2 + (h)) * HTB)
#define PG8_STAGE(bufoff, gbase, voff) do { _Pragma("unroll") for (int _i = 0; _i < 2; ++_i) \
        __builtin_amdgcn_global_load_lds((const unsigned*)((const char*)(gbase) + (voff)[_i]), (PG8_LAS unsigned*)(lds + (bufoff) + ldsw + _i * 8192), 16, 0, 0); } while (0)
#define PG8_LDA(dst, b, h) do { _Pragma("unroll") for (int m = 0; m < 4; ++m) _Pragma("unroll") for (int k = 0; k < 2; ++k) dst[m][k] = *(const PG8_LAS bf16x8*)(lds + PG8_SA(b, h) + aoff + m * 2048 + k * 1024); } while (0)
#define PG8_LDB(dst, b, h) do { _Pragma("unroll") for (int n = 0; n < 2; ++n) _Pragma("unroll") for (int k = 0; k < 2; ++k) dst[n][k] = *(const PG8_LAS bf16x8*)(lds + PG8_SB(b, h) + boff + n * 2048 + k * 1024); } while (0)
#define PG8_MMA(ai, bj, At, Bt) do { __builtin_amdgcn_s_setprio(1); _Pragma("unroll") for (int m = 0; m < 4; ++m) _Pragma("unroll") for (int n = 0; n < 2; ++n) _Pragma("unroll") for (int k = 0; k < 2; ++k) \
        acc[ai][bj][m][n] = __builtin_amdgcn_mfma_f32_16x16x32_bf16(Bt[n][k], At[m][k], acc[ai][bj][m][n], 0, 0, 0); __builtin_amdgcn_s_setprio(0); } while (0)
#define PG8_WAIT_V(n) asm volatile("s_waitcnt vmcnt(" #n ")" ::: "memory")
#define PG8_WAIT_L(n) asm volatile("s_waitcnt lgkmcnt(" #n ")" ::: "memory")
#define PG8_BAR __builtin_amdgcn_s_barrier()
#define PG8_SCHED __builtin_amdgcn_sched_barrier(0)
    Unit cur, nxt; int ui = 0;
    if (!S.next(0, cur)) return;
    f32x4 acc[2][2][4][2];
#pragma unroll
    for (int a = 0; a < 2; ++a)
#pragma unroll
        for (int b = 0; b < 2; ++b)
#pragma unroll
            for (int m = 0; m < 4; ++m)
#pragma unroll
                for (int n = 0; n < 2; ++n) acc[a][b][m][n] = (f32x4){0.f, 0.f, 0.f, 0.f};
    bf16x8 At[4][2], B0[2][2], B1[2][2];
    const char* cA = (const char*)g.A + (size_t)cur.pm * tstepA; const char* cB = (const char*)g.Bt + (size_t)cur.pn * tstepB;
    S.a_ready(cur);
    if constexpr (SP2) {
        PG8_STAGE(PG8_SB(0, 0), cB, voffB); PG8_STAGE(PG8_SB(0, 1), cB + hstepB, voffB); PG8_STAGE(PG8_SA(0, 0), cA, voffA); PG8_STAGE(PG8_SA(0, 1), cA + hstepA, voffA);
        if (wr == 1) PG8_BAR;
        PG8_WAIT_V(2); PG8_BAR;
        PG8_STAGE(PG8_SB(1, 0), cB + kstep, voffB); PG8_STAGE(PG8_SA(1, 0), cA + kstep, voffA); PG8_STAGE(PG8_SB(1, 1), cB + hstepB + kstep, voffB);
        PG8_WAIT_V(6); PG8_BAR;
    } else {
        PG8_STAGE(PG8_SB(0, 0), cB, voffB); PG8_STAGE(PG8_SA(0, 0), cA, voffA); PG8_STAGE(PG8_SB(0, 1), cB + hstepB, voffB); PG8_STAGE(PG8_SA(0, 1), cA + hstepA, voffA);
        if (wr == 1) PG8_BAR;
        PG8_WAIT_V(4); PG8_BAR;
        PG8_STAGE(PG8_SB(1, 0), cB + kstep, voffB); PG8_STAGE(PG8_SA(1, 0), cA + kstep, voffA); PG8_STAGE(PG8_SB(1, 1), cB + hstepB + kstep, voffB);
        PG8_WAIT_V(6); PG8_BAR;
    }
    for (;;) {
        const bool has_next = S.next(ui + 1, nxt);
        const char* nA = has_next ? (const char*)g.A + (size_t)nxt.pm * tstepA : cA; const char* nB = has_next ? (const char*)g.Bt + (size_t)nxt.pn * tstepB : cB;
        for (int t = 0; t < nt; t += 2) {
            const bool last = (t == nt - 2);
            const char* a1 = cA + (size_t)(t + 1) * kstep;
            const char* a2 = last ? nA : cA + (size_t)(t + 2) * kstep; const char* b2 = last ? nB : cB + (size_t)(t + 2) * kstep;
            const char* a3 = a2 + kstep; const char* b3 = b2 + kstep;
            if (last && has_next) S.a_ready(nxt);
            if constexpr (SP2) {
            PG8_LDB(B0, 0, 0); PG8_LDB(B1, 0, 1); PG8_SCHED; PG8_LDA(At, 0, 0); PG8_STAGE(PG8_SA(1, 1), a1 + hstepA, voffA);
            PG8_WAIT_V(8); PG8_WAIT_L(0); PG8_BAR; PG8_MMA(0, 0, At, B0); PG8_MMA(0, 1, At, B1); PG8_BAR; PG8_SCHED;
            PG8_LDA(At, 0, 1); PG8_STAGE(PG8_SB(0, 0), b2, voffB); PG8_STAGE(PG8_SB(0, 1), b2 + hstepB, voffB); PG8_STAGE(PG8_SA(0, 0), a2, voffA);
            PG8_WAIT_V(8); PG8_WAIT_L(0); PG8_BAR; PG8_MMA(1, 0, At, B0); PG8_MMA(1, 1, At, B1); PG8_BAR; PG8_SCHED;
            PG8_LDB(B0, 1, 0); PG8_LDB(B1, 1, 1); PG8_SCHED; PG8_LDA(At, 1, 0); PG8_STAGE(PG8_SA(0, 1), a2 + hstepA, voffA);
            PG8_WAIT_V(8); PG8_WAIT_L(0); PG8_BAR; PG8_MMA(0, 0, At, B0); PG8_MMA(0, 1, At, B1); PG8_BAR; PG8_SCHED;
            PG8_LDA(At, 1, 1); PG8_STAGE(PG8_SB(1, 0), b3, voffB); PG8_STAGE(PG8_SB(1, 1), b3 + hstepB, voffB); PG8_STAGE(PG8_SA(1, 0), a3, voffA);
            PG8_WAIT_V(8); PG8_WAIT_L(0); PG8_BAR; PG8_MMA(1, 0, At, B0); PG8_MMA(1, 1, At, B1); PG8_BAR; PG8_SCHED;
            } else {
            PG8_LDB(B0, 0, 0); PG8_SCHED; PG8_LDA(At, 0, 0); PG8_STAGE(PG8_SA(1, 1), a1 + hstepA, voffA);
            PG8_WAIT_L(8); PG8_BAR; PG8_WAIT_L(0); PG8_MMA(0, 0, At, B0); PG8_BAR; PG8_SCHED;
            PG8_LDB(B1, 0, 1); PG8_STAGE(PG8_SB(0, 0), b2, voffB);
            PG8_BAR; PG8_WAIT_L(0); PG8_MMA(0, 1, At, B1); PG8_BAR;
            PG8_LDA(At, 0, 1); PG8_STAGE(PG8_SA(0, 0), a2, voffA);
            PG8_BAR; PG8_WAIT_L(0); PG8_MMA(1, 0, At, B0); PG8_BAR; PG8_SCHED;
            PG8_STAGE(PG8_SB(0, 1), b2 + hstepB, voffB);
            PG8_WAIT_V(6); PG8_BAR; PG8_MMA(1, 1, At, B1); PG8_BAR;
            PG8_LDB(B0, 1, 0); PG8_SCHED; PG8_LDA(At, 1, 0); PG8_STAGE(PG8_SA(0, 1), a2 + hstepA, voffA);
            PG8_WAIT_L(8); PG8_BAR; PG8_WAIT_L(0); PG8_MMA(0, 0, At, B0); PG8_BAR; PG8_SCHED;
            PG8_LDB(B1, 1, 1); PG8_STAGE(PG8_SB(1, 0), b3, voffB);
            PG8_BAR; PG8_WAIT_L(0); PG8_MMA(0, 1, At, B1); PG8_BAR;
            PG8_LDA(At, 1, 1); PG8_STAGE(PG8_SA(1, 0), a3, voffA);
            PG8_BAR; PG8_WAIT_L(0); PG8_MMA(1, 0, At, B0); PG8_BAR; PG8_SCHED;
            PG8_STAGE(PG8_SB(1, 1), b3 + hstepB, voffB);
            PG8_WAIT_V(6); PG8_BAR; PG8_MMA(1, 1, At, B1); PG8_BAR;
            }
        }
        if constexpr (ALIGN_EPI) { if (wr == 0) PG8_BAR; }
        if constexpr (!Epi::AFTER_DRAIN) { E(acc, cur, wr, wc, fr, fq); S.done(cur); }
        if (!has_next) break;
#pragma unroll
        for (int a = 0; a < 2; ++a)
#pragma unroll
            for (int b = 0; b < 2; ++b)
#pragma unroll
                for (int m = 0; m < 4; ++m)
#pragma unroll
                    for (int n = 0; n < 2; ++n) acc[a][b][m][n] = (f32x4){0.f, 0.f, 0.f, 0.f};
        cur = nxt; cA = nA; cB = nB; ++ui;
        if constexpr (ALIGN_EPI) { if (wr == 1) PG8_BAR; }
    }
    PG8_WAIT_V(0);
    if constexpr (!ALIGN_EPI) { if (wr == 0) PG8_BAR; }
    PG8_BAR;
    if constexpr (Epi::AFTER_DRAIN) { E.fused(acc, cur, wr, wc, fr, fq, lds, wid, lane); S.done(cur); }
#undef PG8_SA
#undef PG8_SB
#undef PG8_STAGE
#undef PG8_LDA
#undef PG8_LDB
#undef PG8_MMA
#undef PG8_WAIT_V
#undef PG8_WAIT_L
#undef PG8_BAR
#undef PG8_SCHED
}
}

constexpr int NWAVES = 8, NTHR = 512;
constexpr int LDS_BYTES = 147456;
#define GAS __attribute__((address_space(1)))
#define LAS __attribute__((address_space(3)))
typedef unsigned short bf16;
typedef unsigned v4u __attribute__((ext_vector_type(4)));
typedef unsigned v2u __attribute__((ext_vector_type(2)));
typedef float f32x4 __attribute__((ext_vector_type(4)));
typedef float f32x2 __attribute__((ext_vector_type(2)));
typedef float f32x16 __attribute__((ext_vector_type(16)));
typedef short bf16x8 __attribute__((ext_vector_type(8)));
typedef short s16x4 __attribute__((ext_vector_type(4)));

constexpr size_t MiB = 1u << 20;
constexpr size_t WS_CTL = 0;
constexpr size_t WS_PART = 1 * MiB;
constexpr size_t WS_ROPE = 3 * MiB;
constexpr size_t WS_HMETA = 4 * MiB;
constexpr size_t WS_LORA = 5 * MiB;
constexpr size_t WS_W = 6 * MiB;
constexpr size_t W_IN0 = WS_W, W_OUT0 = W_IN0 + (size_t)NIN * DM * 2, W_UP0 = W_OUT0 + (size_t)DM * DM * 2, W_DN0 = W_UP0 + (size_t)2 * DFF * DM * 2,
                 W_IN1 = W_DN0 + (size_t)DM * DFF * 2, W_OUT1 = W_IN1 + (size_t)NIN * DM * 2, W_UP1 = W_OUT1 + (size_t)DM * DM * 2, W_DN1 = W_UP1 + (size_t)2 * DFF * DM * 2,
                 W_END = W_DN1 + (size_t)DM * DFF * 2;
constexpr size_t WS_A = 56 * MiB;
constexpr size_t WS_R = 89 * MiB;
static_assert(W_END <= WS_A && WS_A + (size_t)MP * DM * 2 <= WS_R, "ws map");
constexpr size_t R_U = WS_R, R_WC = R_U + (size_t)MP * 512 * 2, R_GB = R_WC + (size_t)MP * 512 * 2, R_Y0 = R_GB + (size_t)MP * 512 * 2;
constexpr size_t R_HM = WS_R, R_EDGE_G = R_HM + (size_t)MP * DFF * 2, R_EDGE_V = R_EDGE_G + (size_t)65 * 2 * DFF * 4, R_HALO = R_EDGE_V + (size_t)65 * 2 * DFF * 4, R_FFN_END = R_HALO + (size_t)65 * 2 * DFF * 4;
constexpr size_t R_Q = WS_R, R_KB = R_Q + (size_t)MP * 512 * 2, R_VB = R_KB + (size_t)MP * 128 * 2, R_PR = R_VB + (size_t)MP * 128 * 2, R_Y1 = R_PR + (size_t)MP * PRW * 2, R_L1_END = R_Y1 + (size_t)MP * DM * 2;
constexpr size_t WS_END = 256 * MiB;
constexpr size_t WS_HFIN = 184 * MiB;
static_assert(EO_PART == WS_PART && EO_HM == R_HM && EO_EDGE_G == R_EDGE_G && EO_EDGE_V == R_EDGE_V && EO_HALO == R_HALO, "epilogue offsets");
static_assert(R_FFN_END <= WS_HFIN && WS_HFIN + (size_t)MR * DM * 4 <= WS_END, "final stream buffer");
static_assert(R_FFN_END <= WS_END && R_L1_END <= WS_END && R_Y0 + (size_t)MP * DM * 2 <= WS_END, "ws map 2");

#define LDS_WAIT() asm volatile("s_waitcnt lgkmcnt(0)" ::: "memory")
__device__ __forceinline__ unsigned f2bf(float f) { unsigned u = __builtin_bit_cast(unsigned, f); return (u + 0x7fffu + ((u >> 16) & 1u)) >> 16; }
__device__ __forceinline__ unsigned pk2(float lo, float hi) { return f2bf(lo) | (f2bf(hi) << 16); }
__device__ __forceinline__ float bf2f(unsigned short v) { return __builtin_bit_cast(float, (unsigned)v << 16); }
__device__ __forceinline__ float bflo(unsigned w) { return __builtin_bit_cast(float, w << 16); }
__device__ __forceinline__ float bfhi(unsigned w) { return __builtin_bit_cast(float, w & 0xffff0000u); }
__device__ __forceinline__ float sigm(float x) { return __builtin_amdgcn_rcpf(1.0f + __expf(-x)); }
__device__ __forceinline__ float dppf(float x, int ctrl_sel) {
    const int v = __builtin_bit_cast(int, x); int r;
    if (ctrl_sel == 0) r = __builtin_amdgcn_update_dpp(v, v, 0xB1, 0xF, 0xF, false);
    else if (ctrl_sel == 1) r = __builtin_amdgcn_update_dpp(v, v, 0x4E, 0xF, 0xF, false);
    else if (ctrl_sel == 2) r = __builtin_amdgcn_update_dpp(v, v, 0x141, 0xF, 0xF, false);
    else r = __builtin_amdgcn_update_dpp(v, v, 0x140, 0xF, 0xF, false);
    return __builtin_bit_cast(float, r);
}
__device__ __forceinline__ float sum16(float x) { x += dppf(x, 0); x += dppf(x, 1); x += dppf(x, 2); x += dppf(x, 3); return x; }

__device__ __forceinline__ void sum16x2(float& x0, float& x1) {
    asm volatile("s_nop 1\n\t"
        "v_add_f32_dpp %0, %0, %0 quad_perm:[1,0,3,2] row_mask:0xf bank_mask:0xf\n\t"
        "v_add_f32_dpp %1, %1, %1 quad_perm:[1,0,3,2] row_mask:0xf bank_mask:0xf\n\t"
        "s_nop 0\n\t"
        "v_add_f32_dpp %0, %0, %0 quad_perm:[2,3,0,1] row_mask:0xf bank_mask:0xf\n\t"
        "v_add_f32_dpp %1, %1, %1 quad_perm:[2,3,0,1] row_mask:0xf bank_mask:0xf\n\t"
        "s_nop 0\n\t"
        "v_add_f32_dpp %0, %0, %0 row_half_mirror row_mask:0xf bank_mask:0xf\n\t"
        "v_add_f32_dpp %1, %1, %1 row_half_mirror row_mask:0xf bank_mask:0xf\n\t"
        "s_nop 0\n\t"
        "v_add_f32_dpp %0, %0, %0 row_mirror row_mask:0xf bank_mask:0xf\n\t"
        "v_add_f32_dpp %1, %1, %1 row_mirror row_mask:0xf bank_mask:0xf\n\t"
        "s_nop 1"
        : "+v"(x0), "+v"(x1));
}
__device__ __forceinline__ float sum32(float x) { x = sum16(x); x += __shfl_xor(x, 16); return x; }
__device__ __forceinline__ float wave_sum(float v) {
#pragma unroll
    for (int o = 1; o < 64; o <<= 1) v += __shfl_xor(v, o);
    return v;
}
__device__ __forceinline__ int row_of(int b, int t) { return t >= NMETA ? b * SEQ + (t - NMETA) : MR + t; }


#define XB_TMO      128
#define XB_XCNT(j)  (256  + 64 * (j))
#define XB_XSUB(j)  (1280 + 64 * (j))
#define XB_XGEN(j)  (2304 + 64 * (j))
#define XB_TOP      3328
#define XB_TOPGEN   3392
#define XCD_BAR_WORDS 3456
#define XB_SPIN_CAP (1u << 18)
constexpr int LDSCTL_OFF = 147328, MISC_OFF = LDSCTL_OFF;
__device__ __forceinline__ unsigned xb_ld(unsigned* p)              { return __hip_atomic_load(p, __ATOMIC_RELAXED, __HIP_MEMORY_SCOPE_AGENT); }
__device__ __forceinline__ unsigned xb_add(unsigned* p, unsigned v) { return __hip_atomic_fetch_add(p, v, __ATOMIC_RELAXED, __HIP_MEMORY_SCOPE_AGENT); }
__device__ __forceinline__ unsigned xb_xcc_id() { return (unsigned)__builtin_amdgcn_s_getreg((3 << 11) | 20) & 0xFu; }
#define XB_SPIN(cond, bar) do { unsigned _sp = 0; while (cond) { __builtin_amdgcn_s_sleep(1); \
    if ((++_sp & 255u) == 0u) { if (xb_ld(&(bar)[XB_TMO])) break; if (_sp > XB_SPIN_CAP) { atomicAdd(&(bar)[XB_TMO], 1u); break; } } } } while (0)
__device__ __forceinline__ void xcd_barrier_complete(unsigned* bar, unsigned x, unsigned& nloc, unsigned& nx) {
    const unsigned G = gridDim.x * gridDim.y * gridDim.z;
    unsigned sum, cnt, mine, sp = 0u;
    for (;;) {
        sum = 0u; cnt = 0u; mine = 0u;
#pragma unroll
        for (unsigned j = 0; j < 16; ++j) { const unsigned c = xb_ld(&bar[XB_XCNT(j)]); sum += c; cnt += (c > 0u) ? 1u : 0u; mine = (j == x) ? c : mine; }
        if (sum == G) break;
        __builtin_amdgcn_s_sleep(1);
        if ((++sp & 255u) == 0u) { if (xb_ld(&bar[XB_TMO])) break; if (sp > XB_SPIN_CAP) { atomicAdd(&bar[XB_TMO], 1u); break; } }
    }
    nloc = mine > 0u ? mine : 1u; nx = cnt > 0u ? cnt : 1u;
}
__device__ __forceinline__ void xcd_barrier(unsigned* bar, volatile LAS unsigned* st, bool t0) {
    asm volatile("s_waitcnt vmcnt(0)" ::: "memory");
    __syncthreads();
    if (t0) {
        const unsigned x = xb_xcc_id();
        __builtin_amdgcn_s_waitcnt(0);
        unsigned nloc = st[0], nx = st[1];
        if (nloc == 0u) { xcd_barrier_complete(bar, x, nloc, nx); st[0] = nloc; st[1] = nx; }
        const unsigned old = xb_add(&bar[XB_XSUB(x)], 1u);
        const unsigned gen = old / nloc;
        if (old + 1u == (gen + 1u) * nloc) {
            __builtin_amdgcn_fence(__ATOMIC_RELEASE, "agent");
            asm volatile("s_waitcnt vmcnt(0)" ::: "memory");
            const unsigned og = xb_add(&bar[XB_TOP], 1u);
            const unsigned tg = og / nx;
            if (og + 1u == (tg + 1u) * nx) xb_add(&bar[XB_TOPGEN], 1u);
            else XB_SPIN(xb_ld(&bar[XB_TOPGEN]) == tg, bar);
            __builtin_amdgcn_fence(__ATOMIC_ACQUIRE, "agent");
            xb_add(&bar[XB_XGEN(x)], 1u);
            asm volatile("s_waitcnt vmcnt(0)" ::: "memory");
        } else {
            XB_SPIN(xb_ld(&bar[XB_XGEN(x)]) == gen, bar);
            __builtin_amdgcn_fence(__ATOMIC_ACQUIRE, "agent");
            asm volatile("s_waitcnt vmcnt(0)" ::: "memory");
        }
    }
    __syncthreads();
}

struct Args { const float* in[29]; float* out; unsigned char* ws; int ph_lo, ph_hi; };
typedef const __attribute__((address_space(4))) Args CArgs;

struct Frame {
    LAS unsigned char* lds; int tid, lane, wave, G, wg;
    float* out; unsigned char* ws;
};

__device__ __forceinline__ int colmap(int kind, int d) {
    if (kind == 0) return d;
    const int tile = d >> 8, bj = (d >> 7) & 1, cc = d & 127;
    if (kind == 1) {
        if (tile < 4) return (bj ? 512 : 0) + 128 * tile + cc;
        if (tile < 8) return (bj ? 2048 : 1536) + 128 * (tile - 4) + cc;
        return 1024 + (d - 2048);
    }
    if (kind == 2) return (bj ? DFF : 0) + 128 * tile + cc;
    const int w = cc >> 5, dd = cc & 31;
    if (tile < 2) return 64 * (4 * tile + w) + 32 * bj + dd;
    if (tile == 2) return (w < 2 ? 512 + 64 * w : 640 + 64 * (w - 2)) + 32 * bj + dd;
    return d;
}
__device__ __forceinline__ void p0_transpose_item(const float* W, int K, int N, bf16* WT, const float* gvec, int kind, LAS float* scr, int item, int nblk, int lane) {
    const int kb = item / nblk, db = item % nblk, k0 = 64 * kb, d0 = 32 * db, n0 = colmap(kind, d0);
#pragma unroll 8
    for (int i = 0; i < 32; ++i) { const int kk = 2 * i + (lane >> 5); float v = W[(size_t)(k0 + kk) * N + n0 + (lane & 31)]; if (gvec) v *= gvec[k0 + kk]; scr[kk * 33 + (lane & 31)] = v; }
    LDS_WAIT(); asm volatile("" ::: "memory");
    const int c = lane & 7;
#pragma unroll
    for (int j = 0; j < 4; ++j) { const int n = (lane >> 3) + 8 * j; const LAS float* s = scr + (8 * c) * 33 + n;
        v4u o; o.x = pk2(s[0 * 33], s[1 * 33]); o.y = pk2(s[2 * 33], s[3 * 33]); o.z = pk2(s[4 * 33], s[5 * 33]); o.w = pk2(s[6 * 33], s[7 * 33]);
        *(GAS v4u*)(WT + (size_t)(d0 + n) * K + k0 + 8 * c) = o; }
    LDS_WAIT(); asm volatile("" ::: "memory");
}
__device__ __forceinline__ void p0_job(Frame& F, LAS float* scr, int gw, int NGW, int& base, const float* W, int K, int N, size_t dst, const float* g, int kind) {
    const int nblk = N / 32, nitems = (K / 64) * nblk;
    int it = gw - (base % NGW); if (it < 0) it += NGW;
    for (; it < nitems; it += NGW) p0_transpose_item(W, K, N, (bf16*)(F.ws + dst), g, kind, scr, it, nblk, F.lane);
    base += nitems;
}
__device__ __forceinline__ void p0_prologue(Frame& F, CArgs& A) {
    LAS float* scr = (LAS float*)(F.lds + F.wave * 16384);
    const int gw = F.wg * NWAVES + F.wave, NGW = F.G * NWAVES, lane = F.lane;
    unsigned char* ws = F.ws;
    const float* norm_mix = A.in[2]; const float* norm_ffn = A.in[3];
    int base = 0;
    p0_job(F, scr, gw, NGW, base, A.in[5], DM, NIN, W_IN0, norm_mix, 1);
    p0_job(F, scr, gw, NGW, base, A.in[10], DM, DM, W_OUT0, nullptr, 0);
    p0_job(F, scr, gw, NGW, base, A.in[25], DM, 2 * DFF, W_UP0, norm_ffn, 2);
    p0_job(F, scr, gw, NGW, base, A.in[28], DFF, DM, W_DN0, nullptr, 0);
    p0_job(F, scr, gw, NGW, base, A.in[11], DM, NIN, W_IN1, norm_mix + DM, 3);
    p0_job(F, scr, gw, NGW, base, A.in[24], DM, DM, W_OUT1, nullptr, 0);
    p0_job(F, scr, gw, NGW, base, A.in[25] + (size_t)DM * 2 * DFF, DM, 2 * DFF, W_UP1, norm_ffn + DM, 2);
    p0_job(F, scr, gw, NGW, base, A.in[28] + (size_t)DFF * DM, DFF, DM, W_DN1, nullptr, 0);
    p0_job(F, scr, gw, NGW, base, A.in[15], 64, 512, WS_LORA, nullptr, 0);
    p0_job(F, scr, gw, NGW, base, A.in[17], 64, 512, WS_LORA + 512 * 64 * 2, nullptr, 0);
    p0_job(F, scr, gw, NGW, base, A.in[18], 128, 512, WS_LORA + 2 * 512 * 64 * 2, nullptr, 0);
    const float* x = A.in[0]; const float* meta = A.in[1];
    bf16* A0 = (bf16*)(ws + WS_A); float* part = (float*)(ws + WS_PART); float* hmeta = (float*)(ws + WS_HMETA);
    for (int row = gw; row < MP; row += NGW) {
        float* pp = part + (size_t)row * 16;
        if (row < MR + NMETA) {
            const float* src = row < MR ? x + (size_t)row * DM : meta + (size_t)(row - MR) * DM;
            float ss = 0.f;
#pragma unroll
            for (int j = 0; j < 4; ++j) { const f32x4 v = *(const GAS f32x4*)(src + j * 256 + lane * 4); ss += (v[0] * v[0] + v[1] * v[1]) + (v[2] * v[2] + v[3] * v[3]);
                v2u o; o.x = pk2(v[0], v[1]); o.y = pk2(v[2], v[3]); *(GAS v2u*)(A0 + (size_t)row * DM + j * 256 + lane * 4) = o;
                if (row >= MR) *(GAS f32x4*)(hmeta + (size_t)(row - MR) * DM + j * 256 + lane * 4) = v; }
            ss = wave_sum(ss);
            if (lane < 16) pp[lane] = lane == 0 ? ss : 0.f;
        } else {
            if (lane < 16) pp[lane] = 0.f;
#pragma unroll
            for (int j = 0; j < 4; ++j) { float zf; asm volatile("v_mov_b32 %0, 0" : "=v"(zf)); *(GAS f32x4*)(hmeta + (size_t)(row - MR) * DM + j * 256 + lane * 4) = (f32x4){zf, zf, zf, zf}; }
        }
    }
    float* rc = (float*)(ws + WS_ROPE); float* rsn = rc + TT * 32;
    for (int i = gw * 64 + lane; i < TT * 32; i += NGW * 64) {
        const int t = i >> 5, d = i & 31;
        const float inv = exp2f(-(float)d * (13.287712379549449f / 32.0f));
        const float ang = (float)t * inv;
        const float rev = ang * 0.15915494309189535f; const float a = (rev - floorf(rev)) * 6.283185307179586f;
        rc[i] = __cosf(a); rsn[i] = __sinf(a);
    }
}

__device__ __forceinline__ void conv0_phase(Frame& F, CArgs& A) {
    const bf16* U = (const bf16*)(F.ws + R_U); const bf16* WC = (const bf16*)(F.ws + R_WC); const bf16* GB = (const bf16*)(F.ws + R_GB); bf16* Y0 = (bf16*)(F.ws + R_Y0);
    const float* conv_a = A.in[6]; const float* ln_g = A.in[7]; const float* ln_b = A.in[8]; const float* conv_b = A.in[9];
    const int half = F.tid >> 8, ht = F.tid & 255, c0 = 2 * ht;
    LAS float* tile = (LAS float*)(F.lds + half * 40960);
    LAS float* stats = (LAS float*)(F.lds + half * 40960 + 32768);
    float wa[31][2];
#pragma unroll
    for (int j = 0; j < 31; ++j) { const f32x2 w = *(const f32x2*)(conv_a + j * 512 + c0); wa[j][0] = w.x; wa[j][1] = w.y; }
    float wb[3][2];
#pragma unroll
    for (int j = 0; j < 3; ++j) { const f32x2 w = *(const f32x2*)(conv_b + j * 512 + c0); wb[j][0] = w.x; wb[j][1] = w.y; }
    const f32x2 lg = *(const f32x2*)(ln_g + c0), lb = *(const f32x2*)(ln_b + c0);
    const int NU = NB * 128 + 1;
    const int nhu = 2 * F.G;
    for (int u0 = 0; u0 < NU; u0 += nhu) {
        const int u = u0 + F.wg * 2 + half; const bool act = u < NU;
        int b = 0, t0 = 0; if (act) { if (u == NB * 128) { b = 0; t0 = 0; } else { b = u >> 7; t0 = 16 + 16 * (u & 127); } }
        if (act) {
            unsigned uin[46];
#pragma unroll
            for (int i = 0; i < 46; ++i) { const int t = t0 - 30 + i; uin[i] = t >= 0 ? *(const unsigned*)(U + (size_t)row_of(b, t) * 512 + c0) : 0u; }
#pragma unroll
            for (int o = 0; o < 16; ++o) { float a0 = 0.f, a1 = 0.f;
#pragma unroll
                for (int j = 0; j < 31; ++j) { a0 += wa[j][0] * bflo(uin[o + j]); a1 += wa[j][1] * bfhi(uin[o + j]); }
                *(LAS f32x2*)(tile + o * 512 + c0) = (f32x2){a0, a1}; }
        }
        __syncthreads();
        if (act) {
            const int tok = ht >> 4, q = ht & 15; float s = 0.f, ss = 0.f;
#pragma unroll
            for (int i = 0; i < 8; ++i) { const f32x4 v = *(const LAS f32x4*)(tile + tok * 512 + i * 64 + q * 4); s += (v[0] + v[1]) + (v[2] + v[3]); ss += (v[0] * v[0] + v[1] * v[1]) + (v[2] * v[2] + v[3] * v[3]); }
            s = sum16(s); ss = sum16(ss);
            if (q == 0) { const float mu = s * (1.f / 512.f); float var = ss * (1.f / 512.f) - mu * mu; var = var < 0.f ? 0.f : var; stats[tok * 2] = mu; stats[tok * 2 + 1] = rsqrtf(var + 1e-5f); }
        }
        __syncthreads();
        if (act) {
            unsigned win[18];
#pragma unroll
            for (int i = 0; i < 18; ++i) { const int t = t0 - 2 + i; win[i] = t >= 0 ? *(const unsigned*)(WC + (size_t)row_of(b, t) * 512 + c0) : 0u; }
#pragma unroll
            for (int o = 0; o < 16; ++o) {
                const int row = row_of(b, t0 + o);
                const f32x2 v = *(const LAS f32x2*)(tile + o * 512 + c0); const float mu = stats[o * 2], rs = stats[o * 2 + 1];
                float y0 = (v.x - mu) * rs * lg.x + lb.x, y1 = (v.y - mu) * rs * lg.y + lb.y; y0 *= sigm(y0); y1 *= sigm(y1);
                *(unsigned*)(Y0 + (size_t)row * DM + c0) = pk2(y0, y1);
                float z0 = 0.f, z1 = 0.f;
#pragma unroll
                for (int j = 0; j < 3; ++j) { z0 += wb[j][0] * bflo(win[o + j]); z1 += wb[j][1] * bfhi(win[o + j]); }
                const unsigned gbv = *(const unsigned*)(GB + (size_t)row * 512 + c0);
                *(unsigned*)(Y0 + (size_t)row * DM + 512 + c0) = pk2(z0 * bflo(gbv), z1 * bfhi(gbv));
            }
        }
        __syncthreads();
    }
}

__device__ __forceinline__ void ffn_fix_phase(Frame& F, CArgs& A, int layer) {
    bf16* HM = (bf16*)(F.ws + R_HM); const float* EG = (const float*)(F.ws + R_EDGE_G); const float* EV = (const float*)(F.ws + R_EDGE_V); const float* HL = (const float*)(F.ws + R_HALO);
    const float* cw = A.in[26] + (size_t)layer * 3 * DFF; const float* cb = A.in[27] + (size_t)layer * DFF;
    const int NIT = 65 * 2 * (DFF / 4);
    for (int it = F.wg * NTHR + F.tid; it < NIT; it += F.G * NTHR) {
        const int c = (it % (DFF / 4)) * 4, pl = it / (DFF / 4), pm = pl >> 1, lr = pl & 1;
        const f32x4 g0 = *(const f32x4*)(EG + (size_t)(pm * 2 + lr) * DFF + c), v = *(const f32x4*)(EV + (size_t)(pm * 2 + lr) * DFF + c);
        f32x4 a254 = (f32x4){0.f, 0.f, 0.f, 0.f}, a255 = a254;
        if (pm < 64) { const int src = (pm & 7) == 0 ? 64 : pm - 1; a254 = *(const f32x4*)(HL + (size_t)(src * 2 + 0) * DFF + c); a255 = *(const f32x4*)(HL + (size_t)(src * 2 + 1) * DFF + c); }
        const f32x4 g1 = lr == 0 ? a255 : *(const f32x4*)(EG + (size_t)(pm * 2) * DFF + c), g2 = lr == 0 ? a254 : a255;
        const f32x4 z = *(const f32x4*)(cw + c) * g2 + *(const f32x4*)(cw + DFF + c) * g1 + *(const f32x4*)(cw + 2 * DFF + c) * g0 + *(const f32x4*)(cb + c);
        const f32x4 o = z * (f32x4){sigm(z[0]), sigm(z[1]), sigm(z[2]), sigm(z[3])} * v;
        v2u ov; ov.x = pk2(o[0], o[1]); ov.y = pk2(o[2], o[3]);
        *(v2u*)(HM + (size_t)(pm * 256 + lr) * DFF + c) = ov;
    }
}

__device__ __forceinline__ int crow(int r, int hi) { return (r & 3) + 8 * (r >> 2) + 4 * hi; }
constexpr int ATT_KS = 72, ATT_VS = 232, ATT_K_BYTES = 224 * ATT_KS * 2;
__device__ __forceinline__ void attn_unit(Frame& F, const float* sinks, int b, int kvh, int qb) {
    const bf16* Q = (const bf16*)(F.ws + R_Q); const bf16* KB = (const bf16*)(F.ws + R_KB); const bf16* VB = (const bf16*)(F.ws + R_VB); bf16* Y1 = (bf16*)(F.ws + R_Y1);
    LAS bf16* Ks = (LAS bf16*)F.lds; LAS bf16* Vt = (LAS bf16*)(F.lds + ATT_K_BYTES);
    const int tid = F.tid, lane = F.lane, wave = F.wave, g = wave >> 1, half = wave & 1, qh = kvh * 4 + g, qi = lane & 31, hi = lane >> 5;
    const bool meta = qb < 0; const int q0 = meta ? 0 : 64 * qb;
#pragma unroll
    for (int i = 0; i < 4; ++i) {
        const int id = tid + 512 * i, key = id >> 3, ch = id & 7;
        if (key < 224) {
            int row = -1;
            if (key < 192) { const int sp = q0 - 128 + key; if (!meta && sp >= 0) row = b * SEQ + sp; }
            else if (key < 208) row = MR + (key - 192);
            v4u kv = (v4u){0u, 0u, 0u, 0u}, vv = (v4u){0u, 0u, 0u, 0u};
            if (row >= 0) { kv = *(const v4u*)(KB + (size_t)row * 128 + kvh * 64 + ch * 8); vv = *(const v4u*)(VB + (size_t)row * 128 + kvh * 64 + ch * 8); }
            *(LAS v4u*)(Ks + key * ATT_KS + ch * 8) = kv;
#pragma unroll
            for (int e = 0; e < 4; ++e) { Vt[(ch * 8 + 2 * e) * ATT_VS + key] = (bf16)(vv[e] & 0xffffu); Vt[(ch * 8 + 2 * e + 1) * ATT_VS + key] = (bf16)(vv[e] >> 16); }
        }
    }
    __syncthreads();
    int qrow; if (meta) { const int m = 32 * half + qi; qrow = MR + (m < NMETA ? m : NMETA - 1); } else qrow = b * SEQ + q0 + 32 * half + qi;
    bf16x8 qr[4];
#pragma unroll
    for (int k4 = 0; k4 < 4; ++k4) qr[k4] = *(const bf16x8*)(Q + (size_t)qrow * 512 + qh * 64 + 16 * k4 + 8 * hi);
    f32x16 sc[6];
#pragma unroll
    for (int i = 0; i < 6; ++i) {
        const int t = i < 5 ? half + i : 6;
        f32x16 a = (f32x16){0.f,0.f,0.f,0.f,0.f,0.f,0.f,0.f,0.f,0.f,0.f,0.f,0.f,0.f,0.f,0.f};
#pragma unroll
        for (int k4 = 0; k4 < 4; ++k4) { const bf16x8 kf = *(const LAS bf16x8*)(Ks + (32 * t + qi) * ATT_KS + 16 * k4 + 8 * hi); a = __builtin_amdgcn_mfma_f32_32x32x16_bf16(kf, qr[k4], a, 0, 0, 0); }
        sc[i] = a;
    }
    const float sink = sinks[qh]; float mx = sink;
    const int mq = 32 * half + qi;
#pragma unroll
    for (int i = 0; i < 6; ++i)
#pragma unroll
        for (int r = 0; r < 16; ++r) {
            const int kr = crow(r, hi); bool ok;
            if (i < 5) { const int dist = 128 - 32 * i + qi - kr; const int sp = q0 - 128 + 32 * (half + i) + kr; ok = !meta && dist >= 0 && dist < 128 && sp >= 0; }
            else ok = kr < NMETA && (!meta || kr <= mq);
            const float v = ok ? sc[i][r] * 0.125f : -1e30f; sc[i][r] = v; mx = fmaxf(mx, v);
        }
    mx = fmaxf(mx, __shfl_xor(mx, 32));
    float ls = 0.f;
#pragma unroll
    for (int i = 0; i < 6; ++i)
#pragma unroll
        for (int r = 0; r < 16; ++r) { const float p = __expf(sc[i][r] - mx); sc[i][r] = p; ls += p; }
    ls += __shfl_xor(ls, 32); ls += __expf(sink - mx);
    const float inv = 1.0f / ls;
    f32x16 o[2];
    o[0] = (f32x16){0.f,0.f,0.f,0.f,0.f,0.f,0.f,0.f,0.f,0.f,0.f,0.f,0.f,0.f,0.f,0.f}; o[1] = o[0];
#pragma unroll
    for (int i = 0; i < 6; ++i) {
        const int t = i < 5 ? half + i : 6;
#pragma unroll
        for (int s2 = 0; s2 < 2; ++s2) {
            v4u pw; pw.x = pg8::cvt_pk_bf16(sc[i][8 * s2 + 0], sc[i][8 * s2 + 1]); pw.y = pg8::cvt_pk_bf16(sc[i][8 * s2 + 2], sc[i][8 * s2 + 3]);
            pw.z = pg8::cvt_pk_bf16(sc[i][8 * s2 + 4], sc[i][8 * s2 + 5]); pw.w = pg8::cvt_pk_bf16(sc[i][8 * s2 + 6], sc[i][8 * s2 + 7]);
            const bf16x8 pa = __builtin_bit_cast(bf16x8, pw);
#pragma unroll
            for (int dt = 0; dt < 2; ++dt) {
                const LAS bf16* vp = Vt + (dt * 32 + qi) * ATT_VS + 32 * t + 16 * s2 + 4 * hi;
                const v2u lo = *(const LAS v2u*)vp, hh = *(const LAS v2u*)(vp + 8);
                const v4u vw = (v4u){lo.x, lo.y, hh.x, hh.y};
                o[dt] = __builtin_amdgcn_mfma_f32_32x32x16_bf16(pa, __builtin_bit_cast(bf16x8, vw), o[dt], 0, 0, 0);
            }
        }
    }
#pragma unroll
    for (int r = 0; r < 16; ++r) {
        const int qq = crow(r, hi); const float iv = __shfl(inv, qq);
        int orow; bool ok = true;
        if (meta) { const int m = 32 * half + qq; ok = m < NMETA; orow = MR + m; } else orow = b * SEQ + q0 + 32 * half + qq;
        if (ok) {
            Y1[(size_t)orow * DM + qh * 64 + qi] = (bf16)f2bf(o[0][r] * iv);
            Y1[(size_t)orow * DM + qh * 64 + 32 + qi] = (bf16)f2bf(o[1][r] * iv);
        }
    }
    __syncthreads();
}

constexpr int IMG_PT = 0, IMG_BK = 4096, IMG_VT = 8192, IMG_QT = 10240, IMG_W16 = 11264, IMG_BYTES = 11520;
constexpr int NBLK = 129, NBLK_H1 = 65;
constexpr size_t WS_IMG = 203 * MiB;
constexpr size_t WS_G = WS_A, WS_RK = WS_A + 17 * MiB, WS_ZS = WS_A + 18 * MiB;
static_assert(WS_IMG >= R_L1_END && WS_IMG + (size_t)64 * NBLK_H1 * IMG_BYTES <= WS_END, "image region");
constexpr int P_PRL = 0, P_FW = 0, P_FK = 4096, P_FA = 8192, P_XR = 15616, P_XK = P_XR + 4096, P_FB = P_XK, P_XV = P_XK + 4096, P_WC = P_XV,
              P_TW = P_XV + 4096, P_XA = P_TW + 2304, P_SG = P_XA + 2304, P_E1 = P_TW, P_E2 = P_E1 + 4608, P_LW = P_TW + 9216, P_LA = P_LW + 4096, P_LG = P_LA + 4096,
              P_ATF = P_LW, P_RTF = P_LA, P_M = P_LG + 4096, P_T = P_M + 4224, P_PTF = P_T + 1088, P_QF = P_PTF + 4096, P_IMG = P_QF + 1088, P_SLOT = P_IMG + IMG_BYTES;
static_assert(2 * P_SLOT + 1792 <= 147328 && (P_SLOT % 16) == 0 && (P_IMG % 16) == 0 && (P_E1 % 16) == 0 && (P_E2 % 16) == 0 && P_SG + 4352 <= P_LW && P_E2 + 4608 <= P_LW, "prep lds map");
constexpr int PRS = 456;
__device__ __forceinline__ float wsum64(float x) { x = sum16(x); x += __shfl_xor(x, 16); x += __shfl_xor(x, 32); return x; }

__device__ __forceinline__ void rwkv_prep_phase(Frame& F, CArgs& A, int nbase, int cnt) {
    const bf16* PR = (const bf16*)(F.ws + R_PR);
    const bf16* w2t = (const bf16*)(F.ws + WS_LORA); const bf16* a2t = w2t + 512 * 64; const bf16* g2t = a2t + 512 * 64;
    const int tid = F.tid, lane = F.lane, wave = F.wave;
    const int nunits = 64 * cnt;
    if (F.wg >= nunits) return;
    int ld_pr[2], ld_pc[2]; bool ld_ok[2];
#pragma unroll
    for (int i = 0; i < 2; ++i) { const int q = tid + 512 * i; ld_ok[i] = q < 952; ld_pr[i] = ld_ok[i] ? q / 56 : 0; ld_pc[i] = ld_ok[i] ? q % 56 : 0; }
#define PP_LOAD(id_, dst) do { const int idc_ = (id_) < nunits ? (id_) : F.wg; const int ch_ = idc_ & 63, n_ = nbase + (idc_ >> 6), b_ = ch_ >> 3, h_ = ch_ & 7; \
        _Pragma("unroll") for (int i_ = 0; i_ < 2; ++i_) { const int pr = ld_pr[i_], pc = ld_pc[i_]; \
            const int col = pc < 8 ? 64 * h_ + 8 * pc : pc < 16 ? 512 + 64 * h_ + 8 * (pc - 8) : pc < 24 ? 1024 + 64 * h_ + 8 * (pc - 16) : 1536 + 8 * (pc - 24); \
            int gr = n_ == 0 ? MR + pr - 1 : n_ == 1 ? (pr == 0 ? MR + NMETA - 1 : b_ * SEQ + pr - 1) : b_ * SEQ + 16 * (n_ - 1) - 1 + pr; \
            const bool zero_ = (n_ == 0 && pr == 0); if (zero_) gr = MR; \
            v4u v_ = *(const v4u*)(PR + (size_t)gr * PRW + col); if (zero_) v_ = (v4u){0u, 0u, 0u, 0u}; dst[i_] = v_; } } while (0)
    v4u pf0[2], pf1[2];
    PP_LOAD(F.wg, pf0); PP_LOAD(F.wg + F.G, pf1);
    int cur_chain = -1;
    LAS float* MU = (LAS float*)(F.lds + 2 * P_SLOT);
    bf16x8 c_bfr[4]; f32x2 c_w0 = (f32x2){0.f, 0.f}, c_a0 = c_w0, c_kk = c_w0, c_ka = c_w0, c_rk = c_w0;
#pragma unroll
    for (int i = 0; i < 4; ++i) c_bfr[i] = (bf16x8){0, 0, 0, 0, 0, 0, 0, 0};
    const int tid_base = tid;
#pragma unroll 1
    for (int id0 = F.wg; id0 < nunits; id0 += 2 * F.G) {
    int tid = tid_base; asm volatile("" : "+v"(tid));
    const int lane = tid & 63, wave = __builtin_amdgcn_readfirstlane(tid >> 6);
    const int tt = tid >> 5, jp = tid & 31, j0 = 2 * jp;
    const int chain = id0 & 63, b = chain >> 3, h = chain & 7, ch0 = 64 * h + j0;
    const bool act1 = id0 + F.G < nunits;
    if (chain != cur_chain) {
        cur_chain = chain;
        const float* mu = A.in[13];
        if (tid < 448) { const int c = tid; const int gcol = c < 64 ? 64 * h + c : c < 128 ? 512 + 64 * h + (c - 64) : c < 192 ? 1024 + 64 * h + (c - 128) : 1536 + (c - 192); MU[c] = mu[gcol]; }
        { const int nb = wave & 3, grp = wave >> 2, ar = lane & 15, ak = 8 * (lane >> 4);
          if (grp == 0) { c_bfr[0] = *(const bf16x8*)(w2t + (size_t)(64 * h + 16 * nb + ar) * 64 + ak); c_bfr[1] = *(const bf16x8*)(w2t + (size_t)(64 * h + 16 * nb + ar) * 64 + 32 + ak);
                          c_bfr[2] = *(const bf16x8*)(a2t + (size_t)(64 * h + 16 * nb + ar) * 64 + ak); c_bfr[3] = *(const bf16x8*)(a2t + (size_t)(64 * h + 16 * nb + ar) * 64 + 32 + ak); }
          else {
#pragma unroll
              for (int k = 0; k < 4; ++k) c_bfr[k] = *(const bf16x8*)(g2t + (size_t)(64 * h + 16 * nb + ar) * 128 + 32 * k + ak); } }
        c_w0 = *(const f32x2*)(A.in[14] + ch0); c_a0 = *(const f32x2*)(A.in[16] + ch0); c_kk = *(const f32x2*)(A.in[19] + ch0); c_ka = *(const f32x2*)(A.in[20] + ch0); c_rk = *(const f32x2*)(A.in[21] + ch0);
    }
#define PP_SLOTS(...) do { _Pragma("unroll") for (int sl = 0; sl < 2; ++sl) { if (sl == 0 || act1) { \
        LAS unsigned char* L = F.lds + sl * P_SLOT; const int n = nbase + ((id0 + sl * F.G) >> 6); const int r0 = n == 0 ? MR : b * SEQ + 16 * (n - 1); (void)L; (void)n; (void)r0; \
        __VA_ARGS__ } } } while (0)
#pragma unroll
    for (int i = 0; i < 2; ++i) if (ld_ok[i]) { *(LAS v4u*)((LAS bf16*)(F.lds + P_PRL) + ld_pr[i] * PRS + 8 * ld_pc[i]) = pf0[i]; *(LAS v4u*)((LAS bf16*)(F.lds + P_SLOT + P_PRL) + ld_pr[i] * PRS + 8 * ld_pc[i]) = pf1[i]; }
    PP_LOAD(id0 + 2 * F.G, pf0); PP_LOAD(id0 + 3 * F.G, pf1);
    __syncthreads();
    PP_SLOTS({
        LAS bf16* PRL = (LAS bf16*)(L + P_PRL); LAS float* XR = (LAS float*)(L + P_XR); LAS float* XK = (LAS float*)(L + P_XK); LAS float* XV = (LAS float*)(L + P_XV);
        LAS bf16* TW = (LAS bf16*)(L + P_TW); LAS bf16* XA = (LAS bf16*)(L + P_XA); LAS bf16* SG = (LAS bf16*)(L + P_SG);
        const int t2 = tid >> 5, l32 = tid & 31;
        _Pragma("unroll") for (int i = 0; i < 14; ++i) {
            const int c = l32 + 32 * i;
            const float cur = bf2f(PRL[(1 + t2) * PRS + c]), prv = bf2f(PRL[t2 * PRS + c]);
            const float x = cur + (prv - cur) * MU[c];
            if (c < 64) XR[t2 * 64 + c] = x; else if (c < 128) XK[t2 * 64 + c - 64] = x; else if (c < 192) XV[t2 * 64 + c - 128] = x;
            else if (c < 256) { const float e = __expf(2.0f * x); TW[t2 * 72 + c - 192] = (bf16)f2bf(1.0f - 2.0f * __builtin_amdgcn_rcpf(e + 1.0f)); }
            else if (c < 320) XA[t2 * 72 + c - 256] = (bf16)f2bf(x); else SG[t2 * 136 + c - 320] = (bf16)f2bf(sigm(x));
        }
    });
    __syncthreads();
    PP_SLOTS({
        LAS bf16* TW = (LAS bf16*)(L + P_TW); LAS bf16* XA = (LAS bf16*)(L + P_XA); LAS bf16* SG = (LAS bf16*)(L + P_SG);
        LAS float* LW = (LAS float*)(L + P_LW); LAS float* LA = (LAS float*)(L + P_LA); LAS float* LG = (LAS float*)(L + P_LG);
        const int nb = wave & 3, grp = wave >> 2, ar = lane & 15, ak = 8 * (lane >> 4);
        pg8::f32x4 d0 = (pg8::f32x4){0.f, 0.f, 0.f, 0.f}, d1 = d0;
        if (grp == 0) {
            _Pragma("unroll") for (int k = 0; k < 2; ++k) { const bf16x8 af = *(const LAS bf16x8*)(TW + ar * 72 + 32 * k + ak); d0 = __builtin_amdgcn_mfma_f32_16x16x32_bf16(af, c_bfr[k], d0, 0, 0, 0); }
            _Pragma("unroll") for (int k = 0; k < 2; ++k) { const bf16x8 af = *(const LAS bf16x8*)(XA + ar * 72 + 32 * k + ak); d1 = __builtin_amdgcn_mfma_f32_16x16x32_bf16(af, c_bfr[2 + k], d1, 0, 0, 0); }
            _Pragma("unroll") for (int r = 0; r < 4; ++r) { LW[(4 * (lane >> 4) + r) * 64 + 16 * nb + ar] = d0[r]; LA[(4 * (lane >> 4) + r) * 64 + 16 * nb + ar] = d1[r]; }
        } else {
            _Pragma("unroll") for (int k = 0; k < 4; ++k) { const bf16x8 af = *(const LAS bf16x8*)(SG + ar * 136 + 32 * k + ak); d0 = __builtin_amdgcn_mfma_f32_16x16x32_bf16(af, c_bfr[k], d0, 0, 0, 0); }
            _Pragma("unroll") for (int r = 0; r < 4; ++r) LG[(4 * (lane >> 4) + r) * 64 + 16 * nb + ar] = d0[r];
        }
    });
    __syncthreads();
    PP_SLOTS({
        LAS float* XR = (LAS float*)(L + P_XR); LAS float* XK = (LAS float*)(L + P_XK); LAS float* XV = (LAS float*)(L + P_XV);
        LAS float* LW = (LAS float*)(L + P_LW); LAS float* LA = (LAS float*)(L + P_LA); LAS float* LG = (LAS float*)(L + P_LG);
        LAS float* FW = (LAS float*)(L + P_FW); LAS float* FK = (LAS float*)(L + P_FK); LAS float* FA = (LAS float*)(L + P_FA); LAS float* FB = (LAS float*)(L + P_FB);
        LAS bf16* I_VT = (LAS bf16*)(L + P_IMG + IMG_VT);
        const f32x2 lw = *(const LAS f32x2*)(LW + tt * 64 + j0), la = *(const LAS f32x2*)(LA + tt * 64 + j0), lg = *(const LAS f32x2*)(LG + tt * 64 + j0);
        const f32x2 xr = *(const LAS f32x2*)(XR + tt * 64 + j0), xk = *(const LAS f32x2*)(XK + tt * 64 + j0), xv = *(const LAS f32x2*)(XV + tt * 64 + j0);
        const float wd0 = __expf(-0.6065306597126334f * sigm(c_w0.x + lw.x)), wd1 = __expf(-0.6065306597126334f * sigm(c_w0.y + lw.y));
        const float al0 = sigm(c_a0.x + la.x), al1 = sigm(c_a0.y + la.y);
        const float q0 = xk.x * c_kk.x, q1 = xk.y * c_kk.y;
        const float nrm = sum32(q0 * q0 + q1 * q1); const float rn = 1.0f / fmaxf(sqrtf(nrm), 1e-12f);
        const float kk0 = q0 * rn, kk1 = q1 * rn;
        const float kn0 = xk.x * (1.0f + (al0 - 1.0f) * c_ka.x), kn1 = xk.y * (1.0f + (al1 - 1.0f) * c_ka.y);
        const float rkp = sum32(xr.x * kn0 * c_rk.x + xr.y * kn1 * c_rk.y);
        asm volatile("" ::: "memory");
        *(LAS f32x2*)(FW + tt * 64 + j0) = (f32x2){wd0, wd1}; *(LAS f32x2*)(FK + tt * 64 + j0) = (f32x2){kn0, kn1};
        *(LAS f32x2*)(FA + tt * 64 + j0) = (f32x2){-kk0, -kk1}; *(LAS f32x2*)(FB + tt * 64 + j0) = (f32x2){kk0 * al0, kk1 * al1};
        I_VT[j0 * 16 + tt] = (bf16)f2bf(xv.x); I_VT[(j0 + 1) * 16 + tt] = (bf16)f2bf(xv.y);
        if (n > 0 || b == 0) {
            *(unsigned*)((bf16*)(F.ws + WS_G) + (size_t)(r0 + tt) * 512 + ch0) = pk2(lg.x, lg.y);
            if (jp == 0) ((float*)(F.ws + WS_RK))[(size_t)(r0 + tt) * 8 + h] = rkp;
        }
    });
    __syncthreads();
    if (tid < 128) { const int sl = tid >> 6, j = tid & 63; if (sl == 0 || act1) { LAS float* FW = (LAS float*)(F.lds + sl * P_SLOT + P_FW); LAS float* WC = (LAS float*)(F.lds + sl * P_SLOT + P_WC); float wc = 1.0f;
#pragma unroll
        for (int s = 0; s < 16; ++s) { wc *= FW[s * 64 + j]; WC[s * 64 + j] = wc; } } }
    __syncthreads();
    PP_SLOTS({
        LAS float* XR = (LAS float*)(L + P_XR); LAS float* FK = (LAS float*)(L + P_FK); LAS float* FA = (LAS float*)(L + P_FA); LAS float* FB = (LAS float*)(L + P_FB);
        LAS float* WC = (LAS float*)(L + P_WC); LAS bf16* E1 = (LAS bf16*)(L + P_E1); LAS bf16* E2 = (LAS bf16*)(L + P_E2); LAS float* ATF = (LAS float*)(L + P_ATF); LAS float* RTF = (LAS float*)(L + P_RTF);
        LAS bf16* I_BK = (LAS bf16*)(L + P_IMG + IMG_BK); LAS float* I_W16 = (LAS float*)(L + P_IMG + IMG_W16);
        const int s = tt;
        _Pragma("unroll") for (int e = 0; e < 2; ++e) { const int j = j0 + e;
            const float wp = s > 0 ? WC[(s - 1) * 64 + j] : 1.0f, wcv = WC[s * 64 + j], w16 = WC[15 * 64 + j], iw = 1.0f / wcv;
            const float at = wp * FA[s * 64 + j], rt = wcv * XR[s * 64 + j], bh = FB[s * 64 + j] * iw, kh = FK[s * 64 + j] * iw;
            E1[s * 72 + j] = (bf16)f2bf(bh); E1[(16 + s) * 72 + j] = (bf16)f2bf(kh); E2[s * 72 + j] = (bf16)f2bf(at); E2[(16 + s) * 72 + j] = (bf16)f2bf(rt);
            ATF[s * 64 + j] = at; RTF[s * 64 + j] = rt;
            I_BK[j * 32 + s] = (bf16)f2bf(bh * w16); I_BK[j * 32 + 16 + s] = (bf16)f2bf(kh * w16);
            if (s == 0) { const int jt = j >> 5, jj = j & 31, hi_ = (jj >> 2) & 1, r_ = (jj & 3) + 4 * (jj >> 3); I_W16[hi_ * 32 + jt * 16 + r_] = w16; }
        }
    });
    __syncthreads();
    if (wave < 2 && (wave == 0 || act1)) {
        LAS unsigned char* L = F.lds + wave * P_SLOT; LAS bf16* E1 = (LAS bf16*)(L + P_E1); LAS bf16* E2 = (LAS bf16*)(L + P_E2); LAS float* M = (LAS float*)(L + P_M);
        const int m = lane & 31, hh = lane >> 5;
        f32x16 d = (f32x16){0.f,0.f,0.f,0.f,0.f,0.f,0.f,0.f,0.f,0.f,0.f,0.f,0.f,0.f,0.f,0.f};
#pragma unroll
        for (int ks = 0; ks < 4; ++ks) { const bf16x8 af = *(const LAS bf16x8*)(E1 + m * 72 + 16 * ks + 8 * hh), bfv = *(const LAS bf16x8*)(E2 + m * 72 + 16 * ks + 8 * hh); d = __builtin_amdgcn_mfma_f32_32x32x16_bf16(af, bfv, d, 0, 0, 0); }
#pragma unroll
        for (int r = 0; r < 16; ++r) { const int mr = crow(r, hh), nc = m; const int u = mr & 15, s = nc & 15; const bool keep = (nc < 16) ? (u < s) : (u <= s);
            M[mr * 33 + nc] = keep ? d[r] : 0.0f; }
    }
    __syncthreads();
    if ((tid & 63) < 16 && tid < 128 && (tid < 64 || act1)) { const int sl = tid >> 6, rr = tid & 15; LAS float* M = (LAS float*)(F.lds + sl * P_SLOT + P_M); LAS float* T = (LAS float*)(F.lds + sl * P_SLOT + P_T); float t[16];
#pragma unroll
        for (int s = 0; s < 16; ++s) { float acc = (rr == s) ? 1.0f : 0.0f;
#pragma unroll
            for (int u = 0; u < s; ++u) acc += t[u] * M[u * 33 + s];
            t[s] = acc; }
#pragma unroll
        for (int s = 0; s < 16; ++s) T[rr * 17 + s] = t[s]; }
    __syncthreads();
    PP_SLOTS({
        LAS float* ATF = (LAS float*)(L + P_ATF); LAS float* M = (LAS float*)(L + P_M); LAS float* T = (LAS float*)(L + P_T); LAS float* PTF = (LAS float*)(L + P_PTF); LAS float* QF = (LAS float*)(L + P_QF);
        LAS bf16* I_PT = (LAS bf16*)(L + P_IMG + IMG_PT); LAS bf16* I_QT = (LAS bf16*)(L + P_IMG + IMG_QT);
        const int s = tt; float p0 = 0.f, p1 = 0.f;
        _Pragma("unroll") for (int u = 0; u < 16; ++u) { const float tv = T[u * 17 + s]; const f32x2 av = *(const LAS f32x2*)(ATF + u * 64 + j0); p0 += tv * av.x; p1 += tv * av.y; }
        *(LAS f32x2*)(PTF + s * 64 + j0) = (f32x2){p0, p1}; *(LAS unsigned*)(I_PT + s * 64 + j0) = pk2(p0, p1);
        if (tid < 256) { const int u = tid >> 4, sq = tid & 15; float q = 0.f;
            _Pragma("unroll") for (int x = 0; x < 16; ++x) q += M[(16 + u) * 33 + x] * T[x * 17 + sq];
            QF[u * 17 + sq] = q; I_QT[sq * 16 + u] = (bf16)f2bf(q); }
    });
    __syncthreads();
    PP_SLOTS({
        LAS float* RTF = (LAS float*)(L + P_RTF); LAS float* M = (LAS float*)(L + P_M); LAS float* PTF = (LAS float*)(L + P_PTF); LAS float* QF = (LAS float*)(L + P_QF);
        LAS bf16* I_PT = (LAS bf16*)(L + P_IMG + IMG_PT); LAS bf16* I_QT = (LAS bf16*)(L + P_IMG + IMG_QT);
        const int s = tt; const f32x2 rv = *(const LAS f32x2*)(RTF + s * 64 + j0); float p0 = rv.x, p1 = rv.y;
        _Pragma("unroll") for (int u = 0; u < 16; ++u) { const float mv = M[u * 33 + 16 + s]; const f32x2 pv = *(const LAS f32x2*)(PTF + u * 64 + j0); p0 += mv * pv.x; p1 += mv * pv.y; }
        *(LAS unsigned*)(I_PT + (16 + s) * 64 + j0) = pk2(p0, p1);
        if (tid < 256) { const int u = tid >> 4, sq = tid & 15; float q = M[(16 + u) * 33 + 16 + sq];
            _Pragma("unroll") for (int x = 0; x < 16; ++x) q += QF[u * 17 + x] * M[x * 33 + 16 + sq];
            I_QT[(16 + sq) * 16 + u] = (bf16)f2bf(q); }
    });
    __syncthreads();
    PP_SLOTS({
        const int nl = n - nbase;
        unsigned char* dst = F.ws + WS_IMG + ((size_t)chain * NBLK_H1 + nl) * IMG_BYTES;
        for (int q = tid; q < IMG_BYTES / 16; q += NTHR) *(v4u*)(dst + q * 16) = *(const LAS v4u*)(L + P_IMG + q * 16);
    });
    asm volatile("s_waitcnt lgkmcnt(0)\n\ts_barrier" ::: "memory");
    }
#undef PP_LOAD
#undef PP_SLOTS
}

constexpr int SL_PT = 0, SL_BK = 4352, SL_VT = SL_BK + 5120, SL_QT = SL_VT + 3072, SL_W16 = SL_QT + 1536, SL_BUF = SL_W16 + 256;
constexpr int SL_YL = 2 * SL_BUF, SL_END = SL_YL + 2 * 4096;
static_assert((SL_BUF % 16) == 0 && SL_END <= 131072, "scan lds map");

__device__ __forceinline__ void rwkv_scan(Frame& F, CArgs& A, int chain, int nlo, int nhi) {
    const int b = chain >> 3, h = chain & 7;
    const int tid = F.tid, lane = F.lane, wave = F.wave;
    LAS unsigned char* L = F.lds;
    const unsigned char* img0 = F.ws + WS_IMG + (size_t)chain * NBLK_H1 * IMG_BYTES;
    const int cnt = nhi - nlo;
#define S3_BAR() asm volatile("s_waitcnt lgkmcnt(0)\n\ts_barrier" ::: "memory")
    if (wave >= 2) {
        bf16* Y1 = (bf16*)(F.ws + R_Y1);
        const int ht = tid - 128;
        int lsrc[2], ldst[2]; bool lok[2];
#pragma unroll
        for (int i = 0; i < 2; ++i) { const int q = ht + 384 * i; lok[i] = q < IMG_BYTES / 16; lsrc[i] = lok[i] ? q * 16 : 0; int d;
            if (q < 256) d = SL_PT + (q >> 3) * 136 + (q & 7) * 16;
            else if (q < 512) d = SL_BK + ((q - 256) >> 2) * 80 + ((q - 256) & 3) * 16;
            else if (q < 640) d = SL_VT + ((q - 512) >> 1) * 48 + ((q - 512) & 1) * 16;
            else if (q < 704) d = SL_QT + ((q - 640) >> 1) * 48 + ((q - 640) & 1) * 16;
            else d = SL_W16 + (q - 704) * 16;
            ldst[i] = d; }
        const bool pw = wave < 6; const int pt = 4 * ((wave - 2) & 3) + (lane >> 4), pc = 4 * (lane & 15);
        const f32x4 c_lg = *(const f32x4*)(A.in[22] + 64 * h + pc), c_lb = *(const f32x4*)(A.in[23] + 64 * h + pc);
        const bf16* Gp = (const bf16*)(F.ws + WS_G) + 64 * h + pc; const float* RKp = (const float*)(F.ws + WS_RK) + h;
#define S3_LOAD(m, pf) do { const int mm_ = (m) < cnt ? (m) : cnt - 1; const unsigned char* ip_ = img0 + (size_t)mm_ * IMG_BYTES; pf[0] = *(const v4u*)(ip_ + lsrc[0]); pf[1] = *(const v4u*)(ip_ + lsrc[1]); } while (0)
#define S3_LAND(buf, pf) do { *(LAS v4u*)(L + (buf) * SL_BUF + ldst[0]) = pf[0]; if (lok[1]) *(LAS v4u*)(L + (buf) * SL_BUF + ldst[1]) = pf[1]; } while (0)
#define S3_PLOAD(m, gg, xv, rk) do { const int mm_ = (m) < cnt ? (m) : cnt - 1; const int nn_ = nlo + mm_; const size_t r0_ = nn_ == 0 ? (size_t)MR : (size_t)(b * SEQ + 16 * (nn_ - 1)); \
        const unsigned char* vt_ = img0 + (size_t)mm_ * IMG_BYTES + IMG_VT + pc * 32 + pt * 2; \
        gg = *(const v2u*)(Gp + (r0_ + pt) * 512); rk = RKp[(r0_ + pt) * 8]; \
        xv[0] = bf2f(*(const bf16*)(vt_)); xv[1] = bf2f(*(const bf16*)(vt_ + 32)); xv[2] = bf2f(*(const bf16*)(vt_ + 64)); xv[3] = bf2f(*(const bf16*)(vt_ + 96)); } while (0)
#define S3_HELP(m, pfN, ggC, xvC, rkC) do { \
        const int cb = (m) & 1; \
        if ((m) + 1 < cnt) S3_LAND(cb ^ 1, pfN); \
        S3_LOAD((m) + 3, pfN); \
        S3_BAR(); \
        if (pw) { const f32x4 y = *(const LAS f32x4*)(L + SL_YL + cb * 4096 + (pt * 64 + pc) * 4); \
          const int nn_ = nlo + (m); const int r0 = nn_ == 0 ? MR : b * SEQ + 16 * (nn_ - 1); \
          const float mean = sum16((y[0] + y[1]) + (y[2] + y[3])) * (1.0f / 64.0f); const f32x4 d = y - mean; \
          const float var = sum16((d[0] * d[0] + d[1] * d[1]) + (d[2] * d[2] + d[3] * d[3])) * (1.0f / 64.0f); const float rs = rsqrtf(var + 64e-5f); \
          const float g0 = bflo(ggC.x), g1 = bfhi(ggC.x), g2 = bflo(ggC.y), g3 = bfhi(ggC.y); \
          const float o0 = (d[0] * rs * c_lg[0] + c_lb[0] + rkC * xvC[0]) * g0, o1 = (d[1] * rs * c_lg[1] + c_lb[1] + rkC * xvC[1]) * g1, \
                      o2 = (d[2] * rs * c_lg[2] + c_lb[2] + rkC * xvC[2]) * g2, o3 = (d[3] * rs * c_lg[3] + c_lb[3] + rkC * xvC[3]) * g3; \
          if (nn_ > 0 || b == 0) { v2u ov; ov.x = pk2(o0, o1); ov.y = pk2(o2, o3); *(v2u*)(Y1 + (size_t)(r0 + pt) * DM + 512 + 64 * h + pc) = ov; } } \
        S3_PLOAD((m) + 2, ggC, xvC, rkC); \
    } while (0)
        v4u pfA[2], pfB[2]; v2u ggA, ggB; float xvA[4], xvB[4], rkA, rkB;
        S3_LOAD(0, pfA); S3_LAND(0, pfA); S3_LOAD(1, pfB); S3_LOAD(2, pfA);
        S3_PLOAD(0, ggA, xvA, rkA); S3_PLOAD(1, ggB, xvB, rkB);
        S3_BAR();
#pragma unroll 1
        for (int m = 0; m < cnt; m += 2) {
            S3_HELP(m, pfB, ggA, xvA, rkA);
            if (m + 1 < cnt) S3_HELP(m + 1, pfA, ggB, xvB, rkB);
        }
#undef S3_LOAD
#undef S3_LAND
#undef S3_PLOAD
#undef S3_HELP
    } else {
        const int it = wave, qi = lane & 31, hi = lane >> 5;
        f32x16 z0 = (f32x16){0.f,0.f,0.f,0.f,0.f,0.f,0.f,0.f,0.f,0.f,0.f,0.f,0.f,0.f,0.f,0.f}, z1 = z0;
        float* zs = (float*)(F.ws + WS_ZS) + ((size_t)(chain * 2 + it) * 2 * 64 + lane) * 16;
        if (nlo > 0) { z0 = *(const f32x16*)zs; z1 = *(const f32x16*)(zs + 64 * 16); }
        S3_BAR();
#define S3_PK(dst, zz, o) do { dst.x = pg8::cvt_pk_bf16(zz[o + 0], zz[o + 1]); dst.y = pg8::cvt_pk_bf16(zz[o + 2], zz[o + 3]); dst.z = pg8::cvt_pk_bf16(zz[o + 4], zz[o + 5]); dst.w = pg8::cvt_pk_bf16(zz[o + 6], zz[o + 7]); } while (0)
#pragma unroll 1
        for (int m = 0; m < cnt; ++m) {
            const int cb = m & 1;
            const LAS unsigned char* B_ = L + cb * SL_BUF;
            const bf16x8 vfr = *(const LAS bf16x8*)(B_ + SL_VT + (32 * it + qi) * 48 + hi * 16);
            const bf16x8 qf = *(const LAS bf16x8*)(B_ + SL_QT + qi * 48 + hi * 16);
            v4u aw[4];
#pragma unroll
            for (int ks = 0; ks < 4; ++ks) {
                const LAS unsigned char* pp = B_ + SL_PT + qi * 136 + (16 * ks + 4 * hi) * 2;
                const v2u lo = *(const LAS v2u*)pp, hh = *(const LAS v2u*)(pp + 16); aw[ks] = (v4u){lo.x, lo.y, hh.x, hh.y}; }
            v4u bw[2]; bf16x8 kf[2]; f32x4 wv[2][4];
            const LAS float* w16 = (const LAS float*)(B_ + SL_W16) + hi * 32;
#pragma unroll
            for (int jt = 0; jt < 2; ++jt) { const LAS unsigned char* bp = B_ + SL_BK + (32 * jt + qi) * 80;
                const v2u lo = *(const LAS v2u*)(bp + 8 * hi), hh = *(const LAS v2u*)(bp + 16 + 8 * hi); bw[jt] = (v4u){lo.x, lo.y, hh.x, hh.y};
                kf[jt] = *(const LAS bf16x8*)(bp + 32 + 16 * hi);
#pragma unroll
                for (int r4 = 0; r4 < 4; ++r4) wv[jt][r4] = *(const LAS f32x4*)(w16 + jt * 16 + 4 * r4); }
            __builtin_amdgcn_sched_barrier(0);
            v4u zb[4]; S3_PK(zb[0], z0, 0); S3_PK(zb[1], z0, 8); S3_PK(zb[2], z1, 0); S3_PK(zb[3], z1, 8);
            f32x16 acc = (f32x16){0.f,0.f,0.f,0.f,0.f,0.f,0.f,0.f,0.f,0.f,0.f,0.f,0.f,0.f,0.f,0.f};
            acc = __builtin_amdgcn_mfma_f32_32x32x16_bf16(qf, vfr, acc, 0, 0, 0);
#pragma unroll
            for (int ks = 0; ks < 4; ++ks) acc = __builtin_amdgcn_mfma_f32_32x32x16_bf16(__builtin_bit_cast(bf16x8, aw[ks]), __builtin_bit_cast(bf16x8, zb[ks]), acc, 0, 0, 0);
            f32x16 zn0, zn1;
#pragma unroll
            for (int r4 = 0; r4 < 4; ++r4)
#pragma unroll
                for (int e = 0; e < 4; ++e) { zn0[4 * r4 + e] = z0[4 * r4 + e] * wv[0][r4][e]; zn1[4 * r4 + e] = z1[4 * r4 + e] * wv[1][r4][e]; }
            { LAS float* YL = (LAS float*)(L + SL_YL + cb * 4096);
#pragma unroll
              for (int r = 8; r < 16; ++r) YL[(crow(r, hi) - 16) * 64 + 32 * it + qi] = acc[r]; }
            v4u sab; S3_PK(sab, acc, 0);
            zn0 = __builtin_amdgcn_mfma_f32_32x32x16_bf16(kf[0], vfr, zn0, 0, 0, 0);
            zn1 = __builtin_amdgcn_mfma_f32_32x32x16_bf16(kf[1], vfr, zn1, 0, 0, 0);
            zn0 = __builtin_amdgcn_mfma_f32_32x32x16_bf16(__builtin_bit_cast(bf16x8, bw[0]), __builtin_bit_cast(bf16x8, sab), zn0, 0, 0, 0);
            zn1 = __builtin_amdgcn_mfma_f32_32x32x16_bf16(__builtin_bit_cast(bf16x8, bw[1]), __builtin_bit_cast(bf16x8, sab), zn1, 0, 0, 0);
            z0 = zn0; z1 = zn1;
            S3_BAR();
        }
        if (nhi < NBLK) { *(f32x16*)zs = z0; *(f32x16*)(zs + 64 * 16) = z1; }
#undef S3_PK
    }
#undef S3_BAR
    __syncthreads();
}

__device__ __forceinline__ void final_phase(Frame& F, CArgs& A) {
    const float* part = (const float*)(F.ws + WS_PART); const float* gf = A.in[4]; float* out = F.out; const float* hin = (const float*)(F.ws + WS_HFIN);
    const int gw = F.wg * NWAVES + F.wave, NGW = F.G * NWAVES, lane = F.lane;
    f32x4 gv[4];
#pragma unroll
    for (int j = 0; j < 4; ++j) gv[j] = *(const f32x4*)(gf + j * 256 + lane * 4);
    for (int row = gw; row < MR; row += NGW) {
        const float rs = pg8::row_rstd(part, row);
#pragma unroll
        for (int j = 0; j < 4; ++j) { const size_t o = (size_t)row * DM + j * 256 + lane * 4; *(f32x4*)(out + o) = *(const f32x4*)(hin + o) * rs * gv[j]; }
    }
}

__device__ __forceinline__ void meta_res_gemm(Frame& F, const bf16* Aop, int lda, const bf16* Bop, int ldb, int K, float* hmeta, bf16* Abuf, float* part, int mode, int g) {
    const int lane = F.lane, wave = F.wave, nb = wave & 3, kh = wave >> 2, kq = 8 * (lane >> 4), r16 = lane & 15;
    const int khalf = K / 2, k0 = kh * khalf, nks = khalf / 32;
    const bf16* ap = Aop + (size_t)(MR + r16) * lda + k0 + kq;
    const bf16* bp = Bop + (size_t)(64 * g + 16 * nb + r16) * ldb + k0 + kq;
    pg8::f32x4 d = (pg8::f32x4){0.f, 0.f, 0.f, 0.f};
#pragma unroll 4
    for (int k = 0; k < nks; ++k) { const bf16x8 af = *(const bf16x8*)(ap + 32 * k); const bf16x8 bfv = *(const bf16x8*)(bp + 32 * k); d = __builtin_amdgcn_mfma_f32_16x16x32_bf16(af, bfv, d, 0, 0, 0); }
    LAS float* red = (LAS float*)F.lds;
    if (kh == 1) *(LAS pg8::f32x4*)(red + (nb * 64 + lane) * 4) = d;
    __syncthreads();
    if (kh == 0) {
        const pg8::f32x4 o = *(const LAS pg8::f32x4*)(red + (nb * 64 + lane) * 4); d += o;
        const int col = 64 * g + 16 * nb + r16;
#pragma unroll
        for (int r = 0; r < 4; ++r) { const int row = 4 * (lane >> 4) + r; float h = hmeta[(size_t)row * DM + col] + d[r]; hmeta[(size_t)row * DM + col] = h; d[r] = h;
            if (mode) Abuf[(size_t)(MR + row) * DM + col] = (bf16)f2bf(h); }
    }
    __syncthreads();
    if (mode) {
        if (kh == 0) {
#pragma unroll
            for (int r = 0; r < 4; ++r) { const float ss = sum16(d[r] * d[r]); if (r16 == 0) red[(4 * (lane >> 4) + r) * 4 + nb] = ss; }
        }
        __syncthreads();
        if (F.tid < 16) { const pg8::f32x4 v = *(const LAS pg8::f32x4*)(red + F.tid * 4); part[(size_t)(MR + F.tid) * 16 + g] = (v[0] + v[1]) + (v[2] + v[3]); }
        __syncthreads();
    }
}

#ifdef NO_ATTN
#define ATTN_UNIT(b, k, q) do { } while (0)
#else
#define ATTN_UNIT(b, k, q) attn_unit(F, A.in[12], (b), (k), (q))
#endif
constexpr int N_PHASES = 17;
#ifndef RES_SP2
#define RES_SP2 true
#endif
#ifndef DBGLAST
#define DBGLAST 6
#endif
#ifndef DBG15
#define DBG15 3
#endif
#ifndef DBG_NPH
#define DBG_NPH 18
#endif
__global__ void __launch_bounds__(NTHR, 2) hyb_fwd(Args args) {
    extern __shared__ __attribute__((aligned(16))) unsigned char lds[];
    const int lo = args.ph_lo, hi = args.ph_hi;
#if MK_N_LAUNCHES == 1
    {
        for (int u = threadIdx.x; u < (LDS_BYTES - LDSCTL_OFF) / 4; u += NTHR) ((LAS unsigned*)((LAS unsigned char*)lds + LDSCTL_OFF))[u] = 0u;
        __syncthreads();
        if (threadIdx.x == 0) (void)xb_add(&((unsigned*)(args.ws + WS_CTL))[1024 + XB_XCNT(xb_xcc_id())], 1u);
    }
#endif
    const int wave_s = __builtin_amdgcn_readfirstlane(threadIdx.x >> 6);
#ifndef PROBE_MASK
#define PROBE_MASK 0u
#endif
#pragma unroll 1
    for (int pq = 2 * lo; pq < 2 * hi; ++pq) {
        const int p = pq >> 1; if ((pq & 1) && !((PROBE_MASK >> p) & 1u)) continue;
#define PHF() CArgs* ap_ = (CArgs*)__builtin_amdgcn_kernarg_segment_ptr(); asm volatile("" : "+s"(ap_)); CArgs& A = *ap_; \
        unsigned z_; asm volatile("s_mov_b32 %0, 0" : "=s"(z_)); \
        Frame F; F.tid = (wave_s << 6) | (int)__builtin_amdgcn_mbcnt_hi(~0u, __builtin_amdgcn_mbcnt_lo(~0u, z_)); asm volatile("" : "+v"(F.tid)); \
        F.lds = (LAS unsigned char*)lds; F.lane = F.tid & 63; F.wave = __builtin_amdgcn_readfirstlane(F.tid >> 6); F.G = gridDim.x; F.wg = blockIdx.x; F.out = A.out; F.ws = A.ws; \
        unsigned char* ws = A.ws; float* part = (float*)(ws + WS_PART); float* hmeta = (float*)(ws + WS_HMETA); pg8::bf16_t* Abuf = (pg8::bf16_t*)(ws + WS_A); (void)part; (void)hmeta; (void)Abuf
        int kind, layer = 0, ch = 0, sub = 2;
        switch (p) {
            case 0: kind = 0; break; case 1: kind = 1; break; case 2: kind = 2; break; case 3: kind = 3; sub = 0; break;
            case 4: kind = 4; break; case 5: kind = 5; break; case 6: kind = 3; break;
            case 7: kind = 6; break; case 8: kind = 7; break; case 9: kind = 9; break; case 10: kind = 7; ch = 1; break; case 11: kind = 9; ch = 1; break;
            case 12: kind = 3; sub = 1; break;
            case 13: kind = 4; layer = 1; break; case 14: kind = 5; layer = 1; break; case 15: kind = 3; layer = 1; break;
            default: kind = 8; break;
        }
        if (kind == 0) { PHF(); p0_prologue(F, A); }
        else if (kind == 1) { PHF(); pg8::Gemm g{Abuf, (const pg8::bf16_t*)(ws + W_IN0), MP, NIN, DM, DM, DM}; pg8::StaticOrder S; S.init(MP, NIN, F.G, F.wg);
            pg8::EpiIn0 E{(pg8::bf16_t*)(ws + R_U), (pg8::bf16_t*)(ws + R_WC), (pg8::bf16_t*)(ws + R_GB), part};
            pg8::gemm_phase<pg8::EpiIn0, pg8::StaticOrder, true, true, DM, DM, DM>(F.lds, g, S, E, F.tid); }
        else if (kind == 2) { PHF(); conv0_phase(F, A); }
        else if (kind == 3) { PHF();
            const bool o0 = (sub == 0), o1 = (sub == 1), od = (sub == 2);
            const pg8::bf16_t* Aop = (const pg8::bf16_t*)(ws + (o0 ? R_Y0 : o1 ? R_Y1 : R_HM));
            const pg8::bf16_t* Bop = (const pg8::bf16_t*)(ws + (o0 ? W_OUT0 : o1 ? W_OUT1 : (layer ? W_DN1 : W_DN0)));
            const int Kd = od ? DFF : DM, ldbd = od ? DFF : DM;
            const float* base = o0 ? A.in[0] : (const float*)A.out;
            const pg8::Gemm g{Aop, Bop, MP, DM, Kd, Kd, ldbd};
            pg8::StaticOrder S; S.init(MR, DM, F.G, F.wg);
            const bool lastres = od && layer == 1;
            pg8::EpiRes E{base, lastres ? (float*)(ws + WS_HFIN) : (float*)A.out, hmeta, Abuf, part, 1, o0 ? 1 : 0, lastres ? 1 : 0};
            if (od) pg8::gemm_phase<pg8::EpiRes, pg8::StaticOrder, true, RES_SP2, DFF, DFF, DFF>(F.lds, g, S, E, F.tid);
            else pg8::gemm_phase<pg8::EpiRes, pg8::StaticOrder, true, RES_SP2, DM, DM, DM>(F.lds, g, S, E, F.tid);
            if (blockIdx.x < 16 && !(pq & 1)) {
                CArgs* am_ = (CArgs*)__builtin_amdgcn_kernarg_segment_ptr(); asm volatile("" : "+s"(am_)); unsigned char* wsm = am_->ws;
                unsigned zm_; asm volatile("s_mov_b32 %0, 0" : "=s"(zm_));
                Frame Fm; Fm.tid = (wave_s << 6) | (int)__builtin_amdgcn_mbcnt_hi(~0u, __builtin_amdgcn_mbcnt_lo(~0u, zm_)); asm volatile("" : "+v"(Fm.tid));
                Fm.lds = (LAS unsigned char*)lds; Fm.lane = Fm.tid & 63; Fm.wave = __builtin_amdgcn_readfirstlane(Fm.tid >> 6); Fm.G = gridDim.x; Fm.wg = blockIdx.x; Fm.out = nullptr; Fm.ws = wsm;
                const bf16* Am = (const bf16*)(wsm + (o0 ? R_Y0 : o1 ? R_Y1 : R_HM));
                const bf16* Bm = (const bf16*)(wsm + (o0 ? W_OUT0 : o1 ? W_OUT1 : (layer ? W_DN1 : W_DN0)));
                meta_res_gemm(Fm, Am, od ? DFF : DM, Bm, od ? DFF : DM, od ? DFF : DM, (float*)(wsm + WS_HMETA), (bf16*)(wsm + WS_A), (float*)(wsm + WS_PART), 1, (int)blockIdx.x);
            } }
        else if (kind == 4) { PHF(); pg8::Gemm g{Abuf, (const pg8::bf16_t*)(ws + (layer ? W_UP1 : W_UP0)), MP, 2 * DFF, DM, DM, DM}; pg8::StaticOrder S; S.init(MP, 2 * DFF, F.G, F.wg);
            pg8::EpiUpConv E{ws, A.in[26] + (size_t)layer * 3 * DFF, A.in[27] + (size_t)layer * DFF};
            pg8::gemm_phase<pg8::EpiUpConv, pg8::StaticOrder, true, true, DM, DM, DM>(F.lds, g, S, E, F.tid); }
        else if (kind == 5) { PHF(); ffn_fix_phase(F, A, layer); }
        else if (kind == 6) { PHF(); pg8::Gemm g{Abuf, (const pg8::bf16_t*)(ws + W_IN1), MP, NIN, DM, DM, DM}; pg8::StaticOrder S; S.init(MP, NIN, F.G, F.wg);
            pg8::EpiIn1 E{(pg8::bf16_t*)(ws + R_Q), (pg8::bf16_t*)(ws + R_KB), (pg8::bf16_t*)(ws + R_VB), (pg8::bf16_t*)(ws + R_PR), part, (const float*)(ws + WS_ROPE), (const float*)(ws + WS_ROPE) + TT * 32};
            pg8::gemm_phase<pg8::EpiIn1, pg8::StaticOrder, true, true, DM, DM, DM>(F.lds, g, S, E, F.tid); }
        else if (kind == 7) { PHF();
            const int cnt = ch == 0 ? NBLK_H1 : NBLK - NBLK_H1, nbase = ch == 0 ? 0 : NBLK_H1;
            rwkv_prep_phase(F, A, nbase, cnt);
        }
        else if (kind == 9) { PHF();
            const int NCH = 64;
            if (F.G > NCH && F.wg < NCH) rwkv_scan(F, A, F.wg, ch == 0 ? 0 : NBLK_H1, ch == 0 ? NBLK_H1 : NBLK);
            else {
                if (F.G <= NCH) for (int c = F.wg; c < NCH; c += F.G) rwkv_scan(F, A, c, ch == 0 ? 0 : NBLK_H1, ch == 0 ? NBLK_H1 : NBLK);
                if (ch == 0) { const int NAW = F.G > NCH ? F.G - NCH : F.G, aw = F.G > NCH ? F.wg - NCH : F.wg;
                    for (int id = aw; id < 514; id += NAW) { if (id < 512) ATTN_UNIT(id >> 6, (id >> 5) & 1, id & 31); else ATTN_UNIT(0, id - 512, -1); } }
            }
        }
        else if (kind == 8) { PHF(); final_phase(F, A); }
#if MK_N_LAUNCHES == 1
        if (pq + 1 < 2 * hi) {
            if (hi > 1000) cg::this_grid().sync();
            CArgs* ab_ = (CArgs*)__builtin_amdgcn_kernarg_segment_ptr(); asm volatile("" : "+s"(ab_));
            unsigned zb_; asm volatile("s_mov_b32 %0, 0" : "=s"(zb_));
            const bool t0 = (wave_s == 0) && (__builtin_amdgcn_mbcnt_hi(~0u, __builtin_amdgcn_mbcnt_lo(~0u, zb_)) == 0u);
            xcd_barrier((unsigned*)(ab_->ws + WS_CTL) + 1024, (volatile LAS unsigned*)((LAS unsigned char*)lds + MISC_OFF) + 8, t0);
        }
#endif
    }
}

extern "C" void kernel_launch(void* const* d_in, const int* in_sizes, int n_in, void* d_out, int out_size, void* d_ws, size_t ws_size, hipStream_t stream) {
    static int grid = 0;
    if (grid == 0) {
        if (n_in != 29 || out_size != MR * DM || ws_size < WS_END) { fprintf(stderr, "kernel_launch: unexpected shapes (n_in %d out %d ws %zu)\n", n_in, out_size, ws_size); grid = -1; return; }
        int dev = 0, cus = 0, per_cu = 0;
        if (hipGetDevice(&dev) != hipSuccess || hipDeviceGetAttribute(&cus, hipDeviceAttributeMultiprocessorCount, dev) != hipSuccess) { grid = -1; return; }
        if (hipFuncSetAttribute((const void*)hyb_fwd, hipFuncAttributeMaxDynamicSharedMemorySize, LDS_BYTES) != hipSuccess) { fprintf(stderr, "kernel_launch: hipFuncSetAttribute failed\n"); grid = -1; return; }
        if (hipOccupancyMaxActiveBlocksPerMultiprocessor(&per_cu, (const void*)hyb_fwd, NTHR, LDS_BYTES) != hipSuccess || per_cu < 1) { fprintf(stderr, "kernel_launch: occupancy query says %d\n", per_cu); per_cu = 1; }
        (void)hipGetLastError();
        grid = cus;
    }
    if (grid < 0) return;
    Args a{};
    for (int i = 0; i < 29; ++i) a.in[i] = (const float*)d_in[i];
    a.out = (float*)d_out; a.ws = (unsigned char*)d_ws;
#if MK_N_LAUNCHES == 1
    if (hipMemsetAsync((char*)d_ws + WS_CTL, 0, 65536, stream) != hipSuccess) { fprintf(stderr, "kernel_launch: memset failed\n"); return; }
    a.ph_lo = 0; a.ph_hi = N_PHASES;
    void* kargs[] = {&a};
    hipError_t e = hipLaunchCooperativeKernel((const void*)hyb_fwd, dim3(grid), dim3(NTHR), kargs, LDS_BYTES, stream);
    if (e != hipSuccess) fprintf(stderr, "cooperative launch failed: %s (grid %d)\n", hipGetErrorString(e), grid);
#else
    for (int p = 0; p < N_PHASES; ++p) { a.ph_lo = p; a.ph_hi = p + 1; hipLaunchKernelGGL(hyb_fwd, dim3(grid), dim3(NTHR), LDS_BYTES, stream, a); }
#endif
}
```

```cpp
#include <hip/hip_runtime.h>
#include <hip/hip_cooperative_groups.h>
#include <cstdio>
#include <cstdint>
namespace cg = cooperative_groups;

#ifndef MK_N_LAUNCHES
#define MK_N_LAUNCHES 1
#endif

constexpr int NB = 8, SEQ = 2048, NMETA = 16, TT = SEQ + NMETA, DM = 1024;
constexpr int MR = NB * SEQ;
constexpr int MP = MR + 256;
constexpr int DFF = 2816, FCH = 1408;
constexpr int NIN = 2560;
constexpr int PRW = 1792;

constexpr size_t EO_PART = (size_t)1 << 20, EO_HM = (size_t)89 << 20, EO_EDGE_G = EO_HM + (size_t)MP * DFF * 2, EO_EDGE_V = EO_EDGE_G + (size_t)65 * 2 * DFF * 4, EO_HALO = EO_EDGE_V + (size_t)65 * 2 * DFF * 4;
namespace pg8 {
#define PG8_LAS __attribute__((address_space(3)))
typedef unsigned short bf16_t;
typedef short bf16x8 __attribute__((ext_vector_type(8)));
typedef float f32x4 __attribute__((ext_vector_type(4)));
typedef unsigned u32x4 __attribute__((ext_vector_type(4)));
constexpr int BM = 256, BK = 64, HALF = 128, HTB = HALF * BK * 2  , STAGE_BYTES = 8 * HTB, NXCD = 8, WGM = 8;

__host__ __device__ __forceinline__ int lds_byte(int r, int c) { const int st = (r >> 4) * 2 + (c >> 5), rr = r & 15, cc = c & 31, ob = rr * 64 + cc * 2; return st * 1024 + (ob ^ (((ob >> 9) & 1) << 5)); }
__host__ __device__ __forceinline__ void stage_rc(int b, int& R, int& C) { const int st = b / 1024, sb = b % 1024, swz = sb ^ (((sb >> 9) & 1) << 5); R = (st >> 1) * 16 + swz / 64; C = (st & 1) * 32 + (swz % 64) / 2; }
__host__ __device__ __forceinline__ int perm32(int rho) { const int n = rho >> 4, i = rho & 15; return 8 * (i >> 2) + 4 * n + (i & 3); }

struct Unit { int pm, pn; };
struct Gemm { const bf16_t* A; const bf16_t* Bt; int M, N, K, lda, ldb; };

struct StaticOrder {
    int nM, nN, nwg, G, c;
    __host__ __device__ void init(int M, int N, int G_, int c_) { nM = M / BM; nN = N / BM; nwg = nM * nN; G = G_; c = c_; }
    __host__ __device__ bool next(int i, Unit& u) const {
        const long L = (long)i * G + c; if (L >= nwg) return false;
        int wgid = (int)L; { const int q = nwg / NXCD, r = nwg % NXCD, xcd = wgid % NXCD, off = wgid / NXCD; wgid = (xcd < r ? xcd * (q + 1) : r * (q + 1) + (xcd - r) * q) + off; }
        const int nig = WGM * nN, gid = wgid / nig, fm = gid * WGM, gsz = (nM - fm) < WGM ? (nM - fm) : WGM;
        u.pm = fm + ((wgid % nig) % gsz); u.pn = (wgid % nig) / gsz; return true;
    }
    __device__ __forceinline__ void a_ready(const Unit&) const {}
    __device__ __forceinline__ void done(const Unit&) const {}
};

__device__ __forceinline__ unsigned cvt_pk_bf16(float lo, float hi) { unsigned r; asm volatile("v_cvt_pk_bf16_f32 %0, %1, %2" : "=v"(r) : "v"(lo), "v"(hi)); return r; }
__device__ __forceinline__ u32x4 pack8(const f32x4 a, const f32x4 b) { u32x4 w; w.x = cvt_pk_bf16(a[0], a[1]); w.y = cvt_pk_bf16(a[2], a[3]); w.z = cvt_pk_bf16(b[0], b[1]); w.w = cvt_pk_bf16(b[2], b[3]); return w; }
__device__ __forceinline__ float sigmoidf_(float x) { return __builtin_amdgcn_rcpf(1.0f + __expf(-x)); }
__device__ __forceinline__ f32x4 sig4(const f32x4 x) { return (f32x4){sigmoidf_(x[0]), sigmoidf_(x[1]), sigmoidf_(x[2]), sigmoidf_(x[3])}; }
__device__ __forceinline__ float row_rstd(const float* part, int row) {
    const f32x4* p = (const f32x4*)(part + (size_t)row * 16); const f32x4 a = p[0], b = p[1], c = p[2], d = p[3];
    const float s = ((a[0] + a[1]) + (a[2] + a[3])) + ((b[0] + b[1]) + (b[2] + b[3])) + ((c[0] + c[1]) + (c[2] + c[3])) + ((d[0] + d[1]) + (d[2] + d[3]));
    return rsqrtf(s * (1.0f / 1024.0f) + 1e-6f);
}
__device__ __forceinline__ int tpos_of_row(int row) { return row < MR ? (NMETA + (row & (SEQ - 1))) : (row < MR + NMETA ? row - MR : 0); }

struct EpiIn0 {
    static constexpr bool PERM = true, AFTER_DRAIN = false;
    bf16_t* U; bf16_t* WC; bf16_t* GB; const float* part;
    __device__ __forceinline__ void operator()(const f32x4 (&acc)[2][2][4][2], const Unit& u, int wr, int wc, int fr, int fq) const {
        const int row0 = u.pm * BM + wr * 64 + fr;
#pragma unroll
        for (int ai = 0; ai < 2; ++ai)
#pragma unroll
            for (int m = 0; m < 4; ++m) {
                const int row = row0 + ai * HALF + m * 16; const float rs = row_rstd(part, row);
                if (u.pn < 8) {
                    bf16_t* dst = (u.pn < 4 ? U : WC) + (size_t)row * 512 + (u.pn & 3) * 128 + wc * 32 + 8 * fq;
                    const f32x4 a0 = acc[ai][0][m][0] * rs, a1 = acc[ai][0][m][1] * rs, b0 = acc[ai][1][m][0] * rs, b1 = acc[ai][1][m][1] * rs;
                    f32x4 o0, o1;
                    if (u.pn < 4) { o0 = a0 * sig4(b0); o1 = a1 * sig4(b1); } else { o0 = a0 * b0; o1 = a1 * b1; }
                    *(u32x4*)dst = pack8(o0, o1);
                } else {
#pragma unroll
                    for (int bj = 0; bj < 2; ++bj) { bf16_t* dst = GB + (size_t)row * 512 + (u.pn - 8) * 256 + bj * HALF + wc * 32 + 8 * fq;
                        *(u32x4*)dst = pack8(acc[ai][bj][m][0] * rs, acc[ai][bj][m][1] * rs); }
                }
            }
    }
};
struct EpiRes {
    static constexpr bool PERM = true, AFTER_DRAIN = false;
    const float* base; float* out; float* hmeta; bf16_t* Abuf; float* part; int mode; int in_nat, out_nat;
    __device__ __forceinline__ void operator()(const f32x4 (&acc)[2][2][4][2], const Unit& u, int wr, int wc, int fr, int fq) const {
        const size_t tb = (size_t)(u.pm * 4 + u.pn) * 65536; const int wl = ((wr * 4 + wc) * 64 + fq * 16 + fr) * 8;
#pragma unroll
        for (int ai = 0; ai < 2; ++ai)
#pragma unroll
            for (int m = 0; m < 4; ++m) {
                const int lr = wr * 64 + fr + ai * HALF + m * 16, row = u.pm * BM + lr; float ss = 0.f;
#pragma unroll
                for (int bj = 0; bj < 2; ++bj) { const int col = u.pn * BM + bj * HALF + wc * 32 + 8 * fq;
                    const size_t nat = (size_t)row * DM + col, blk = tb + (size_t)(((ai * 4 + m) * 2 + bj) * 4096) + wl;
                    const float* ip = base + (in_nat ? nat : blk); float* op = out + (out_nat ? nat : blk);
                    f32x4 h0 = *(const f32x4*)ip, h1 = *(const f32x4*)(ip + 4);
                    h0 += acc[ai][bj][m][0]; h1 += acc[ai][bj][m][1];
                    *(f32x4*)op = h0; *(f32x4*)(op + 4) = h1;
                    if (mode) { ss += (h0[0] * h0[0] + h0[1] * h0[1]) + (h0[2] * h0[2] + h0[3] * h0[3]) + (h1[0] * h1[0] + h1[1] * h1[1]) + (h1[2] * h1[2] + h1[3] * h1[3]);
                        *(u32x4*)(Abuf + (size_t)row * DM + col) = pack8(h0, h1); } }
                if (mode) { ss += __shfl_xor(ss, 16); ss += __shfl_xor(ss, 32); if (fq == 0) part[(size_t)row * 16 + u.pn * 4 + wc] = ss; }
            }
    }
};
__device__ __forceinline__ float dpp_ror1(float x) { return __builtin_bit_cast(float, __builtin_amdgcn_update_dpp(0, __builtin_bit_cast(int, x), 0x121, 0xF, 0xF, false)); }
__device__ __forceinline__ float dpp_ror2(float x) { return __builtin_bit_cast(float, __builtin_amdgcn_update_dpp(0, __builtin_bit_cast(int, x), 0x122, 0xF, 0xF, false)); }
__device__ __forceinline__ f32x4 ror1_4(const f32x4 v) { return (f32x4){dpp_ror1(v[0]), dpp_ror1(v[1]), dpp_ror1(v[2]), dpp_ror1(v[3])}; }
__device__ __forceinline__ f32x4 ror2_4(const f32x4 v) { return (f32x4){dpp_ror2(v[0]), dpp_ror2(v[1]), dpp_ror2(v[2]), dpp_ror2(v[3])}; }
__device__ __forceinline__ f32x4 silu4(const f32x4 z) { return z * sig4(z); }
struct EpiUpConv {
    static constexpr bool PERM = true, AFTER_DRAIN = false;
    unsigned char* ws; const float* cw; const float* cb;
    __device__ __forceinline__ void operator()(const f32x4 (&acc)[2][2][4][2], const Unit& u, int wr, int wc, int fr, int fq) const {
        bf16_t* HM = (bf16_t*)(ws + EO_HM); float* EDGE_G = (float*)(ws + EO_EDGE_G); float* EDGE_V = (float*)(ws + EO_EDGE_V); float* HALO = (float*)(ws + EO_HALO); const float* part = (const float*)(ws + EO_PART);
        const int c0 = u.pn * 128 + wc * 32 + 8 * fq, row0 = u.pm * BM + wr * 64 + fr;
        PG8_LAS f32x4* X = (PG8_LAS f32x4*)131072;
        if (fr >= 14) {
#pragma unroll
            for (int ai = 0; ai < 2; ++ai) { const float rs = row_rstd(part, row0 + ai * HALF + 48); const int sidx = ((((2 * ai + wr) * 2 + (fr - 14)) * 4 + wc) * 4 + fq) * 2; X[sidx] = acc[ai][0][3][0] * rs; X[sidx + 1] = acc[ai][0][3][1] * rs;
                if (ai == 1 && u.pm < 64 && wr == 1) { float* hp = HALO + ((size_t)(u.pm * 2 + (fr - 14))) * 2816 + c0; *(f32x4*)hp = acc[1][0][3][0] * rs; *(f32x4*)(hp + 4) = acc[1][0][3][1] * rs; } }
            if (u.pm == 64 && wr == 0) { const float rs = row_rstd(part, row0); float* hp = HALO + ((size_t)(64 * 2 + (fr - 14))) * 2816 + c0; *(f32x4*)hp = acc[0][0][0][0] * rs; *(f32x4*)(hp + 4) = acc[0][0][0][1] * rs; }
        }
        asm volatile("s_waitcnt lgkmcnt(0)\n\ts_barrier" ::: "memory");
        const f32x4 w0a = *(const f32x4*)(cw + c0), w0b = *(const f32x4*)(cw + c0 + 4), w1a = *(const f32x4*)(cw + 2816 + c0), w1b = *(const f32x4*)(cw + 2816 + c0 + 4),
                    w2a = *(const f32x4*)(cw + 5632 + c0), w2b = *(const f32x4*)(cw + 5632 + c0 + 4), bba = *(const f32x4*)(cb + c0), bbb = *(const f32x4*)(cb + c0 + 4);
#pragma unroll
        for (int ai = 0; ai < 2; ++ai) {
            const int sg = 2 * ai + wr;
            f32x4 x15a = (f32x4){0.f, 0.f, 0.f, 0.f}, x15b = x15a, x14a = x15a, x14b = x15a;
            if (sg > 0 && fr < 2) { const int b15 = ((((sg - 1) * 2 + 1) * 4 + wc) * 4 + fq) * 2, b14 = ((((sg - 1) * 2 + 0) * 4 + wc) * 4 + fq) * 2; x15a = X[b15]; x15b = X[b15 + 1]; x14a = X[b14]; x14b = X[b14 + 1]; }
            f32x4 q1a = x15a, q1b = x15b, q2a = x14a, q2b = x14b;
#pragma unroll
            for (int m = 0; m < 4; ++m) {
                const int row = row0 + ai * HALF + m * 16; const float rs = row_rstd(part, row);
                const f32x4 ga = acc[ai][0][m][0] * rs, gb = acc[ai][0][m][1] * rs;
                const f32x4 r1a = ror1_4(ga), r1b = ror1_4(gb), r2a = ror2_4(ga), r2b = ror2_4(gb);
                f32x4 p1a = r1a, p1b = r1b, p2a = r2a, p2b = r2b;
                if (m > 0) { if (fr < 1) { p1a = q1a; p1b = q1b; } if (fr < 2) { p2a = q2a; p2b = q2b; } }
                else { if (fr == 0) { p1a = x15a; p1b = x15b; p2a = x14a; p2b = x14b; } else if (fr == 1) { p2a = x15a; p2b = x15b; } }
                q1a = r1a; q1b = r1b; q2a = r2a; q2b = r2b;
                const f32x4 va = acc[ai][1][m][0] * rs, vb = acc[ai][1][m][1] * rs;
                if (sg == 0 && m == 0 && fr < 2) {
                    float* eg = EDGE_G + ((size_t)(u.pm * 2 + fr)) * 2816 + c0; float* ev = EDGE_V + ((size_t)(u.pm * 2 + fr)) * 2816 + c0;
                    *(f32x4*)eg = ga; *(f32x4*)(eg + 4) = gb; *(f32x4*)ev = va; *(f32x4*)(ev + 4) = vb;
                } else {
                    const f32x4 za = w0a * p2a + w1a * p1a + w2a * ga + bba, zb = w0b * p2b + w1b * p1b + w2b * gb + bbb;
                    *(u32x4*)(HM + (size_t)row * 2816 + c0) = pack8(silu4(za) * va, silu4(zb) * vb);
                }
                asm volatile("" ::: "memory");
            }
        }
    }
};
struct EpiIn1 {
    static constexpr bool PERM = true, AFTER_DRAIN = false;
    bf16_t* Q; bf16_t* KB; bf16_t* VB; bf16_t* PR; const float* part; const float* ropec; const float* ropes;
    __device__ __forceinline__ void operator()(const f32x4 (&acc)[2][2][4][2], const Unit& u, int wr, int wc, int fr, int fq) const {
        const int row0 = u.pm * BM + wr * 64 + fr;
#pragma unroll
        for (int ai = 0; ai < 2; ++ai)
#pragma unroll
            for (int m = 0; m < 4; ++m) {
                const int row = row0 + ai * HALF + m * 16; const float rs = row_rstd(part, row);
                if (u.pn >= 3) {
#pragma unroll
                    for (int bj = 0; bj < 2; ++bj) *(u32x4*)(PR + (size_t)row * PRW + (u.pn - 3) * 256 + bj * HALF + wc * 32 + 8 * fq) = pack8(acc[ai][bj][m][0] * rs, acc[ai][bj][m][1] * rs);
                } else {
                    const f32x4 a0 = acc[ai][0][m][0] * rs, a1 = acc[ai][0][m][1] * rs, b0 = acc[ai][1][m][0] * rs, b1 = acc[ai][1][m][1] * rs;
                    if (u.pn == 2 && wc >= 2) {
                        bf16_t* dst = VB + (size_t)row * 128 + (wc - 2) * 64 + 8 * fq;
                        *(u32x4*)dst = pack8(a0, a1); *(u32x4*)(dst + 32) = pack8(b0, b1);
                    } else {
                        const int t = tpos_of_row(row);
                        const f32x4 c0 = *(const f32x4*)(ropec + t * 32 + 8 * fq), c1 = *(const f32x4*)(ropec + t * 32 + 8 * fq + 4);
                        const f32x4 s0 = *(const f32x4*)(ropes + t * 32 + 8 * fq), s1 = *(const f32x4*)(ropes + t * 32 + 8 * fq + 4);
                        const f32x4 x0 = a0 * c0 - b0 * s0, x1 = a1 * c1 - b1 * s1, y0 = b0 * c0 + a0 * s0, y1 = b1 * c1 + a1 * s1;
                        bf16_t* dst = (u.pn == 2) ? KB + (size_t)row * 128 + wc * 64 + 8 * fq : Q + (size_t)row * 512 + (u.pn * 4 + wc) * 64 + 8 * fq;
                        *(u32x4*)dst = pack8(x0, x1); *(u32x4*)(dst + 32) = pack8(y0, y1);
                    }
                }
            }
    }
};

template <class Epi, class Sched, bool ALIGN_EPI = false, bool SP2 = false, int CK = 0, int CLDA = 0, int CLDB = 0>
__device__ __forceinline__ void gemm_phase(PG8_LAS unsigned char* lds, const Gemm g, const Sched& S, const Epi& E, const int tid_in) {
    int tid_ = tid_in; asm volatile("" : "+v"(tid_));
    const int tid = tid_, wid = __builtin_amdgcn_readfirstlane(tid >> 6), lane = tid & 63, wr = wid >> 2, wc = wid & 3, fr = lane & 15, fq = lane >> 4;
    const int K = CK ? CK : g.K, nt = K / BK; const int lda_ = CLDA ? CLDA : g.lda, ldb_ = CLDB ? CLDB : g.ldb;
    unsigned voffA[2], voffB[2];
#pragma unroll
    for (int i = 0; i < 2; ++i) { int R, C; stage_rc(tid * 16 + i * 8192, R, C); const int Rb = Epi::PERM ? ((R & ~31) + perm32(R & 31)) : R;
        voffA[i] = (unsigned)(R * lda_ + C) * 2u; voffB[i] = (unsigned)(Rb * ldb_ + C) * 2u; }
    const size_t kstep = (size_t)(BK * 2);
    const size_t hstepA = (size_t)HALF * lda_ * 2, hstepB = (size_t)HALF * ldb_ * 2;
    const size_t tstepA = 2 * hstepA, tstepB = 2 * hstepB;
    const unsigned ldsw = (unsigned)wid * 1024u;
    const int aoff = lds_byte(wr * 64 + fr, fq * 8), boff = lds_byte(wc * 32 + fr, fq * 8);
#define PG8_SA(b, h) (((b) * 2 + (h)) * HTB)
#define PG8_SB(b, h) ((4 + (b) * 2 + (h)) * HTB)
#define PG8_STAGE(bufoff, gbase, voff) do { _Pragma("unroll") for (int _i = 0; _i < 2; ++_i) \
        __builtin_amdgcn_global_load_lds((const unsigned*)((const char*)(gbase) + (voff)[_i]), (PG8_LAS unsigned*)(lds + (bufoff) + ldsw + _i * 8192), 16, 0, 0); } while (0)
#define PG8_LDA(dst, b, h) do { _Pragma("unroll") for (int m = 0; m < 4; ++m) _Pragma("unroll") for (int k = 0; k < 2; ++k) dst[m][k] = *(const PG8_LAS bf16x8*)(lds + PG8_SA(b, h) + aoff + m * 2048 + k * 1024); } while (0)
#define PG8_LDB(dst, b, h) do { _Pragma("unroll") for (int n = 0; n < 2; ++n) _Pragma("unroll") for (int k = 0; k < 2; ++k) dst[n][k] = *(const PG8_LAS bf16x8*)(lds + PG8_SB(b, h) + boff + n * 2048 + k * 1024); } while (0)
#define PG8_MMA(ai, bj, At, Bt) do { __builtin_amdgcn_s_setprio(1); _Pragma("unroll") for (int m = 0; m < 4; ++m) _Pragma("unroll") for (int n = 0; n < 2; ++n) _Pragma("unroll") for (int k = 0; k < 2; ++k) \
        acc[ai][bj][m][n] = __builtin_amdgcn_mfma_f32_16x16x32_bf16(Bt[n][k], At[m][k], acc[ai][bj][m][n], 0, 0, 0); __builtin_amdgcn_s_setprio(0); } while (0)
#define PG8_WAIT_V(n) asm volatile("s_waitcnt vmcnt(" #n ")" ::: "memory")
#define PG8_WAIT_L(n) asm volatile("s_waitcnt lgkmcnt(" #n ")" ::: "memory")
#define PG8_BAR __builtin_amdgcn_s_barrier()
#define PG8_SCHED __builtin_amdgcn_sched_barrier(0)
    Unit cur, nxt; int ui = 0;
    if (!S.next(0, cur)) return;
    f32x4 acc[2][2][4][2];
#pragma unroll
    for (int a = 0; a < 2; ++a)
#pragma unroll
        for (int b = 0; b < 2; ++b)
#pragma unroll
            for (int m = 0; m < 4; ++m)
#pragma unroll
                for (int n = 0; n < 2; ++n) acc[a][b][m][n] = (f32x4){0.f, 0.f, 0.f, 0.f};
    bf16x8 At[4][2], B0[2][2], B1[2][2];
    const char* cA = (const char*)g.A + (size_t)cur.pm * tstepA; const char* cB = (const char*)g.Bt + (size_t)cur.pn * tstepB;
    S.a_ready(cur);
    if constexpr (SP2) {
        PG8_STAGE(PG8_SB(0, 0), cB, voffB); PG8_STAGE(PG8_SB(0, 1), cB + hstepB, voffB); PG8_STAGE(PG8_SA(0, 0), cA, voffA); PG8_STAGE(PG8_SA(0, 1), cA + hstepA, voffA);
        if (wr == 1) PG8_BAR;
        PG8_WAIT_V(2); PG8_BAR;
        PG8_STAGE(PG8_SB(1, 0), cB + kstep, voffB); PG8_STAGE(PG8_SA(1, 0), cA + kstep, voffA); PG8_STAGE(PG8_SB(1, 1), cB + hstepB + kstep, voffB);
        PG8_WAIT_V(6); PG8_BAR;
    } else {
        PG8_STAGE(PG8_SB(0, 0), cB, voffB); PG8_STAGE(PG8_SA(0, 0), cA, voffA); PG8_STAGE(PG8_SB(0, 1), cB + hstepB, voffB); PG8_STAGE(PG8_SA(0, 1), cA + hstepA, voffA);
        if (wr == 1) PG8_BAR;
        PG8_WAIT_V(4); PG8_BAR;
        PG8_STAGE(PG8_SB(1, 0), cB + kstep, voffB); PG8_STAGE(PG8_SA(1, 0), cA + kstep, voffA); PG8_STAGE(PG8_SB(1, 1), cB + hstepB + kstep, voffB);
        PG8_WAIT_V(6); PG8_BAR;
    }
    for (;;) {
        const bool has_next = S.next(ui + 1, nxt);
        const char* nA = has_next ? (const char*)g.A + (size_t)nxt.pm * tstepA : cA; const char* nB = has_next ? (const char*)g.Bt + (size_t)nxt.pn * tstepB : cB;
        for (int t = 0; t < nt; t += 2) {
            const bool last = (t == nt - 2);
            const char* a1 = cA + (size_t)(t + 1) * kstep;
            const char* a2 = last ? nA : cA + (size_t)(t + 2) * kstep; const char* b2 = last ? nB : cB + (size_t)(t + 2) * kstep;
            const char* a3 = a2 + kstep; const char* b3 = b2 + kstep;
            if (last && has_next) S.a_ready(nxt);
            if constexpr (SP2) {
            PG8_LDB(B0, 0, 0); PG8_LDB(B1, 0, 1); PG8_SCHED; PG8_LDA(At, 0, 0); PG8_STAGE(PG8_SA(1, 1), a1 + hstepA, voffA);
            PG8_WAIT_V(8); PG8_WAIT_L(0); PG8_BAR; PG8_MMA(0, 0, At, B0); PG8_MMA(0, 1, At, B1); PG8_BAR; PG8_SCHED;
            PG8_LDA(At, 0, 1); PG8_STAGE(PG8_SB(0, 0), b2, voffB); PG8_STAGE(PG8_SB(0, 1), b2 + hstepB, voffB); PG8_STAGE(PG8_SA(0, 0), a2, voffA);
            PG8_WAIT_V(8); PG8_WAIT_L(0); PG8_BAR; PG8_MMA(1, 0, At, B0); PG8_MMA(1, 1, At, B1); PG8_BAR; PG8_SCHED;
            PG8_LDB(B0, 1, 0); PG8_LDB(B1, 1, 1); PG8_SCHED; PG8_LDA(At, 1, 0); PG8_STAGE(PG8_SA(0, 1), a2 + hstepA, voffA);
            PG8_WAIT_V(8); PG8_WAIT_L(0); PG8_BAR; PG8_MMA(0, 0, At, B0); PG8_MMA(0, 1, At, B1); PG8_BAR; PG8_SCHED;
            PG8_LDA(At, 1, 1); PG8_STAGE(PG8_SB(1, 0), b3, voffB); PG8_STAGE(PG8_SB(1, 1), b3 + hstepB, voffB); PG8_STAGE(PG8_SA(1, 0), a3, voffA);
            PG8_WAIT_V(8); PG8_WAIT_L(0); PG8_BAR; PG8_MMA(1, 0, At, B0); PG8_MMA(1, 1, At, B1); PG8_BAR; PG8_SCHED;
            } else {
            PG8_LDB(B0, 0, 0); PG8_SCHED; PG8_LDA(At, 0, 0); PG8_STAGE(PG8_SA(1, 1), a1 + hstepA, voffA);
            PG8_WAIT_L(8); PG8_BAR; PG8_WAIT_L(0); PG8_MMA(0, 0, At, B0); PG8_BAR; PG8_SCHED;
            PG8_LDB(B1, 0, 1); PG8_STAGE(PG8_SB(0, 0), b2, voffB);
            PG8_BAR; PG8_WAIT_L(0); PG8_MMA(0, 1, At, B1); PG8_BAR;
            PG8_LDA(At, 0, 1); PG8_STAGE(PG8_SA(0, 0), a2, voffA);
            PG8_BAR; PG8_WAIT_L(0); PG8_MMA(1, 0, At, B0); PG8_BAR; PG8_SCHED;
            PG8_STAGE(PG8_SB(0, 1), b2 + hstepB, voffB);
            PG8_WAIT_V(6); PG8_BAR; PG8_MMA(1, 1, At, B1); PG8_BAR;
            PG8_LDB(B0, 1, 0); PG8_SCHED; PG8_LDA(At, 1, 0); PG8_STAGE(PG8_SA(0, 1), a2 + hstepA, voffA);
            PG8_WAIT_L(8); PG8_BAR; PG8_WAIT_L(0); PG8_MMA(0, 0, At, B0); PG8_BAR; PG8_SCHED;
            PG8_LDB(B1, 1, 1); PG8_STAGE(PG8_SB(1, 0), b3, voffB);
            PG8_BAR; PG8_WAIT_L(0); PG8_MMA(0, 1, At, B1); PG8_BAR;
            PG8_LDA(At, 1, 1); PG8_STAGE(PG8_SA(1, 0), a3, voffA);
            PG8_BAR; PG8_WAIT_L(0); PG8_MMA(1, 0, At, B0); PG8_BAR; PG8_SCHED;
            PG8_STAGE(PG8_SB(1, 1), b3 + hstepB, voffB);
            PG8_WAIT_V(6); PG8_BAR; PG8_MMA(1, 1, At, B1); PG8_BAR;
            }
        }
        if constexpr (ALIGN_EPI) { if (wr == 0) PG8_BAR; }
        if constexpr (!Epi::AFTER_DRAIN) { E(acc, cur, wr, wc, fr, fq); S.done(cur); }
        if (!has_next) break;
#pragma unroll
        for (int a = 0; a < 2; ++a)
#pragma unroll
            for (int b = 0; b < 2; ++b)
#pragma unroll
                for (int m = 0; m < 4; ++m)
#pragma unroll
                    for (int n = 0; n < 2; ++n) acc[a][b][m][n] = (f32x4){0.f, 0.f, 0.f, 0.f};
        cur = nxt; cA = nA; cB = nB; ++ui;
        if constexpr (ALIGN_EPI) { if (wr == 1) PG8_BAR; }
    }
    PG8_WAIT_V(0);
    if constexpr (!ALIGN_EPI) { if (wr == 0) PG8_BAR; }
    PG8_BAR;
    if constexpr (Epi::AFTER_DRAIN) { E.fused(acc, cur, wr, wc, fr, fq, lds, wid, lane); S.done(cur); }
#undef PG8_SA
#undef PG8_SB
#undef PG8_STAGE
#undef PG8_LDA
#undef PG8_LDB
#undef PG8_MMA
#undef PG8_WAIT_V
#undef PG8_WAIT_L
#undef PG8_BAR
#undef PG8_SCHED
}
}

constexpr int NWAVES = 8, NTHR = 512;
constexpr int LDS_BYTES = 147456;
#define GAS __attribute__((address_space(1)))
#define LAS __attribute__((address_space(3)))
typedef unsigned short bf16;
typedef unsigned v4u __attribute__((ext_vector_type(4)));
typedef unsigned v2u __attribute__((ext_vector_type(2)));
typedef float f32x4 __attribute__((ext_vector_type(4)));
typedef float f32x2 __attribute__((ext_vector_type(2)));
typedef float f32x16 __attribute__((ext_vector_type(16)));
typedef short bf16x8 __attribute__((ext_vector_type(8)));
typedef short s16x4 __attribute__((ext_vector_type(4)));

constexpr size_t MiB = 1u << 20;
constexpr size_t WS_CTL = 0;
constexpr size_t WS_PART = 1 * MiB;
constexpr size_t WS_ROPE = 3 * MiB;
constexpr size_t WS_HMETA = 4 * MiB;
constexpr size_t WS_LORA = 5 * MiB;
constexpr size_t WS_W = 6 * MiB;
constexpr size_t W_IN0 = WS_W, W_OUT0 = W_IN0 + (size_t)NIN * DM * 2, W_UP0 = W_OUT0 + (size_t)DM * DM * 2, W_DN0 = W_UP0 + (size_t)2 * DFF * DM * 2,
                 W_IN1 = W_DN0 + (size_t)DM * DFF * 2, W_OUT1 = W_IN1 + (size_t)NIN * DM * 2, W_UP1 = W_OUT1 + (size_t)DM * DM * 2, W_DN1 = W_UP1 + (size_t)2 * DFF * DM * 2,
                 W_END = W_DN1 + (size_t)DM * DFF * 2;
constexpr size_t WS_A = 56 * MiB;
constexpr size_t WS_R = 89 * MiB;
static_assert(W_END <= WS_A && WS_A + (size_t)MP * DM * 2 <= WS_R, "ws map");
constexpr size_t R_U = WS_R, R_WC = R_U + (size_t)MP * 512 * 2, R_GB = R_WC + (size_t)MP * 512 * 2, R_Y0 = R_GB + (size_t)MP * 512 * 2;
constexpr size_t R_HM = WS_R, R_EDGE_G = R_HM + (size_t)MP * DFF * 2, R_EDGE_V = R_EDGE_G + (size_t)65 * 2 * DFF * 4, R_HALO = R_EDGE_V + (size_t)65 * 2 * DFF * 4, R_FFN_END = R_HALO + (size_t)65 * 2 * DFF * 4;
constexpr size_t R_Q = WS_R, R_KB = R_Q + (size_t)MP * 512 * 2, R_VB = R_KB + (size_t)MP * 128 * 2, R_PR = R_VB + (size_t)MP * 128 * 2, R_Y1 = R_PR + (size_t)MP * PRW * 2, R_L1_END = R_Y1 + (size_t)MP * DM * 2;
constexpr size_t WS_END = 256 * MiB;
constexpr size_t WS_HFIN = 184 * MiB;
static_assert(EO_PART == WS_PART && EO_HM == R_HM && EO_EDGE_G == R_EDGE_G && EO_EDGE_V == R_EDGE_V && EO_HALO == R_HALO, "epilogue offsets");
static_assert(R_FFN_END <= WS_HFIN && WS_HFIN + (size_t)MR * DM * 4 <= WS_END, "final stream buffer");
static_assert(R_FFN_END <= WS_END && R_L1_END <= WS_END && R_Y0 + (size_t)MP * DM * 2 <= WS_END, "ws map 2");

#define LDS_WAIT() asm volatile("s_waitcnt lgkmcnt(0)" ::: "memory")
__device__ __forceinline__ unsigned f2bf(float f) { unsigned u = __builtin_bit_cast(unsigned, f); return (u + 0x7fffu + ((u >> 16) & 1u)) >> 16; }
__device__ __forceinline__ unsigned pk2(float lo, float hi) { return f2bf(lo) | (f2bf(hi) << 16); }
__device__ __forceinline__ float bf2f(unsigned short v) { return __builtin_bit_cast(float, (unsigned)v << 16); }
__device__ __forceinline__ float bflo(unsigned w) { return __builtin_bit_cast(float, w << 16); }
__device__ __forceinline__ float bfhi(unsigned w) { return __builtin_bit_cast(float, w & 0xffff0000u); }
__device__ __forceinline__ float sigm(float x) { return __builtin_amdgcn_rcpf(1.0f + __expf(-x)); }
__device__ __forceinline__ float dppf(float x, int ctrl_sel) {
    const int v = __builtin_bit_cast(int, x); int r;
    if (ctrl_sel == 0) r = __builtin_amdgcn_update_dpp(v, v, 0xB1, 0xF, 0xF, false);
    else if (ctrl_sel == 1) r = __builtin_amdgcn_update_dpp(v, v, 0x4E, 0xF, 0xF, false);
    else if (ctrl_sel == 2) r = __builtin_amdgcn_update_dpp(v, v, 0x141, 0xF, 0xF, false);
    else r = __builtin_amdgcn_update_dpp(v, v, 0x140, 0xF, 0xF, false);
    return __builtin_bit_cast(float, r);
}
__device__ __forceinline__ float sum16(float x) { x += dppf(x, 0); x += dppf(x, 1); x += dppf(x, 2); x += dppf(x, 3); return x; }

__device__ __forceinline__ void sum16x2(float& x0, float& x1) {
    asm volatile("s_nop 1\n\t"
        "v_add_f32_dpp %0, %0, %0 quad_perm:[1,0,3,2] row_mask:0xf bank_mask:0xf\n\t"
        "v_add_f32_dpp %1, %1, %1 quad_perm:[1,0,3,2] row_mask:0xf bank_mask:0xf\n\t"
        "s_nop 0\n\t"
        "v_add_f32_dpp %0, %0, %0 quad_perm:[2,3,0,1] row_mask:0xf bank_mask:0xf\n\t"
        "v_add_f32_dpp %1, %1, %1 quad_perm:[2,3,0,1] row_mask:0xf bank_mask:0xf\n\t"
        "s_nop 0\n\t"
        "v_add_f32_dpp %0, %0, %0 row_half_mirror row_mask:0xf bank_mask:0xf\n\t"
        "v_add_f32_dpp %1, %1, %1 row_half_mirror row_mask:0xf bank_mask:0xf\n\t"
        "s_nop 0\n\t"
        "v_add_f32_dpp %0, %0, %0 row_mirror row_mask:0xf bank_mask:0xf\n\t"
        "v_add_f32_dpp %1, %1, %1 row_mirror row_mask:0xf bank_mask:0xf\n\t"
        "s_nop 1"
        : "+v"(x0), "+v"(x1));
}
__device__ __forceinline__ float sum32(float x) { x = sum16(x); x += __shfl_xor(x, 16); return x; }
__device__ __forceinline__ float wave_sum(float v) {
#pragma unroll
    for (int o = 1; o < 64; o <<= 1) v += __shfl_xor(v, o);
    return v;
}
__device__ __forceinline__ int row_of(int b, int t) { return t >= NMETA ? b * SEQ + (t - NMETA) : MR + t; }


#define XB_TMO      128
#define XB_XCNT(j)  (256  + 64 * (j))
#define XB_XSUB(j)  (1280 + 64 * (j))
#define XB_XGEN(j)  (2304 + 64 * (j))
#define XB_TOP      3328
#define XB_TOPGEN   3392
#define XCD_BAR_WORDS 3456
#define XB_SPIN_CAP (1u << 18)
constexpr int LDSCTL_OFF = 147328, MISC_OFF = LDSCTL_OFF;
__device__ __forceinline__ unsigned xb_ld(unsigned* p)              { return __hip_atomic_load(p, __ATOMIC_RELAXED, __HIP_MEMORY_SCOPE_AGENT); }
__device__ __forceinline__ unsigned xb_add(unsigned* p, unsigned v) { return __hip_atomic_fetch_add(p, v, __ATOMIC_RELAXED, __HIP_MEMORY_SCOPE_AGENT); }
__device__ __forceinline__ unsigned xb_xcc_id() { return (unsigned)__builtin_amdgcn_s_getreg((3 << 11) | 20) & 0xFu; }
#define XB_SPIN(cond, bar) do { unsigned _sp = 0; while (cond) { __builtin_amdgcn_s_sleep(1); \
    if ((++_sp & 255u) == 0u) { if (xb_ld(&(bar)[XB_TMO])) break; if (_sp > XB_SPIN_CAP) { atomicAdd(&(bar)[XB_TMO], 1u); break; } } } } while (0)
__device__ __forceinline__ void xcd_barrier_complete(unsigned* bar, unsigned x, unsigned& nloc, unsigned& nx) {
    const unsigned G = gridDim.x * gridDim.y * gridDim.z;
    unsigned sum, cnt, mine, sp = 0u;
    for (;;) {
        sum = 0u; cnt = 0u; mine = 0u;
#pragma unroll
        for (unsigned j = 0; j < 16; ++j) { const unsigned c = xb_ld(&bar[XB_XCNT(j)]); sum += c; cnt += (c > 0u) ? 1u : 0u; mine = (j == x) ? c : mine; }
        if (sum == G) break;
        __builtin_amdgcn_s_sleep(1);
        if ((++sp & 255u) == 0u) { if (xb_ld(&bar[XB_TMO])) break; if (sp > XB_SPIN_CAP) { atomicAdd(&bar[XB_TMO], 1u); break; } }
    }
    nloc = mine > 0u ? mine : 1u; nx = cnt > 0u ? cnt : 1u;
}
__device__ __forceinline__ void xcd_barrier(unsigned* bar, volatile LAS unsigned* st, bool t0) {
    asm volatile("s_waitcnt vmcnt(0)" ::: "memory");
    __syncthreads();
    if (t0) {
        const unsigned x = xb_xcc_id();
        __builtin_amdgcn_s_waitcnt(0);
        unsigned nloc = st[0], nx = st[1];
        if (nloc == 0u) { xcd_barrier_complete(bar, x, nloc, nx); st[0] = nloc; st[1] = nx; }
        const unsigned old = xb_add(&bar[XB_XSUB(x)], 1u);
        const unsigned gen = old / nloc;
        if (old + 1u == (gen + 1u) * nloc) {
            __builtin_amdgcn_fence(__ATOMIC_RELEASE, "agent");
            asm volatile("s_waitcnt vmcnt(0)" ::: "memory");
            const unsigned og = xb_add(&bar[XB_TOP], 1u);
            const unsigned tg = og / nx;
            if (og + 1u == (tg + 1u) * nx) xb_add(&bar[XB_TOPGEN], 1u);
            else XB_SPIN(xb_ld(&bar[XB_TOPGEN]) == tg, bar);
            __builtin_amdgcn_fence(__ATOMIC_ACQUIRE, "agent");
            xb_add(&bar[XB_XGEN(x)], 1u);
            asm volatile("s_waitcnt vmcnt(0)" ::: "memory");
        } else {
            XB_SPIN(xb_ld(&bar[XB_XGEN(x)]) == gen, bar);
            __builtin_amdgcn_fence(__ATOMIC_ACQUIRE, "agent");
            asm volatile("s_waitcnt vmcnt(0)" ::: "memory");
        }
    }
    __syncthreads();
}

struct Args { const float* in[29]; float* out; unsigned char* ws; int ph_lo, ph_hi; };
typedef const __attribute__((address_space(4))) Args CArgs;

struct Frame {
    LAS unsigned char* lds; int tid, lane, wave, G, wg;
    float* out; unsigned char* ws;
};

__device__ __forceinline__ int colmap(int kind, int d) {
    if (kind == 0) return d;
    const int tile = d >> 8, bj = (d >> 7) & 1, cc = d & 127;
    if (kind == 1) {
        if (tile < 4) return (bj ? 512 : 0) + 128 * tile + cc;
        if (tile < 8) return (bj ? 2048 : 1536) + 128 * (tile - 4) + cc;
        return 1024 + (d - 2048);
    }
    if (kind == 2) return (bj ? DFF : 0) + 128 * tile + cc;
    const int w = cc >> 5, dd = cc & 31;
    if (tile < 2) return 64 * (4 * tile + w) + 32 * bj + dd;
    if (tile == 2) return (w < 2 ? 512 + 64 * w : 640 + 64 * (w - 2)) + 32 * bj + dd;
    return d;
}
__device__ __forceinline__ void p0_transpose_item(const float* W, int K, int N, bf16* WT, const float* gvec, int kind, LAS float* scr, int item, int nblk, int lane) {
    const int kb = item / nblk, db = item % nblk, k0 = 64 * kb, d0 = 32 * db, n0 = colmap(kind, d0);
#pragma unroll 8
    for (int i = 0; i < 32; ++i) { const int kk = 2 * i + (lane >> 5); float v = W[(size_t)(k0 + kk) * N + n0 + (lane & 31)]; if (gvec) v *= gvec[k0 + kk]; scr[kk * 33 + (lane & 31)] = v; }
    LDS_WAIT(); asm volatile("" ::: "memory");
    const int c = lane & 7;
#pragma unroll
    for (int j = 0; j < 4; ++j) { const int n = (lane >> 3) + 8 * j; const LAS float* s = scr + (8 * c) * 33 + n;
        v4u o; o.x = pk2(s[0 * 33], s[1 * 33]); o.y = pk2(s[2 * 33], s[3 * 33]); o.z = pk2(s[4 * 33], s[5 * 33]); o.w = pk2(s[6 * 33], s[7 * 33]);
        *(GAS v4u*)(WT + (size_t)(d0 + n) * K + k0 + 8 * c) = o; }
    LDS_WAIT(); asm volatile("" ::: "memory");
}
__device__ __forceinline__ void p0_job(Frame& F, LAS float* scr, int gw, int NGW, int& base, const float* W, int K, int N, size_t dst, const float* g, int kind) {
    const int nblk = N / 32, nitems = (K / 64) * nblk;
    int it = gw - (base % NGW); if (it < 0) it += NGW;
    for (; it < nitems; it += NGW) p0_transpose_item(W, K, N, (bf16*)(F.ws + dst), g, kind, scr, it, nblk, F.lane);
    base += nitems;
}
__device__ __forceinline__ void p0_prologue(Frame& F, CArgs& A) {
    LAS float* scr = (LAS float*)(F.lds + F.wave * 16384);
    const int gw = F.wg * NWAVES + F.wave, NGW = F.G * NWAVES, lane = F.lane;
    unsigned char* ws = F.ws;
    const float* norm_mix = A.in[2]; const float* norm_ffn = A.in[3];
    int base = 0;
    p0_job(F, scr, gw, NGW, base, A.in[5], DM, NIN, W_IN0, norm_mix, 1);
    p0_job(F, scr, gw, NGW, base, A.in[10], DM, DM, W_OUT0, nullptr, 0);
    p0_job(F, scr, gw, NGW, base, A.in[25], DM, 2 * DFF, W_UP0, norm_ffn, 2);
    p0_job(F, scr, gw, NGW, base, A.in[28], DFF, DM, W_DN0, nullptr, 0);
    p0_job(F, scr, gw, NGW, base, A.in[11], DM, NIN, W_IN1, norm_mix + DM, 3);
    p0_job(F, scr, gw, NGW, base, A.in[24], DM, DM, W_OUT1, nullptr, 0);
    p0_job(F, scr, gw, NGW, base, A.in[25] + (size_t)DM * 2 * DFF, DM, 2 * DFF, W_UP1, norm_ffn + DM, 2);
    p0_job(F, scr, gw, NGW, base, A.in[28] + (size_t)DFF * DM, DFF, DM, W_DN1, nullptr, 0);
    p0_job(F, scr, gw, NGW, base, A.in[15], 64, 512, WS_LORA, nullptr, 0);
    p0_job(F, scr, gw, NGW, base, A.in[17], 64, 512, WS_LORA + 512 * 64 * 2, nullptr, 0);
    p0_job(F, scr, gw, NGW, base, A.in[18], 128, 512, WS_LORA + 2 * 512 * 64 * 2, nullptr, 0);
    const float* x = A.in[0]; const float* meta = A.in[1];
    bf16* A0 = (bf16*)(ws + WS_A); float* part = (float*)(ws + WS_PART); float* hmeta = (float*)(ws + WS_HMETA);
    for (int row = gw; row < MP; row += NGW) {
        float* pp = part + (size_t)row * 16;
        if (row < MR + NMETA) {
            const float* src = row < MR ? x + (size_t)row * DM : meta + (size_t)(row - MR) * DM;
            float ss = 0.f;
#pragma unroll
            for (int j = 0; j < 4; ++j) { const f32x4 v = *(const GAS f32x4*)(src + j * 256 + lane * 4); ss += (v[0] * v[0] + v[1] * v[1]) + (v[2] * v[2] + v[3] * v[3]);
                v2u o; o.x = pk2(v[0], v[1]); o.y = pk2(v[2], v[3]); *(GAS v2u*)(A0 + (size_t)row * DM + j * 256 + lane * 4) = o;
                if (row >= MR) *(GAS f32x4*)(hmeta + (size_t)(row - MR) * DM + j * 256 + lane * 4) = v; }
            ss = wave_sum(ss);
            if (lane < 16) pp[lane] = lane == 0 ? ss : 0.f;
        } else {
            if (lane < 16) pp[lane] = 0.f;
#pragma unroll
            for (int j = 0; j < 4; ++j) { float zf; asm volatile("v_mov_b32 %0, 0" : "=v"(zf)); *(GAS f32x4*)(hmeta + (size_t)(row - MR) * DM + j * 256 + lane * 4) = (f32x4){zf, zf, zf, zf}; }
        }
    }
    float* rc = (float*)(ws + WS_ROPE); float* rsn = rc + TT * 32;
    for (int i = gw * 64 + lane; i < TT * 32; i += NGW * 64) {
        const int t = i >> 5, d = i & 31;
        const float inv = exp2f(-(float)d * (13.287712379549449f / 32.0f));
        const float ang = (float)t * inv;
        const float rev = ang * 0.15915494309189535f; const float a = (rev - floorf(rev)) * 6.283185307179586f;
        rc[i] = __cosf(a); rsn[i] = __sinf(a);
    }
}

__device__ __forceinline__ void conv0_phase(Frame& F, CArgs& A) {
    const bf16* U = (const bf16*)(F.ws + R_U); const bf16* WC = (const bf16*)(F.ws + R_WC); const bf16* GB = (const bf16*)(F.ws + R_GB); bf16* Y0 = (bf16*)(F.ws + R_Y0);
    const float* conv_a = A.in[6]; const float* ln_g = A.in[7]; const float* ln_b = A.in[8]; const float* conv_b = A.in[9];
    const int half = F.tid >> 8, ht = F.tid & 255, c0 = 2 * ht;
    LAS float* tile = (LAS float*)(F.lds + half * 40960);
    LAS float* stats = (LAS float*)(F.lds + half * 40960 + 32768);
    float wa[31][2];
#pragma unroll
    for (int j = 0; j < 31; ++j) { const f32x2 w = *(const f32x2*)(conv_a + j * 512 + c0); wa[j][0] = w.x; wa[j][1] = w.y; }
    float wb[3][2];
#pragma unroll
    for (int j = 0; j < 3; ++j) { const f32x2 w = *(const f32x2*)(conv_b + j * 512 + c0); wb[j][0] = w.x; wb[j][1] = w.y; }
    const f32x2 lg = *(const f32x2*)(ln_g + c0), lb = *(const f32x2*)(ln_b + c0);
    const int NU = NB * 128 + 1;
    const int nhu = 2 * F.G;
    for (int u0 = 0; u0 < NU; u0 += nhu) {
        const int u = u0 + F.wg * 2 + half; const bool act = u < NU;
        int b = 0, t0 = 0; if (act) { if (u == NB * 128) { b = 0; t0 = 0; } else { b = u >> 7; t0 = 16 + 16 * (u & 127); } }
        if (act) {
            unsigned uin[46];
#pragma unroll
            for (int i = 0; i < 46; ++i) { const int t = t0 - 30 + i; uin[i] = t >= 0 ? *(const unsigned*)(U + (size_t)row_of(b, t) * 512 + c0) : 0u; }
#pragma unroll
            for (int o = 0; o < 16; ++o) { float a0 = 0.f, a1 = 0.f;
#pragma unroll
                for (int j = 0; j < 31; ++j) { a0 += wa[j][0] * bflo(uin[o + j]); a1 += wa[j][1] * bfhi(uin[o + j]); }
                *(LAS f32x2*)(tile + o * 512 + c0) = (f32x2){a0, a1}; }
        }
        __syncthreads();
        if (act) {
            const int tok = ht >> 4, q = ht & 15; float s = 0.f, ss = 0.f;
#pragma unroll
            for (int i = 0; i < 8; ++i) { const f32x4 v = *(const LAS f32x4*)(tile + tok * 512 + i * 64 + q * 4); s += (v[0] + v[1]) + (v[2] + v[3]); ss += (v[0] * v[0] + v[1] * v[1]) + (v[2] * v[2] + v[3] * v[3]); }
            s = sum16(s); ss = sum16(ss);
            if (q == 0) { const float mu = s * (1.f / 512.f); float var = ss * (1.f / 512.f) - mu * mu; var = var < 0.f ? 0.f : var; stats[tok * 2] = mu; stats[tok * 2 + 1] = rsqrtf(var + 1e-5f); }
        }
        __syncthreads();
        if (act) {
            unsigned win[18];
#pragma unroll
            for (int i = 0; i < 18; ++i) { const int t = t0 - 2 + i; win[i] = t >= 0 ? *(const unsigned*)(WC + (size_t)row_of(b, t) * 512 + c0) : 0u; }
#pragma unroll
            for (int o = 0; o < 16; ++o) {
                const int row = row_of(b, t0 + o);
                const f32x2 v = *(const LAS f32x2*)(tile + o * 512 + c0); const float mu = stats[o * 2], rs = stats[o * 2 + 1];
                float y0 = (v.x - mu) * rs * lg.x + lb.x, y1 = (v.y - mu) * rs * lg.y + lb.y; y0 *= sigm(y0); y1 *= sigm(y1);
                *(unsigned*)(Y0 + (size_t)row * DM + c0) = pk2(y0, y1);
                float z0 = 0.f, z1 = 0.f;
#pragma unroll
                for (int j = 0; j < 3; ++j) { z0 += wb[j][0] * bflo(win[o + j]); z1 += wb[j][1] * bfhi(win[o + j]); }
                const unsigned gbv = *(const unsigned*)(GB + (size_t)row * 512 + c0);
                *(unsigned*)(Y0 + (size_t)row * DM + 512 + c0) = pk2(z0 * bflo(gbv), z1 * bfhi(gbv));
            }
        }
        __syncthreads();
    }
}

__device__ __forceinline__ void ffn_fix_phase(Frame& F, CArgs& A, int layer) {
    bf16* HM = (bf16*)(F.ws + R_HM); const float* EG = (const float*)(F.ws + R_EDGE_G); const float* EV = (const float*)(F.ws + R_EDGE_V); const float* HL = (const float*)(F.ws + R_HALO);
    const float* cw = A.in[26] + (size_t)layer * 3 * DFF; const float* cb = A.in[27] + (size_t)layer * DFF;
    const int NIT = 65 * 2 * (DFF / 4);
    for (int it = F.wg * NTHR + F.tid; it < NIT; it += F.G * NTHR) {
        const int c = (it % (DFF / 4)) * 4, pl = it / (DFF / 4), pm = pl >> 1, lr = pl & 1;
        const f32x4 g0 = *(const f32x4*)(EG + (size_t)(pm * 2 + lr) * DFF + c), v = *(const f32x4*)(EV + (size_t)(pm * 2 + lr) * DFF + c);
        f32x4 a254 = (f32x4){0.f, 0.f, 0.f, 0.f}, a255 = a254;
        if (pm < 64) { const int src = (pm & 7) == 0 ? 64 : pm - 1; a254 = *(const f32x4*)(HL + (size_t)(src * 2 + 0) * DFF + c); a255 = *(const f32x4*)(HL + (size_t)(src * 2 + 1) * DFF + c); }
        const f32x4 g1 = lr == 0 ? a255 : *(const f32x4*)(EG + (size_t)(pm * 2) * DFF + c), g2 = lr == 0 ? a254 : a255;
        const f32x4 z = *(const f32x4*)(cw + c) * g2 + *(const f32x4*)(cw + DFF + c) * g1 + *(const f32x4*)(cw + 2 * DFF + c) * g0 + *(const f32x4*)(cb + c);
        const f32x4 o = z * (f32x4){sigm(z[0]), sigm(z[1]), sigm(z[2]), sigm(z[3])} * v;
        v2u ov; ov.x = pk2(o[0], o[1]); ov.y = pk2(o[2], o[3]);
        *(v2u*)(HM + (size_t)(pm * 256 + lr) * DFF + c) = ov;
    }
}

__device__ __forceinline__ int crow(int r, int hi) { return (r & 3) + 8 * (r >> 2) + 4 * hi; }
constexpr int ATT_KS = 72, ATT_VS = 232, ATT_K_BYTES = 224 * ATT_KS * 2;
__device__ __forceinline__ void attn_unit(Frame& F, const float* sinks, int b, int kvh, int qb) {
    const bf16* Q = (const bf16*)(F.ws + R_Q); const bf16* KB = (const bf16*)(F.ws + R_KB); const bf16* VB = (const bf16*)(F.ws + R_VB); bf16* Y1 = (bf16*)(F.ws + R_Y1);
    LAS bf16* Ks = (LAS bf16*)F.lds; LAS bf16* Vt = (LAS bf16*)(F.lds + ATT_K_BYTES);
    const int tid = F.tid, lane = F.lane, wave = F.wave, g = wave >> 1, half = wave & 1, qh = kvh * 4 + g, qi = lane & 31, hi = lane >> 5;
    const bool meta = qb < 0; const int q0 = meta ? 0 : 64 * qb;
#pragma unroll
    for (int i = 0; i < 4; ++i) {
        const int id = tid + 512 * i, key = id >> 3, ch = id & 7;
        if (key < 224) {
            int row = -1;
            if (key < 192) { const int sp = q0 - 128 + key; if (!meta && sp >= 0) row = b * SEQ + sp; }
            else if (key < 208) row = MR + (key - 192);
            v4u kv = (v4u){0u, 0u, 0u, 0u}, vv = (v4u){0u, 0u, 0u, 0u};
            if (row >= 0) { kv = *(const v4u*)(KB + (size_t)row * 128 + kvh * 64 + ch * 8); vv = *(const v4u*)(VB + (size_t)row * 128 + kvh * 64 + ch * 8); }
            *(LAS v4u*)(Ks + key * ATT_KS + ch * 8) = kv;
#pragma unroll
            for (int e = 0; e < 4; ++e) { Vt[(ch * 8 + 2 * e) * ATT_VS + key] = (bf16)(vv[e] & 0xffffu); Vt[(ch * 8 + 2 * e + 1) * ATT_VS + key] = (bf16)(vv[e] >> 16); }
        }
    }
    __syncthreads();
    int qrow; if (meta) { const int m = 32 * half + qi; qrow = MR + (m < NMETA ? m : NMETA - 1); } else qrow = b * SEQ + q0 + 32 * half + qi;
    bf16x8 qr[4];
#pragma unroll
    for (int k4 = 0; k4 < 4; ++k4) qr[k4] = *(const bf16x8*)(Q + (size_t)qrow * 512 + qh * 64 + 16 * k4 + 8 * hi);
    f32x16 sc[6];
#pragma unroll
    for (int i = 0; i < 6; ++i) {
        const int t = i < 5 ? half + i : 6;
        f32x16 a = (f32x16){0.f,0.f,0.f,0.f,0.f,0.f,0.f,0.f,0.f,0.f,0.f,0.f,0.f,0.f,0.f,0.f};
#pragma unroll
        for (int k4 = 0; k4 < 4; ++k4) { const bf16x8 kf = *(const LAS bf16x8*)(Ks + (32 * t + qi) * ATT_KS + 16 * k4 + 8 * hi); a = __builtin_amdgcn_mfma_f32_32x32x16_bf16(kf, qr[k4], a, 0, 0, 0); }
        sc[i] = a;
    }
    const float sink = sinks[qh]; float mx = sink;
    const int mq = 32 * half + qi;
#pragma unroll
    for (int i = 0; i < 6; ++i)
#pragma unroll
        for (int r = 0; r < 16; ++r) {
            const int kr = crow(r, hi); bool ok;
            if (i < 5) { const int dist = 128 - 32 * i + qi - kr; const int sp = q0 - 128 + 32 * (half + i) + kr; ok = !meta && dist >= 0 && dist < 128 && sp >= 0; }
            else ok = kr < NMETA && (!meta || kr <= mq);
            const float v = ok ? sc[i][r] * 0.125f : -1e30f; sc[i][r] = v; mx = fmaxf(mx, v);
        }
    mx = fmaxf(mx, __shfl_xor(mx, 32));
    float ls = 0.f;
#pragma unroll
    for (int i = 0; i < 6; ++i)
#pragma unroll
        for (int r = 0; r < 16; ++r) { const float p = __expf(sc[i][r] - mx); sc[i][r] = p; ls += p; }
    ls += __shfl_xor(ls, 32); ls += __expf(sink - mx);
    const float inv = 1.0f / ls;
    f32x16 o[2];
    o[0] = (f32x16){0.f,0.f,0.f,0.f,0.f,0.f,0.f,0.f,0.f,0.f,0.f,0.f,0.f,0.f,0.f,0.f}; o[1] = o[0];
#pragma unroll
    for (int i = 0; i < 6; ++i) {
        const int t = i < 5 ? half + i : 6;
#pragma unroll
        for (int s2 = 0; s2 < 2; ++s2) {
            v4u pw; pw.x = pg8::cvt_pk_bf16(sc[i][8 * s2 + 0], sc[i][8 * s2 + 1]); pw.y = pg8::cvt_pk_bf16(sc[i][8 * s2 + 2], sc[i][8 * s2 + 3]);
            pw.z = pg8::cvt_pk_bf16(sc[i][8 * s2 + 4], sc[i][8 * s2 + 5]); pw.w = pg8::cvt_pk_bf16(sc[i][8 * s2 + 6], sc[i][8 * s2 + 7]);
            const bf16x8 pa = __builtin_bit_cast(bf16x8, pw);
#pragma unroll
            for (int dt = 0; dt < 2; ++dt) {
                const LAS bf16* vp = Vt + (dt * 32 + qi) * ATT_VS + 32 * t + 16 * s2 + 4 * hi;
                const v2u lo = *(const LAS v2u*)vp, hh = *(const LAS v2u*)(vp + 8);
                const v4u vw = (v4u){lo.x, lo.y, hh.x, hh.y};
                o[dt] = __builtin_amdgcn_mfma_f32_32x32x16_bf16(pa, __builtin_bit_cast(bf16x8, vw), o[dt], 0, 0, 0);
            }
        }
    }
#pragma unroll
    for (int r = 0; r < 16; ++r) {
        const int qq = crow(r, hi); const float iv = __shfl(inv, qq);
        int orow; bool ok = true;
        if (meta) { const int m = 32 * half + qq; ok = m < NMETA; orow = MR + m; } else orow = b * SEQ + q0 + 32 * half + qq;
        if (ok) {
            Y1[(size_t)orow * DM + qh * 64 + qi] = (bf16)f2bf(o[0][r] * iv);
            Y1[(size_t)orow * DM + qh * 64 + 32 + qi] = (bf16)f2bf(o[1][r] * iv);
        }
    }
    __syncthreads();
}

constexpr int IMG_PT = 0, IMG_BK = 4096, IMG_VT = 8192, IMG_QT = 10240, IMG_W16 = 11264, IMG_BYTES = 11520;
constexpr int NBLK = 129, NBLK_H1 = 65;
constexpr size_t WS_IMG = 203 * MiB;
constexpr size_t WS_G = WS_A, WS_RK = WS_A + 17 * MiB, WS_ZS = WS_A + 18 * MiB;
static_assert(WS_IMG >= R_L1_END && WS_IMG + (size_t)64 * NBLK_H1 * IMG_BYTES <= WS_END, "image region");
constexpr int P_PRL = 0, P_FW = 0, P_FK = 4096, P_FA = 8192, P_XR = 15616, P_XK = P_XR + 4096, P_FB = P_XK, P_XV = P_XK + 4096, P_WC = P_XV,
              P_TW = P_XV + 4096, P_XA = P_TW + 2304, P_SG = P_XA + 2304, P_E1 = P_TW, P_E2 = P_E1 + 4608, P_LW = P_TW + 9216, P_LA = P_LW + 4096, P_LG = P_LA + 4096,
              P_ATF = P_LW, P_RTF = P_LA, P_M = P_LG + 4096, P_T = P_M + 4608, P_PTF = P_T + 1280, P_QF = P_PTF + 4096, P_IMG = P_QF + 1088,
              PI_PT = 0, PI_BK = 4096, PI_VT = PI_BK + 4608, PI_QT = PI_VT + 2048, PI_W16 = PI_QT + 1024, PI_BYTES = PI_W16 + 256, P_SLOT = P_IMG + PI_BYTES;
constexpr int MS = 36, TS = 20, BKS = 36;
static_assert(2 * P_SLOT + 1792 <= 147328 && (P_SLOT % 16) == 0 && (P_IMG % 16) == 0 && (P_E1 % 16) == 0 && (P_E2 % 16) == 0 && P_SG + 4352 <= P_LW && P_E2 + 4608 <= P_LW && (P_T % 16) == 0 && (P_M % 16) == 0, "prep lds map");
constexpr int PRS = 456;
__device__ __forceinline__ float wsum64(float x) { x = sum16(x); x += __shfl_xor(x, 16); x += __shfl_xor(x, 32); return x; }

__device__ __forceinline__ void rwkv_prep_phase(Frame& F, CArgs& A, int nbase, int cnt) {
    const bf16* PR = (const bf16*)(F.ws + R_PR);
    const bf16* w2t = (const bf16*)(F.ws + WS_LORA); const bf16* a2t = w2t + 512 * 64; const bf16* g2t = a2t + 512 * 64;
    const int tid = F.tid, lane = F.lane, wave = F.wave;
    const int nunits = 64 * cnt;
    if (F.wg >= nunits) return;
    int ld_pr[2], ld_pc[2]; bool ld_ok[2];
#pragma unroll
    for (int i = 0; i < 2; ++i) { const int q = tid + 512 * i; ld_ok[i] = q < 952; ld_pr[i] = ld_ok[i] ? q / 56 : 0; ld_pc[i] = ld_ok[i] ? q % 56 : 0; }
#define PP_BAR() asm volatile("s_waitcnt lgkmcnt(0)\n\ts_barrier" ::: "memory")
#define PP_LOAD(id_, dst) do { const int idc_ = (id_) < nunits ? (id_) : F.wg; const int ch_ = idc_ & 63, n_ = nbase + (idc_ >> 6), b_ = ch_ >> 3, h_ = ch_ & 7; \
        _Pragma("unroll") for (int i_ = 0; i_ < 2; ++i_) { const int pr = ld_pr[i_], pc = ld_pc[i_]; \
            const int col = pc < 8 ? 64 * h_ + 8 * pc : pc < 16 ? 512 + 64 * h_ + 8 * (pc - 8) : pc < 24 ? 1024 + 64 * h_ + 8 * (pc - 16) : 1536 + 8 * (pc - 24); \
            int gr = n_ == 0 ? MR + pr - 1 : n_ == 1 ? (pr == 0 ? MR + NMETA - 1 : b_ * SEQ + pr - 1) : b_ * SEQ + 16 * (n_ - 1) - 1 + pr; \
            const bool zero_ = (n_ == 0 && pr == 0); if (zero_) gr = MR; \
            v4u v_ = *(const v4u*)(PR + (size_t)gr * PRW + col); if (zero_) v_ = (v4u){0u, 0u, 0u, 0u}; dst[i_] = v_; } } while (0)
    v4u pf0[2], pf1[2];
    PP_LOAD(F.wg, pf0); PP_LOAD(F.wg + F.G, pf1);
    int cur_chain = -1;
    LAS float* MU = (LAS float*)(F.lds + 2 * P_SLOT);
    bf16x8 c_bfr[4]; f32x2 c_w0 = (f32x2){0.f, 0.f}, c_a0 = c_w0, c_kk = c_w0, c_ka = c_w0, c_rk = c_w0;
#pragma unroll
    for (int i = 0; i < 4; ++i) c_bfr[i] = (bf16x8){0, 0, 0, 0, 0, 0, 0, 0};
    const int tid_base = tid;
#pragma unroll 1
    for (int id0 = F.wg; id0 < nunits; id0 += 2 * F.G) {
    int tid = tid_base; asm volatile("" : "+v"(tid));
    const int lane = tid & 63, wave = __builtin_amdgcn_readfirstlane(tid >> 6);
    const int tt = tid >> 5, jp = tid & 31, j0 = 2 * jp;
    const int chain = id0 & 63, b = chain >> 3, h = chain & 7, ch0 = 64 * h + j0;
    const bool act1 = id0 + F.G < nunits;
    if (chain != cur_chain) {
        cur_chain = chain;
        const float* mu = A.in[13];
        if (tid < 448) { const int c = tid; const int gcol = c < 64 ? 64 * h + c : c < 128 ? 512 + 64 * h + (c - 64) : c < 192 ? 1024 + 64 * h + (c - 128) : 1536 + (c - 192); MU[c] = mu[gcol]; }
        { const int nb = wave & 3, grp = wave >> 2, ar = lane & 15, ak = 8 * (lane >> 4);
          if (grp == 0) { c_bfr[0] = *(const bf16x8*)(w2t + (size_t)(64 * h + 16 * nb + ar) * 64 + ak); c_bfr[1] = *(const bf16x8*)(w2t + (size_t)(64 * h + 16 * nb + ar) * 64 + 32 + ak);
                          c_bfr[2] = *(const bf16x8*)(a2t + (size_t)(64 * h + 16 * nb + ar) * 64 + ak); c_bfr[3] = *(const bf16x8*)(a2t + (size_t)(64 * h + 16 * nb + ar) * 64 + 32 + ak); }
          else {
#pragma unroll
              for (int k = 0; k < 4; ++k) c_bfr[k] = *(const bf16x8*)(g2t + (size_t)(64 * h + 16 * nb + ar) * 128 + 32 * k + ak); } }
        c_w0 = *(const f32x2*)(A.in[14] + ch0); c_a0 = *(const f32x2*)(A.in[16] + ch0); c_kk = *(const f32x2*)(A.in[19] + ch0); c_ka = *(const f32x2*)(A.in[20] + ch0); c_rk = *(const f32x2*)(A.in[21] + ch0);
    }
#define PP_SLOTS(...) do { _Pragma("unroll") for (int sl = 0; sl < 2; ++sl) { if (sl == 0 || act1) { \
        LAS unsigned char* L = F.lds + sl * P_SLOT; const int n = nbase + ((id0 + sl * F.G) >> 6); const int r0 = n == 0 ? MR : b * SEQ + 16 * (n - 1); (void)L; (void)n; (void)r0; \
        __VA_ARGS__ } } } while (0)
#pragma unroll
    for (int i = 0; i < 2; ++i) if (ld_ok[i]) { *(LAS v4u*)((LAS bf16*)(F.lds + P_PRL) + ld_pr[i] * PRS + 8 * ld_pc[i]) = pf0[i]; *(LAS v4u*)((LAS bf16*)(F.lds + P_SLOT + P_PRL) + ld_pr[i] * PRS + 8 * ld_pc[i]) = pf1[i]; }
    PP_LOAD(id0 + 2 * F.G, pf0); PP_LOAD(id0 + 3 * F.G, pf1);
    PP_BAR();
    PP_SLOTS({
        LAS bf16* PRL = (LAS bf16*)(L + P_PRL); LAS float* XR = (LAS float*)(L + P_XR); LAS float* XK = (LAS float*)(L + P_XK); LAS float* XV = (LAS float*)(L + P_XV);
        LAS bf16* TW = (LAS bf16*)(L + P_TW); LAS bf16* XA = (LAS bf16*)(L + P_XA); LAS bf16* SG = (LAS bf16*)(L + P_SG);
        const int t2 = tid >> 5, l32 = tid & 31;
        _Pragma("unroll") for (int i = 0; i < 7; ++i) {
            const int c = 2 * l32 + 64 * i;
            const unsigned cu = *(const LAS unsigned*)(PRL + (1 + t2) * PRS + c), pv = *(const LAS unsigned*)(PRL + t2 * PRS + c); const f32x2 m2 = *(const LAS f32x2*)(MU + c);
            const float c0_ = bflo(cu), c1_ = bfhi(cu); const float x0 = c0_ + (bflo(pv) - c0_) * m2.x, x1 = c1_ + (bfhi(pv) - c1_) * m2.y;
            if (i == 0) *(LAS f32x2*)(XR + t2 * 64 + 2 * l32) = (f32x2){x0, x1};
            else if (i == 1) *(LAS f32x2*)(XK + t2 * 64 + 2 * l32) = (f32x2){x0, x1};
            else if (i == 2) *(LAS f32x2*)(XV + t2 * 64 + 2 * l32) = (f32x2){x0, x1};
            else if (i == 3) { const float e0 = __expf(2.0f * x0), e1 = __expf(2.0f * x1); *(LAS unsigned*)(TW + t2 * 72 + 2 * l32) = pk2(1.0f - 2.0f * __builtin_amdgcn_rcpf(e0 + 1.0f), 1.0f - 2.0f * __builtin_amdgcn_rcpf(e1 + 1.0f)); }
            else if (i == 4) *(LAS unsigned*)(XA + t2 * 72 + 2 * l32) = pk2(x0, x1);
            else *(LAS unsigned*)(SG + t2 * 136 + 64 * (i - 5) + 2 * l32) = pk2(sigm(x0), sigm(x1));
        }
    });
    PP_BAR();
    PP_SLOTS({
        LAS bf16* TW = (LAS bf16*)(L + P_TW); LAS bf16* XA = (LAS bf16*)(L + P_XA); LAS bf16* SG = (LAS bf16*)(L + P_SG);
        LAS float* LW = (LAS float*)(L + P_LW); LAS float* LA = (LAS float*)(L + P_LA); LAS float* LG = (LAS float*)(L + P_LG);
        const int nb = wave & 3, grp = wave >> 2, ar = lane & 15, ak = 8 * (lane >> 4);
        pg8::f32x4 d0 = (pg8::f32x4){0.f, 0.f, 0.f, 0.f}, d1 = d0;
        if (grp == 0) {
            _Pragma("unroll") for (int k = 0; k < 2; ++k) { const bf16x8 af = *(const LAS bf16x8*)(TW + ar * 72 + 32 * k + ak); d0 = __builtin_amdgcn_mfma_f32_16x16x32_bf16(af, c_bfr[k], d0, 0, 0, 0); }
            _Pragma("unroll") for (int k = 0; k < 2; ++k) { const bf16x8 af = *(const LAS bf16x8*)(XA + ar * 72 + 32 * k + ak); d1 = __builtin_amdgcn_mfma_f32_16x16x32_bf16(af, c_bfr[2 + k], d1, 0, 0, 0); }
            _Pragma("unroll") for (int r = 0; r < 4; ++r) { LW[(4 * (lane >> 4) + r) * 64 + 16 * nb + ar] = d0[r]; LA[(4 * (lane >> 4) + r) * 64 + 16 * nb + ar] = d1[r]; }
        } else {
            _Pragma("unroll") for (int k = 0; k < 4; ++k) { const bf16x8 af = *(const LAS bf16x8*)(SG + ar * 136 + 32 * k + ak); d0 = __builtin_amdgcn_mfma_f32_16x16x32_bf16(af, c_bfr[k], d0, 0, 0, 0); }
            _Pragma("unroll") for (int r = 0; r < 4; ++r) LG[(4 * (lane >> 4) + r) * 64 + 16 * nb + ar] = d0[r];
        }
    });
    PP_BAR();
    PP_SLOTS({
        LAS float* XR = (LAS float*)(L + P_XR); LAS float* XK = (LAS float*)(L + P_XK); LAS float* XV = (LAS float*)(L + P_XV);
        LAS float* LW = (LAS float*)(L + P_LW); LAS float* LA = (LAS float*)(L + P_LA); LAS float* LG = (LAS float*)(L + P_LG);
        LAS float* FW = (LAS float*)(L + P_FW); LAS float* FK = (LAS float*)(L + P_FK); LAS float* FA = (LAS float*)(L + P_FA); LAS float* FB = (LAS float*)(L + P_FB);
        LAS bf16* I_VT = (LAS bf16*)(L + P_IMG + PI_VT);
        const f32x2 lw = *(const LAS f32x2*)(LW + tt * 64 + j0), la = *(const LAS f32x2*)(LA + tt * 64 + j0), lg = *(const LAS f32x2*)(LG + tt * 64 + j0);
        const f32x2 xr = *(const LAS f32x2*)(XR + tt * 64 + j0), xk = *(const LAS f32x2*)(XK + tt * 64 + j0), xv = *(const LAS f32x2*)(XV + tt * 64 + j0);
        const float wd0 = __expf(-0.6065306597126334f * sigm(c_w0.x + lw.x)), wd1 = __expf(-0.6065306597126334f * sigm(c_w0.y + lw.y));
        const float al0 = sigm(c_a0.x + la.x), al1 = sigm(c_a0.y + la.y);
        const float q0 = xk.x * c_kk.x, q1 = xk.y * c_kk.y;
        const float nrm = sum32(q0 * q0 + q1 * q1); const float rn = 1.0f / fmaxf(sqrtf(nrm), 1e-12f);
        const float kk0 = q0 * rn, kk1 = q1 * rn;
        const float kn0 = xk.x * (1.0f + (al0 - 1.0f) * c_ka.x), kn1 = xk.y * (1.0f + (al1 - 1.0f) * c_ka.y);
        const float rkp = sum32(xr.x * kn0 * c_rk.x + xr.y * kn1 * c_rk.y);
        asm volatile("" ::: "memory");
        *(LAS f32x2*)(FW + tt * 64 + j0) = (f32x2){wd0, wd1}; *(LAS f32x2*)(FK + tt * 64 + j0) = (f32x2){kn0, kn1};
        *(LAS f32x2*)(FA + tt * 64 + j0) = (f32x2){-kk0, -kk1}; *(LAS f32x2*)(FB + tt * 64 + j0) = (f32x2){kk0 * al0, kk1 * al1};
        I_VT[j0 * 16 + tt] = (bf16)f2bf(xv.x); I_VT[(j0 + 1) * 16 + tt] = (bf16)f2bf(xv.y);
        if (n > 0 || b == 0) {
            *(unsigned*)((bf16*)(F.ws + WS_G) + (size_t)(r0 + tt) * 512 + ch0) = pk2(lg.x, lg.y);
            if (jp == 0) ((float*)(F.ws + WS_RK))[(size_t)(r0 + tt) * 8 + h] = rkp;
        }
    });
    PP_BAR();
    if (tid < 128) { const int sl = tid >> 6, j = tid & 63; if (sl == 0 || act1) { LAS float* FW = (LAS float*)(F.lds + sl * P_SLOT + P_FW); LAS float* WC = (LAS float*)(F.lds + sl * P_SLOT + P_WC); float wc = 1.0f; float fwv[16];
#pragma unroll
        for (int s = 0; s < 16; ++s) fwv[s] = FW[s * 64 + j];
        __builtin_amdgcn_sched_barrier(0);
#pragma unroll
        for (int s = 0; s < 16; ++s) { wc *= fwv[s]; WC[s * 64 + j] = wc; } } }
    PP_BAR();
    PP_SLOTS({
        LAS float* XR = (LAS float*)(L + P_XR); LAS float* FK = (LAS float*)(L + P_FK); LAS float* FA = (LAS float*)(L + P_FA); LAS float* FB = (LAS float*)(L + P_FB);
        LAS float* WC = (LAS float*)(L + P_WC); LAS bf16* E1 = (LAS bf16*)(L + P_E1); LAS bf16* E2 = (LAS bf16*)(L + P_E2); LAS float* ATF = (LAS float*)(L + P_ATF); LAS float* RTF = (LAS float*)(L + P_RTF);
        LAS bf16* I_BK = (LAS bf16*)(L + P_IMG + PI_BK); LAS float* I_W16 = (LAS float*)(L + P_IMG + PI_W16);
        {
            const int s = tt;
            const f32x2 wcv = *(const LAS f32x2*)(WC + s * 64 + j0); f32x2 wp = (f32x2){1.0f, 1.0f}; if (s > 0) wp = *(const LAS f32x2*)(WC + (s - 1) * 64 + j0);
            const f32x2 fa = *(const LAS f32x2*)(FA + s * 64 + j0), xr = *(const LAS f32x2*)(XR + s * 64 + j0), fb = *(const LAS f32x2*)(FB + s * 64 + j0), fk = *(const LAS f32x2*)(FK + s * 64 + j0);
            const float iw0 = __builtin_amdgcn_rcpf(wcv.x), iw1 = __builtin_amdgcn_rcpf(wcv.y);
            const float at0 = wp.x * fa.x, at1 = wp.y * fa.y, rt0 = wcv.x * xr.x, rt1 = wcv.y * xr.y;
            *(LAS unsigned*)(E1 + s * 72 + j0) = pk2(fb.x * iw0, fb.y * iw1); *(LAS unsigned*)(E1 + (16 + s) * 72 + j0) = pk2(fk.x * iw0, fk.y * iw1);
            *(LAS unsigned*)(E2 + s * 72 + j0) = pk2(at0, at1); *(LAS unsigned*)(E2 + (16 + s) * 72 + j0) = pk2(rt0, rt1);
            *(LAS f32x2*)(ATF + s * 64 + j0) = (f32x2){at0, at1}; *(LAS f32x2*)(RTF + s * 64 + j0) = (f32x2){rt0, rt1};
        }
        {
            const int j = tid & 63, ug = tid >> 6; const float w16 = WC[15 * 64 + j];
            float bw_[2], kw_[2];
            _Pragma("unroll") for (int e = 0; e < 2; ++e) { const int u = 2 * ug + e; const float sc = w16 * __builtin_amdgcn_rcpf(WC[u * 64 + j]); bw_[e] = FB[u * 64 + j] * sc; kw_[e] = FK[u * 64 + j] * sc; }
            *(LAS unsigned*)(I_BK + j * BKS + 2 * ug) = pk2(bw_[0], bw_[1]); *(LAS unsigned*)(I_BK + j * BKS + 16 + 2 * ug) = pk2(kw_[0], kw_[1]);
            if (ug == 0) { const int jt = j >> 5, jj = j & 31, hi_ = (jj >> 2) & 1, r_ = (jj & 3) + 4 * (jj >> 3); I_W16[hi_ * 32 + jt * 16 + r_] = w16; }
        }
    });
    PP_BAR();
    if (wave < 2 && (wave == 0 || act1)) {
        LAS unsigned char* L = F.lds + wave * P_SLOT; LAS bf16* E1 = (LAS bf16*)(L + P_E1); LAS bf16* E2 = (LAS bf16*)(L + P_E2); LAS float* M = (LAS float*)(L + P_M);
        const int m = lane & 31, hh = lane >> 5;
        f32x16 d = (f32x16){0.f,0.f,0.f,0.f,0.f,0.f,0.f,0.f,0.f,0.f,0.f,0.f,0.f,0.f,0.f,0.f};
#pragma unroll
        for (int ks = 0; ks < 4; ++ks) { const bf16x8 af = *(const LAS bf16x8*)(E1 + m * 72 + 16 * ks + 8 * hh), bfv = *(const LAS bf16x8*)(E2 + m * 72 + 16 * ks + 8 * hh); d = __builtin_amdgcn_mfma_f32_32x32x16_bf16(af, bfv, d, 0, 0, 0); }
#pragma unroll
        for (int r = 0; r < 16; ++r) { const int mr = crow(r, hh), nc = m; const int u = mr & 15, s = nc & 15; const bool keep = (nc < 16) ? (u < s) : (u <= s);
            M[mr * MS + nc] = keep ? d[r] : 0.0f; }
    }
    PP_BAR();
    if ((tid & 63) < 16 && tid < 128 && (tid < 64 || act1)) { const int sl = tid >> 6, rr = tid & 15; LAS float* M = (LAS float*)(F.lds + sl * P_SLOT + P_M); LAS float* T = (LAS float*)(F.lds + sl * P_SLOT + P_T);
        float mb[16][16];
#pragma unroll
        for (int s = 1; s < 16; ++s)
#pragma unroll
            for (int u = 0; u < s; ++u) mb[u][s] = M[u * MS + s];
        __builtin_amdgcn_sched_barrier(0);
        float t[16];
#pragma unroll
        for (int s = 0; s < 16; ++s) { float acc = (rr == s) ? 1.0f : 0.0f;
#pragma unroll
            for (int u = 0; u < s; ++u) acc += t[u] * mb[u][s];
            t[s] = acc; }
#pragma unroll
        for (int s = 0; s < 16; ++s) T[rr * TS + s] = t[s]; }
    PP_BAR();
    PP_SLOTS({
        LAS float* ATF = (LAS float*)(L + P_ATF); LAS float* M = (LAS float*)(L + P_M); LAS float* T = (LAS float*)(L + P_T); LAS float* PTF = (LAS float*)(L + P_PTF); LAS float* QF = (LAS float*)(L + P_QF);
        LAS bf16* I_PT = (LAS bf16*)(L + P_IMG + PI_PT); LAS bf16* I_QT = (LAS bf16*)(L + P_IMG + PI_QT);
        if (tid < 128) {
            const int sq = tid >> 4, jq = tid & 15; f32x4 pa = (f32x4){0.f, 0.f, 0.f, 0.f}, pb = pa;
            f32x2 tv_[16]; f32x4 av_[16];
            _Pragma("unroll") for (int u = 0; u < 16; ++u) { tv_[u] = *(const LAS f32x2*)(T + u * TS + 2 * sq); av_[u] = *(const LAS f32x4*)(ATF + u * 64 + 4 * jq); }
            __builtin_amdgcn_sched_barrier(0);
            _Pragma("unroll") for (int u = 0; u < 16; ++u) { pa += av_[u] * tv_[u].x; pb += av_[u] * tv_[u].y; }
            *(LAS f32x4*)(PTF + (2 * sq) * 64 + 4 * jq) = pa; *(LAS f32x4*)(PTF + (2 * sq + 1) * 64 + 4 * jq) = pb;
            *(LAS v2u*)(I_PT + (2 * sq) * 64 + 4 * jq) = (v2u){pk2(pa[0], pa[1]), pk2(pa[2], pa[3])}; *(LAS v2u*)(I_PT + (2 * sq + 1) * 64 + 4 * jq) = (v2u){pk2(pb[0], pb[1]), pk2(pb[2], pb[3])};
        } else if (tid >= 256 && tid < 320) {
            const int u = (tid - 256) >> 2, s4 = (tid & 3) * 4; f32x4 q = (f32x4){0.f, 0.f, 0.f, 0.f};
            float mk_[16]; f32x4 t4_[16];
            _Pragma("unroll") for (int x = 0; x < 16; ++x) { mk_[x] = M[(16 + u) * MS + x]; t4_[x] = *(const LAS f32x4*)(T + x * TS + s4); }
            __builtin_amdgcn_sched_barrier(0);
            _Pragma("unroll") for (int x = 0; x < 16; ++x) q += t4_[x] * mk_[x];
            _Pragma("unroll") for (int e = 0; e < 4; ++e) { QF[u * 17 + s4 + e] = q[e]; I_QT[(s4 + e) * 16 + u] = (bf16)f2bf(q[e]); }
        }
    });
    PP_BAR();
    PP_SLOTS({
        LAS float* RTF = (LAS float*)(L + P_RTF); LAS float* M = (LAS float*)(L + P_M); LAS float* PTF = (LAS float*)(L + P_PTF); LAS float* QF = (LAS float*)(L + P_QF);
        LAS bf16* I_PT = (LAS bf16*)(L + P_IMG + PI_PT); LAS bf16* I_QT = (LAS bf16*)(L + P_IMG + PI_QT);
        if (tid < 128) {
            const int sq = tid >> 4, jq = tid & 15; f32x4 pa = *(const LAS f32x4*)(RTF + (2 * sq) * 64 + 4 * jq), pb = *(const LAS f32x4*)(RTF + (2 * sq + 1) * 64 + 4 * jq);
            f32x2 mv_[16]; f32x4 pv_[16];
            _Pragma("unroll") for (int u = 0; u < 16; ++u) { mv_[u] = *(const LAS f32x2*)(M + u * MS + 16 + 2 * sq); pv_[u] = *(const LAS f32x4*)(PTF + u * 64 + 4 * jq); }
            __builtin_amdgcn_sched_barrier(0);
            _Pragma("unroll") for (int u = 0; u < 16; ++u) { pa += pv_[u] * mv_[u].x; pb += pv_[u] * mv_[u].y; }
            *(LAS v2u*)(I_PT + (16 + 2 * sq) * 64 + 4 * jq) = (v2u){pk2(pa[0], pa[1]), pk2(pa[2], pa[3])}; *(LAS v2u*)(I_PT + (17 + 2 * sq) * 64 + 4 * jq) = (v2u){pk2(pb[0], pb[1]), pk2(pb[2], pb[3])};
        } else if (tid >= 256 && tid < 320) {
            const int u = (tid - 256) >> 2, s4 = (tid & 3) * 4; f32x4 q = *(const LAS f32x4*)(M + (16 + u) * MS + 16 + s4);
            float qf_[16]; f32x4 m4_[16];
            _Pragma("unroll") for (int x = 0; x < 16; ++x) { qf_[x] = QF[u * 17 + x]; m4_[x] = *(const LAS f32x4*)(M + x * MS + 16 + s4); }
            __builtin_amdgcn_sched_barrier(0);
            _Pragma("unroll") for (int x = 0; x < 16; ++x) q += m4_[x] * qf_[x];
            _Pragma("unroll") for (int e = 0; e < 4; ++e) I_QT[(16 + s4 + e) * 16 + u] = (bf16)f2bf(q[e]);
        }
    });
    PP_BAR();
    PP_SLOTS({
        const int nl = n - nbase;
        unsigned char* dst = F.ws + WS_IMG + ((size_t)chain * NBLK_H1 + nl) * IMG_BYTES;
        for (int q = tid; q < IMG_BYTES / 16; q += NTHR) {
            int so;
            if (q < 256) so = PI_PT + q * 16; else if (q < 512) so = PI_BK + ((q - 256) >> 2) * (BKS * 2) + ((q - 256) & 3) * 16;
            else if (q < 640) so = PI_VT + (q - 512) * 16; else if (q < 704) so = PI_QT + (q - 640) * 16; else so = PI_W16 + (q - 704) * 16;
            const v2u lo = *(const LAS v2u*)(L + P_IMG + so), hh = *(const LAS v2u*)(L + P_IMG + so + 8);
            *(v4u*)(dst + q * 16) = (v4u){lo.x, lo.y, hh.x, hh.y}; }
    });
    asm volatile("s_waitcnt lgkmcnt(0)\n\ts_barrier" ::: "memory");
    }
#undef PP_LOAD
#undef PP_BAR
#undef PP_SLOTS
}

constexpr int SL_PT = 0, SL_BK = 4352, SL_VT = SL_BK + 5120, SL_QT = SL_VT + 3072, SL_W16 = SL_QT + 1536, SL_BUF = SL_W16 + 256;
constexpr int SL_YL = 3 * SL_BUF, SL_END = SL_YL + 2 * 4096;
static_assert((SL_BUF % 16) == 0 && SL_END <= 131072, "scan lds map");

__device__ __forceinline__ void rwkv_scan(Frame& F, CArgs& A, int chain, int nlo, int nhi) {
    const int b = chain >> 3, h = chain & 7;
    const int tid = F.tid, lane = F.lane, wave = F.wave;
    LAS unsigned char* L = F.lds;
    const unsigned char* img0 = F.ws + WS_IMG + (size_t)chain * NBLK_H1 * IMG_BYTES;
    const int cnt = nhi - nlo;
#define S3_BAR() asm volatile("s_waitcnt lgkmcnt(0)\n\ts_barrier" ::: "memory")
    if (wave >= 2) {
        bf16* Y1 = (bf16*)(F.ws + R_Y1);
        const int ht = tid - 128;
        int lsrc[2], ldst[2]; bool lok[2];
#pragma unroll
        for (int i = 0; i < 2; ++i) { const int q = ht + 384 * i; lok[i] = q < IMG_BYTES / 16; lsrc[i] = lok[i] ? q * 16 : 0; int d;
            if (q < 256) d = SL_PT + (q >> 3) * 136 + (q & 7) * 16;
            else if (q < 512) d = SL_BK + ((q - 256) >> 2) * 80 + ((q - 256) & 3) * 16;
            else if (q < 640) d = SL_VT + ((q - 512) >> 1) * 48 + ((q - 512) & 1) * 16;
            else if (q < 704) d = SL_QT + ((q - 640) >> 1) * 48 + ((q - 640) & 1) * 16;
            else d = SL_W16 + (q - 704) * 16;
            ldst[i] = d; }
        const bool pw = wave < 6; const int pt = 4 * ((wave - 2) & 3) + (lane >> 4), pc = 4 * (lane & 15);
        const f32x4 c_lg = *(const f32x4*)(A.in[22] + 64 * h + pc), c_lb = *(const f32x4*)(A.in[23] + 64 * h + pc);
        const bf16* Gp = (const bf16*)(F.ws + WS_G) + 64 * h + pc; const float* RKp = (const float*)(F.ws + WS_RK) + h;
#define S3_LOAD(m, pf) do { const int mm_ = (m) < cnt ? (m) : cnt - 1; const unsigned char* ip_ = img0 + (size_t)mm_ * IMG_BYTES; pf[0] = *(const v4u*)(ip_ + lsrc[0]); pf[1] = *(const v4u*)(ip_ + lsrc[1]); } while (0)
#define S3_LAND(buf, pf) do { *(LAS v4u*)(L + (buf) * SL_BUF + ldst[0]) = pf[0]; if (lok[1]) *(LAS v4u*)(L + (buf) * SL_BUF + ldst[1]) = pf[1]; } while (0)
#define S3_PLOAD(m, gg, xv, rk) do { const int mm_ = (m) < cnt ? (m) : cnt - 1; const int nn_ = nlo + mm_; const size_t r0_ = nn_ == 0 ? (size_t)MR : (size_t)(b * SEQ + 16 * (nn_ - 1)); \
        gg = *(const v2u*)(Gp + (r0_ + pt) * 512); rk = RKp[(r0_ + pt) * 8]; (void)xv; } while (0)
#define S3_HELP(m, pfN, ggC, xvC, rkC) do { \
        const int cb = (m) & 1; const int b3n = b3 == 2 ? 0 : b3 + 1; \
        if ((m) + 1 < cnt) S3_LAND(b3n, pfN); \
        S3_LOAD((m) + 5, pfN); \
        S3_BAR(); \
        if (pw) { const f32x4 y = *(const LAS f32x4*)(L + SL_YL + cb * 4096 + (pt * 64 + pc) * 4); \
          const int nn_ = nlo + (m); const int r0 = nn_ == 0 ? MR : b * SEQ + 16 * (nn_ - 1); \
          const float mean = sum16((y[0] + y[1]) + (y[2] + y[3])) * (1.0f / 64.0f); const f32x4 d = y - mean; \
          const float var = sum16((d[0] * d[0] + d[1] * d[1]) + (d[2] * d[2] + d[3] * d[3])) * (1.0f / 64.0f); const float rs = rsqrtf(var + 64e-5f); \
          const float g0 = bflo(ggC.x), g1 = bfhi(ggC.x), g2 = bflo(ggC.y), g3 = bfhi(ggC.y); \
          { const LAS bf16* vl_ = (const LAS bf16*)(L + b3 * SL_BUF + SL_VT) + pc * 24 + pt; xvC[0] = bf2f(vl_[0]); xvC[1] = bf2f(vl_[24]); xvC[2] = bf2f(vl_[48]); xvC[3] = bf2f(vl_[72]); } \
          const float o0 = (d[0] * rs * c_lg[0] + c_lb[0] + rkC * xvC[0]) * g0, o1 = (d[1] * rs * c_lg[1] + c_lb[1] + rkC * xvC[1]) * g1, \
                      o2 = (d[2] * rs * c_lg[2] + c_lb[2] + rkC * xvC[2]) * g2, o3 = (d[3] * rs * c_lg[3] + c_lb[3] + rkC * xvC[3]) * g3; \
          if (nn_ > 0 || b == 0) { v2u ov; ov.x = pk2(o0, o1); ov.y = pk2(o2, o3); *(v2u*)(Y1 + (size_t)(r0 + pt) * DM + 512 + 64 * h + pc) = ov; } } \
        S3_PLOAD((m) + 4, ggC, xvC, rkC); b3 = b3n; \
    } while (0)
        v4u pf0[2], pf1[2], pf2[2], pf3[2]; v2u gg0, gg1, gg2, gg3; float xv0[4], xv1[4], xv2[4], xv3[4], rk0, rk1, rk2, rk3;
        int b3 = 0;
        S3_LOAD(0, pf0); S3_LAND(0, pf0); S3_LOAD(1, pf1); S3_LOAD(2, pf2); S3_LOAD(3, pf3); S3_LOAD(4, pf0);
        S3_PLOAD(0, gg0, xv0, rk0); S3_PLOAD(1, gg1, xv1, rk1); S3_PLOAD(2, gg2, xv2, rk2); S3_PLOAD(3, gg3, xv3, rk3);
        S3_BAR();
        int m = 0;
#pragma unroll 1
        for (; m + 3 < cnt; m += 4) {
            S3_HELP(m, pf1, gg0, xv0, rk0);
            S3_HELP(m + 1, pf2, gg1, xv1, rk1);
            S3_HELP(m + 2, pf3, gg2, xv2, rk2);
            S3_HELP(m + 3, pf0, gg3, xv3, rk3);
        }
        if (m < cnt) { S3_HELP(m, pf1, gg0, xv0, rk0); ++m; }
        if (m < cnt) { S3_HELP(m, pf2, gg1, xv1, rk1); ++m; }
        if (m < cnt) { S3_HELP(m, pf3, gg2, xv2, rk2); ++m; }
#undef S3_LOAD
#undef S3_LAND
#undef S3_PLOAD
#undef S3_HELP
    } else {
        const int it = wave, qi = lane & 31, hi = lane >> 5;
        f32x16 z0 = (f32x16){0.f,0.f,0.f,0.f,0.f,0.f,0.f,0.f,0.f,0.f,0.f,0.f,0.f,0.f,0.f,0.f}, z1 = z0;
        float* zs = (float*)(F.ws + WS_ZS) + ((size_t)(chain * 2 + it) * 2 * 64 + lane) * 16;
        if (nlo > 0) { z0 = *(const f32x16*)zs; z1 = *(const f32x16*)(zs + 64 * 16); }
        S3_BAR();
        int b3 = 0;
#define S3_PK(dst, zz, o) do { dst.x = pg8::cvt_pk_bf16(zz[o + 0], zz[o + 1]); dst.y = pg8::cvt_pk_bf16(zz[o + 2], zz[o + 3]); dst.z = pg8::cvt_pk_bf16(zz[o + 4], zz[o + 5]); dst.w = pg8::cvt_pk_bf16(zz[o + 6], zz[o + 7]); } while (0)
#pragma unroll 1
        for (int m = 0; m < cnt; ++m) {
            const int cb = m & 1;
            const LAS unsigned char* B_ = L + b3 * SL_BUF; b3 = b3 == 2 ? 0 : b3 + 1;
            const bf16x8 vfr = *(const LAS bf16x8*)(B_ + SL_VT + (32 * it + qi) * 48 + hi * 16);
            const bf16x8 qf = *(const LAS bf16x8*)(B_ + SL_QT + qi * 48 + hi * 16);
            v4u aw[4];
#pragma unroll
            for (int ks = 0; ks < 4; ++ks) {
                const LAS unsigned char* pp = B_ + SL_PT + qi * 136 + (16 * ks + 4 * hi) * 2;
                const v2u lo = *(const LAS v2u*)pp, hh = *(const LAS v2u*)(pp + 16); aw[ks] = (v4u){lo.x, lo.y, hh.x, hh.y}; }
            v4u bw[2]; bf16x8 kf[2]; f32x4 wv[2][4];
            const LAS float* w16 = (const LAS float*)(B_ + SL_W16) + hi * 32;
#pragma unroll
            for (int jt = 0; jt < 2; ++jt) { const LAS unsigned char* bp = B_ + SL_BK + (32 * jt + qi) * 80;
                const v2u lo = *(const LAS v2u*)(bp + 8 * hi), hh = *(const LAS v2u*)(bp + 16 + 8 * hi); bw[jt] = (v4u){lo.x, lo.y, hh.x, hh.y};
                kf[jt] = *(const LAS bf16x8*)(bp + 32 + 16 * hi);
#pragma unroll
                for (int r4 = 0; r4 < 4; ++r4) wv[jt][r4] = *(const LAS f32x4*)(w16 + jt * 16 + 4 * r4); }
            __builtin_amdgcn_sched_barrier(0);
            v4u zb[4]; S3_PK(zb[0], z0, 0); S3_PK(zb[1], z0, 8); S3_PK(zb[2], z1, 0); S3_PK(zb[3], z1, 8);
            f32x16 acc = (f32x16){0.f,0.f,0.f,0.f,0.f,0.f,0.f,0.f,0.f,0.f,0.f,0.f,0.f,0.f,0.f,0.f};
            acc = __builtin_amdgcn_mfma_f32_32x32x16_bf16(qf, vfr, acc, 0, 0, 0);
#pragma unroll
            for (int ks = 0; ks < 4; ++ks) acc = __builtin_amdgcn_mfma_f32_32x32x16_bf16(__builtin_bit_cast(bf16x8, aw[ks]), __builtin_bit_cast(bf16x8, zb[ks]), acc, 0, 0, 0);
            f32x16 zn0, zn1;
#pragma unroll
            for (int r4 = 0; r4 < 4; ++r4)
#pragma unroll
                for (int e = 0; e < 4; ++e) { zn0[4 * r4 + e] = z0[4 * r4 + e] * wv[0][r4][e]; zn1[4 * r4 + e] = z1[4 * r4 + e] * wv[1][r4][e]; }
            { LAS float* YL = (LAS float*)(L + SL_YL + cb * 4096);
#pragma unroll
              for (int r = 8; r < 16; ++r) YL[(crow(r, hi) - 16) * 64 + 32 * it + qi] = acc[r]; }
            v4u sab; S3_PK(sab, acc, 0);
            zn0 = __builtin_amdgcn_mfma_f32_32x32x16_bf16(kf[0], vfr, zn0, 0, 0, 0);
            zn1 = __builtin_amdgcn_mfma_f32_32x32x16_bf16(kf[1], vfr, zn1, 0, 0, 0);
            zn0 = __builtin_amdgcn_mfma_f32_32x32x16_bf16(__builtin_bit_cast(bf16x8, bw[0]), __builtin_bit_cast(bf16x8, sab), zn0, 0, 0, 0);
            zn1 = __builtin_amdgcn_mfma_f32_32x32x16_bf16(__builtin_bit_cast(bf16x8, bw[1]), __builtin_bit_cast(bf16x8, sab), zn1, 0, 0, 0);
            z0 = zn0; z1 = zn1;
            S3_BAR();
        }
        if (nhi < NBLK) { *(f32x16*)zs = z0; *(f32x16*)(zs + 64 * 16) = z1; }
#undef S3_PK
    }
#undef S3_BAR
    __syncthreads();
}

__device__ __forceinline__ void final_phase(Frame& F, CArgs& A) {
    const float* part = (const float*)(F.ws + WS_PART); const float* gf = A.in[4]; float* out = F.out; const float* hin = (const float*)(F.ws + WS_HFIN);
    const int gw = F.wg * NWAVES + F.wave, NGW = F.G * NWAVES, lane = F.lane;
    f32x4 gv[4];
#pragma unroll
    for (int j = 0; j < 4; ++j) gv[j] = *(const f32x4*)(gf + j * 256 + lane * 4);
    for (int row = gw; row < MR; row += NGW) {
        const float rs = pg8::row_rstd(part, row);
#pragma unroll
        for (int j = 0; j < 4; ++j) { const size_t o = (size_t)row * DM + j * 256 + lane * 4; *(f32x4*)(out + o) = *(const f32x4*)(hin + o) * rs * gv[j]; }
    }
}

__device__ __forceinline__ void meta_res_gemm(Frame& F, const bf16* Aop, int lda, const bf16* Bop, int ldb, int K, float* hmeta, bf16* Abuf, float* part, int mode, int g) {
    const int lane = F.lane, wave = F.wave, nb = wave & 3, kh = wave >> 2, kq = 8 * (lane >> 4), r16 = lane & 15;
    const int khalf = K / 2, k0 = kh * khalf, nks = khalf / 32;
    const bf16* ap = Aop + (size_t)(MR + r16) * lda + k0 + kq;
    const bf16* bp = Bop + (size_t)(64 * g + 16 * nb + r16) * ldb + k0 + kq;
    pg8::f32x4 d = (pg8::f32x4){0.f, 0.f, 0.f, 0.f};
#pragma unroll 4
    for (int k = 0; k < nks; ++k) { const bf16x8 af = *(const bf16x8*)(ap + 32 * k); const bf16x8 bfv = *(const bf16x8*)(bp + 32 * k); d = __builtin_amdgcn_mfma_f32_16x16x32_bf16(af, bfv, d, 0, 0, 0); }
    LAS float* red = (LAS float*)F.lds;
    if (kh == 1) *(LAS pg8::f32x4*)(red + (nb * 64 + lane) * 4) = d;
    __syncthreads();
    if (kh == 0) {
        const pg8::f32x4 o = *(const LAS pg8::f32x4*)(red + (nb * 64 + lane) * 4); d += o;
        const int col = 64 * g + 16 * nb + r16;
#pragma unroll
        for (int r = 0; r < 4; ++r) { const int row = 4 * (lane >> 4) + r; float h = hmeta[(size_t)row * DM + col] + d[r]; hmeta[(size_t)row * DM + col] = h; d[r] = h;
            if (mode) Abuf[(size_t)(MR + row) * DM + col] = (bf16)f2bf(h); }
    }
    __syncthreads();
    if (mode) {
        if (kh == 0) {
#pragma unroll
            for (int r = 0; r < 4; ++r) { const float ss = sum16(d[r] * d[r]); if (r16 == 0) red[(4 * (lane >> 4) + r) * 4 + nb] = ss; }
        }
        __syncthreads();
        if (F.tid < 16) { const pg8::f32x4 v = *(const LAS pg8::f32x4*)(red + F.tid * 4); part[(size_t)(MR + F.tid) * 16 + g] = (v[0] + v[1]) + (v[2] + v[3]); }
        __syncthreads();
    }
}

#ifdef NO_ATTN
#define ATTN_UNIT(b, k, q) do { } while (0)
#else
#define ATTN_UNIT(b, k, q) attn_unit(F, A.in[12], (b), (k), (q))
#endif
constexpr int N_PHASES = 17;
#ifndef RES_SP2
#define RES_SP2 true
#endif
#ifndef DBGLAST
#define DBGLAST 6
#endif
#ifndef DBG15
#define DBG15 3
#endif
#ifndef DBG_NPH
#define DBG_NPH 18
#endif
__global__ void __launch_bounds__(NTHR, 2) hyb_fwd(Args args) {
    extern __shared__ __attribute__((aligned(16))) unsigned char lds[];
    const int lo = args.ph_lo, hi = args.ph_hi;
#if MK_N_LAUNCHES == 1
    {
        for (int u = threadIdx.x; u < (LDS_BYTES - LDSCTL_OFF) / 4; u += NTHR) ((LAS unsigned*)((LAS unsigned char*)lds + LDSCTL_OFF))[u] = 0u;
        __syncthreads();
        if (threadIdx.x == 0) (void)xb_add(&((unsigned*)(args.ws + WS_CTL))[1024 + XB_XCNT(xb_xcc_id())], 1u);
    }
#endif
    const int wave_s = __builtin_amdgcn_readfirstlane(threadIdx.x >> 6);
#ifndef PROBE_MASK
#define PROBE_MASK 0u
#endif
#pragma unroll 1
    for (int pq = 2 * lo; pq < 2 * hi; ++pq) {
        const int p = pq >> 1; if ((pq & 1) && !((PROBE_MASK >> p) & 1u)) continue;
#define PHF() CArgs* ap_ = (CArgs*)__builtin_amdgcn_kernarg_segment_ptr(); asm volatile("" : "+s"(ap_)); CArgs& A = *ap_; \
        unsigned z_; asm volatile("s_mov_b32 %0, 0" : "=s"(z_)); \
        Frame F; F.tid = (wave_s << 6) | (int)__builtin_amdgcn_mbcnt_hi(~0u, __builtin_amdgcn_mbcnt_lo(~0u, z_)); asm volatile("" : "+v"(F.tid)); \
        F.lds = (LAS unsigned char*)lds; F.lane = F.tid & 63; F.wave = __builtin_amdgcn_readfirstlane(F.tid >> 6); F.G = gridDim.x; F.wg = blockIdx.x; F.out = A.out; F.ws = A.ws; \
        unsigned char* ws = A.ws; float* part = (float*)(ws + WS_PART); float* hmeta = (float*)(ws + WS_HMETA); pg8::bf16_t* Abuf = (pg8::bf16_t*)(ws + WS_A); (void)part; (void)hmeta; (void)Abuf
        int kind, layer = 0, ch = 0, sub = 2;
        switch (p) {
            case 0: kind = 0; break; case 1: kind = 1; break; case 2: kind = 2; break; case 3: kind = 3; sub = 0; break;
            case 4: kind = 4; break; case 5: kind = 5; break; case 6: kind = 3; break;
            case 7: kind = 6; break; case 8: kind = 7; break; case 9: kind = 9; break; case 10: kind = 7; ch = 1; break; case 11: kind = 9; ch = 1; break;
            case 12: kind = 3; sub = 1; break;
            case 13: kind = 4; layer = 1; break; case 14: kind = 5; layer = 1; break; case 15: kind = 3; layer = 1; break;
            default: kind = 8; break;
        }
        if (kind == 0) { PHF(); p0_prologue(F, A); }
        else if (kind == 1) { PHF(); pg8::Gemm g{Abuf, (const pg8::bf16_t*)(ws + W_IN0), MP, NIN, DM, DM, DM}; pg8::StaticOrder S; S.init(MP, NIN, F.G, F.wg);
            pg8::EpiIn0 E{(pg8::bf16_t*)(ws + R_U), (pg8::bf16_t*)(ws + R_WC), (pg8::bf16_t*)(ws + R_GB), part};
            pg8::gemm_phase<pg8::EpiIn0, pg8::StaticOrder, true, true, DM, DM, DM>(F.lds, g, S, E, F.tid); }
        else if (kind == 2) { PHF(); conv0_phase(F, A); }
        else if (kind == 3) { PHF();
            const bool o0 = (sub == 0), o1 = (sub == 1), od = (sub == 2);
            const pg8::bf16_t* Aop = (const pg8::bf16_t*)(ws + (o0 ? R_Y0 : o1 ? R_Y1 : R_HM));
            const pg8::bf16_t* Bop = (const pg8::bf16_t*)(ws + (o0 ? W_OUT0 : o1 ? W_OUT1 : (layer ? W_DN1 : W_DN0)));
            const int Kd = od ? DFF : DM, ldbd = od ? DFF : DM;
            const float* base = o0 ? A.in[0] : (const float*)A.out;
            const pg8::Gemm g{Aop, Bop, MP, DM, Kd, Kd, ldbd};
            pg8::StaticOrder S; S.init(MR, DM, F.G, F.wg);
            const bool lastres = od && layer == 1;
            pg8::EpiRes E{base, lastres ? (float*)(ws + WS_HFIN) : (float*)A.out, hmeta, Abuf, part, 1, o0 ? 1 : 0, lastres ? 1 : 0};
            if (od) pg8::gemm_phase<pg8::EpiRes, pg8::StaticOrder, true, RES_SP2, DFF, DFF, DFF>(F.lds, g, S, E, F.tid);
            else pg8::gemm_phase<pg8::EpiRes, pg8::StaticOrder, true, RES_SP2, DM, DM, DM>(F.lds, g, S, E, F.tid);
            if (blockIdx.x < 16 && !(pq & 1)) {
                CArgs* am_ = (CArgs*)__builtin_amdgcn_kernarg_segment_ptr(); asm volatile("" : "+s"(am_)); unsigned char* wsm = am_->ws;
                unsigned zm_; asm volatile("s_mov_b32 %0, 0" : "=s"(zm_));
                Frame Fm; Fm.tid = (wave_s << 6) | (int)__builtin_amdgcn_mbcnt_hi(~0u, __builtin_amdgcn_mbcnt_lo(~0u, zm_)); asm volatile("" : "+v"(Fm.tid));
                Fm.lds = (LAS unsigned char*)lds; Fm.lane = Fm.tid & 63; Fm.wave = __builtin_amdgcn_readfirstlane(Fm.tid >> 6); Fm.G = gridDim.x; Fm.wg = blockIdx.x; Fm.out = nullptr; Fm.ws = wsm;
                const bf16* Am = (const bf16*)(wsm + (o0 ? R_Y0 : o1 ? R_Y1 : R_HM));
                const bf16* Bm = (const bf16*)(wsm + (o0 ? W_OUT0 : o1 ? W_OUT1 : (layer ? W_DN1 : W_DN0)));
                meta_res_gemm(Fm, Am, od ? DFF : DM, Bm, od ? DFF : DM, od ? DFF : DM, (float*)(wsm + WS_HMETA), (bf16*)(wsm + WS_A), (float*)(wsm + WS_PART), 1, (int)blockIdx.x);
            } }
        else if (kind == 4) { PHF(); pg8::Gemm g{Abuf, (const pg8::bf16_t*)(ws + (layer ? W_UP1 : W_UP0)), MP, 2 * DFF, DM, DM, DM}; pg8::StaticOrder S; S.init(MP, 2 * DFF, F.G, F.wg);
            pg8::EpiUpConv E{ws, A.in[26] + (size_t)layer * 3 * DFF, A.in[27] + (size_t)layer * DFF};
            pg8::gemm_phase<pg8::EpiUpConv, pg8::StaticOrder, true, true, DM, DM, DM>(F.lds, g, S, E, F.tid); }
        else if (kind == 5) { PHF(); ffn_fix_phase(F, A, layer); }
        else if (kind == 6) { PHF(); pg8::Gemm g{Abuf, (const pg8::bf16_t*)(ws + W_IN1), MP, NIN, DM, DM, DM}; pg8::StaticOrder S; S.init(MP, NIN, F.G, F.wg);
            pg8::EpiIn1 E{(pg8::bf16_t*)(ws + R_Q), (pg8::bf16_t*)(ws + R_KB), (pg8::bf16_t*)(ws + R_VB), (pg8::bf16_t*)(ws + R_PR), part, (const float*)(ws + WS_ROPE), (const float*)(ws + WS_ROPE) + TT * 32};
            pg8::gemm_phase<pg8::EpiIn1, pg8::StaticOrder, true, true, DM, DM, DM>(F.lds, g, S, E, F.tid); }
        else if (kind == 7) { PHF();
            const int cnt = ch == 0 ? NBLK_H1 : NBLK - NBLK_H1, nbase = ch == 0 ? 0 : NBLK_H1;
            rwkv_prep_phase(F, A, nbase, cnt);
        }
        else if (kind == 9) { PHF();
            const int NCH = 64;
            if (F.G > NCH && F.wg < NCH) rwkv_scan(F, A, F.wg, ch == 0 ? 0 : NBLK_H1, ch == 0 ? NBLK_H1 : NBLK);
            else {
                if (F.G <= NCH) for (int c = F.wg; c < NCH; c += F.G) rwkv_scan(F, A, c, ch == 0 ? 0 : NBLK_H1, ch == 0 ? NBLK_H1 : NBLK);
                if (ch == 0) { const int NAW = F.G > NCH ? F.G - NCH : F.G, aw = F.G > NCH ? F.wg - NCH : F.wg;
                    for (int id = aw; id < 514; id += NAW) { if (id < 512) ATTN_UNIT(id >> 6, (id >> 5) & 1, id & 31); else ATTN_UNIT(0, id - 512, -1); } }
            }
        }
        else if (kind == 8) { PHF(); final_phase(F, A); }
#if MK_N_LAUNCHES == 1
        if (pq + 1 < 2 * hi) {
            if (hi > 1000) cg::this_grid().sync();
            CArgs* ab_ = (CArgs*)__builtin_amdgcn_kernarg_segment_ptr(); asm volatile("" : "+s"(ab_));
            unsigned zb_; asm volatile("s_mov_b32 %0, 0" : "=s"(zb_));
            const bool t0 = (wave_s == 0) && (__builtin_amdgcn_mbcnt_hi(~0u, __builtin_amdgcn_mbcnt_lo(~0u, zb_)) == 0u);
            xcd_barrier((unsigned*)(ab_->ws + WS_CTL) + 1024, (volatile LAS unsigned*)((LAS unsigned char*)lds + MISC_OFF) + 8, t0);
#ifdef BAR_PROBE
            if (p == 5) { for (int rep_ = 0; rep_ < BAR_PROBE; ++rep_) xcd_barrier((unsigned*)(ab_->ws + WS_CTL) + 1024, (volatile LAS unsigned*)((LAS unsigned char*)lds + MISC_OFF) + 8, t0); }
#endif
        }
#endif
    }
}

extern "C" void kernel_launch(void* const* d_in, const int* in_sizes, int n_in, void* d_out, int out_size, void* d_ws, size_t ws_size, hipStream_t stream) {
    static int grid = 0;
    if (grid == 0) {
        if (n_in != 29 || out_size != MR * DM || ws_size < WS_END) { fprintf(stderr, "kernel_launch: unexpected shapes (n_in %d out %d ws %zu)\n", n_in, out_size, ws_size); grid = -1; return; }
        int dev = 0, cus = 0, per_cu = 0;
        if (hipGetDevice(&dev) != hipSuccess || hipDeviceGetAttribute(&cus, hipDeviceAttributeMultiprocessorCount, dev) != hipSuccess) { grid = -1; return; }
        if (hipFuncSetAttribute((const void*)hyb_fwd, hipFuncAttributeMaxDynamicSharedMemorySize, LDS_BYTES) != hipSuccess) { fprintf(stderr, "kernel_launch: hipFuncSetAttribute failed\n"); grid = -1; return; }
        if (hipOccupancyMaxActiveBlocksPerMultiprocessor(&per_cu, (const void*)hyb_fwd, NTHR, LDS_BYTES) != hipSuccess || per_cu < 1) { fprintf(stderr, "kernel_launch: occupancy query says %d\n", per_cu); per_cu = 1; }
        (void)hipGetLastError();
        grid = cus;
    }
    if (grid < 0) return;
    Args a{};
    for (int i = 0; i < 29; ++i) a.in[i] = (const float*)d_in[i];
    a.out = (float*)d_out; a.ws = (unsigned char*)d_ws;
#if MK_N_LAUNCHES == 1
    if (hipMemsetAsync((char*)d_ws + WS_CTL, 0, 65536, stream) != hipSuccess) { fprintf(stderr, "kernel_launch: memset failed\n"); return; }
    a.ph_lo = 0; a.ph_hi = N_PHASES;
    void* kargs[] = {&a};
    hipError_t e = hipLaunchCooperativeKernel((const void*)hyb_fwd, dim3(grid), dim3(NTHR), kargs, LDS_BYTES, stream);
    if (e != hipSuccess) fprintf(stderr, "cooperative launch failed: %s (grid %d)\n", hipGetErrorString(e), grid);
#else
    for (int p = 0; p < N_PHASES; ++p) { a.ph_lo = p; a.ph_hi = p + 1; hipLaunchKernelGGL(hyb_fwd, dim3(grid), dim3(NTHR), LDS_BYTES, stream, a); }
#endif
}
```

```cpp
#include <hip/hip_runtime.h>
#include <hip/hip_cooperative_groups.h>
#include <cstdio>
#include <cstdint>
namespace cg = cooperative_groups;

#ifndef MK_N_LAUNCHES
#define MK_N_LAUNCHES 1
#endif

constexpr int NB = 8, SEQ = 2048, NMETA = 16, TT = SEQ + NMETA, DM = 1024;
constexpr int MR = NB * SEQ;
constexpr int MP = MR + 256;
constexpr int DFF = 2816, FCH = 1408;
constexpr int NIN = 2560;
constexpr int PRW = 1792;

constexpr size_t EO_PART = (size_t)1 << 20, EO_HM = (size_t)89 << 20, EO_EDGE_G = EO_HM + (size_t)MP * DFF * 2, EO_EDGE_V = EO_EDGE_G + (size_t)65 * 2 * DFF * 4, EO_HALO = EO_EDGE_V + (size_t)65 * 2 * DFF * 4;
namespace pg8 {
#define PG8_LAS __attribute__((address_space(3)))
typedef unsigned short bf16_t;
typedef short bf16x8 __attribute__((ext_vector_type(8)));
typedef float f32x4 __attribute__((ext_vector_type(4)));
typedef unsigned u32x4 __attribute__((ext_vector_type(4)));
constexpr int BM = 256, BK = 64, HALF = 128, HTB = HALF * BK * 2  , STAGE_BYTES = 8 * HTB, NXCD = 8, WGM = 8;

__host__ __device__ __forceinline__ int lds_byte(int r, int c) { const int st = (r >> 4) * 2 + (c >> 5), rr = r & 15, cc = c & 31, ob = rr * 64 + cc * 2; return st * 1024 + (ob ^ (((ob >> 9) & 1) << 5)); }
__host__ __device__ __forceinline__ void stage_rc(int b, int& R, int& C) { const int st = b / 1024, sb = b % 1024, swz = sb ^ (((sb >> 9) & 1) << 5); R = (st >> 1) * 16 + swz / 64; C = (st & 1) * 32 + (swz % 64) / 2; }
__host__ __device__ __forceinline__ int perm32(int rho) { const int n = rho >> 4, i = rho & 15; return 8 * (i >> 2) + 4 * n + (i & 3); }

struct Unit { int pm, pn; };
struct Gemm { const bf16_t* A; const bf16_t* Bt; int M, N, K, lda, ldb; };

struct StaticOrder {
    int nM, nN, nwg, G, c;
    __host__ __device__ void init(int M, int N, int G_, int c_) { nM = M / BM; nN = N / BM; nwg = nM * nN; G = G_; c = c_; }
    __host__ __device__ bool next(int i, Unit& u) const {
        const long L = (long)i * G + c; if (L >= nwg) return false;
        int wgid = (int)L; { const int q = nwg / NXCD, r = nwg % NXCD, xcd = wgid % NXCD, off = wgid / NXCD; wgid = (xcd < r ? xcd * (q + 1) : r * (q + 1) + (xcd - r) * q) + off; }
        const int nig = WGM * nN, gid = wgid / nig, fm = gid * WGM, gsz = (nM - fm) < WGM ? (nM - fm) : WGM;
        u.pm = fm + ((wgid % nig) % gsz); u.pn = (wgid % nig) / gsz; return true;
    }
    __device__ __forceinline__ void a_ready(const Unit&, int, int) const {}
    __device__ __forceinline__ void done(const Unit&) const {}
};
#define PG8_RSL ((PG8_LAS float*)(131072 + 4096))
struct RsOrder : StaticOrder {
    const float* part;
    __device__ __forceinline__ void a_ready(const Unit& u, int ui, int tid) const;
};

__device__ __forceinline__ unsigned cvt_pk_bf16(float lo, float hi) { unsigned r; asm volatile("v_cvt_pk_bf16_f32 %0, %1, %2" : "=v"(r) : "v"(lo), "v"(hi)); return r; }
__device__ __forceinline__ u32x4 pack8(const f32x4 a, const f32x4 b) { u32x4 w; w.x = cvt_pk_bf16(a[0], a[1]); w.y = cvt_pk_bf16(a[2], a[3]); w.z = cvt_pk_bf16(b[0], b[1]); w.w = cvt_pk_bf16(b[2], b[3]); return w; }
__device__ __forceinline__ float sigmoidf_(float x) { return __builtin_amdgcn_rcpf(1.0f + __expf(-x)); }
__device__ __forceinline__ f32x4 sig4(const f32x4 x) { return (f32x4){sigmoidf_(x[0]), sigmoidf_(x[1]), sigmoidf_(x[2]), sigmoidf_(x[3])}; }
__device__ __forceinline__ float row_rstd(const float* part, int row) {
    const f32x4* p = (const f32x4*)(part + (size_t)row * 16); const f32x4 a = p[0], b = p[1], c = p[2], d = p[3];
    const float s = ((a[0] + a[1]) + (a[2] + a[3])) + ((b[0] + b[1]) + (b[2] + b[3])) + ((c[0] + c[1]) + (c[2] + c[3])) + ((d[0] + d[1]) + (d[2] + d[3]));
    return rsqrtf(s * (1.0f / 1024.0f) + 1e-6f);
}
__device__ __forceinline__ void RsOrder::a_ready(const Unit& u, int ui, int tid) const { if (tid < 256) PG8_RSL[(ui & 1) * 256 + tid] = row_rstd(part, u.pm * BM + tid); }
__device__ __forceinline__ int tpos_of_row(int row) { return row < MR ? (NMETA + (row & (SEQ - 1))) : (row < MR + NMETA ? row - MR : 0); }

struct EpiIn0 {
    static constexpr bool PERM = true, AFTER_DRAIN = false;
    bf16_t* U; bf16_t* WC; bf16_t* GB; const float* part;
    __device__ __forceinline__ void operator()(const f32x4 (&acc)[2][2][4][2], const Unit& u, int wr, int wc, int fr, int fq, int ui) const {
        const int row0 = u.pm * BM + wr * 64 + fr;
#pragma unroll
        for (int ai = 0; ai < 2; ++ai)
#pragma unroll
            for (int m = 0; m < 4; ++m) {
                const int row = row0 + ai * HALF + m * 16; const float rs = PG8_RSL[(ui & 1) * 256 + (row - u.pm * BM)];
                if (u.pn < 8) {
                    bf16_t* dst = (u.pn < 4 ? U : WC) + (size_t)row * 512 + (u.pn & 3) * 128 + wc * 32 + 8 * fq;
                    const f32x4 a0 = acc[ai][0][m][0] * rs, a1 = acc[ai][0][m][1] * rs, b0 = acc[ai][1][m][0] * rs, b1 = acc[ai][1][m][1] * rs;
                    f32x4 o0, o1;
                    if (u.pn < 4) { o0 = a0 * sig4(b0); o1 = a1 * sig4(b1); } else { o0 = a0 * b0; o1 = a1 * b1; }
                    *(u32x4*)dst = pack8(o0, o1);
                } else {
#pragma unroll
                    for (int bj = 0; bj < 2; ++bj) { bf16_t* dst = GB + (size_t)row * 512 + (u.pn - 8) * 256 + bj * HALF + wc * 32 + 8 * fq;
                        *(u32x4*)dst = pack8(acc[ai][bj][m][0] * rs, acc[ai][bj][m][1] * rs); }
                }
            }
    }
};
struct EpiRes {
    static constexpr bool PERM = true, AFTER_DRAIN = false;
    const float* base; float* out; float* hmeta; bf16_t* Abuf; float* part; int mode; int in_nat, out_nat;
    __device__ __forceinline__ void operator()(const f32x4 (&acc)[2][2][4][2], const Unit& u, int wr, int wc, int fr, int fq, int ui) const {
        const size_t tb = (size_t)(u.pm * 4 + u.pn) * 65536; const int wl = ((wr * 4 + wc) * 64 + fq * 16 + fr) * 8;
#pragma unroll
        for (int ai = 0; ai < 2; ++ai)
#pragma unroll
            for (int m = 0; m < 4; ++m) {
                const int lr = wr * 64 + fr + ai * HALF + m * 16, row = u.pm * BM + lr; float ss = 0.f;
#pragma unroll
                for (int bj = 0; bj < 2; ++bj) { const int col = u.pn * BM + bj * HALF + wc * 32 + 8 * fq;
                    const size_t nat = (size_t)row * DM + col, blk = tb + (size_t)(((ai * 4 + m) * 2 + bj) * 4096) + wl;
                    const float* ip = base + (in_nat ? nat : blk); float* op = out + (out_nat ? nat : blk);
                    f32x4 h0 = *(const f32x4*)ip, h1 = *(const f32x4*)(ip + 4);
                    h0 += acc[ai][bj][m][0]; h1 += acc[ai][bj][m][1];
                    *(f32x4*)op = h0; *(f32x4*)(op + 4) = h1;
                    if (mode) { ss += (h0[0] * h0[0] + h0[1] * h0[1]) + (h0[2] * h0[2] + h0[3] * h0[3]) + (h1[0] * h1[0] + h1[1] * h1[1]) + (h1[2] * h1[2] + h1[3] * h1[3]);
                        *(u32x4*)(Abuf + (size_t)row * DM + col) = pack8(h0, h1); } }
                if (mode) { ss += __shfl_xor(ss, 16); ss += __shfl_xor(ss, 32); if (fq == 0) part[(size_t)row * 16 + u.pn * 4 + wc] = ss; }
            }
    }
};
__device__ __forceinline__ float dpp_ror1(float x) { return __builtin_bit_cast(float, __builtin_amdgcn_update_dpp(0, __builtin_bit_cast(int, x), 0x121, 0xF, 0xF, false)); }
__device__ __forceinline__ float dpp_ror2(float x) { return __builtin_bit_cast(float, __builtin_amdgcn_update_dpp(0, __builtin_bit_cast(int, x), 0x122, 0xF, 0xF, false)); }
__device__ __forceinline__ f32x4 ror1_4(const f32x4 v) { return (f32x4){dpp_ror1(v[0]), dpp_ror1(v[1]), dpp_ror1(v[2]), dpp_ror1(v[3])}; }
__device__ __forceinline__ f32x4 ror2_4(const f32x4 v) { return (f32x4){dpp_ror2(v[0]), dpp_ror2(v[1]), dpp_ror2(v[2]), dpp_ror2(v[3])}; }
__device__ __forceinline__ f32x4 silu4(const f32x4 z) { return z * sig4(z); }
struct EpiUpConv {
    static constexpr bool PERM = true, AFTER_DRAIN = false;
    unsigned char* ws; const float* cw; const float* cb;
    __device__ __forceinline__ void operator()(const f32x4 (&acc)[2][2][4][2], const Unit& u, int wr, int wc, int fr, int fq, int ui) const {
        bf16_t* HM = (bf16_t*)(ws + EO_HM); float* EDGE_G = (float*)(ws + EO_EDGE_G); float* EDGE_V = (float*)(ws + EO_EDGE_V); float* HALO = (float*)(ws + EO_HALO); const float* part = (const float*)(ws + EO_PART);
        const int c0 = u.pn * 128 + wc * 32 + 8 * fq, row0 = u.pm * BM + wr * 64 + fr;
        PG8_LAS f32x4* X = (PG8_LAS f32x4*)131072;
        if (fr >= 14) {
#pragma unroll
            for (int ai = 0; ai < 2; ++ai) { const float rs = PG8_RSL[(ui & 1) * 256 + (row0 - u.pm * BM) + ai * HALF + 48]; const int sidx = ((((2 * ai + wr) * 2 + (fr - 14)) * 4 + wc) * 4 + fq) * 2; X[sidx] = acc[ai][0][3][0] * rs; X[sidx + 1] = acc[ai][0][3][1] * rs;
                if (ai == 1 && u.pm < 64 && wr == 1) { float* hp = HALO + ((size_t)(u.pm * 2 + (fr - 14))) * 2816 + c0; *(f32x4*)hp = acc[1][0][3][0] * rs; *(f32x4*)(hp + 4) = acc[1][0][3][1] * rs; } }
            if (u.pm == 64 && wr == 0) { const float rs = PG8_RSL[(ui & 1) * 256 + (row0 - u.pm * BM)]; float* hp = HALO + ((size_t)(64 * 2 + (fr - 14))) * 2816 + c0; *(f32x4*)hp = acc[0][0][0][0] * rs; *(f32x4*)(hp + 4) = acc[0][0][0][1] * rs; }
        }
        asm volatile("s_waitcnt lgkmcnt(0)\n\ts_barrier" ::: "memory");
        const f32x4 w0a = *(const f32x4*)(cw + c0), w0b = *(const f32x4*)(cw + c0 + 4), w1a = *(const f32x4*)(cw + 2816 + c0), w1b = *(const f32x4*)(cw + 2816 + c0 + 4),
                    w2a = *(const f32x4*)(cw + 5632 + c0), w2b = *(const f32x4*)(cw + 5632 + c0 + 4), bba = *(const f32x4*)(cb + c0), bbb = *(const f32x4*)(cb + c0 + 4);
#pragma unroll
        for (int ai = 0; ai < 2; ++ai) {
            const int sg = 2 * ai + wr;
            f32x4 x15a = (f32x4){0.f, 0.f, 0.f, 0.f}, x15b = x15a, x14a = x15a, x14b = x15a;
            if (sg > 0 && fr < 2) { const int b15 = ((((sg - 1) * 2 + 1) * 4 + wc) * 4 + fq) * 2, b14 = ((((sg - 1) * 2 + 0) * 4 + wc) * 4 + fq) * 2; x15a = X[b15]; x15b = X[b15 + 1]; x14a = X[b14]; x14b = X[b14 + 1]; }
            f32x4 q1a = x15a, q1b = x15b, q2a = x14a, q2b = x14b;
#pragma unroll
            for (int m = 0; m < 4; ++m) {
                const int row = row0 + ai * HALF + m * 16; const float rs = PG8_RSL[(ui & 1) * 256 + (row - u.pm * BM)];
                const f32x4 ga = acc[ai][0][m][0] * rs, gb = acc[ai][0][m][1] * rs;
                const f32x4 r1a = ror1_4(ga), r1b = ror1_4(gb), r2a = ror2_4(ga), r2b = ror2_4(gb);
                f32x4 p1a = r1a, p1b = r1b, p2a = r2a, p2b = r2b;
                if (m > 0) { if (fr < 1) { p1a = q1a; p1b = q1b; } if (fr < 2) { p2a = q2a; p2b = q2b; } }
                else { if (fr == 0) { p1a = x15a; p1b = x15b; p2a = x14a; p2b = x14b; } else if (fr == 1) { p2a = x15a; p2b = x15b; } }
                q1a = r1a; q1b = r1b; q2a = r2a; q2b = r2b;
                const f32x4 va = acc[ai][1][m][0] * rs, vb = acc[ai][1][m][1] * rs;
                if (sg == 0 && m == 0 && fr < 2) {
                    float* eg = EDGE_G + ((size_t)(u.pm * 2 + fr)) * 2816 + c0; float* ev = EDGE_V + ((size_t)(u.pm * 2 + fr)) * 2816 + c0;
                    *(f32x4*)eg = ga; *(f32x4*)(eg + 4) = gb; *(f32x4*)ev = va; *(f32x4*)(ev + 4) = vb;
                } else {
                    const f32x4 za = w0a * p2a + w1a * p1a + w2a * ga + bba, zb = w0b * p2b + w1b * p1b + w2b * gb + bbb;
                    *(u32x4*)(HM + (size_t)row * 2816 + c0) = pack8(silu4(za) * va, silu4(zb) * vb);
                }
                asm volatile("" ::: "memory");
            }
        }
    }
};
struct EpiIn1 {
    static constexpr bool PERM = true, AFTER_DRAIN = false;
    bf16_t* Q; bf16_t* KB; bf16_t* VB; bf16_t* PR; const float* part; const float* ropec; const float* ropes;
    __device__ __forceinline__ void operator()(const f32x4 (&acc)[2][2][4][2], const Unit& u, int wr, int wc, int fr, int fq, int ui) const {
        const int row0 = u.pm * BM + wr * 64 + fr;
#pragma unroll
        for (int ai = 0; ai < 2; ++ai)
#pragma unroll
            for (int m = 0; m < 4; ++m) {
                const int row = row0 + ai * HALF + m * 16; const float rs = PG8_RSL[(ui & 1) * 256 + (row - u.pm * BM)];
                if (u.pn >= 3) {
#pragma unroll
                    for (int bj = 0; bj < 2; ++bj) *(u32x4*)(PR + (size_t)row * PRW + (u.pn - 3) * 256 + bj * HALF + wc * 32 + 8 * fq) = pack8(acc[ai][bj][m][0] * rs, acc[ai][bj][m][1] * rs);
                } else {
                    const f32x4 a0 = acc[ai][0][m][0] * rs, a1 = acc[ai][0][m][1] * rs, b0 = acc[ai][1][m][0] * rs, b1 = acc[ai][1][m][1] * rs;
                    if (u.pn == 2 && wc >= 2) {
                        bf16_t* dst = VB + (size_t)row * 128 + (wc - 2) * 64 + 8 * fq;
                        *(u32x4*)dst = pack8(a0, a1); *(u32x4*)(dst + 32) = pack8(b0, b1);
                    } else {
                        const int t = tpos_of_row(row);
                        const f32x4 c0 = *(const f32x4*)(ropec + t * 32 + 8 * fq), c1 = *(const f32x4*)(ropec + t * 32 + 8 * fq + 4);
                        const f32x4 s0 = *(const f32x4*)(ropes + t * 32 + 8 * fq), s1 = *(const f32x4*)(ropes + t * 32 + 8 * fq + 4);
                        const f32x4 x0 = a0 * c0 - b0 * s0, x1 = a1 * c1 - b1 * s1, y0 = b0 * c0 + a0 * s0, y1 = b1 * c1 + a1 * s1;
                        bf16_t* dst = (u.pn == 2) ? KB + (size_t)row * 128 + wc * 64 + 8 * fq : Q + (size_t)row * 512 + (u.pn * 4 + wc) * 64 + 8 * fq;
                        *(u32x4*)dst = pack8(x0, x1); *(u32x4*)(dst + 32) = pack8(y0, y1);
                    }
                }
            }
    }
};

template <class Epi, class Sched, bool ALIGN_EPI = false, bool SP2 = false, int CK = 0, int CLDA = 0, int CLDB = 0>
__device__ __forceinline__ void gemm_phase(PG8_LAS unsigned char* lds, const Gemm g, const Sched& S, const Epi& E, const int tid_in) {
    int tid_ = tid_in; asm volatile("" : "+v"(tid_));
    const int tid = tid_, wid = __builtin_amdgcn_readfirstlane(tid >> 6), lane = tid & 63, wr = wid >> 2, wc = wid & 3, fr = lane & 15, fq = lane >> 4;
    const int K = CK ? CK : g.K, nt = K / BK; const int lda_ = CLDA ? CLDA : g.lda, ldb_ = CLDB ? CLDB : g.ldb;
    unsigned voffA[2], voffB[2];
#pragma unroll
    for (int i = 0; i < 2; ++i) { int R, C; stage_rc(tid * 16 + i * 8192, R, C); const int Rb = Epi::PERM ? ((R & ~31) + perm32(R & 31)) : R;
        voffA[i] = (unsigned)(R * lda_ + C) * 2u; voffB[i] = (unsigned)(Rb * ldb_ + C) * 2u; }
    const size_t kstep = (size_t)(BK * 2);
    const size_t hstepA = (size_t)HALF * lda_ * 2, hstepB = (size_t)HALF * ldb_ * 2;
    const size_t tstepA = 2 * hstepA, tstepB = 2 * hstepB;
    const unsigned ldsw = (unsigned)wid * 1024u;
    const int aoff = lds_byte(wr * 64 + fr, fq * 8), boff = lds_byte(wc * 32 + fr, fq * 8);
#define PG8_SA(b, h) (((b) * 2 + (h)) * HTB)
#define PG8_SB(b, h) ((4 + (b) * 2 + (h)) * HTB)
#define PG8_STAGE(bufoff, gbase, voff) do { _Pragma("unroll") for (int _i = 0; _i < 2; ++_i) \
        __builtin_amdgcn_global_load_lds((const unsigned*)((const char*)(gbase) + (voff)[_i]), (PG8_LAS unsigned*)(lds + (bufoff) + ldsw + _i * 8192), 16, 0, 0); } while (0)
#define PG8_LDA(dst, b, h) do { _Pragma("unroll") for (int m = 0; m < 4; ++m) _Pragma("unroll") for (int k = 0; k < 2; ++k) dst[m][k] = *(const PG8_LAS bf16x8*)(lds + PG8_SA(b, h) + aoff + m * 2048 + k * 1024); } while (0)
#define PG8_LDB(dst, b, h) do { _Pragma("unroll") for (int n = 0; n < 2; ++n) _Pragma("unroll") for (int k = 0; k < 2; ++k) dst[n][k] = *(const PG8_LAS bf16x8*)(lds + PG8_SB(b, h) + boff + n * 2048 + k * 1024); } while (0)
#define PG8_MMA(ai, bj, At, Bt) do { __builtin_amdgcn_s_setprio(1); _Pragma("unroll") for (int m = 0; m < 4; ++m) _Pragma("unroll") for (int n = 0; n < 2; ++n) _Pragma("unroll") for (int k = 0; k < 2; ++k) \
        acc[ai][bj][m][n] = __builtin_amdgcn_mfma_f32_16x16x32_bf16(Bt[n][k], At[m][k], acc[ai][bj][m][n], 0, 0, 0); __builtin_amdgcn_s_setprio(0); } while (0)
#define PG8_WAIT_V(n) asm volatile("s_waitcnt vmcnt(" #n ")" ::: "memory")
#define PG8_WAIT_L(n) asm volatile("s_waitcnt lgkmcnt(" #n ")" ::: "memory")
#define PG8_BAR __builtin_amdgcn_s_barrier()
#define PG8_SCHED __builtin_amdgcn_sched_barrier(0)
    Unit cur, nxt; int ui = 0;
    if (!S.next(0, cur)) return;
    f32x4 acc[2][2][4][2];
#pragma unroll
    for (int a = 0; a < 2; ++a)
#pragma unroll
        for (int b = 0; b < 2; ++b)
#pragma unroll
            for (int m = 0; m < 4; ++m)
#pragma unroll
                for (int n = 0; n < 2; ++n) acc[a][b][m][n] = (f32x4){0.f, 0.f, 0.f, 0.f};
    bf16x8 At[4][2], B0[2][2], B1[2][2];
    const char* cA = (const char*)g.A + (size_t)cur.pm * tstepA; const char* cB = (const char*)g.Bt + (size_t)cur.pn * tstepB;
    S.a_ready(cur, 0, tid);
    if constexpr (SP2) {
        PG8_STAGE(PG8_SB(0, 0), cB, voffB); PG8_STAGE(PG8_SB(0, 1), cB + hstepB, voffB); PG8_STAGE(PG8_SA(0, 0), cA, voffA); PG8_STAGE(PG8_SA(0, 1), cA + hstepA, voffA);
        if (wr == 1) PG8_BAR;
        PG8_WAIT_V(2); PG8_BAR;
        PG8_STAGE(PG8_SB(1, 0), cB + kstep, voffB); PG8_STAGE(PG8_SA(1, 0), cA + kstep, voffA); PG8_STAGE(PG8_SB(1, 1), cB + hstepB + kstep, voffB);
        PG8_WAIT_V(6); PG8_BAR;
    } else {
        PG8_STAGE(PG8_SB(0, 0), cB, voffB); PG8_STAGE(PG8_SA(0, 0), cA, voffA); PG8_STAGE(PG8_SB(0, 1), cB + hstepB, voffB); PG8_STAGE(PG8_SA(0, 1), cA + hstepA, voffA);
        if (wr == 1) PG8_BAR;
        PG8_WAIT_V(4); PG8_BAR;
        PG8_STAGE(PG8_SB(1, 0), cB + kstep, voffB); PG8_STAGE(PG8_SA(1, 0), cA + kstep, voffA); PG8_STAGE(PG8_SB(1, 1), cB + hstepB + kstep, voffB);
        PG8_WAIT_V(6); PG8_BAR;
    }
    for (;;) {
        const bool has_next = S.next(ui + 1, nxt);
        const char* nA = has_next ? (const char*)g.A + (size_t)nxt.pm * tstepA : cA; const char* nB = has_next ? (const char*)g.Bt + (size_t)nxt.pn * tstepB : cB;
        for (int t = 0; t < nt; t += 2) {
            const bool last = (t == nt - 2);
            const char* a1 = cA + (size_t)(t + 1) * kstep;
            const char* a2 = last ? nA : cA + (size_t)(t + 2) * kstep; const char* b2 = last ? nB : cB + (size_t)(t + 2) * kstep;
            const char* a3 = a2 + kstep; const char* b3 = b2 + kstep;
            if (last && has_next) S.a_ready(nxt, ui + 1, tid);
            if constexpr (SP2) {
            PG8_LDB(B0, 0, 0); PG8_LDB(B1, 0, 1); PG8_SCHED; PG8_LDA(At, 0, 0); PG8_STAGE(PG8_SA(1, 1), a1 + hstepA, voffA);
            PG8_WAIT_V(8); PG8_WAIT_L(0); PG8_BAR; PG8_MMA(0, 0, At, B0); PG8_MMA(0, 1, At, B1); PG8_BAR; PG8_SCHED;
            PG8_LDA(At, 0, 1); PG8_STAGE(PG8_SB(0, 0), b2, voffB); PG8_STAGE(PG8_SB(0, 1), b2 + hstepB, voffB); PG8_STAGE(PG8_SA(0, 0), a2, voffA);
            PG8_WAIT_V(8); PG8_WAIT_L(0); PG8_BAR; PG8_MMA(1, 0, At, B0); PG8_MMA(1, 1, At, B1); PG8_BAR; PG8_SCHED;
            PG8_LDB(B0, 1, 0); PG8_LDB(B1, 1, 1); PG8_SCHED; PG8_LDA(At, 1, 0); PG8_STAGE(PG8_SA(0, 1), a2 + hstepA, voffA);
            PG8_WAIT_V(8); PG8_WAIT_L(0); PG8_BAR; PG8_MMA(0, 0, At, B0); PG8_MMA(0, 1, At, B1); PG8_BAR; PG8_SCHED;
            PG8_LDA(At, 1, 1); PG8_STAGE(PG8_SB(1, 0), b3, voffB); PG8_STAGE(PG8_SB(1, 1), b3 + hstepB, voffB); PG8_STAGE(PG8_SA(1, 0), a3, voffA);
            PG8_WAIT_V(8); PG8_WAIT_L(0); PG8_BAR; PG8_MMA(1, 0, At, B0); PG8_MMA(1, 1, At, B1); PG8_BAR; PG8_SCHED;
            } else {
            PG8_LDB(B0, 0, 0); PG8_SCHED; PG8_LDA(At, 0, 0); PG8_STAGE(PG8_SA(1, 1), a1 + hstepA, voffA);
            PG8_WAIT_L(8); PG8_BAR; PG8_WAIT_L(0); PG8_MMA(0, 0, At, B0); PG8_BAR; PG8_SCHED;
            PG8_LDB(B1, 0, 1); PG8_STAGE(PG8_SB(0, 0), b2, voffB);
            PG8_BAR; PG8_WAIT_L(0); PG8_MMA(0, 1, At, B1); PG8_BAR;
            PG8_LDA(At, 0, 1); PG8_STAGE(PG8_SA(0, 0), a2, voffA);
            PG8_BAR; PG8_WAIT_L(0); PG8_MMA(1, 0, At, B0); PG8_BAR; PG8_SCHED;
            PG8_STAGE(PG8_SB(0, 1), b2 + hstepB, voffB);
            PG8_WAIT_V(6); PG8_BAR; PG8_MMA(1, 1, At, B1); PG8_BAR;
            PG8_LDB(B0, 1, 0); PG8_SCHED; PG8_LDA(At, 1, 0); PG8_STAGE(PG8_SA(0, 1), a2 + hstepA, voffA);
            PG8_WAIT_L(8); PG8_BAR; PG8_WAIT_L(0); PG8_MMA(0, 0, At, B0); PG8_BAR; PG8_SCHED;
            PG8_LDB(B1, 1, 1); PG8_STAGE(PG8_SB(1, 0), b3, voffB);
            PG8_BAR; PG8_WAIT_L(0); PG8_MMA(0, 1, At, B1); PG8_BAR;
            PG8_LDA(At, 1, 1); PG8_STAGE(PG8_SA(1, 0), a3, voffA);
            PG8_BAR; PG8_WAIT_L(0); PG8_MMA(1, 0, At, B0); PG8_BAR; PG8_SCHED;
            PG8_STAGE(PG8_SB(1, 1), b3 + hstepB, voffB);
            PG8_WAIT_V(6); PG8_BAR; PG8_MMA(1, 1, At, B1); PG8_BAR;
            }
        }
        if constexpr (ALIGN_EPI) { if (wr == 0) PG8_BAR; }
        if constexpr (!Epi::AFTER_DRAIN) { E(acc, cur, wr, wc, fr, fq, ui); S.done(cur); }
        if (!has_next) break;
#pragma unroll
        for (int a = 0; a < 2; ++a)
#pragma unroll
            for (int b = 0; b < 2; ++b)
#pragma unroll
                for (int m = 0; m < 4; ++m)
#pragma unroll
                    for (int n = 0; n < 2; ++n) acc[a][b][m][n] = (f32x4){0.f, 0.f, 0.f, 0.f};
        cur = nxt; cA = nA; cB = nB; ++ui;
        if constexpr (ALIGN_EPI) { if (wr == 1) PG8_BAR; }
    }
    PG8_WAIT_V(0);
    if constexpr (!ALIGN_EPI) { if (wr == 0) PG8_BAR; }
    PG8_BAR;
    if constexpr (Epi::AFTER_DRAIN) { E.fused(acc, cur, wr, wc, fr, fq, lds, wid, lane); S.done(cur); }
#undef PG8_SA
#undef PG8_SB
#undef PG8_STAGE
#undef PG8_LDA
#undef PG8_LDB
#undef PG8_MMA
#undef PG8_WAIT_V
#undef PG8_WAIT_L
#undef PG8_BAR
#undef PG8_SCHED
}
}

constexpr int NWAVES = 8, NTHR = 512;
constexpr int LDS_BYTES = 147456;
#define GAS __attribute__((address_space(1)))
#define LAS __attribute__((address_space(3)))
typedef unsigned short bf16;
typedef unsigned v4u __attribute__((ext_vector_type(4)));
typedef unsigned v2u __attribute__((ext_vector_type(2)));
typedef float f32x4 __attribute__((ext_vector_type(4)));
typedef float f32x2 __attribute__((ext_vector_type(2)));
typedef float f32x16 __attribute__((ext_vector_type(16)));
typedef short bf16x8 __attribute__((ext_vector_type(8)));
typedef short s16x4 __attribute__((ext_vector_type(4)));

constexpr size_t MiB = 1u << 20;
constexpr size_t WS_CTL = 0;
constexpr size_t WS_PART = 1 * MiB;
constexpr size_t WS_ROPE = 3 * MiB;
constexpr size_t WS_HMETA = 4 * MiB;
constexpr size_t WS_LORA = 5 * MiB;
constexpr size_t WS_W = 6 * MiB;
constexpr size_t W_IN0 = WS_W, W_OUT0 = W_IN0 + (size_t)NIN * DM * 2, W_UP0 = W_OUT0 + (size_t)DM * DM * 2, W_DN0 = W_UP0 + (size_t)2 * DFF * DM * 2,
                 W_IN1 = W_DN0 + (size_t)DM * DFF * 2, W_OUT1 = W_IN1 + (size_t)NIN * DM * 2, W_UP1 = W_OUT1 + (size_t)DM * DM * 2, W_DN1 = W_UP1 + (size_t)2 * DFF * DM * 2,
                 W_END = W_DN1 + (size_t)DM * DFF * 2;
constexpr size_t WS_A = 56 * MiB;
constexpr size_t WS_R = 89 * MiB;
static_assert(W_END <= WS_A && WS_A + (size_t)MP * DM * 2 <= WS_R, "ws map");
constexpr size_t R_U = WS_R, R_WC = R_U + (size_t)MP * 512 * 2, R_GB = R_WC + (size_t)MP * 512 * 2, R_Y0 = R_GB + (size_t)MP * 512 * 2;
constexpr size_t R_HM = WS_R, R_EDGE_G = R_HM + (size_t)MP * DFF * 2, R_EDGE_V = R_EDGE_G + (size_t)65 * 2 * DFF * 4, R_HALO = R_EDGE_V + (size_t)65 * 2 * DFF * 4, R_FFN_END = R_HALO + (size_t)65 * 2 * DFF * 4;
constexpr size_t R_Q = WS_R, R_KB = R_Q + (size_t)MP * 512 * 2, R_VB = R_KB + (size_t)MP * 128 * 2, R_PR = R_VB + (size_t)MP * 128 * 2, R_Y1 = R_PR + (size_t)MP * PRW * 2, R_L1_END = R_Y1 + (size_t)MP * DM * 2;
constexpr size_t WS_END = 256 * MiB;
constexpr size_t WS_HFIN = 184 * MiB;
static_assert(EO_PART == WS_PART && EO_HM == R_HM && EO_EDGE_G == R_EDGE_G && EO_EDGE_V == R_EDGE_V && EO_HALO == R_HALO, "epilogue offsets");
static_assert(R_FFN_END <= WS_HFIN && WS_HFIN + (size_t)MR * DM * 4 <= WS_END, "final stream buffer");
static_assert(R_FFN_END <= WS_END && R_L1_END <= WS_END && R_Y0 + (size_t)MP * DM * 2 <= WS_END, "ws map 2");

#define LDS_WAIT() asm volatile("s_waitcnt lgkmcnt(0)" ::: "memory")
__device__ __forceinline__ unsigned f2bf(float f) { unsigned u = __builtin_bit_cast(unsigned, f); return (u + 0x7fffu + ((u >> 16) & 1u)) >> 16; }
__device__ __forceinline__ unsigned pk2(float lo, float hi) { return f2bf(lo) | (f2bf(hi) << 16); }
__device__ __forceinline__ float bf2f(unsigned short v) { return __builtin_bit_cast(float, (unsigned)v << 16); }
__device__ __forceinline__ float bflo(unsigned w) { return __builtin_bit_cast(float, w << 16); }
__device__ __forceinline__ float bfhi(unsigned w) { return __builtin_bit_cast(float, w & 0xffff0000u); }
__device__ __forceinline__ float sigm(float x) { return __builtin_amdgcn_rcpf(1.0f + __expf(-x)); }
__device__ __forceinline__ float dppf(float x, int ctrl_sel) {
    const int v = __builtin_bit_cast(int, x); int r;
    if (ctrl_sel == 0) r = __builtin_amdgcn_update_dpp(v, v, 0xB1, 0xF, 0xF, false);
    else if (ctrl_sel == 1) r = __builtin_amdgcn_update_dpp(v, v, 0x4E, 0xF, 0xF, false);
    else if (ctrl_sel == 2) r = __builtin_amdgcn_update_dpp(v, v, 0x141, 0xF, 0xF, false);
    else r = __builtin_amdgcn_update_dpp(v, v, 0x140, 0xF, 0xF, false);
    return __builtin_bit_cast(float, r);
}
__device__ __forceinline__ float sum16(float x) { x += dppf(x, 0); x += dppf(x, 1); x += dppf(x, 2); x += dppf(x, 3); return x; }

__device__ __forceinline__ void sum16x2(float& x0, float& x1) {
    asm volatile("s_nop 1\n\t"
        "v_add_f32_dpp %0, %0, %0 quad_perm:[1,0,3,2] row_mask:0xf bank_mask:0xf\n\t"
        "v_add_f32_dpp %1, %1, %1 quad_perm:[1,0,3,2] row_mask:0xf bank_mask:0xf\n\t"
        "s_nop 0\n\t"
        "v_add_f32_dpp %0, %0, %0 quad_perm:[2,3,0,1] row_mask:0xf bank_mask:0xf\n\t"
        "v_add_f32_dpp %1, %1, %1 quad_perm:[2,3,0,1] row_mask:0xf bank_mask:0xf\n\t"
        "s_nop 0\n\t"
        "v_add_f32_dpp %0, %0, %0 row_half_mirror row_mask:0xf bank_mask:0xf\n\t"
        "v_add_f32_dpp %1, %1, %1 row_half_mirror row_mask:0xf bank_mask:0xf\n\t"
        "s_nop 0\n\t"
        "v_add_f32_dpp %0, %0, %0 row_mirror row_mask:0xf bank_mask:0xf\n\t"
        "v_add_f32_dpp %1, %1, %1 row_mirror row_mask:0xf bank_mask:0xf\n\t"
        "s_nop 1"
        : "+v"(x0), "+v"(x1));
}
__device__ __forceinline__ float sum32(float x) { x = sum16(x); x += __shfl_xor(x, 16); return x; }
__device__ __forceinline__ float wave_sum(float v) {
#pragma unroll
    for (int o = 1; o < 64; o <<= 1) v += __shfl_xor(v, o);
    return v;
}
__device__ __forceinline__ int row_of(int b, int t) { return t >= NMETA ? b * SEQ + (t - NMETA) : MR + t; }


#define XB_TMO      128
#define XB_XCNT(j)  (256  + 64 * (j))
#define XB_XSUB(j)  (1280 + 64 * (j))
#define XB_XGEN(j)  (2304 + 64 * (j))
#define XB_TOP      3328
#define XB_TOPGEN   3392
#define XCD_BAR_WORDS 3456
#define XB_SPIN_CAP (1u << 18)
constexpr int LDSCTL_OFF = 147328, MISC_OFF = LDSCTL_OFF;
__device__ __forceinline__ unsigned xb_ld(unsigned* p)              { return __hip_atomic_load(p, __ATOMIC_RELAXED, __HIP_MEMORY_SCOPE_AGENT); }
__device__ __forceinline__ unsigned xb_add(unsigned* p, unsigned v) { return __hip_atomic_fetch_add(p, v, __ATOMIC_RELAXED, __HIP_MEMORY_SCOPE_AGENT); }
__device__ __forceinline__ unsigned xb_xcc_id() { return (unsigned)__builtin_amdgcn_s_getreg((3 << 11) | 20) & 0xFu; }
#define XB_SPIN(cond, bar) do { unsigned _sp = 0; while (cond) { __builtin_amdgcn_s_sleep(1); \
    if ((++_sp & 255u) == 0u) { if (xb_ld(&(bar)[XB_TMO])) break; if (_sp > XB_SPIN_CAP) { atomicAdd(&(bar)[XB_TMO], 1u); break; } } } } while (0)
__device__ __forceinline__ void xcd_barrier_complete(unsigned* bar, unsigned x, unsigned& nloc, unsigned& nx) {
    const unsigned G = gridDim.x * gridDim.y * gridDim.z;
    unsigned sum, cnt, mine, sp = 0u;
    for (;;) {
        sum = 0u; cnt = 0u; mine = 0u;
#pragma unroll
        for (unsigned j = 0; j < 16; ++j) { const unsigned c = xb_ld(&bar[XB_XCNT(j)]); sum += c; cnt += (c > 0u) ? 1u : 0u; mine = (j == x) ? c : mine; }
        if (sum == G) break;
        __builtin_amdgcn_s_sleep(1);
        if ((++sp & 255u) == 0u) { if (xb_ld(&bar[XB_TMO])) break; if (sp > XB_SPIN_CAP) { atomicAdd(&bar[XB_TMO], 1u); break; } }
    }
    nloc = mine > 0u ? mine : 1u; nx = cnt > 0u ? cnt : 1u;
}
__device__ __forceinline__ void xcd_barrier(unsigned* bar, volatile LAS unsigned* st, bool t0) {
    asm volatile("s_waitcnt vmcnt(0)" ::: "memory");
    __syncthreads();
    if (t0) {
        const unsigned x = xb_xcc_id();
        __builtin_amdgcn_s_waitcnt(0);
        unsigned nloc = st[0], nx = st[1];
        if (nloc == 0u) { xcd_barrier_complete(bar, x, nloc, nx); st[0] = nloc; st[1] = nx; }
        const unsigned old = xb_add(&bar[XB_XSUB(x)], 1u);
        const unsigned gen = old / nloc;
        if (old + 1u == (gen + 1u) * nloc) {
            __builtin_amdgcn_fence(__ATOMIC_RELEASE, "agent");
            asm volatile("s_waitcnt vmcnt(0)" ::: "memory");
            const unsigned og = xb_add(&bar[XB_TOP], 1u);
            const unsigned tg = og / nx;
            if (og + 1u == (tg + 1u) * nx) xb_add(&bar[XB_TOPGEN], 1u);
            else XB_SPIN(xb_ld(&bar[XB_TOPGEN]) == tg, bar);
            __builtin_amdgcn_fence(__ATOMIC_ACQUIRE, "agent");
            xb_add(&bar[XB_XGEN(x)], 1u);
            asm volatile("s_waitcnt vmcnt(0)" ::: "memory");
        } else {
            XB_SPIN(xb_ld(&bar[XB_XGEN(x)]) == gen, bar);
            __builtin_amdgcn_fence(__ATOMIC_ACQUIRE, "agent");
            asm volatile("s_waitcnt vmcnt(0)" ::: "memory");
        }
    }
    __syncthreads();
}

struct Args { const float* in[29]; float* out; unsigned char* ws; int ph_lo, ph_hi; };
typedef const __attribute__((address_space(4))) Args CArgs;

struct Frame {
    LAS unsigned char* lds; int tid, lane, wave, G, wg;
    float* out; unsigned char* ws;
};

__device__ __forceinline__ int colmap(int kind, int d) {
    if (kind == 0) return d;
    const int tile = d >> 8, bj = (d >> 7) & 1, cc = d & 127;
    if (kind == 1) {
        if (tile < 4) return (bj ? 512 : 0) + 128 * tile + cc;
        if (tile < 8) return (bj ? 2048 : 1536) + 128 * (tile - 4) + cc;
        return 1024 + (d - 2048);
    }
    if (kind == 2) return (bj ? DFF : 0) + 128 * tile + cc;
    const int w = cc >> 5, dd = cc & 31;
    if (tile < 2) return 64 * (4 * tile + w) + 32 * bj + dd;
    if (tile == 2) return (w < 2 ? 512 + 64 * w : 640 + 64 * (w - 2)) + 32 * bj + dd;
    return d;
}
__device__ __forceinline__ void p0_transpose_item(const float* W, int K, int N, bf16* WT, const float* gvec, int kind, LAS float* scr, int item, int nblk, int lane) {
    const int kb = item / nblk, db = item % nblk, k0 = 64 * kb, d0 = 32 * db, n0 = colmap(kind, d0);
    float wv_[32];
#pragma unroll
    for (int i = 0; i < 32; ++i) { const int kk = 2 * i + (lane >> 5); wv_[i] = W[(size_t)(k0 + kk) * N + n0 + (lane & 31)]; }
    if (gvec) {
#pragma unroll
        for (int i = 0; i < 32; ++i) wv_[i] *= gvec[k0 + 2 * i + (lane >> 5)]; }
#pragma unroll
    for (int i = 0; i < 32; ++i) scr[(2 * i + (lane >> 5)) * 33 + (lane & 31)] = wv_[i];
    LDS_WAIT(); asm volatile("" ::: "memory");
    const int c = lane & 7;
#pragma unroll
    for (int j = 0; j < 4; ++j) { const int n = (lane >> 3) + 8 * j; const LAS float* s = scr + (8 * c) * 33 + n;
        v4u o; o.x = pk2(s[0 * 33], s[1 * 33]); o.y = pk2(s[2 * 33], s[3 * 33]); o.z = pk2(s[4 * 33], s[5 * 33]); o.w = pk2(s[6 * 33], s[7 * 33]);
        *(GAS v4u*)(WT + (size_t)(d0 + n) * K + k0 + 8 * c) = o; }
    LDS_WAIT(); asm volatile("" ::: "memory");
}
__device__ __forceinline__ void p0_job(Frame& F, LAS float* scr, int gw, int NGW, int& base, const float* W, int K, int N, size_t dst, const float* g, int kind) {
    const int nblk = N / 32, nitems = (K / 64) * nblk;
    int it = gw - (base % NGW); if (it < 0) it += NGW;
    for (; it < nitems; it += NGW) p0_transpose_item(W, K, N, (bf16*)(F.ws + dst), g, kind, scr, it, nblk, F.lane);
    base += nitems;
}
__device__ __forceinline__ void p0_prologue(Frame& F, CArgs& A) {
    LAS float* scr = (LAS float*)(F.lds + F.wave * 16384);
    const int gw = F.wg * NWAVES + F.wave, NGW = F.G * NWAVES, lane = F.lane;
    unsigned char* ws = F.ws;
    const float* norm_mix = A.in[2]; const float* norm_ffn = A.in[3];
    int base = 0;
    p0_job(F, scr, gw, NGW, base, A.in[5], DM, NIN, W_IN0, norm_mix, 1);
    p0_job(F, scr, gw, NGW, base, A.in[10], DM, DM, W_OUT0, nullptr, 0);
    p0_job(F, scr, gw, NGW, base, A.in[25], DM, 2 * DFF, W_UP0, norm_ffn, 2);
    p0_job(F, scr, gw, NGW, base, A.in[28], DFF, DM, W_DN0, nullptr, 0);
    p0_job(F, scr, gw, NGW, base, A.in[11], DM, NIN, W_IN1, norm_mix + DM, 3);
    p0_job(F, scr, gw, NGW, base, A.in[24], DM, DM, W_OUT1, nullptr, 0);
    p0_job(F, scr, gw, NGW, base, A.in[25] + (size_t)DM * 2 * DFF, DM, 2 * DFF, W_UP1, norm_ffn + DM, 2);
    p0_job(F, scr, gw, NGW, base, A.in[28] + (size_t)DFF * DM, DFF, DM, W_DN1, nullptr, 0);
    p0_job(F, scr, gw, NGW, base, A.in[15], 64, 512, WS_LORA, nullptr, 0);
    p0_job(F, scr, gw, NGW, base, A.in[17], 64, 512, WS_LORA + 512 * 64 * 2, nullptr, 0);
    p0_job(F, scr, gw, NGW, base, A.in[18], 128, 512, WS_LORA + 2 * 512 * 64 * 2, nullptr, 0);
    const float* x = A.in[0]; const float* meta = A.in[1];
    bf16* A0 = (bf16*)(ws + WS_A); float* part = (float*)(ws + WS_PART); float* hmeta = (float*)(ws + WS_HMETA);
    for (int row = gw; row < MR; row += 4 * NGW) {
        f32x4 v[4][4];
#pragma unroll
        for (int r = 0; r < 4; ++r) { const int rr = row + r * NGW < MR ? row + r * NGW : row;
#pragma unroll
            for (int j = 0; j < 4; ++j) v[r][j] = *(const GAS f32x4*)(x + (size_t)rr * DM + j * 256 + lane * 4); }
#pragma unroll
        for (int r = 0; r < 4; ++r) { const int rr = row + r * NGW; if (rr < MR) { float ss = 0.f;
#pragma unroll
            for (int j = 0; j < 4; ++j) { const f32x4 w = v[r][j]; ss += (w[0] * w[0] + w[1] * w[1]) + (w[2] * w[2] + w[3] * w[3]);
                v2u o; o.x = pk2(w[0], w[1]); o.y = pk2(w[2], w[3]); *(GAS v2u*)(A0 + (size_t)rr * DM + j * 256 + lane * 4) = o; }
            ss = wave_sum(ss);
            if (lane < 16) part[(size_t)rr * 16 + lane] = lane == 0 ? ss : 0.f; } }
    }
    for (int row = MR + gw; row < MP; row += NGW) {
        float* pp = part + (size_t)row * 16;
        if (row < MR + NMETA) {
            const float* src = meta + (size_t)(row - MR) * DM;
            float ss = 0.f;
#pragma unroll
            for (int j = 0; j < 4; ++j) { const f32x4 v = *(const GAS f32x4*)(src + j * 256 + lane * 4); ss += (v[0] * v[0] + v[1] * v[1]) + (v[2] * v[2] + v[3] * v[3]);
                v2u o; o.x = pk2(v[0], v[1]); o.y = pk2(v[2], v[3]); *(GAS v2u*)(A0 + (size_t)row * DM + j * 256 + lane * 4) = o;
                *(GAS f32x4*)(hmeta + (size_t)(row - MR) * DM + j * 256 + lane * 4) = v; }
            ss = wave_sum(ss);
            if (lane < 16) pp[lane] = lane == 0 ? ss : 0.f;
        } else {
            if (lane < 16) pp[lane] = 0.f;
#pragma unroll
            for (int j = 0; j < 4; ++j) { float zf; asm volatile("v_mov_b32 %0, 0" : "=v"(zf)); *(GAS f32x4*)(hmeta + (size_t)(row - MR) * DM + j * 256 + lane * 4) = (f32x4){zf, zf, zf, zf}; }
        }
    }
    float* rc = (float*)(ws + WS_ROPE); float* rsn = rc + TT * 32;
    for (int i = gw * 64 + lane; i < TT * 32; i += NGW * 64) {
        const int t = i >> 5, d = i & 31;
        const float inv = exp2f(-(float)d * (13.287712379549449f / 32.0f));
        const float ang = (float)t * inv;
        const float rev = ang * 0.15915494309189535f; const float a = (rev - floorf(rev)) * 6.283185307179586f;
        rc[i] = __cosf(a); rsn[i] = __sinf(a);
    }
}

__device__ __forceinline__ void conv0_phase(Frame& F, CArgs& A) {
    const bf16* U = (const bf16*)(F.ws + R_U); const bf16* WC = (const bf16*)(F.ws + R_WC); const bf16* GB = (const bf16*)(F.ws + R_GB); bf16* Y0 = (bf16*)(F.ws + R_Y0);
    const float* conv_a = A.in[6]; const float* ln_g = A.in[7]; const float* ln_b = A.in[8]; const float* conv_b = A.in[9];
    const int half = F.tid >> 8, ht = F.tid & 255, c0 = 2 * ht;
    LAS float* tile = (LAS float*)(F.lds + half * 40960);
    LAS float* stats = (LAS float*)(F.lds + half * 40960 + 32768);
    float wa[31][2];
#pragma unroll
    for (int j = 0; j < 31; ++j) { const f32x2 w = *(const f32x2*)(conv_a + j * 512 + c0); wa[j][0] = w.x; wa[j][1] = w.y; }
    float wb[3][2];
#pragma unroll
    for (int j = 0; j < 3; ++j) { const f32x2 w = *(const f32x2*)(conv_b + j * 512 + c0); wb[j][0] = w.x; wb[j][1] = w.y; }
    const f32x2 lg = *(const f32x2*)(ln_g + c0), lb = *(const f32x2*)(ln_b + c0);
    const int NU = NB * 128 + 1;
    const int nhu = 2 * F.G;
    for (int u0 = 0; u0 < NU; u0 += nhu) {
        const int u = u0 + F.wg * 2 + half; const bool act = u < NU;
        int b = 0, t0 = 0; if (act) { if (u == NB * 128) { b = 0; t0 = 0; } else { b = u >> 7; t0 = 16 + 16 * (u & 127); } }
        if (act) {
            unsigned uin[46];
#pragma unroll
            for (int i = 0; i < 46; ++i) { const int t = t0 - 30 + i; uin[i] = t >= 0 ? *(const unsigned*)(U + (size_t)row_of(b, t) * 512 + c0) : 0u; }
#pragma unroll
            for (int o = 0; o < 16; ++o) { float a0 = 0.f, a1 = 0.f;
#pragma unroll
                for (int j = 0; j < 31; ++j) { a0 += wa[j][0] * bflo(uin[o + j]); a1 += wa[j][1] * bfhi(uin[o + j]); }
                *(LAS f32x2*)(tile + o * 512 + c0) = (f32x2){a0, a1}; }
        }
        __syncthreads();
        if (act) {
            const int tok = ht >> 4, q = ht & 15; float s = 0.f, ss = 0.f;
#pragma unroll
            for (int i = 0; i < 8; ++i) { const f32x4 v = *(const LAS f32x4*)(tile + tok * 512 + i * 64 + q * 4); s += (v[0] + v[1]) + (v[2] + v[3]); ss += (v[0] * v[0] + v[1] * v[1]) + (v[2] * v[2] + v[3] * v[3]); }
            s = sum16(s); ss = sum16(ss);
            if (q == 0) { const float mu = s * (1.f / 512.f); float var = ss * (1.f / 512.f) - mu * mu; var = var < 0.f ? 0.f : var; stats[tok * 2] = mu; stats[tok * 2 + 1] = rsqrtf(var + 1e-5f); }
        }
        __syncthreads();
        if (act) {
            unsigned win[18];
#pragma unroll
            for (int i = 0; i < 18; ++i) { const int t = t0 - 2 + i; win[i] = t >= 0 ? *(const unsigned*)(WC + (size_t)row_of(b, t) * 512 + c0) : 0u; }
#pragma unroll
            for (int o = 0; o < 16; ++o) {
                const int row = row_of(b, t0 + o);
                const f32x2 v = *(const LAS f32x2*)(tile + o * 512 + c0); const float mu = stats[o * 2], rs = stats[o * 2 + 1];
                float y0 = (v.x - mu) * rs * lg.x + lb.x, y1 = (v.y - mu) * rs * lg.y + lb.y; y0 *= sigm(y0); y1 *= sigm(y1);
                *(unsigned*)(Y0 + (size_t)row * DM + c0) = pk2(y0, y1);
                float z0 = 0.f, z1 = 0.f;
#pragma unroll
                for (int j = 0; j < 3; ++j) { z0 += wb[j][0] * bflo(win[o + j]); z1 += wb[j][1] * bfhi(win[o + j]); }
                const unsigned gbv = *(const unsigned*)(GB + (size_t)row * 512 + c0);
                *(unsigned*)(Y0 + (size_t)row * DM + 512 + c0) = pk2(z0 * bflo(gbv), z1 * bfhi(gbv));
            }
        }
        __syncthreads();
    }
}

__device__ __forceinline__ void ffn_fix_phase(Frame& F, CArgs& A, int layer) {
    bf16* HM = (bf16*)(F.ws + R_HM); const float* EG = (const float*)(F.ws + R_EDGE_G); const float* EV = (const float*)(F.ws + R_EDGE_V); const float* HL = (const float*)(F.ws + R_HALO);
    const float* cw = A.in[26] + (size_t)layer * 3 * DFF; const float* cb = A.in[27] + (size_t)layer * DFF;
    const int NIT = 65 * 2 * (DFF / 4);
    for (int it = F.wg * NTHR + F.tid; it < NIT; it += F.G * NTHR) {
        const int c = (it % (DFF / 4)) * 4, pl = it / (DFF / 4), pm = pl >> 1, lr = pl & 1;
        const f32x4 g0 = *(const f32x4*)(EG + (size_t)(pm * 2 + lr) * DFF + c), v = *(const f32x4*)(EV + (size_t)(pm * 2 + lr) * DFF + c);
        f32x4 a254 = (f32x4){0.f, 0.f, 0.f, 0.f}, a255 = a254;
        if (pm < 64) { const int src = (pm & 7) == 0 ? 64 : pm - 1; a254 = *(const f32x4*)(HL + (size_t)(src * 2 + 0) * DFF + c); a255 = *(const f32x4*)(HL + (size_t)(src * 2 + 1) * DFF + c); }
        const f32x4 g1 = lr == 0 ? a255 : *(const f32x4*)(EG + (size_t)(pm * 2) * DFF + c), g2 = lr == 0 ? a254 : a255;
        const f32x4 z = *(const f32x4*)(cw + c) * g2 + *(const f32x4*)(cw + DFF + c) * g1 + *(const f32x4*)(cw + 2 * DFF + c) * g0 + *(const f32x4*)(cb + c);
        const f32x4 o = z * (f32x4){sigm(z[0]), sigm(z[1]), sigm(z[2]), sigm(z[3])} * v;
        v2u ov; ov.x = pk2(o[0], o[1]); ov.y = pk2(o[2], o[3]);
        *(v2u*)(HM + (size_t)(pm * 256 + lr) * DFF + c) = ov;
    }
}

__device__ __forceinline__ int crow(int r, int hi) { return (r & 3) + 8 * (r >> 2) + 4 * hi; }
constexpr int ATT_KS = 72, ATT_VS = 232, ATT_K_BYTES = 224 * ATT_KS * 2;
__device__ __forceinline__ void attn_unit(Frame& F, const float* sinks, int b, int kvh, int qb) {
    const bf16* Q = (const bf16*)(F.ws + R_Q); const bf16* KB = (const bf16*)(F.ws + R_KB); const bf16* VB = (const bf16*)(F.ws + R_VB); bf16* Y1 = (bf16*)(F.ws + R_Y1);
    LAS bf16* Ks = (LAS bf16*)F.lds; LAS bf16* Vt = (LAS bf16*)(F.lds + ATT_K_BYTES);
    const int tid = F.tid, lane = F.lane, wave = F.wave, g = wave >> 1, half = wave & 1, qh = kvh * 4 + g, qi = lane & 31, hi = lane >> 5;
    const bool meta = qb < 0; const int q0 = meta ? 0 : 64 * qb;
#pragma unroll
    for (int i = 0; i < 4; ++i) {
        const int id = tid + 512 * i, key = id >> 3, ch = id & 7;
        if (key < 224) {
            int row = -1;
            if (key < 192) { const int sp = q0 - 128 + key; if (!meta && sp >= 0) row = b * SEQ + sp; }
            else if (key < 208) row = MR + (key - 192);
            v4u kv = (v4u){0u, 0u, 0u, 0u}, vv = (v4u){0u, 0u, 0u, 0u};
            if (row >= 0) { kv = *(const v4u*)(KB + (size_t)row * 128 + kvh * 64 + ch * 8); vv = *(const v4u*)(VB + (size_t)row * 128 + kvh * 64 + ch * 8); }
            *(LAS v4u*)(Ks + key * ATT_KS + ch * 8) = kv;
#pragma unroll
            for (int e = 0; e < 4; ++e) { Vt[(ch * 8 + 2 * e) * ATT_VS + key] = (bf16)(vv[e] & 0xffffu); Vt[(ch * 8 + 2 * e + 1) * ATT_VS + key] = (bf16)(vv[e] >> 16); }
        }
    }
    __syncthreads();
    int qrow; if (meta) { const int m = 32 * half + qi; qrow = MR + (m < NMETA ? m : NMETA - 1); } else qrow = b * SEQ + q0 + 32 * half + qi;
    bf16x8 qr[4];
#pragma unroll
    for (int k4 = 0; k4 < 4; ++k4) qr[k4] = *(const bf16x8*)(Q + (size_t)qrow * 512 + qh * 64 + 16 * k4 + 8 * hi);
    f32x16 sc[6];
#pragma unroll
    for (int i = 0; i < 6; ++i) {
        const int t = i < 5 ? half + i : 6;
        f32x16 a = (f32x16){0.f,0.f,0.f,0.f,0.f,0.f,0.f,0.f,0.f,0.f,0.f,0.f,0.f,0.f,0.f,0.f};
#pragma unroll
        for (int k4 = 0; k4 < 4; ++k4) { const bf16x8 kf = *(const LAS bf16x8*)(Ks + (32 * t + qi) * ATT_KS + 16 * k4 + 8 * hi); a = __builtin_amdgcn_mfma_f32_32x32x16_bf16(kf, qr[k4], a, 0, 0, 0); }
        sc[i] = a;
    }
    const float sink = sinks[qh]; float mx = sink;
    const int mq = 32 * half + qi;
#pragma unroll
    for (int i = 0; i < 6; ++i)
#pragma unroll
        for (int r = 0; r < 16; ++r) {
            const int kr = crow(r, hi); bool ok;
            if (i < 5) { const int dist = 128 - 32 * i + qi - kr; const int sp = q0 - 128 + 32 * (half + i) + kr; ok = !meta && dist >= 0 && dist < 128 && sp >= 0; }
            else ok = kr < NMETA && (!meta || kr <= mq);
            const float v = ok ? sc[i][r] * 0.125f : -1e30f; sc[i][r] = v; mx = fmaxf(mx, v);
        }
    mx = fmaxf(mx, __shfl_xor(mx, 32));
    float ls = 0.f;
#pragma unroll
    for (int i = 0; i < 6; ++i)
#pragma unroll
        for (int r = 0; r < 16; ++r) { const float p = __expf(sc[i][r] - mx); sc[i][r] = p; ls += p; }
    ls += __shfl_xor(ls, 32); ls += __expf(sink - mx);
    const float inv = 1.0f / ls;
    f32x16 o[2];
    o[0] = (f32x16){0.f,0.f,0.f,0.f,0.f,0.f,0.f,0.f,0.f,0.f,0.f,0.f,0.f,0.f,0.f,0.f}; o[1] = o[0];
#pragma unroll
    for (int i = 0; i < 6; ++i) {
        const int t = i < 5 ? half + i : 6;
#pragma unroll
        for (int s2 = 0; s2 < 2; ++s2) {
            v4u pw; pw.x = pg8::cvt_pk_bf16(sc[i][8 * s2 + 0], sc[i][8 * s2 + 1]); pw.y = pg8::cvt_pk_bf16(sc[i][8 * s2 + 2], sc[i][8 * s2 + 3]);
            pw.z = pg8::cvt_pk_bf16(sc[i][8 * s2 + 4], sc[i][8 * s2 + 5]); pw.w = pg8::cvt_pk_bf16(sc[i][8 * s2 + 6], sc[i][8 * s2 + 7]);
            const bf16x8 pa = __builtin_bit_cast(bf16x8, pw);
#pragma unroll
            for (int dt = 0; dt < 2; ++dt) {
                const LAS bf16* vp = Vt + (dt * 32 + qi) * ATT_VS + 32 * t + 16 * s2 + 4 * hi;
                const v2u lo = *(const LAS v2u*)vp, hh = *(const LAS v2u*)(vp + 8);
                const v4u vw = (v4u){lo.x, lo.y, hh.x, hh.y};
                o[dt] = __builtin_amdgcn_mfma_f32_32x32x16_bf16(pa, __builtin_bit_cast(bf16x8, vw), o[dt], 0, 0, 0);
            }
        }
    }
#pragma unroll
    for (int r = 0; r < 16; ++r) {
        const int qq = crow(r, hi); const float iv = __shfl(inv, qq);
        int orow; bool ok = true;
        if (meta) { const int m = 32 * half + qq; ok = m < NMETA; orow = MR + m; } else orow = b * SEQ + q0 + 32 * half + qq;
        if (ok) {
            Y1[(size_t)orow * DM + qh * 64 + qi] = (bf16)f2bf(o[0][r] * iv);
            Y1[(size_t)orow * DM + qh * 64 + 32 + qi] = (bf16)f2bf(o[1][r] * iv);
        }
    }
    __syncthreads();
}

constexpr int IMG_PT = 0, IMG_BK = 4096, IMG_VT = 8192, IMG_QT = 10240, IMG_W16 = 11264, IMG_BYTES = 11520;
constexpr int NBLK = 129, NBLK_H1 = 65;
constexpr size_t WS_IMG = 203 * MiB;
constexpr size_t WS_G = WS_A, WS_RK = WS_A + 17 * MiB, WS_ZS = WS_A + 18 * MiB;
static_assert(WS_IMG >= R_L1_END && WS_IMG + (size_t)64 * NBLK_H1 * IMG_BYTES <= WS_END, "image region");
constexpr int P_PRL = 0, P_FW = 0, P_FK = 4096, P_FA = 8192, P_XR = 15616, P_XK = P_XR + 4096, P_FB = P_XK, P_XV = P_XK + 4096, P_WC = P_XV,
              P_TW = P_XV + 4096, P_XA = P_TW + 2304, P_SG = P_XA + 2304, P_E1 = P_TW, P_E2 = P_E1 + 4608, P_LW = P_TW + 9216, P_LA = P_LW + 4096, P_LG = P_LA + 4096,
              P_ATF = P_LW, P_RTF = P_LA, P_M = P_LG + 4096, P_T = P_M + 4608, P_PTF = P_T + 1280, P_QF = P_PTF + 4096, P_IMG = P_QF + 1088,
              PI_PT = 0, PI_BK = 4096, PI_VT = PI_BK + 4608, PI_QT = PI_VT + 2048, PI_W16 = PI_QT + 1024, PI_BYTES = PI_W16 + 256, P_SLOT = P_IMG + PI_BYTES;
constexpr int MS = 36, TS = 20, BKS = 36;
static_assert(2 * P_SLOT + 1792 <= 147328 && (P_SLOT % 16) == 0 && (P_IMG % 16) == 0 && (P_E1 % 16) == 0 && (P_E2 % 16) == 0 && P_SG + 4352 <= P_LW && P_E2 + 4608 <= P_LW && (P_T % 16) == 0 && (P_M % 16) == 0, "prep lds map");
constexpr int PRS = 456;
__device__ __forceinline__ float wsum64(float x) { x = sum16(x); x += __shfl_xor(x, 16); x += __shfl_xor(x, 32); return x; }

__device__ __forceinline__ void rwkv_prep_phase(Frame& F, CArgs& A, int nbase, int cnt) {
    const bf16* PR = (const bf16*)(F.ws + R_PR);
    const bf16* w2t = (const bf16*)(F.ws + WS_LORA); const bf16* a2t = w2t + 512 * 64; const bf16* g2t = a2t + 512 * 64;
    const int tid = F.tid, lane = F.lane, wave = F.wave;
    const int nunits = 64 * cnt;
    if (F.wg >= nunits) return;
    int ld_pr[2], ld_pc[2]; bool ld_ok[2];
#pragma unroll
    for (int i = 0; i < 2; ++i) { const int q = tid + 512 * i; ld_ok[i] = q < 952; ld_pr[i] = ld_ok[i] ? q / 56 : 0; ld_pc[i] = ld_ok[i] ? q % 56 : 0; }
#define PP_BAR() asm volatile("s_waitcnt lgkmcnt(0)\n\ts_barrier" ::: "memory")
#define PP_LOAD(id_, dst) do { const int idc_ = (id_) < nunits ? (id_) : F.wg; const int ch_ = idc_ & 63, n_ = nbase + (idc_ >> 6), b_ = ch_ >> 3, h_ = ch_ & 7; \
        _Pragma("unroll") for (int i_ = 0; i_ < 2; ++i_) { const int pr = ld_pr[i_], pc = ld_pc[i_]; \
            const int col = pc < 8 ? 64 * h_ + 8 * pc : pc < 16 ? 512 + 64 * h_ + 8 * (pc - 8) : pc < 24 ? 1024 + 64 * h_ + 8 * (pc - 16) : 1536 + 8 * (pc - 24); \
            int gr = n_ == 0 ? MR + pr - 1 : n_ == 1 ? (pr == 0 ? MR + NMETA - 1 : b_ * SEQ + pr - 1) : b_ * SEQ + 16 * (n_ - 1) - 1 + pr; \
            const bool zero_ = (n_ == 0 && pr == 0); if (zero_) gr = MR; \
            v4u v_ = *(const v4u*)(PR + (size_t)gr * PRW + col); if (zero_) v_ = (v4u){0u, 0u, 0u, 0u}; dst[i_] = v_; } } while (0)
    v4u pf0[2], pf1[2];
    PP_LOAD(F.wg, pf0); PP_LOAD(F.wg + F.G, pf1);
    int cur_chain = -1;
    LAS float* MU = (LAS float*)(F.lds + 2 * P_SLOT);
    bf16x8 c_bfr[4]; f32x2 c_w0 = (f32x2){0.f, 0.f}, c_a0 = c_w0, c_kk = c_w0, c_ka = c_w0, c_rk = c_w0;
#pragma unroll
    for (int i = 0; i < 4; ++i) c_bfr[i] = (bf16x8){0, 0, 0, 0, 0, 0, 0, 0};
    const int tid_base = tid;
#pragma unroll 1
    for (int id0 = F.wg; id0 < nunits; id0 += 2 * F.G) {
    int tid = tid_base; asm volatile("" : "+v"(tid));
    const int lane = tid & 63, wave = __builtin_amdgcn_readfirstlane(tid >> 6);
    const int tt = tid >> 5, jp = tid & 31, j0 = 2 * jp;
    const int chain = id0 & 63, b = chain >> 3, h = chain & 7, ch0 = 64 * h + j0;
    const bool act1 = id0 + F.G < nunits;
    if (chain != cur_chain) {
        cur_chain = chain;
        const float* mu = A.in[13];
        if (tid < 448) { const int c = tid; const int gcol = c < 64 ? 64 * h + c : c < 128 ? 512 + 64 * h + (c - 64) : c < 192 ? 1024 + 64 * h + (c - 128) : 1536 + (c - 192); MU[c] = mu[gcol]; }
        { const int nb = wave & 3, grp = wave >> 2, ar = lane & 15, ak = 8 * (lane >> 4);
          if (grp == 0) { c_bfr[0] = *(const bf16x8*)(w2t + (size_t)(64 * h + 16 * nb + ar) * 64 + ak); c_bfr[1] = *(const bf16x8*)(w2t + (size_t)(64 * h + 16 * nb + ar) * 64 + 32 + ak);
                          c_bfr[2] = *(const bf16x8*)(a2t + (size_t)(64 * h + 16 * nb + ar) * 64 + ak); c_bfr[3] = *(const bf16x8*)(a2t + (size_t)(64 * h + 16 * nb + ar) * 64 + 32 + ak); }
          else {
#pragma unroll
              for (int k = 0; k < 4; ++k) c_bfr[k] = *(const bf16x8*)(g2t + (size_t)(64 * h + 16 * nb + ar) * 128 + 32 * k + ak); } }
        c_w0 = *(const f32x2*)(A.in[14] + ch0); c_a0 = *(const f32x2*)(A.in[16] + ch0); c_kk = *(const f32x2*)(A.in[19] + ch0); c_ka = *(const f32x2*)(A.in[20] + ch0); c_rk = *(const f32x2*)(A.in[21] + ch0);
    }
#define PP_SLOTS(...) do { _Pragma("unroll") for (int sl = 0; sl < 2; ++sl) { if (sl == 0 || act1) { \
        LAS unsigned char* L = F.lds + sl * P_SLOT; const int n = nbase + ((id0 + sl * F.G) >> 6); const int r0 = n == 0 ? MR : b * SEQ + 16 * (n - 1); (void)L; (void)n; (void)r0; \
        __VA_ARGS__ } } } while (0)
#pragma unroll
    for (int i = 0; i < 2; ++i) if (ld_ok[i]) { *(LAS v4u*)((LAS bf16*)(F.lds + P_PRL) + ld_pr[i] * PRS + 8 * ld_pc[i]) = pf0[i]; *(LAS v4u*)((LAS bf16*)(F.lds + P_SLOT + P_PRL) + ld_pr[i] * PRS + 8 * ld_pc[i]) = pf1[i]; }
    PP_LOAD(id0 + 2 * F.G, pf0); PP_LOAD(id0 + 3 * F.G, pf1);
    PP_BAR();
    PP_SLOTS({
        LAS bf16* PRL = (LAS bf16*)(L + P_PRL); LAS float* XR = (LAS float*)(L + P_XR); LAS float* XK = (LAS float*)(L + P_XK); LAS float* XV = (LAS float*)(L + P_XV);
        LAS bf16* TW = (LAS bf16*)(L + P_TW); LAS bf16* XA = (LAS bf16*)(L + P_XA); LAS bf16* SG = (LAS bf16*)(L + P_SG);
        const int t2 = tid >> 5, l32 = tid & 31;
        _Pragma("unroll") for (int i = 0; i < 7; ++i) {
            const int c = 2 * l32 + 64 * i;
            const unsigned cu = *(const LAS unsigned*)(PRL + (1 + t2) * PRS + c), pv = *(const LAS unsigned*)(PRL + t2 * PRS + c); const f32x2 m2 = *(const LAS f32x2*)(MU + c);
            const float c0_ = bflo(cu), c1_ = bfhi(cu); const float x0 = c0_ + (bflo(pv) - c0_) * m2.x, x1 = c1_ + (bfhi(pv) - c1_) * m2.y;
            if (i == 0) *(LAS f32x2*)(XR + t2 * 64 + 2 * l32) = (f32x2){x0, x1};
            else if (i == 1) *(LAS f32x2*)(XK + t2 * 64 + 2 * l32) = (f32x2){x0, x1};
            else if (i == 2) *(LAS f32x2*)(XV + t2 * 64 + 2 * l32) = (f32x2){x0, x1};
            else if (i == 3) { const float e0 = __expf(2.0f * x0), e1 = __expf(2.0f * x1); *(LAS unsigned*)(TW + t2 * 72 + 2 * l32) = pk2(1.0f - 2.0f * __builtin_amdgcn_rcpf(e0 + 1.0f), 1.0f - 2.0f * __builtin_amdgcn_rcpf(e1 + 1.0f)); }
            else if (i == 4) *(LAS unsigned*)(XA + t2 * 72 + 2 * l32) = pk2(x0, x1);
            else *(LAS unsigned*)(SG + t2 * 136 + 64 * (i - 5) + 2 * l32) = pk2(sigm(x0), sigm(x1));
        }
    });
    PP_BAR();
    PP_SLOTS({
        LAS bf16* TW = (LAS bf16*)(L + P_TW); LAS bf16* XA = (LAS bf16*)(L + P_XA); LAS bf16* SG = (LAS bf16*)(L + P_SG);
        LAS float* LW = (LAS float*)(L + P_LW); LAS float* LA = (LAS float*)(L + P_LA); LAS float* LG = (LAS float*)(L + P_LG);
        const int nb = wave & 3, grp = wave >> 2, ar = lane & 15, ak = 8 * (lane >> 4);
        pg8::f32x4 d0 = (pg8::f32x4){0.f, 0.f, 0.f, 0.f}, d1 = d0;
        if (grp == 0) {
            _Pragma("unroll") for (int k = 0; k < 2; ++k) { const bf16x8 af = *(const LAS bf16x8*)(TW + ar * 72 + 32 * k + ak); d0 = __builtin_amdgcn_mfma_f32_16x16x32_bf16(af, c_bfr[k], d0, 0, 0, 0); }
            _Pragma("unroll") for (int k = 0; k < 2; ++k) { const bf16x8 af = *(const LAS bf16x8*)(XA + ar * 72 + 32 * k + ak); d1 = __builtin_amdgcn_mfma_f32_16x16x32_bf16(af, c_bfr[2 + k], d1, 0, 0, 0); }
            _Pragma("unroll") for (int r = 0; r < 4; ++r) { LW[(4 * (lane >> 4) + r) * 64 + 16 * nb + ar] = d0[r]; LA[(4 * (lane >> 4) + r) * 64 + 16 * nb + ar] = d1[r]; }
        } else {
            _Pragma("unroll") for (int k = 0; k < 4; ++k) { const bf16x8 af = *(const LAS bf16x8*)(SG + ar * 136 + 32 * k + ak); d0 = __builtin_amdgcn_mfma_f32_16x16x32_bf16(af, c_bfr[k], d0, 0, 0, 0); }
            _Pragma("unroll") for (int r = 0; r < 4; ++r) LG[(4 * (lane >> 4) + r) * 64 + 16 * nb + ar] = d0[r];
        }
    });
    PP_BAR();
    PP_SLOTS({
        LAS float* XR = (LAS float*)(L + P_XR); LAS float* XK = (LAS float*)(L + P_XK); LAS float* XV = (LAS float*)(L + P_XV);
        LAS float* LW = (LAS float*)(L + P_LW); LAS float* LA = (LAS float*)(L + P_LA); LAS float* LG = (LAS float*)(L + P_LG);
        LAS float* FW = (LAS float*)(L + P_FW); LAS float* FK = (LAS float*)(L + P_FK); LAS float* FA = (LAS float*)(L + P_FA); LAS float* FB = (LAS float*)(L + P_FB);
        LAS bf16* I_VT = (LAS bf16*)(L + P_IMG + PI_VT);
        const f32x2 lw = *(const LAS f32x2*)(LW + tt * 64 + j0), la = *(const LAS f32x2*)(LA + tt * 64 + j0), lg = *(const LAS f32x2*)(LG + tt * 64 + j0);
        const f32x2 xr = *(const LAS f32x2*)(XR + tt * 64 + j0), xk = *(const LAS f32x2*)(XK + tt * 64 + j0), xv = *(const LAS f32x2*)(XV + tt * 64 + j0);
        const float wd0 = __expf(-0.6065306597126334f * sigm(c_w0.x + lw.x)), wd1 = __expf(-0.6065306597126334f * sigm(c_w0.y + lw.y));
        const float al0 = sigm(c_a0.x + la.x), al1 = sigm(c_a0.y + la.y);
        const float q0 = xk.x * c_kk.x, q1 = xk.y * c_kk.y;
        const float nrm = sum32(q0 * q0 + q1 * q1); const float rn = 1.0f / fmaxf(sqrtf(nrm), 1e-12f);
        const float kk0 = q0 * rn, kk1 = q1 * rn;
        const float kn0 = xk.x * (1.0f + (al0 - 1.0f) * c_ka.x), kn1 = xk.y * (1.0f + (al1 - 1.0f) * c_ka.y);
        const float rkp = sum32(xr.x * kn0 * c_rk.x + xr.y * kn1 * c_rk.y);
        asm volatile("" ::: "memory");
        *(LAS f32x2*)(FW + tt * 64 + j0) = (f32x2){wd0, wd1}; *(LAS f32x2*)(FK + tt * 64 + j0) = (f32x2){kn0, kn1};
        *(LAS f32x2*)(FA + tt * 64 + j0) = (f32x2){-kk0, -kk1}; *(LAS f32x2*)(FB + tt * 64 + j0) = (f32x2){kk0 * al0, kk1 * al1};
        I_VT[j0 * 16 + tt] = (bf16)f2bf(xv.x); I_VT[(j0 + 1) * 16 + tt] = (bf16)f2bf(xv.y);
        if (n > 0 || b == 0) {
            *(unsigned*)((bf16*)(F.ws + WS_G) + (size_t)(r0 + tt) * 512 + ch0) = pk2(lg.x, lg.y);
            if (jp == 0) ((float*)(F.ws + WS_RK))[(size_t)(r0 + tt) * 8 + h] = rkp;
        }
    });
    PP_BAR();
    if (tid < 128) { const int sl = tid >> 6, j = tid & 63; if (sl == 0 || act1) { LAS float* FW = (LAS float*)(F.lds + sl * P_SLOT + P_FW); LAS float* WC = (LAS float*)(F.lds + sl * P_SLOT + P_WC); float wc = 1.0f; float fwv[16];
#pragma unroll
        for (int s = 0; s < 16; ++s) fwv[s] = FW[s * 64 + j];
        __builtin_amdgcn_sched_barrier(0);
#pragma unroll
        for (int s = 0; s < 16; ++s) { wc *= fwv[s]; WC[s * 64 + j] = wc; } } }
    PP_BAR();
    PP_SLOTS({
        LAS float* XR = (LAS float*)(L + P_XR); LAS float* FK = (LAS float*)(L + P_FK); LAS float* FA = (LAS float*)(L + P_FA); LAS float* FB = (LAS float*)(L + P_FB);
        LAS float* WC = (LAS float*)(L + P_WC); LAS bf16* E1 = (LAS bf16*)(L + P_E1); LAS bf16* E2 = (LAS bf16*)(L + P_E2); LAS float* ATF = (LAS float*)(L + P_ATF); LAS float* RTF = (LAS float*)(L + P_RTF);
        LAS bf16* I_BK = (LAS bf16*)(L + P_IMG + PI_BK); LAS float* I_W16 = (LAS float*)(L + P_IMG + PI_W16);
        {
            const int s = tt;
            const f32x2 wcv = *(const LAS f32x2*)(WC + s * 64 + j0); f32x2 wp = (f32x2){1.0f, 1.0f}; if (s > 0) wp = *(const LAS f32x2*)(WC + (s - 1) * 64 + j0);
            const f32x2 fa = *(const LAS f32x2*)(FA + s * 64 + j0), xr = *(const LAS f32x2*)(XR + s * 64 + j0), fb = *(const LAS f32x2*)(FB + s * 64 + j0), fk = *(const LAS f32x2*)(FK + s * 64 + j0);
            const float iw0 = __builtin_amdgcn_rcpf(wcv.x), iw1 = __builtin_amdgcn_rcpf(wcv.y);
            const float at0 = wp.x * fa.x, at1 = wp.y * fa.y, rt0 = wcv.x * xr.x, rt1 = wcv.y * xr.y;
            *(LAS unsigned*)(E1 + s * 72 + j0) = pk2(fb.x * iw0, fb.y * iw1); *(LAS unsigned*)(E1 + (16 + s) * 72 + j0) = pk2(fk.x * iw0, fk.y * iw1);
            *(LAS unsigned*)(E2 + s * 72 + j0) = pk2(at0, at1); *(LAS unsigned*)(E2 + (16 + s) * 72 + j0) = pk2(rt0, rt1);
            *(LAS f32x2*)(ATF + s * 64 + j0) = (f32x2){at0, at1}; *(LAS f32x2*)(RTF + s * 64 + j0) = (f32x2){rt0, rt1};
        }
        {
            const int j = tid & 63, ug = tid >> 6; const float w16 = WC[15 * 64 + j];
            float bw_[2], kw_[2];
            _Pragma("unroll") for (int e = 0; e < 2; ++e) { const int u = 2 * ug + e; const float sc = w16 * __builtin_amdgcn_rcpf(WC[u * 64 + j]); bw_[e] = FB[u * 64 + j] * sc; kw_[e] = FK[u * 64 + j] * sc; }
            *(LAS unsigned*)(I_BK + j * BKS + 2 * ug) = pk2(bw_[0], bw_[1]); *(LAS unsigned*)(I_BK + j * BKS + 16 + 2 * ug) = pk2(kw_[0], kw_[1]);
            if (ug == 0) { const int jt = j >> 5, jj = j & 31, hi_ = (jj >> 2) & 1, r_ = (jj & 3) + 4 * (jj >> 3); I_W16[hi_ * 32 + jt * 16 + r_] = w16; }
        }
    });
    PP_BAR();
    if (wave < 2 && (wave == 0 || act1)) {
        LAS unsigned char* L = F.lds + wave * P_SLOT; LAS bf16* E1 = (LAS bf16*)(L + P_E1); LAS bf16* E2 = (LAS bf16*)(L + P_E2); LAS float* M = (LAS float*)(L + P_M);
        const int m = lane & 31, hh = lane >> 5;
        f32x16 d = (f32x16){0.f,0.f,0.f,0.f,0.f,0.f,0.f,0.f,0.f,0.f,0.f,0.f,0.f,0.f,0.f,0.f};
#pragma unroll
        for (int ks = 0; ks < 4; ++ks) { const bf16x8 af = *(const LAS bf16x8*)(E1 + m * 72 + 16 * ks + 8 * hh), bfv = *(const LAS bf16x8*)(E2 + m * 72 + 16 * ks + 8 * hh); d = __builtin_amdgcn_mfma_f32_32x32x16_bf16(af, bfv, d, 0, 0, 0); }
#pragma unroll
        for (int r = 0; r < 16; ++r) { const int mr = crow(r, hh), nc = m; const int u = mr & 15, s = nc & 15; const bool keep = (nc < 16) ? (u < s) : (u <= s);
            M[mr * MS + nc] = keep ? d[r] : 0.0f; }
    }
    PP_BAR();
    if ((tid & 63) < 16 && tid < 128 && (tid < 64 || act1)) { const int sl = tid >> 6, rr = tid & 15; LAS float* M = (LAS float*)(F.lds + sl * P_SLOT + P_M); LAS float* T = (LAS float*)(F.lds + sl * P_SLOT + P_T);
        float mb[16][16];
#pragma unroll
        for (int s = 1; s < 16; ++s)
#pragma unroll
            for (int u = 0; u < s; ++u) mb[u][s] = M[u * MS + s];
        __builtin_amdgcn_sched_barrier(0);
        float t[16];
#pragma unroll
        for (int s = 0; s < 16; ++s) { float acc = (rr == s) ? 1.0f : 0.0f;
#pragma unroll
            for (int u = 0; u < s; ++u) acc += t[u] * mb[u][s];
            t[s] = acc; }
#pragma unroll
        for (int s = 0; s < 16; ++s) T[rr * TS + s] = t[s]; }
    PP_BAR();
    PP_SLOTS({
        LAS float* ATF = (LAS float*)(L + P_ATF); LAS float* M = (LAS float*)(L + P_M); LAS float* T = (LAS float*)(L + P_T); LAS float* PTF = (LAS float*)(L + P_PTF); LAS float* QF = (LAS float*)(L + P_QF);
        LAS bf16* I_PT = (LAS bf16*)(L + P_IMG + PI_PT); LAS bf16* I_QT = (LAS bf16*)(L + P_IMG + PI_QT);
        if (tid < 128) {
            const int sq = tid >> 4, jq = tid & 15; f32x4 pa = (f32x4){0.f, 0.f, 0.f, 0.f}, pb = pa;
            f32x2 tv_[16]; f32x4 av_[16];
            _Pragma("unroll") for (int u = 0; u < 16; ++u) { tv_[u] = *(const LAS f32x2*)(T + u * TS + 2 * sq); av_[u] = *(const LAS f32x4*)(ATF + u * 64 + 4 * jq); }
            __builtin_amdgcn_sched_barrier(0);
            _Pragma("unroll") for (int u = 0; u < 16; ++u) { pa += av_[u] * tv_[u].x; pb += av_[u] * tv_[u].y; }
            *(LAS f32x4*)(PTF + (2 * sq) * 64 + 4 * jq) = pa; *(LAS f32x4*)(PTF + (2 * sq + 1) * 64 + 4 * jq) = pb;
            *(LAS v2u*)(I_PT + (2 * sq) * 64 + 4 * jq) = (v2u){pk2(pa[0], pa[1]), pk2(pa[2], pa[3])}; *(LAS v2u*)(I_PT + (2 * sq + 1) * 64 + 4 * jq) = (v2u){pk2(pb[0], pb[1]), pk2(pb[2], pb[3])};
        } else if (tid >= 256 && tid < 320) {
            const int u = (tid - 256) >> 2, s4 = (tid & 3) * 4; f32x4 q = (f32x4){0.f, 0.f, 0.f, 0.f};
            float mk_[16]; f32x4 t4_[16];
            _Pragma("unroll") for (int x = 0; x < 16; ++x) { mk_[x] = M[(16 + u) * MS + x]; t4_[x] = *(const LAS f32x4*)(T + x * TS + s4); }
            __builtin_amdgcn_sched_barrier(0);
            _Pragma("unroll") for (int x = 0; x < 16; ++x) q += t4_[x] * mk_[x];
            _Pragma("unroll") for (int e = 0; e < 4; ++e) { QF[u * 17 + s4 + e] = q[e]; I_QT[(s4 + e) * 16 + u] = (bf16)f2bf(q[e]); }
        }
    });
    PP_BAR();
    PP_SLOTS({
        LAS float* RTF = (LAS float*)(L + P_RTF); LAS float* M = (LAS float*)(L + P_M); LAS float* PTF = (LAS float*)(L + P_PTF); LAS float* QF = (LAS float*)(L + P_QF);
        LAS bf16* I_PT = (LAS bf16*)(L + P_IMG + PI_PT); LAS bf16* I_QT = (LAS bf16*)(L + P_IMG + PI_QT);
        if (tid < 128) {
            const int sq = tid >> 4, jq = tid & 15; f32x4 pa = *(const LAS f32x4*)(RTF + (2 * sq) * 64 + 4 * jq), pb = *(const LAS f32x4*)(RTF + (2 * sq + 1) * 64 + 4 * jq);
            f32x2 mv_[16]; f32x4 pv_[16];
            _Pragma("unroll") for (int u = 0; u < 16; ++u) { mv_[u] = *(const LAS f32x2*)(M + u * MS + 16 + 2 * sq); pv_[u] = *(const LAS f32x4*)(PTF + u * 64 + 4 * jq); }
            __builtin_amdgcn_sched_barrier(0);
            _Pragma("unroll") for (int u = 0; u < 16; ++u) { pa += pv_[u] * mv_[u].x; pb += pv_[u] * mv_[u].y; }
            *(LAS v2u*)(I_PT + (16 + 2 * sq) * 64 + 4 * jq) = (v2u){pk2(pa[0], pa[1]), pk2(pa[2], pa[3])}; *(LAS v2u*)(I_PT + (17 + 2 * sq) * 64 + 4 * jq) = (v2u){pk2(pb[0], pb[1]), pk2(pb[2], pb[3])};
        } else if (tid >= 256 && tid < 320) {
            const int u = (tid - 256) >> 2, s4 = (tid & 3) * 4; f32x4 q = *(const LAS f32x4*)(M + (16 + u) * MS + 16 + s4);
            float qf_[16]; f32x4 m4_[16];
            _Pragma("unroll") for (int x = 0; x < 16; ++x) { qf_[x] = QF[u * 17 + x]; m4_[x] = *(const LAS f32x4*)(M + x * MS + 16 + s4); }
            __builtin_amdgcn_sched_barrier(0);
            _Pragma("unroll") for (int x = 0; x < 16; ++x) q += m4_[x] * qf_[x];
            _Pragma("unroll") for (int e = 0; e < 4; ++e) I_QT[(16 + s4 + e) * 16 + u] = (bf16)f2bf(q[e]);
        }
    });
    PP_BAR();
    PP_SLOTS({
        const int nl = n - nbase;
        unsigned char* dst = F.ws + WS_IMG + ((size_t)chain * NBLK_H1 + nl) * IMG_BYTES;
        for (int q = tid; q < IMG_BYTES / 16; q += NTHR) {
            int so;
            if (q < 256) so = PI_PT + q * 16; else if (q < 512) so = PI_BK + ((q - 256) >> 2) * (BKS * 2) + ((q - 256) & 3) * 16;
            else if (q < 640) so = PI_VT + (q - 512) * 16; else if (q < 704) so = PI_QT + (q - 640) * 16; else so = PI_W16 + (q - 704) * 16;
            const v2u lo = *(const LAS v2u*)(L + P_IMG + so), hh = *(const LAS v2u*)(L + P_IMG + so + 8);
            *(v4u*)(dst + q * 16) = (v4u){lo.x, lo.y, hh.x, hh.y}; }
    });
    asm volatile("s_waitcnt lgkmcnt(0)\n\ts_barrier" ::: "memory");
    }
#undef PP_LOAD
#undef PP_BAR
#undef PP_SLOTS
}

constexpr int SL_PT = 0, SL_BK = 4352, SL_VT = SL_BK + 5120, SL_QT = SL_VT + 3072, SL_W16 = SL_QT + 1536, SL_BUF = SL_W16 + 256;
constexpr int SL_YL = 3 * SL_BUF, SL_END = SL_YL + 2 * 4096;
static_assert((SL_BUF % 16) == 0 && SL_END <= 131072, "scan lds map");

__device__ __forceinline__ void rwkv_scan(Frame& F, CArgs& A, int chain, int nlo, int nhi) {
    const int b = chain >> 3, h = chain & 7;
    const int tid = F.tid, lane = F.lane, wave = F.wave;
    LAS unsigned char* L = F.lds;
    const unsigned char* img0 = F.ws + WS_IMG + (size_t)chain * NBLK_H1 * IMG_BYTES;
    const int cnt = nhi - nlo;
#define S3_BAR() asm volatile("s_waitcnt lgkmcnt(0)\n\ts_barrier" ::: "memory")
    if (wave >= 2) {
        bf16* Y1 = (bf16*)(F.ws + R_Y1);
        const int ht = tid - 128;
        int lsrc[2], ldst[2]; bool lok[2];
#pragma unroll
        for (int i = 0; i < 2; ++i) { const int q = ht + 384 * i; lok[i] = q < IMG_BYTES / 16; lsrc[i] = lok[i] ? q * 16 : 0; int d;
            if (q < 256) d = SL_PT + (q >> 3) * 136 + (q & 7) * 16;
            else if (q < 512) d = SL_BK + ((q - 256) >> 2) * 80 + ((q - 256) & 3) * 16;
            else if (q < 640) d = SL_VT + ((q - 512) >> 1) * 48 + ((q - 512) & 1) * 16;
            else if (q < 704) d = SL_QT + ((q - 640) >> 1) * 48 + ((q - 640) & 1) * 16;
            else d = SL_W16 + (q - 704) * 16;
            ldst[i] = d; }
        const bool pw = wave < 6; const int pt = 4 * ((wave - 2) & 3) + (lane >> 4), pc = 4 * (lane & 15);
        const f32x4 c_lg = *(const f32x4*)(A.in[22] + 64 * h + pc), c_lb = *(const f32x4*)(A.in[23] + 64 * h + pc);
        const bf16* Gp = (const bf16*)(F.ws + WS_G) + 64 * h + pc; const float* RKp = (const float*)(F.ws + WS_RK) + h;
#define S3_LOAD(m, pf) do { const int mm_ = (m) < cnt ? (m) : cnt - 1; const unsigned char* ip_ = img0 + (size_t)mm_ * IMG_BYTES; pf[0] = *(const v4u*)(ip_ + lsrc[0]); pf[1] = *(const v4u*)(ip_ + lsrc[1]); } while (0)
#define S3_LAND(buf, pf) do { *(LAS v4u*)(L + (buf) * SL_BUF + ldst[0]) = pf[0]; if (lok[1]) *(LAS v4u*)(L + (buf) * SL_BUF + ldst[1]) = pf[1]; } while (0)
#define S3_PLOAD(m, gg, xv, rk) do { const int mm_ = (m) < cnt ? (m) : cnt - 1; const int nn_ = nlo + mm_; const size_t r0_ = nn_ == 0 ? (size_t)MR : (size_t)(b * SEQ + 16 * (nn_ - 1)); \
        gg = *(const v2u*)(Gp + (r0_ + pt) * 512); rk = RKp[(r0_ + pt) * 8]; (void)xv; } while (0)
#define S3_HELP(m, pfN, ggC, xvC, rkC) do { \
        const int cb = (m) & 1; const int b3n = b3 == 2 ? 0 : b3 + 1; \
        if ((m) + 1 < cnt) S3_LAND(b3n, pfN); \
        S3_LOAD((m) + 5, pfN); \
        S3_BAR(); \
        if (pw) { const f32x4 y = *(const LAS f32x4*)(L + SL_YL + cb * 4096 + (pt * 64 + pc) * 4); \
          const int nn_ = nlo + (m); const int r0 = nn_ == 0 ? MR : b * SEQ + 16 * (nn_ - 1); \
          const float mean = sum16((y[0] + y[1]) + (y[2] + y[3])) * (1.0f / 64.0f); const f32x4 d = y - mean; \
          const float var = sum16((d[0] * d[0] + d[1] * d[1]) + (d[2] * d[2] + d[3] * d[3])) * (1.0f / 64.0f); const float rs = rsqrtf(var + 64e-5f); \
          const float g0 = bflo(ggC.x), g1 = bfhi(ggC.x), g2 = bflo(ggC.y), g3 = bfhi(ggC.y); \
          { const LAS bf16* vl_ = (const LAS bf16*)(L + b3 * SL_BUF + SL_VT) + pc * 24 + pt; xvC[0] = bf2f(vl_[0]); xvC[1] = bf2f(vl_[24]); xvC[2] = bf2f(vl_[48]); xvC[3] = bf2f(vl_[72]); } \
          const float o0 = (d[0] * rs * c_lg[0] + c_lb[0] + rkC * xvC[0]) * g0, o1 = (d[1] * rs * c_lg[1] + c_lb[1] + rkC * xvC[1]) * g1, \
                      o2 = (d[2] * rs * c_lg[2] + c_lb[2] + rkC * xvC[2]) * g2, o3 = (d[3] * rs * c_lg[3] + c_lb[3] + rkC * xvC[3]) * g3; \
          if (nn_ > 0 || b == 0) { v2u ov; ov.x = pk2(o0, o1); ov.y = pk2(o2, o3); *(v2u*)(Y1 + (size_t)(r0 + pt) * DM + 512 + 64 * h + pc) = ov; } } \
        S3_PLOAD((m) + 4, ggC, xvC, rkC); b3 = b3n; \
    } while (0)
        v4u pf0[2], pf1[2], pf2[2], pf3[2]; v2u gg0, gg1, gg2, gg3; float xv0[4], xv1[4], xv2[4], xv3[4], rk0, rk1, rk2, rk3;
        int b3 = 0;
        S3_LOAD(0, pf0); S3_LAND(0, pf0); S3_LOAD(1, pf1); S3_LOAD(2, pf2); S3_LOAD(3, pf3); S3_LOAD(4, pf0);
        S3_PLOAD(0, gg0, xv0, rk0); S3_PLOAD(1, gg1, xv1, rk1); S3_PLOAD(2, gg2, xv2, rk2); S3_PLOAD(3, gg3, xv3, rk3);
        S3_BAR();
        int m = 0;
#pragma unroll 1
        for (; m + 3 < cnt; m += 4) {
            S3_HELP(m, pf1, gg0, xv0, rk0);
            S3_HELP(m + 1, pf2, gg1, xv1, rk1);
            S3_HELP(m + 2, pf3, gg2, xv2, rk2);
            S3_HELP(m + 3, pf0, gg3, xv3, rk3);
        }
        if (m < cnt) { S3_HELP(m, pf1, gg0, xv0, rk0); ++m; }
        if (m < cnt) { S3_HELP(m, pf2, gg1, xv1, rk1); ++m; }
        if (m < cnt) { S3_HELP(m, pf3, gg2, xv2, rk2); ++m; }
#undef S3_LOAD
#undef S3_LAND
#undef S3_PLOAD
#undef S3_HELP
    } else {
        const int it = wave, qi = lane & 31, hi = lane >> 5;
        f32x16 z0 = (f32x16){0.f,0.f,0.f,0.f,0.f,0.f,0.f,0.f,0.f,0.f,0.f,0.f,0.f,0.f,0.f,0.f}, z1 = z0;
        float* zs = (float*)(F.ws + WS_ZS) + ((size_t)(chain * 2 + it) * 2 * 64 + lane) * 16;
        if (nlo > 0) { z0 = *(const f32x16*)zs; z1 = *(const f32x16*)(zs + 64 * 16); }
        S3_BAR();
        int b3 = 0;
#define S3_PK(dst, zz, o) do { dst.x = pg8::cvt_pk_bf16(zz[o + 0], zz[o + 1]); dst.y = pg8::cvt_pk_bf16(zz[o + 2], zz[o + 3]); dst.z = pg8::cvt_pk_bf16(zz[o + 4], zz[o + 5]); dst.w = pg8::cvt_pk_bf16(zz[o + 6], zz[o + 7]); } while (0)
#pragma unroll 1
        for (int m = 0; m < cnt; ++m) {
            const int cb = m & 1;
            const LAS unsigned char* B_ = L + b3 * SL_BUF; b3 = b3 == 2 ? 0 : b3 + 1;
            const bf16x8 vfr = *(const LAS bf16x8*)(B_ + SL_VT + (32 * it + qi) * 48 + hi * 16);
            const bf16x8 qf = *(const LAS bf16x8*)(B_ + SL_QT + qi * 48 + hi * 16);
            v4u aw[4];
#pragma unroll
            for (int ks = 0; ks < 4; ++ks) {
                const LAS unsigned char* pp = B_ + SL_PT + qi * 136 + (16 * ks + 4 * hi) * 2;
                const v2u lo = *(const LAS v2u*)pp, hh = *(const LAS v2u*)(pp + 16); aw[ks] = (v4u){lo.x, lo.y, hh.x, hh.y}; }
            v4u bw[2]; bf16x8 kf[2]; f32x4 wv[2][4];
            const LAS float* w16 = (const LAS float*)(B_ + SL_W16) + hi * 32;
#pragma unroll
            for (int jt = 0; jt < 2; ++jt) { const LAS unsigned char* bp = B_ + SL_BK + (32 * jt + qi) * 80;
                const v2u lo = *(const LAS v2u*)(bp + 8 * hi), hh = *(const LAS v2u*)(bp + 16 + 8 * hi); bw[jt] = (v4u){lo.x, lo.y, hh.x, hh.y};
                kf[jt] = *(const LAS bf16x8*)(bp + 32 + 16 * hi);
#pragma unroll
                for (int r4 = 0; r4 < 4; ++r4) wv[jt][r4] = *(const LAS f32x4*)(w16 + jt * 16 + 4 * r4); }
            __builtin_amdgcn_sched_barrier(0);
            v4u zb[4]; S3_PK(zb[0], z0, 0); S3_PK(zb[1], z0, 8); S3_PK(zb[2], z1, 0); S3_PK(zb[3], z1, 8);
            f32x16 acc = (f32x16){0.f,0.f,0.f,0.f,0.f,0.f,0.f,0.f,0.f,0.f,0.f,0.f,0.f,0.f,0.f,0.f};
            acc = __builtin_amdgcn_mfma_f32_32x32x16_bf16(qf, vfr, acc, 0, 0, 0);
#pragma unroll
            for (int ks = 0; ks < 4; ++ks) acc = __builtin_amdgcn_mfma_f32_32x32x16_bf16(__builtin_bit_cast(bf16x8, aw[ks]), __builtin_bit_cast(bf16x8, zb[ks]), acc, 0, 0, 0);
            f32x16 zn0, zn1;
#pragma unroll
            for (int r4 = 0; r4 < 4; ++r4)
#pragma unroll
                for (int e = 0; e < 4; ++e) { zn0[4 * r4 + e] = z0[4 * r4 + e] * wv[0][r4][e]; zn1[4 * r4 + e] = z1[4 * r4 + e] * wv[1][r4][e]; }
            { LAS float* YL = (LAS float*)(L + SL_YL + cb * 4096);
#pragma unroll
              for (int r = 8; r < 16; ++r) YL[(crow(r, hi) - 16) * 64 + 32 * it + qi] = acc[r]; }
            v4u sab; S3_PK(sab, acc, 0);
            zn0 = __builtin_amdgcn_mfma_f32_32x32x16_bf16(kf[0], vfr, zn0, 0, 0, 0);
            zn1 = __builtin_amdgcn_mfma_f32_32x32x16_bf16(kf[1], vfr, zn1, 0, 0, 0);
            zn0 = __builtin_amdgcn_mfma_f32_32x32x16_bf16(__builtin_bit_cast(bf16x8, bw[0]), __builtin_bit_cast(bf16x8, sab), zn0, 0, 0, 0);
            zn1 = __builtin_amdgcn_mfma_f32_32x32x16_bf16(__builtin_bit_cast(bf16x8, bw[1]), __builtin_bit_cast(bf16x8, sab), zn1, 0, 0, 0);
            z0 = zn0; z1 = zn1;
            S3_BAR();
        }
        if (nhi < NBLK) { *(f32x16*)zs = z0; *(f32x16*)(zs + 64 * 16) = z1; }
#undef S3_PK
    }
#undef S3_BAR
    __syncthreads();
}

__device__ __forceinline__ void final_phase(Frame& F, CArgs& A) {
    const float* part = (const float*)(F.ws + WS_PART); const float* gf = A.in[4]; float* out = F.out; const float* hin = (const float*)(F.ws + WS_HFIN);
    const int gw = F.wg * NWAVES + F.wave, NGW = F.G * NWAVES, lane = F.lane;
    f32x4 gv[4];
#pragma unroll
    for (int j = 0; j < 4; ++j) gv[j] = *(const f32x4*)(gf + j * 256 + lane * 4);
    for (int row = gw; row < MR; row += 4 * NGW) {
        f32x4 hv[4][4]; float rs[4];
#pragma unroll
        for (int r = 0; r < 4; ++r) { const int rr = row + r * NGW < MR ? row + r * NGW : row; rs[r] = pg8::row_rstd(part, rr);
#pragma unroll
            for (int j = 0; j < 4; ++j) hv[r][j] = *(const f32x4*)(hin + (size_t)rr * DM + j * 256 + lane * 4); }
#pragma unroll
        for (int r = 0; r < 4; ++r) { const int rr = row + r * NGW; if (rr < MR) {
#pragma unroll
            for (int j = 0; j < 4; ++j) *(f32x4*)(out + (size_t)rr * DM + j * 256 + lane * 4) = hv[r][j] * rs[r] * gv[j]; } }
    }
}

__device__ __forceinline__ void meta_res_gemm(Frame& F, const bf16* Aop, int lda, const bf16* Bop, int ldb, int K, float* hmeta, bf16* Abuf, float* part, int mode, int g) {
    const int lane = F.lane, wave = F.wave, nb = wave & 3, kh = wave >> 2, kq = 8 * (lane >> 4), r16 = lane & 15;
    const int khalf = K / 2, k0 = kh * khalf, nks = khalf / 32;
    const bf16* ap = Aop + (size_t)(MR + r16) * lda + k0 + kq;
    const bf16* bp = Bop + (size_t)(64 * g + 16 * nb + r16) * ldb + k0 + kq;
    pg8::f32x4 d = (pg8::f32x4){0.f, 0.f, 0.f, 0.f};
#pragma unroll 11
    for (int k = 0; k < nks; ++k) { const bf16x8 af = *(const bf16x8*)(ap + 32 * k); const bf16x8 bfv = *(const bf16x8*)(bp + 32 * k); d = __builtin_amdgcn_mfma_f32_16x16x32_bf16(af, bfv, d, 0, 0, 0); }
    LAS float* red = (LAS float*)F.lds;
    if (kh == 1) *(LAS pg8::f32x4*)(red + (nb * 64 + lane) * 4) = d;
    __syncthreads();
    if (kh == 0) {
        const pg8::f32x4 o = *(const LAS pg8::f32x4*)(red + (nb * 64 + lane) * 4); d += o;
        const int col = 64 * g + 16 * nb + r16;
#pragma unroll
        for (int r = 0; r < 4; ++r) { const int row = 4 * (lane >> 4) + r; float h = hmeta[(size_t)row * DM + col] + d[r]; hmeta[(size_t)row * DM + col] = h; d[r] = h;
            if (mode) Abuf[(size_t)(MR + row) * DM + col] = (bf16)f2bf(h); }
    }
    __syncthreads();
    if (mode) {
        if (kh == 0) {
#pragma unroll
            for (int r = 0; r < 4; ++r) { const float ss = sum16(d[r] * d[r]); if (r16 == 0) red[(4 * (lane >> 4) + r) * 4 + nb] = ss; }
        }
        __syncthreads();
        if (F.tid < 16) { const pg8::f32x4 v = *(const LAS pg8::f32x4*)(red + F.tid * 4); part[(size_t)(MR + F.tid) * 16 + g] = (v[0] + v[1]) + (v[2] + v[3]); }
        __syncthreads();
    }
}

#ifdef NO_ATTN
#define ATTN_UNIT(b, k, q) do { } while (0)
#else
#define ATTN_UNIT(b, k, q) attn_unit(F, A.in[12], (b), (k), (q))
#endif
constexpr int N_PHASES = 17;
#ifndef RES_SP2
#define RES_SP2 true
#endif
#ifndef DBGLAST
#define DBGLAST 6
#endif
#ifndef DBG15
#define DBG15 3
#endif
#ifndef DBG_NPH
#define DBG_NPH 18
#endif
__global__ void __launch_bounds__(NTHR, 2) hyb_fwd(Args args) {
    extern __shared__ __attribute__((aligned(16))) unsigned char lds[];
    const int lo = args.ph_lo, hi = args.ph_hi;
#if MK_N_LAUNCHES == 1
    {
        for (int u = threadIdx.x; u < (LDS_BYTES - LDSCTL_OFF) / 4; u += NTHR) ((LAS unsigned*)((LAS unsigned char*)lds + LDSCTL_OFF))[u] = 0u;
        __syncthreads();
        if (threadIdx.x == 0) (void)xb_add(&((unsigned*)(args.ws + WS_CTL))[1024 + XB_XCNT(xb_xcc_id())], 1u);
    }
#endif
    const int wave_s = __builtin_amdgcn_readfirstlane(threadIdx.x >> 6);
#ifndef PROBE_MASK
#define PROBE_MASK 0u
#endif
#pragma unroll 1
    for (int pq = 2 * lo; pq < 2 * hi; ++pq) {
        const int p = pq >> 1; if ((pq & 1) && !((PROBE_MASK >> p) & 1u)) continue;
#define PHF() CArgs* ap_ = (CArgs*)__builtin_amdgcn_kernarg_segment_ptr(); asm volatile("" : "+s"(ap_)); CArgs& A = *ap_; \
        unsigned z_; asm volatile("s_mov_b32 %0, 0" : "=s"(z_)); \
        Frame F; F.tid = (wave_s << 6) | (int)__builtin_amdgcn_mbcnt_hi(~0u, __builtin_amdgcn_mbcnt_lo(~0u, z_)); asm volatile("" : "+v"(F.tid)); \
        F.lds = (LAS unsigned char*)lds; F.lane = F.tid & 63; F.wave = __builtin_amdgcn_readfirstlane(F.tid >> 6); F.G = gridDim.x; F.wg = blockIdx.x; F.out = A.out; F.ws = A.ws; \
        unsigned char* ws = A.ws; float* part = (float*)(ws + WS_PART); float* hmeta = (float*)(ws + WS_HMETA); pg8::bf16_t* Abuf = (pg8::bf16_t*)(ws + WS_A); (void)part; (void)hmeta; (void)Abuf
        int kind, layer = 0, ch = 0, sub = 2;
        switch (p) {
            case 0: kind = 0; break; case 1: kind = 1; break; case 2: kind = 2; break; case 3: kind = 3; sub = 0; break;
            case 4: kind = 4; break; case 5: kind = 5; break; case 6: kind = 3; break;
            case 7: kind = 6; break; case 8: kind = 7; break; case 9: kind = 9; break; case 10: kind = 7; ch = 1; break; case 11: kind = 9; ch = 1; break;
            case 12: kind = 3; sub = 1; break;
            case 13: kind = 4; layer = 1; break; case 14: kind = 5; layer = 1; break; case 15: kind = 3; layer = 1; break;
            default: kind = 8; break;
        }
        if (kind == 0) { PHF(); p0_prologue(F, A); }
        else if (kind == 1) { PHF(); pg8::Gemm g{Abuf, (const pg8::bf16_t*)(ws + W_IN0), MP, NIN, DM, DM, DM}; pg8::RsOrder S; S.init(MP, NIN, F.G, F.wg); S.part = part;
            pg8::EpiIn0 E{(pg8::bf16_t*)(ws + R_U), (pg8::bf16_t*)(ws + R_WC), (pg8::bf16_t*)(ws + R_GB), part};
            pg8::gemm_phase<pg8::EpiIn0, pg8::RsOrder, true, true, DM, DM, DM>(F.lds, g, S, E, F.tid); }
        else if (kind == 2) { PHF(); conv0_phase(F, A); }
        else if (kind == 3) { PHF();
            const bool o0 = (sub == 0), o1 = (sub == 1), od = (sub == 2);
            const pg8::bf16_t* Aop = (const pg8::bf16_t*)(ws + (o0 ? R_Y0 : o1 ? R_Y1 : R_HM));
            const pg8::bf16_t* Bop = (const pg8::bf16_t*)(ws + (o0 ? W_OUT0 : o1 ? W_OUT1 : (layer ? W_DN1 : W_DN0)));
            const int Kd = od ? DFF : DM, ldbd = od ? DFF : DM;
            const float* base = o0 ? A.in[0] : (const float*)A.out;
            const pg8::Gemm g{Aop, Bop, MP, DM, Kd, Kd, ldbd};
            pg8::StaticOrder S; S.init(MR, DM, F.G, F.wg);
            const bool lastres = od && layer == 1;
            pg8::EpiRes E{base, lastres ? (float*)(ws + WS_HFIN) : (float*)A.out, hmeta, Abuf, part, 1, o0 ? 1 : 0, lastres ? 1 : 0};
            if (od) pg8::gemm_phase<pg8::EpiRes, pg8::StaticOrder, true, RES_SP2, DFF, DFF, DFF>(F.lds, g, S, E, F.tid);
            else pg8::gemm_phase<pg8::EpiRes, pg8::StaticOrder, true, RES_SP2, DM, DM, DM>(F.lds, g, S, E, F.tid);
            if (blockIdx.x < 16 && !(pq & 1)) {
                CArgs* am_ = (CArgs*)__builtin_amdgcn_kernarg_segment_ptr(); asm volatile("" : "+s"(am_)); unsigned char* wsm = am_->ws;
                unsigned zm_; asm volatile("s_mov_b32 %0, 0" : "=s"(zm_));
                Frame Fm; Fm.tid = (wave_s << 6) | (int)__builtin_amdgcn_mbcnt_hi(~0u, __builtin_amdgcn_mbcnt_lo(~0u, zm_)); asm volatile("" : "+v"(Fm.tid));
                Fm.lds = (LAS unsigned char*)lds; Fm.lane = Fm.tid & 63; Fm.wave = __builtin_amdgcn_readfirstlane(Fm.tid >> 6); Fm.G = gridDim.x; Fm.wg = blockIdx.x; Fm.out = nullptr; Fm.ws = wsm;
                const bf16* Am = (const bf16*)(wsm + (o0 ? R_Y0 : o1 ? R_Y1 : R_HM));
                const bf16* Bm = (const bf16*)(wsm + (o0 ? W_OUT0 : o1 ? W_OUT1 : (layer ? W_DN1 : W_DN0)));
                meta_res_gemm(Fm, Am, od ? DFF : DM, Bm, od ? DFF : DM, od ? DFF : DM, (float*)(wsm + WS_HMETA), (bf16*)(wsm + WS_A), (float*)(wsm + WS_PART), 1, (int)blockIdx.x);
            } }
        else if (kind == 4) { PHF(); pg8::Gemm g{Abuf, (const pg8::bf16_t*)(ws + (layer ? W_UP1 : W_UP0)), MP, 2 * DFF, DM, DM, DM}; pg8::RsOrder S; S.init(MP, 2 * DFF, F.G, F.wg); S.part = part;
            pg8::EpiUpConv E{ws, A.in[26] + (size_t)layer * 3 * DFF, A.in[27] + (size_t)layer * DFF};
            pg8::gemm_phase<pg8::EpiUpConv, pg8::RsOrder, true, true, DM, DM, DM>(F.lds, g, S, E, F.tid); }
        else if (kind == 5) { PHF(); ffn_fix_phase(F, A, layer); }
        else if (kind == 6) { PHF(); pg8::Gemm g{Abuf, (const pg8::bf16_t*)(ws + W_IN1), MP, NIN, DM, DM, DM}; pg8::RsOrder S; S.init(MP, NIN, F.G, F.wg); S.part = part;
            pg8::EpiIn1 E{(pg8::bf16_t*)(ws + R_Q), (pg8::bf16_t*)(ws + R_KB), (pg8::bf16_t*)(ws + R_VB), (pg8::bf16_t*)(ws + R_PR), part, (const float*)(ws + WS_ROPE), (const float*)(ws + WS_ROPE) + TT * 32};
            pg8::gemm_phase<pg8::EpiIn1, pg8::RsOrder, true, true, DM, DM, DM>(F.lds, g, S, E, F.tid); }
        else if (kind == 7) { PHF();
            const int cnt = ch == 0 ? NBLK_H1 : NBLK - NBLK_H1, nbase = ch == 0 ? 0 : NBLK_H1;
            rwkv_prep_phase(F, A, nbase, cnt);
        }
        else if (kind == 9) { PHF();
            const int NCH = 64;
            if (F.G > NCH && F.wg < NCH) rwkv_scan(F, A, F.wg, ch == 0 ? 0 : NBLK_H1, ch == 0 ? NBLK_H1 : NBLK);
            else {
                if (F.G <= NCH) for (int c = F.wg; c < NCH; c += F.G) rwkv_scan(F, A, c, ch == 0 ? 0 : NBLK_H1, ch == 0 ? NBLK_H1 : NBLK);
                if (ch == 0) { const int NAW = F.G > NCH ? F.G - NCH : F.G, aw = F.G > NCH ? F.wg - NCH : F.wg;
                    for (int id = aw; id < 514; id += NAW) { if (id < 512) ATTN_UNIT(id >> 6, (id >> 5) & 1, id & 31); else ATTN_UNIT(0, id - 512, -1); } }
            }
        }
        else if (kind == 8) { PHF(); final_phase(F, A); }
#if MK_N_LAUNCHES == 1
        if (pq + 1 < 2 * hi) {
            if (hi > 1000) cg::this_grid().sync();
            CArgs* ab_ = (CArgs*)__builtin_amdgcn_kernarg_segment_ptr(); asm volatile("" : "+s"(ab_));
            unsigned zb_; asm volatile("s_mov_b32 %0, 0" : "=s"(zb_));
            const bool t0 = (wave_s == 0) && (__builtin_amdgcn_mbcnt_hi(~0u, __builtin_amdgcn_mbcnt_lo(~0u, zb_)) == 0u);
            xcd_barrier((unsigned*)(ab_->ws + WS_CTL) + 1024, (volatile LAS unsigned*)((LAS unsigned char*)lds + MISC_OFF) + 8, t0);
#ifdef BAR_PROBE
            if (p == 5) { for (int rep_ = 0; rep_ < BAR_PROBE; ++rep_) xcd_barrier((unsigned*)(ab_->ws + WS_CTL) + 1024, (volatile LAS unsigned*)((LAS unsigned char*)lds + MISC_OFF) + 8, t0); }
#endif
        }
#endif
    }
}

extern "C" void kernel_launch(void* const* d_in, const int* in_sizes, int n_in, void* d_out, int out_size, void* d_ws, size_t ws_size, hipStream_t stream) {
    static int grid = 0;
    if (grid == 0) {
        if (n_in != 29 || out_size != MR * DM || ws_size < WS_END) { fprintf(stderr, "kernel_launch: unexpected shapes (n_in %d out %d ws %zu)\n", n_in, out_size, ws_size); grid = -1; return; }
        int dev = 0, cus = 0, per_cu = 0;
        if (hipGetDevice(&dev) != hipSuccess || hipDeviceGetAttribute(&cus, hipDeviceAttributeMultiprocessorCount, dev) != hipSuccess) { grid = -1; return; }
        if (hipFuncSetAttribute((const void*)hyb_fwd, hipFuncAttributeMaxDynamicSharedMemorySize, LDS_BYTES) != hipSuccess) { fprintf(stderr, "kernel_launch: hipFuncSetAttribute failed\n"); grid = -1; return; }
        if (hipOccupancyMaxActiveBlocksPerMultiprocessor(&per_cu, (const void*)hyb_fwd, NTHR, LDS_BYTES) != hipSuccess || per_cu < 1) { fprintf(stderr, "kernel_launch: occupancy query says %d\n", per_cu); per_cu = 1; }
        (void)hipGetLastError();
        grid = cus;
    }
    if (grid < 0) return;
    Args a{};
    for (int i = 0; i < 29; ++i) a.in[i] = (const float*)d_in[i];
    a.out = (float*)d_out; a.ws = (unsigned char*)d_ws;
#if MK_N_LAUNCHES == 1
    if (hipMemsetAsync((char*)d_ws + WS_CTL, 0, 65536, stream) != hipSuccess) { fprintf(stderr, "kernel_launch: memset failed\n"); return; }
    a.ph_lo = 0; a.ph_hi = N_PHASES;
    void* kargs[] = {&a};
    hipError_t e = hipLaunchCooperativeKernel((const void*)hyb_fwd, dim3(grid), dim3(NTHR), kargs, LDS_BYTES, stream);
    if (e != hipSuccess) fprintf(stderr, "cooperative launch failed: %s (grid %d)\n", hipGetErrorString(e), grid);
#else
    for (int p = 0; p < N_PHASES; ++p) { a.ph_lo = p; a.ph_hi = p + 1; hipLaunchKernelGGL(hyb_fwd, dim3(grid), dim3(NTHR), LDS_BYTES, stream, a); }
#endif
}
```
